# Optimizing an MI355X kernel written in HIP

```python
import math
import jax
import jax.numpy as jnp
from jax import lax
import numpy as np

D_MODEL = 2048
BATCH = 4
SEQ = 2048
DEPTH = 1
DEC_BATCH = 128
DEC_SEQ = 4
PAST_LEN = 16384
PAGE_SIZE = 128

MIX_A = D_MODEL // 2
MIX_B = D_MODEL - MIX_A
GDN_HEADS = 8
GDN_DK = MIX_A // GDN_HEADS
GDN_DV = MIX_A // GDN_HEADS
QK_W = GDN_HEADS * GDN_DK
QKV_W = 2 * QK_W + GDN_HEADS * GDN_DV
CONV_W = 4
CHUNK = 64
POOL_WINDOWS = (2, 4, 8, 16)
POOL_GROUPS = len(POOL_WINDOWS)
POOL_CH = MIX_B // POOL_GROUPS
POOL_BUF = max(POOL_WINDOWS) - 1
N_MEM = 256
X_HEADS = 4
X_HEAD_DIM = D_MODEL // X_HEADS
EPS = 1e-6
COL_ZA = QKV_W
COL_A = COL_ZA + GDN_HEADS * GDN_DV
COL_B = COL_A + GDN_HEADS
COL_U = COL_B + GDN_HEADS
COL_ZB = COL_U + MIX_B
IN_COLS = COL_ZB + MIX_B

kernel_name = "hymba_gdn_pool_memxattn_step"


def rmsnorm(x, g):
    xf = x.astype(jnp.float32)
    y = xf * lax.rsqrt(jnp.mean(xf * xf, axis=-1, keepdims=True) + EPS) * g.astype(jnp.float32)
    return y.astype(x.dtype)


def l2norm(x):
    xf = x.astype(jnp.float32)
    return xf * lax.rsqrt(jnp.sum(xf * xf, axis=-1, keepdims=True) + EPS)


def short_conv(x, buf, w):
    t_len = x.shape[1]
    ext = jnp.concatenate([buf.astype(x.dtype), x], axis=1)
    y = sum(ext[:, j:j + t_len] * w[j] for j in range(CONV_W))
    return jax.nn.silu(y), ext[:, ext.shape[1] - (CONV_W - 1):]


def gated_delta_rule(q, k, v, g, beta, s0, chunk):
    bsz, t_len, n_h, _ = q.shape
    dv = v.shape[-1]
    n_c = t_len // chunk

    def blocks(a):
        a = a.astype(jnp.float32).reshape((bsz, n_c, chunk, n_h) + a.shape[3:])
        return jnp.moveaxis(a, (1, 3), (0, 2))

    qc, kc, vc, bc = blocks(q), blocks(k), blocks(v), blocks(beta)
    gc = jnp.cumsum(blocks(g), axis=-1)
    kb = kc * bc[..., None]
    vb = vc * bc[..., None]
    idx = jnp.arange(chunk)
    incl = idx[:, None] >= idx[None, :]
    strict = idx[:, None] > idx[None, :]
    diff = gc[..., :, None] - gc[..., None, :]
    decay_incl = jnp.exp(jnp.where(incl, diff, -jnp.inf))
    decay_strict = jnp.where(strict, decay_incl, 0.0)
    low = jnp.einsum('nbhik,nbhjk->nbhij', kb, kc) * decay_strict
    eye = jnp.eye(chunk, dtype=jnp.float32)
    t_inv = lax.linalg.triangular_solve(low + eye, jnp.broadcast_to(eye, low.shape),
                                        left_side=True, lower=True, unit_diagonal=True)
    u = jnp.einsum('nbhij,nbhjv->nbhiv', t_inv, vb)
    w = jnp.einsum('nbhij,nbhjk->nbhik', t_inv, kb * jnp.exp(gc)[..., None])
    a_intra = jnp.einsum('nbhik,nbhjk->nbhij', qc, kc) * decay_incl

    def step(s, xs):
        q_, k_, u_, w_, g_, a_ = xs
        v_new = u_ - jnp.einsum('bhck,bhkv->bhcv', w_, s)
        o = (jnp.einsum('bhck,bhkv->bhcv', q_ * jnp.exp(g_)[..., None], s)
             + jnp.einsum('bhij,bhjv->bhiv', a_, v_new))
        g_last = g_[..., -1]
        k_dec = k_ * jnp.exp(g_last[..., None] - g_)[..., None]
        s = s * jnp.exp(g_last)[..., None, None] + jnp.einsum('bhck,bhcv->bhkv', k_dec, v_new)
        return s, o

    s_fin, o = lax.scan(step, s0.astype(jnp.float32), (qc, kc, u, w, gc, a_intra))
    o = jnp.moveaxis(o, (0, 2), (1, 3)).reshape(bsz, t_len, n_h, dv)
    return o, s_fin


def multiscale_pool(u, buf, pos0, pool_w, pool_scale):
    bsz, t_len, c = u.shape
    ext = jnp.concatenate([buf.astype(u.dtype), u], axis=1)
    cs = jnp.cumsum(ext.astype(jnp.float32), axis=1)
    cs = jnp.concatenate([jnp.zeros((bsz, 1, c), jnp.float32), cs], axis=1)
    pos = pos0 + jnp.arange(t_len)
    outs = []
    for gi, win in enumerate(POOL_WINDOWS):
        sl = slice(gi * POOL_CH, (gi + 1) * POOL_CH)
        hi = cs[:, POOL_BUF + 1:POOL_BUF + 1 + t_len, sl]
        lo = cs[:, POOL_BUF + 1 - win:POOL_BUF + 1 - win + t_len, sl]
        cnt = jnp.minimum(win, pos + 1).astype(jnp.float32)[None, :, None]
        d = (hi - lo) / cnt - u[:, :, sl].astype(jnp.float32)
        outs.append(jnp.einsum('btc,cd->btd', d.astype(u.dtype), pool_w[gi]))
    y = jnp.concatenate(outs, axis=-1) * pool_scale
    return y, ext[:, ext.shape[1] - POOL_BUF:]


def memory_kv(mem, norm_mem, w_ck, w_cv):
    bsz, n_mem, _ = mem.shape
    hm = rmsnorm(mem, norm_mem)
    mk = (hm @ w_ck).reshape(bsz, n_mem, X_HEADS, X_HEAD_DIM)
    mv = (hm @ w_cv).reshape(bsz, n_mem, X_HEADS, X_HEAD_DIM)
    return mk, mv


def hybrid_layer(x, mem_k, mem_v, s0, conv_buf, pool_buf, pos0, chunk,
                 norm_mix, w_in, conv_w, a_log, dt_bias, gdn_norm, pool_w, pool_scale, w_out,
                 norm_cross, w_cq, w_co):
    bsz, t_len, _ = x.shape
    h = rmsnorm(x, norm_mix)
    proj = h @ w_in
    qkv, conv_new = short_conv(proj[..., :QKV_W], conv_buf, conv_w)
    q = l2norm(qkv[..., :QK_W].reshape(bsz, t_len, GDN_HEADS, GDN_DK)) * (GDN_DK ** -0.5)
    k = l2norm(qkv[..., QK_W:2 * QK_W].reshape(bsz, t_len, GDN_HEADS, GDN_DK))
    v = qkv[..., 2 * QK_W:].reshape(bsz, t_len, GDN_HEADS, GDN_DV)
    z_a = proj[..., COL_ZA:COL_A].reshape(bsz, t_len, GDN_HEADS, GDN_DV)
    beta = jax.nn.sigmoid(proj[..., COL_B:COL_U].astype(jnp.float32))
    g = -jnp.exp(a_log.astype(jnp.float32)) * jax.nn.softplus(
        proj[..., COL_A:COL_B].astype(jnp.float32) + dt_bias.astype(jnp.float32))
    o, s_new = gated_delta_rule(q, k, v, g, beta, s0, chunk)
    o_a = (rmsnorm(o.astype(x.dtype), gdn_norm) * jax.nn.silu(z_a)).reshape(bsz, t_len, MIX_A)
    pooled, pool_new = multiscale_pool(proj[..., COL_U:COL_ZB], pool_buf, pos0, pool_w, pool_scale)
    o_b = pooled * jax.nn.silu(proj[..., COL_ZB:])
    x = x + jnp.concatenate([o_a, o_b], axis=-1) @ w_out
    h2 = rmsnorm(x, norm_cross)
    qx = (h2 @ w_cq).reshape(bsz, t_len, X_HEADS, X_HEAD_DIM)
    scores = jnp.einsum('bthd,bmhd->bhtm', qx, mem_k).astype(jnp.float32) * (X_HEAD_DIM ** -0.5)
    probs = jax.nn.softmax(scores, axis=-1).astype(x.dtype)
    ctx = jnp.einsum('bhtm,bmhd->bthd', probs, mem_v).reshape(bsz, t_len, D_MODEL)
    x = x + ctx @ w_co
    return x, s_new, conv_new, pool_new


def setup_inputs(seed: int = 0) -> dict:
    key = jax.random.key(seed)
    ks = jax.random.split(key, 26)
    f32 = jnp.float32
    n_l = DEPTH

    def nrm(k, shape, scale):
        return jax.random.normal(k, shape, f32) * scale

    def gain(k, shape):
        return 1.0 + 0.02 * jax.random.normal(k, shape, f32)

    dt = jnp.exp(jax.random.uniform(ks[11], (n_l, GDN_HEADS), f32, math.log(1e-3), math.log(1e-1)))
    dt_bias = dt + jnp.log(-jnp.expm1(-dt))
    a_log = jnp.log(jax.random.uniform(ks[12], (n_l, GDN_HEADS), f32, 1.0, 16.0))
    return {
        "x_prompt": nrm(ks[0], (BATCH, SEQ, D_MODEL), 1.0),
        "x_sample": nrm(ks[1], (DEC_BATCH, DEC_SEQ, D_MODEL), 1.0),
        "mem_prompt": nrm(ks[2], (BATCH, N_MEM, D_MODEL), 1.0),
        "cache_mem_k": nrm(ks[3], (n_l, DEC_BATCH, N_MEM, X_HEADS, X_HEAD_DIM), 1.0),
        "cache_mem_v": nrm(ks[4], (n_l, DEC_BATCH, N_MEM, X_HEADS, X_HEAD_DIM), 1.0),
        "state_delta": nrm(ks[5], (n_l, DEC_BATCH, GDN_HEADS, GDN_DK, GDN_DV), 0.1),
        "state_conv": nrm(ks[6], (n_l, DEC_BATCH, CONV_W - 1, QKV_W), 1.0),
        "state_pool": nrm(ks[7], (n_l, DEC_BATCH, POOL_BUF, MIX_B), 1.0),
        "norm_mix": gain(ks[8], (n_l, D_MODEL)),
        "w_in": nrm(ks[9], (n_l, D_MODEL, IN_COLS), D_MODEL ** -0.5),
        "conv_w": nrm(ks[10], (n_l, CONV_W, QKV_W), CONV_W ** -0.5),
        "a_log": a_log,
        "dt_bias": dt_bias,
        "gdn_norm": gain(ks[13], (n_l, GDN_DV)),
        "pool_w": nrm(ks[14], (n_l, POOL_GROUPS, POOL_CH, POOL_CH), POOL_CH ** -0.5),
        "pool_scale": gain(ks[15], (n_l, MIX_B)),
        "w_out": nrm(ks[16], (n_l, D_MODEL, D_MODEL), D_MODEL ** -0.5),
        "norm_mem": gain(ks[17], (n_l, D_MODEL)),
        "norm_cross": gain(ks[18], (n_l, D_MODEL)),
        "w_cq": nrm(ks[19], (n_l, D_MODEL, D_MODEL), D_MODEL ** -0.5),
        "w_ck": nrm(ks[20], (n_l, D_MODEL, D_MODEL), D_MODEL ** -0.5),
        "w_cv": nrm(ks[21], (n_l, D_MODEL, D_MODEL), D_MODEL ** -0.5),
        "w_co": nrm(ks[22], (n_l, D_MODEL, D_MODEL), D_MODEL ** -0.5),
        "norm_final": gain(ks[23], (D_MODEL,)),
    }


def reference(x_prompt, x_sample, mem_prompt, cache_mem_k, cache_mem_v, state_delta, state_conv,
              state_pool, norm_mix, w_in, conv_w, a_log, dt_bias, gdn_norm, pool_w, pool_scale,
              w_out, norm_mem, norm_cross, w_cq, w_ck, w_cv, w_co, norm_final):
    xp, xs = x_prompt, x_sample
    bp, tp, _ = xp.shape
    ts = xs.shape[1]
    chunk_p = min(CHUNK, tp)
    mk_l, mv_l, dp_l, cp_l, pp_l, ds_l, cs_l, ps_l = [], [], [], [], [], [], [], []
    for l in range(DEPTH):
        lw = dict(norm_mix=norm_mix[l], w_in=w_in[l], conv_w=conv_w[l], a_log=a_log[l],
                  dt_bias=dt_bias[l], gdn_norm=gdn_norm[l], pool_w=pool_w[l],
                  pool_scale=pool_scale[l], w_out=w_out[l], norm_cross=norm_cross[l],
                  w_cq=w_cq[l], w_co=w_co[l])
        mk_p, mv_p = memory_kv(mem_prompt, norm_mem[l], w_ck[l], w_cv[l])
        xp, d_p, c_p, p_p = hybrid_layer(
            xp, mk_p, mv_p,
            jnp.zeros((bp, GDN_HEADS, GDN_DK, GDN_DV), jnp.float32),
            jnp.zeros((bp, CONV_W - 1, QKV_W), xp.dtype),
            jnp.zeros((bp, POOL_BUF, MIX_B), xp.dtype),
            0, chunk_p, **lw)
        xs, d_s, c_s, p_s = hybrid_layer(
            xs, cache_mem_k[l], cache_mem_v[l], state_delta[l], state_conv[l], state_pool[l],
            PAST_LEN, ts, **lw)
        mk_l.append(mk_p); mv_l.append(mv_p); dp_l.append(d_p); cp_l.append(c_p); pp_l.append(p_p)
        ds_l.append(d_s); cs_l.append(c_s); ps_l.append(p_s)
    y_prompt = rmsnorm(xp, norm_final)
    y_sample = rmsnorm(xs, norm_final)
    return (y_prompt, y_sample, jnp.stack(mk_l), jnp.stack(mv_l), jnp.stack(dp_l), jnp.stack(cp_l),
            jnp.stack(pp_l), jnp.stack(ds_l), jnp.stack(cs_l), jnp.stack(ps_l))
```

```cpp
#include <hip/hip_runtime.h>
#include <hip/hip_cooperative_groups.h>
#include <cstdio>
#include <cstdint>

typedef unsigned short bf16_t;
typedef short bf16x8 __attribute__((ext_vector_type(8)));
typedef float f32x4 __attribute__((ext_vector_type(4)));
#define DEV __device__ __forceinline__
#define LAS __attribute__((address_space(3)))

constexpr int D = 2048, TP = 8192, TS = 512, TT = 8704, SEQ = 2048, NB = 4, SB = 128;
constexpr int NPJ = 6144;
constexpr int C_ZA = 3072, C_U = 4096, C_ZB = 5120;
constexpr int NWIN = 6272;
constexpr float EPS = 1e-6f;

constexpr size_t O_YP = 0, O_YS = 16777216, O_MK = 17825792, O_MV = 19922944, O_DP = 22020096, O_CP = 22544384,
                 O_PP = 22581248, O_DS = 22642688, O_CS = 39419904, O_PS = 40599552;

constexpr size_t al256(size_t x) { return (x + 255) & ~(size_t)255; }
constexpr size_t WS_BAR = 0;
constexpr size_t WS_WIN = 16384;
constexpr size_t WS_WOUT = WS_WIN + (size_t)NWIN * D * 2;
constexpr size_t WS_WCQ = WS_WOUT + (size_t)D * D * 2;
constexpr size_t WS_WCO = WS_WCQ + (size_t)D * D * 2;
constexpr size_t WS_WCKV = WS_WCO + (size_t)D * D * 2;
constexpr size_t WS_WPOOL = WS_WCKV + (size_t)2 * D * D * 2;
constexpr size_t WS_H = WS_WPOOL + (size_t)1024 * 256 * 2;
constexpr size_t WS_HM = WS_H + (size_t)TT * D * 2;
constexpr size_t WS_PROJ = WS_HM + (size_t)1024 * D * 2;
constexpr size_t WS_AB = WS_PROJ + (size_t)TT * NPJ * 2;
constexpr size_t WS_MKB = WS_AB + (size_t)TT * 16 * 4;
constexpr size_t WS_MVT = WS_MKB + (size_t)1024 * D * 2;
constexpr size_t WS_GW = WS_MVT + (size_t)1024 * D * 2;
constexpr size_t WS_GQ = WS_GW + (size_t)1024 * 8192 * 2;
constexpr size_t WS_GKT = WS_GQ + (size_t)1024 * 8192 * 2;
constexpr size_t WS_GA = WS_GKT + (size_t)1024 * 8192 * 2;
constexpr size_t WS_GU = WS_GA + (size_t)1024 * 4096 * 2;
constexpr size_t WS_GE = WS_GU + (size_t)1024 * 8192 * 4;
constexpr size_t WS_O = WS_GE + 4096;
constexpr size_t WS_DPL = WS_O + (size_t)TP * 1024 * 4;
constexpr size_t WS_MIX = WS_DPL + (size_t)TT * 1024 * 2;
constexpr size_t WS_X1 = WS_MIX + (size_t)TT * D * 2;
constexpr size_t WS_QX = WS_X1 + (size_t)TT * D * 4;
constexpr size_t WS_SC = WS_QX + (size_t)TT * D * 2;
constexpr size_t WS_PB = WS_SC + (size_t)TP * 1024 * 4;
constexpr size_t WS_CTX = WS_PB + (size_t)TP * 1024 * 2;
constexpr size_t WS_X2 = WS_CTX + (size_t)TT * D * 2;
constexpr size_t WS_END = WS_X2 + (size_t)TT * D * 4;

#ifndef LASTP
#define LASTP 99
#endif
struct Params { const float* in[24]; float* out; unsigned char* ws; int ph_lo, ph_hi; };

typedef __bf16 bf16x2_t __attribute__((ext_vector_type(2)));
typedef float f32x2_t __attribute__((ext_vector_type(2)));
DEV unsigned cvt_pk_bf16(float lo, float hi) { const f32x2_t v = {lo, hi}; const bf16x2_t b = __builtin_convertvector(v, bf16x2_t); return __builtin_bit_cast(unsigned, b); }
DEV bf16_t f2bf(float f) { return (bf16_t)(cvt_pk_bf16(f, 0.f) & 0xffffu); }
DEV float bf2f(unsigned b) { return __uint_as_float(b << 16); }
DEV float bflo(unsigned u) { return __uint_as_float(u << 16); }
DEV float bfhi(unsigned u) { return __uint_as_float(u & 0xffff0000u); }
DEV float silu_f(float x) { return x / (1.f + __expf(-x)); }
DEV float wave_sum(float v) {
#pragma unroll
    for (int o = 32; o >= 1; o >>= 1) v += __shfl_xor(v, o);
    return v;
}
DEV float wave_max(float v) {
#pragma unroll
    for (int o = 32; o >= 1; o >>= 1) v = fmaxf(v, __shfl_xor(v, o));
    return v;
}
DEV void store_bf4(bf16_t* p, f32x4 v) { uint2 w; w.x = cvt_pk_bf16(v[0], v[1]); w.y = cvt_pk_bf16(v[2], v[3]); *(uint2*)p = w; }

#define XB_TMO      128
#define XB_XCNT(j)  (256  + 64 * (j))
#define XB_XSUB(j)  (1280 + 64 * (j))
#define XB_XGEN(j)  (2304 + 64 * (j))
#define XB_TOP      3328
#define XB_TOPGEN   3392
#define XCD_BAR_WORDS 3456
#define XB_SPIN_CAP (1u << 22)
DEV unsigned xb_ld(unsigned* p) { return __hip_atomic_load(p, __ATOMIC_RELAXED, __HIP_MEMORY_SCOPE_AGENT); }
DEV unsigned xb_add(unsigned* p, unsigned v) { return __hip_atomic_fetch_add(p, v, __ATOMIC_RELAXED, __HIP_MEMORY_SCOPE_AGENT); }
DEV unsigned xb_xcc_id() { return (unsigned)__builtin_amdgcn_s_getreg((3 << 11) | 20) & 0xFu; }
#define XB_SPIN(cond, bar) do { unsigned _sp = 0; while (cond) { __builtin_amdgcn_s_sleep(1); \
    if ((++_sp & 255u) == 0u) { if (xb_ld(&(bar)[XB_TMO])) break; if (_sp > XB_SPIN_CAP) { atomicAdd(&(bar)[XB_TMO], 1u); break; } } } } while (0)
struct XcdBarrier { unsigned* bar; unsigned x; volatile LAS unsigned* st; };
DEV XcdBarrier xcd_barrier_post(unsigned* bar, volatile LAS unsigned* st) {
    XcdBarrier b; b.bar = bar; b.x = xb_xcc_id(); b.st = st;
    if (threadIdx.x == 0) (void)xb_add(&bar[XB_XCNT(b.x)], 1u);
    return b;
}
DEV void xcd_barrier_complete(unsigned* bar, unsigned x, unsigned& nloc, unsigned& nx) {
    const unsigned G = gridDim.x;
    unsigned sum, cnt, mine, sp = 0u;
    for (;;) {
        sum = 0u; cnt = 0u; mine = 0u;
#pragma unroll
        for (unsigned j = 0; j < 16; ++j) { const unsigned c = xb_ld(&bar[XB_XCNT(j)]); sum += c; cnt += (c > 0u) ? 1u : 0u; mine = (j == x) ? c : mine; }
        if (sum == G) break;
        __builtin_amdgcn_s_sleep(1);
        if ((++sp & 255u) == 0u) { if (xb_ld(&bar[XB_TMO])) break; if (sp > XB_SPIN_CAP) { atomicAdd(&bar[XB_TMO], 1u); break; } }
    }
    nloc = mine > 0u ? mine : 1u; nx = cnt > 0u ? cnt : 1u;
}
DEV void xcd_barrier(const XcdBarrier& b) {
    asm volatile("s_waitcnt vmcnt(0)" ::: "memory");
    __syncthreads();
    if (threadIdx.x == 0) {
        unsigned* bar = b.bar;
        __builtin_amdgcn_s_waitcnt(0);
        unsigned nloc = b.st[0], nx = b.st[1];
        if (nloc == 0u) { xcd_barrier_complete(bar, b.x, nloc, nx); b.st[0] = nloc; b.st[1] = nx; }
        const unsigned old = xb_add(&bar[XB_XSUB(b.x)], 1u);
        const unsigned gen = old / nloc;
        if (old + 1u == (gen + 1u) * nloc) {
            __builtin_amdgcn_fence(__ATOMIC_RELEASE, "agent");
            asm volatile("s_waitcnt vmcnt(0)" ::: "memory");
            const unsigned og = xb_add(&bar[XB_TOP], 1u);
            const unsigned tg = og / nx;
            if (og + 1u == (tg + 1u) * nx) xb_add(&bar[XB_TOPGEN], 1u);
            else XB_SPIN(xb_ld(&bar[XB_TOPGEN]) == tg, bar);
            __builtin_amdgcn_fence(__ATOMIC_ACQUIRE, "agent");
            xb_add(&bar[XB_XGEN(b.x)], 1u);
            asm volatile("s_waitcnt vmcnt(0)" ::: "memory");
        } else {
            XB_SPIN(xb_ld(&bar[XB_XGEN(b.x)]) == gen, bar);
            __builtin_amdgcn_fence(__ATOMIC_ACQUIRE, "agent");
            asm volatile("s_waitcnt vmcnt(0)" ::: "memory");
        }
    }
    __syncthreads();
}

template <class Epi>
DEV void gemm_tile(const bf16_t* __restrict__ A, int lda, const bf16_t* __restrict__ Bt, int ldb, int K, unsigned char* lds, const Epi& epi) {
    int tid = threadIdx.x; asm volatile("" : "+v"(tid)); const int lane = tid & 63, wid = tid >> 6;
    const int wr = wid >> 1, wc = wid & 1, fr = lane & 15, fq = lane >> 4;
    f32x4 acc[4][4];
#pragma unroll
    for (int i = 0; i < 4; ++i)
#pragma unroll
        for (int j = 0; j < 4; ++j) acc[i][j] = (f32x4){0.f, 0.f, 0.f, 0.f};
    const int lrow = tid >> 3, lc = tid & 7;
    const bf16_t* ap = A + (size_t)lrow * lda + lc * 8;
    const bf16_t* bp = Bt + (size_t)lrow * ldb + lc * 8;
    const int woff = lrow * 128 + ((lc ^ (lrow & 7)) << 4);
    uint4 ra[4], rb[4];
    const int nk = K >> 6;
#pragma unroll
    for (int i = 0; i < 4; ++i) { ra[i] = *(const uint4*)(ap + (size_t)(32 * i) * lda); rb[i] = *(const uint4*)(bp + (size_t)(32 * i) * ldb); }
#pragma unroll
    for (int i = 0; i < 4; ++i) { *(uint4*)(lds + woff + i * 4096) = ra[i]; *(uint4*)(lds + 16384 + woff + i * 4096) = rb[i]; }
    __syncthreads();
    const int aoff = (wr * 64 + fr) * 128, boff = 16384 + (wc * 64 + fr) * 128, sw = fr & 7;
    for (int kt = 0; kt < nk; ++kt) {
        const int cur = (kt & 1) * 32768;
        const bool more = (kt + 1 < nk);
        if (more) {
#pragma unroll
            for (int i = 0; i < 4; ++i) { ra[i] = *(const uint4*)(ap + (size_t)(32 * i) * lda + (kt + 1) * 64); rb[i] = *(const uint4*)(bp + (size_t)(32 * i) * ldb + (kt + 1) * 64); }
        }
#pragma unroll
        for (int kh = 0; kh < 2; ++kh) {
            bf16x8 af[4], bfr[4];
            const int ch = ((kh * 4 + fq) ^ sw) << 4;
#pragma unroll
            for (int i = 0; i < 4; ++i) { af[i] = *(const bf16x8*)(lds + cur + aoff + i * 2048 + ch); bfr[i] = *(const bf16x8*)(lds + cur + boff + i * 2048 + ch); }
#pragma unroll
            for (int mi = 0; mi < 4; ++mi)
#pragma unroll
                for (int ni = 0; ni < 4; ++ni) acc[mi][ni] = __builtin_amdgcn_mfma_f32_16x16x32_bf16(bfr[ni], af[mi], acc[mi][ni], 0, 0, 0);
        }
        if (more) {
            const int nxt = cur ^ 32768;
#pragma unroll
            for (int i = 0; i < 4; ++i) { *(uint4*)(lds + nxt + woff + i * 4096) = ra[i]; *(uint4*)(lds + nxt + 16384 + woff + i * 4096) = rb[i]; }
        }
        __syncthreads();
    }
#pragma unroll
    for (int mi = 0; mi < 4; ++mi)
#pragma unroll
        for (int ni = 0; ni < 4; ++ni) epi(wr * 64 + mi * 16 + fr, wc * 64 + ni * 16 + fq * 4, acc[mi][ni]);
}

struct EpiProj {
    int m0, n0; bf16_t* proj; float* ab; float* out;
    DEV void operator()(int r, int c, f32x4 v) const {
        const int row = m0 + r, col = n0 + c;
        if (col < NPJ) {
            store_bf4(proj + (size_t)row * NPJ + col, v);
            const bool isconv = col < 3072, ispool = (col >= C_U && col < C_ZB);
            if (isconv || ispool) {
                if (row < TP) {
                    const int b = row >> 11, t = row & 2047;
                    if (isconv) { if (t >= 2045) *(f32x4*)(out + O_CP + ((size_t)(b * 3 + (t - 2045))) * 3072 + col) = v; }
                    else { if (t >= 2033) *(f32x4*)(out + O_PP + ((size_t)(b * 15 + (t - 2033))) * 1024 + (col - C_U)) = v; }
                } else {
                    const int sb = (row - TP) >> 2, t = (row - TP) & 3;
                    if (isconv) { if (t >= 1) *(f32x4*)(out + O_CS + ((size_t)(sb * 3 + (t - 1))) * 3072 + col) = v; }
                    else *(f32x4*)(out + O_PS + ((size_t)(sb * 15 + 11 + t)) * 1024 + (col - C_U)) = v;
                }
            }
        } else if (col < NPJ + 16) {
            *(f32x4*)(ab + (size_t)row * 16 + (col - NPJ)) = v;
        }
    }
};
struct EpiMKV {
    int m0, n0; bf16_t* mkb; bf16_t* mvt; float* out;
    DEV void operator()(int r, int c, f32x4 v) const {
        const int row = m0 + r, col = n0 + c;
        if (col < D) {
            *(f32x4*)(out + O_MK + (size_t)row * D + col) = v;
            store_bf4(mkb + (size_t)row * D + col, v);
        } else {
            const int cc = col - D, b = row >> 8, m = row & 255;
            *(f32x4*)(out + O_MV + (size_t)row * D + cc) = v;
            bf16_t* p = mvt + ((size_t)b * D + cc) * 256 + m;
            p[0] = f2bf(v[0]); p[256] = f2bf(v[1]); p[512] = f2bf(v[2]); p[768] = f2bf(v[3]);
        }
    }
};
struct EpiPool {
    int m0, n0; const bf16_t* proj; const float* scale; bf16_t* mix;
    DEV void operator()(int r, int c, f32x4 v) const {
        const int row = m0 + r, col = n0 + c;
        const uint2 z = *(const uint2*)(proj + (size_t)row * NPJ + C_ZB + col);
        const f32x4 s = *(const f32x4*)(scale + col);
        f32x4 o;
        o[0] = v[0] * s[0] * silu_f(bflo(z.x)); o[1] = v[1] * s[1] * silu_f(bfhi(z.x));
        o[2] = v[2] * s[2] * silu_f(bflo(z.y)); o[3] = v[3] * s[3] * silu_f(bfhi(z.y));
        store_bf4(mix + (size_t)row * D + 1024 + col, o);
    }
};
struct EpiResid {
    const float* res; float* dst;
    DEV void operator()(int r, int c, f32x4 v) const {
        const f32x4 x = *(const f32x4*)(res + (size_t)r * D + c);
        *(f32x4*)(dst + (size_t)r * D + c) = x + v;
    }
};
struct EpiBf {
    bf16_t* dst; int ld;
    DEV void operator()(int r, int c, f32x4 v) const { store_bf4(dst + (size_t)r * ld + c, v); }
};
struct EpiF32s {
    float* dst; int ld; float s;
    DEV void operator()(int r, int c, f32x4 v) const { *(f32x4*)(dst + (size_t)r * ld + c) = v * s; }
};

DEV int win_srccol(int n) { return n < 4096 ? n : (n < 6144 ? n + 16 : (n < 6160 ? 4096 + (n - 6144) : -1)); }
DEV void transpose_tile(const float* __restrict__ src, int ld, int srccol0, bool remap, int k0, bf16_t* __restrict__ dstrow0, int ldd, float* tile) {
    int tid = threadIdx.x; asm volatile("" : "+v"(tid));
    const int tx = tid & 63, ty = tid >> 6;
    const int sc = remap ? win_srccol(srccol0 + tx) : (srccol0 + tx);
#pragma unroll 4
    for (int i = 0; i < 16; ++i) { const int k = ty + 4 * i; tile[k * 65 + tx] = sc >= 0 ? src[(size_t)(k0 + k) * ld + sc] : 0.f; }
    __syncthreads();
    const int c2 = tid & 31, rr = tid >> 5;
#pragma unroll
    for (int i = 0; i < 8; ++i) { const int r = rr + 8 * i; *(unsigned*)(dstrow0 + (size_t)r * ldd + k0 + 2 * c2) = cvt_pk_bf16(tile[(2 * c2) * 65 + r], tile[(2 * c2 + 1) * 65 + r]); }
    __syncthreads();
}
DEV void rmsnorm_row_bf16(const float* __restrict__ x, const float* __restrict__ g, bf16_t* __restrict__ y, int lane) {
    f32x4 v[8]; float ss = 0.f;
#pragma unroll
    for (int i = 0; i < 8; ++i) { v[i] = ((const f32x4*)x)[i * 64 + lane]; ss += v[i][0] * v[i][0] + v[i][1] * v[i][1] + v[i][2] * v[i][2] + v[i][3] * v[i][3]; }
    ss = wave_sum(ss);
    const float rs = rsqrtf(ss * (1.f / 2048.f) + EPS);
#pragma unroll
    for (int i = 0; i < 8; ++i) { const f32x4 gg = ((const f32x4*)g)[i * 64 + lane]; store_bf4(y + (size_t)(i * 64 + lane) * 4, v[i] * rs * gg); }
}
DEV void rmsnorm_row_f32(const float* __restrict__ x, const float* __restrict__ g, float* __restrict__ y, int lane) {
    f32x4 v[8]; float ss = 0.f;
#pragma unroll
    for (int i = 0; i < 8; ++i) { v[i] = ((const f32x4*)x)[i * 64 + lane]; ss += v[i][0] * v[i][0] + v[i][1] * v[i][1] + v[i][2] * v[i][2] + v[i][3] * v[i][3]; }
    ss = wave_sum(ss);
    const float rs = rsqrtf(ss * (1.f / 2048.f) + EPS);
#pragma unroll
    for (int i = 0; i < 8; ++i) { const f32x4 gg = ((const f32x4*)g)[i * 64 + lane]; ((f32x4*)y)[i * 64 + lane] = v[i] * rs * gg; }
}

constexpr int QS = 136;
DEV void gdn_prep_chunk(const Params& p, int item, unsigned char* lds) {
    int tid = threadIdx.x; asm volatile("" : "+v"(tid)); const int lane = tid & 63, wid = tid >> 6;
    const int c = item & 31, h = (item >> 5) & 7, b = item >> 8;
    const int row0 = b * SEQ + c * 64;
    const bf16_t* proj = (const bf16_t*)(p.ws + WS_PROJ);
    const float* ab = (const float*)(p.ws + WS_AB);
    bf16_t* qs = (bf16_t*)lds; bf16_t* ks = qs + 64 * QS; bf16_t* vs = ks + 64 * QS;
    float* lowT = (float*)lds;
    float* gcs = (float*)(lds + 3 * 64 * QS * 2);
    float* bts = gcs + 64;
    bf16_t* gW = (bf16_t*)(p.ws + WS_GW) + (size_t)item * 8192;
    bf16_t* gQ = (bf16_t*)(p.ws + WS_GQ) + (size_t)item * 8192;
    bf16_t* gKT = (bf16_t*)(p.ws + WS_GKT) + (size_t)item * 8192;
    bf16_t* gA = (bf16_t*)(p.ws + WS_GA) + (size_t)item * 4096;
    float* gU = (float*)(p.ws + WS_GU) + (size_t)item * 8192;
    float* gE = (float*)(p.ws + WS_GE) + item;

    if (wid == 3) {
        const float a = ab[(size_t)(row0 + lane) * 16 + h], bb = ab[(size_t)(row0 + lane) * 16 + 8 + h];
        const float xx = a + p.in[12][h];
        const float sp = xx > 20.f ? xx : log1pf(__expf(xx));
        float s = -__expf(p.in[11][h]) * sp;
#pragma unroll
        for (int d = 1; d < 64; d <<= 1) { const float t = __shfl_up(s, d); if (lane >= d) s += t; }
        gcs[lane] = s; bts[lane] = 1.f / (1.f + __expf(-bb));
    } else {
        const int mat = wid, rg = lane >> 4, cv = lane & 15;
        const int colg = mat * 1024 + h * 128 + cv * 8;
        const float* cw = p.in[10];
        float w[4][8];
#pragma unroll
        for (int j = 0; j < 4; ++j) { const f32x4 w0 = *(const f32x4*)(cw + j * 3072 + colg), w1 = *(const f32x4*)(cw + j * 3072 + colg + 4);
            w[j][0] = w0[0]; w[j][1] = w0[1]; w[j][2] = w0[2]; w[j][3] = w0[3]; w[j][4] = w1[0]; w[j][5] = w1[1]; w[j][6] = w1[2]; w[j][7] = w1[3]; }
        const int tl0 = rg * 16;
        uint4 raw[19];
#pragma unroll
        for (int i = 0; i < 19; ++i) {
            const int tl = tl0 - 3 + i;
            if (c * 64 + tl >= 0) raw[i] = *(const uint4*)(proj + (size_t)(row0 + tl) * NPJ + colg);
            else raw[i] = make_uint4(0u, 0u, 0u, 0u);
        }
        bf16_t* dst = (mat == 0 ? qs : (mat == 1 ? ks : vs));
#pragma unroll
        for (int r = 0; r < 16; ++r) {
            float y[8]; float ss = 0.f;
#pragma unroll
            for (int e = 0; e < 8; ++e) {
                float a = 0.f;
#pragma unroll
                for (int j = 0; j < 4; ++j) {
                    const uint4 u = raw[r + j];
                    const unsigned wd = (e < 2 ? u.x : (e < 4 ? u.y : (e < 6 ? u.z : u.w)));
                    const float xv = (e & 1) ? bfhi(wd) : bflo(wd);
                    a += w[j][e] * xv;
                }
                y[e] = silu_f(a); ss += y[e] * y[e];
            }
            if (mat < 2) {
                ss += __shfl_xor(ss, 1); ss += __shfl_xor(ss, 2); ss += __shfl_xor(ss, 4); ss += __shfl_xor(ss, 8);
                float inv = rsqrtf(ss + EPS); if (mat == 0) inv *= 0.08838834764831845f;
#pragma unroll
                for (int e = 0; e < 8; ++e) y[e] *= inv;
            }
            uint4 o; o.x = cvt_pk_bf16(y[0], y[1]); o.y = cvt_pk_bf16(y[2], y[3]); o.z = cvt_pk_bf16(y[4], y[5]); o.w = cvt_pk_bf16(y[6], y[7]);
            *(uint4*)(dst + (tl0 + r) * QS + cv * 8) = o;
        }
    }
    __syncthreads();
    {
        const float glast = gcs[63];
        if (tid == 0) *gE = __expf(glast);
#pragma unroll
        for (int i = 0; i < 4; ++i) {
            const int ci = tid + 256 * i, t = ci >> 4, cc = (ci & 15) * 8;
            const uint4 u = *(const uint4*)(qs + t * QS + cc);
            const float e = __expf(gcs[t]);
            uint4 o; o.x = cvt_pk_bf16(bflo(u.x) * e, bfhi(u.x) * e); o.y = cvt_pk_bf16(bflo(u.y) * e, bfhi(u.y) * e);
            o.z = cvt_pk_bf16(bflo(u.z) * e, bfhi(u.z) * e); o.w = cvt_pk_bf16(bflo(u.w) * e, bfhi(u.w) * e);
            *(uint4*)(gQ + t * 128 + cc) = o;
        }
        const float dk = __expf(glast - gcs[lane]);
#pragma unroll 8
        for (int i = 0; i < 32; ++i) { const int d = wid * 32 + i; gKT[d * 64 + lane] = f2bf(bf2f(ks[lane * QS + d]) * dk); }
    }
    f32x4 kk[4], qk[4];
    {
        const int fr = lane & 15, fq = lane >> 4, it = wid;
        bf16x8 kfi[4], qfi[4];
#pragma unroll
        for (int s = 0; s < 4; ++s) { kfi[s] = *(const bf16x8*)(ks + (it * 16 + fr) * QS + s * 32 + fq * 8); qfi[s] = *(const bf16x8*)(qs + (it * 16 + fr) * QS + s * 32 + fq * 8); }
#pragma unroll
        for (int jt = 0; jt < 4; ++jt) {
            kk[jt] = (f32x4){0.f, 0.f, 0.f, 0.f}; qk[jt] = (f32x4){0.f, 0.f, 0.f, 0.f};
#pragma unroll
            for (int s = 0; s < 4; ++s) {
                const bf16x8 kfj = *(const bf16x8*)(ks + (jt * 16 + fr) * QS + s * 32 + fq * 8);
                kk[jt] = __builtin_amdgcn_mfma_f32_16x16x32_bf16(kfi[s], kfj, kk[jt], 0, 0, 0);
                qk[jt] = __builtin_amdgcn_mfma_f32_16x16x32_bf16(kfj, qfi[s], qk[jt], 0, 0, 0);
            }
        }
    }
    __syncthreads();
    {
        const int fr = lane & 15, fq = lane >> 4, it = wid;
#pragma unroll
        for (int jt = 0; jt < 4; ++jt) {
            const int j = jt * 16 + fr; const float gj = gcs[j];
            f32x4 lv;
#pragma unroll
            for (int e = 0; e < 4; ++e) { const int i = it * 16 + fq * 4 + e; lv[e] = (i > j) ? bts[i] * kk[jt][e] * __expf(gcs[i] - gj) : 0.f; }
            *(f32x4*)(lowT + j * 68 + it * 16 + fq * 4) = lv;
            const int i2 = it * 16 + fr; const float gi = gcs[i2];
            f32x4 av;
#pragma unroll
            for (int e = 0; e < 4; ++e) { const int j2 = jt * 16 + fq * 4 + e; av[e] = (i2 >= j2) ? qk[jt][e] * __expf(gi - gcs[j2]) : 0.f; }
            store_bf4(gA + i2 * 64 + jt * 16 + fq * 4, av);
        }
    }
    __syncthreads();
    {
        const int cc = tid & 127; const bool isw = tid >= 128;
        bf16_t* src = isw ? ks : vs;
#pragma unroll 1
        for (int ib = 0; ib < 4; ++ib) {
            float acc[16];
#pragma unroll
            for (int r = 0; r < 16; ++r) { const int j = ib * 16 + r; float f = bts[j]; if (isw) f *= __expf(gcs[j]); acc[r] = f * bf2f(src[j * QS + cc]); }
            const float* lrow = lowT + ib * 16;
#pragma unroll 2
            for (int j = 0; j < ib * 16; ++j) {
                const float xj = bf2f(src[j * QS + cc]);
                const f32x4 l0 = *(const f32x4*)(lrow + j * 68), l1 = *(const f32x4*)(lrow + j * 68 + 4), l2 = *(const f32x4*)(lrow + j * 68 + 8), l3 = *(const f32x4*)(lrow + j * 68 + 12);
#pragma unroll
                for (int e = 0; e < 4; ++e) { acc[e] -= l0[e] * xj; acc[4 + e] -= l1[e] * xj; acc[8 + e] -= l2[e] * xj; acc[12 + e] -= l3[e] * xj; }
            }
#pragma unroll 1
            for (int r2 = 0; r2 < 15; ++r2) {
                float xj = acc[0];
#pragma unroll
                for (int r = 1; r < 16; ++r) xj = (r2 == r) ? acc[r] : xj;
                const float* lp = lrow + (ib * 16 + r2) * 68;
                const f32x4 l0 = *(const f32x4*)(lp), l1 = *(const f32x4*)(lp + 4), l2 = *(const f32x4*)(lp + 8), l3 = *(const f32x4*)(lp + 12);
#pragma unroll
                for (int e = 0; e < 4; ++e) { acc[e] -= l0[e] * xj; acc[4 + e] -= l1[e] * xj; acc[8 + e] -= l2[e] * xj; acc[12 + e] -= l3[e] * xj; }
            }
#pragma unroll
            for (int r = 0; r < 16; ++r) {
                const int j = ib * 16 + r; const bf16_t xb = f2bf(acc[r]);
                src[j * QS + cc] = xb;
                if (isw) gW[j * 128 + cc] = xb; else gU[j * 128 + cc] = acc[r];
            }
        }
    }
    __syncthreads();
}

DEV void gdn_scan_item(const Params& p, int item, unsigned char* lds) {
    int tid = threadIdx.x; asm volatile("" : "+v"(tid)); const int lane = tid & 63, w = tid >> 6, fr = lane & 15, fq = lane >> 4;
    const int s = item & 7, bh = item >> 3;
    const int b = bh >> 3, h = bh & 7;
    bf16_t* ST = (bf16_t*)lds;
    bf16_t* VT = ST + 16 * QS;
    const bf16_t* gW = (const bf16_t*)(p.ws + WS_GW) + (size_t)bh * 32 * 8192;
    const bf16_t* gQ = (const bf16_t*)(p.ws + WS_GQ) + (size_t)bh * 32 * 8192;
    const bf16_t* gKT = (const bf16_t*)(p.ws + WS_GKT) + (size_t)bh * 32 * 8192;
    const bf16_t* gA = (const bf16_t*)(p.ws + WS_GA) + (size_t)bh * 32 * 4096;
    const float* gU = (const float*)(p.ws + WS_GU) + (size_t)bh * 32 * 8192;
    const float* gE = (const float*)(p.ws + WS_GE) + bh * 32;
    float* obuf = (float*)(p.ws + WS_O);
    f32x4 S0 = {0.f, 0.f, 0.f, 0.f}, S1 = {0.f, 0.f, 0.f, 0.f};
    for (int i = tid; i < 16 * QS / 2; i += 256) ((unsigned*)ST)[i] = 0u;
    bf16x8 fw[4], fqg[4], fa[2], fk0[2], fk1[2]; f32x4 uu; float eg;
#define SCAN_LOAD(ch) do { \
        const bf16_t* W_ = gW + (size_t)(ch) * 8192 + (w * 16 + fr) * 128 + fq * 8; const bf16_t* Q_ = gQ + (size_t)(ch) * 8192 + (w * 16 + fr) * 128 + fq * 8; \
        _Pragma("unroll") for (int k_ = 0; k_ < 4; ++k_) { fw[k_] = *(const bf16x8*)(W_ + k_ * 32); fqg[k_] = *(const bf16x8*)(Q_ + k_ * 32); } \
        const bf16_t* A_ = gA + (size_t)(ch) * 4096 + (w * 16 + fr) * 64 + fq * 8; fa[0] = *(const bf16x8*)(A_); fa[1] = *(const bf16x8*)(A_ + 32); \
        const bf16_t* K_ = gKT + (size_t)(ch) * 8192 + (w * 32 + fr) * 64 + fq * 8; fk0[0] = *(const bf16x8*)(K_); fk0[1] = *(const bf16x8*)(K_ + 32); \
        fk1[0] = *(const bf16x8*)(K_ + 16 * 64); fk1[1] = *(const bf16x8*)(K_ + 16 * 64 + 32); \
        const float* U_ = gU + (size_t)(ch) * 8192 + (w * 16 + fq * 4) * 128 + s * 16 + fr; uu[0] = U_[0]; uu[1] = U_[128]; uu[2] = U_[256]; uu[3] = U_[384]; \
        eg = gE[ch]; } while (0)
    SCAN_LOAD(0);
    __syncthreads();
    for (int ch = 0; ch < 32; ++ch) {
        bf16x8 cw[4], cq[4], ca[2], ck0[2], ck1[2]; f32x4 cu = uu; const float ceg = eg;
#pragma unroll
        for (int k = 0; k < 4; ++k) { cw[k] = fw[k]; cq[k] = fqg[k]; }
        ca[0] = fa[0]; ca[1] = fa[1]; ck0[0] = fk0[0]; ck0[1] = fk0[1]; ck1[0] = fk1[0]; ck1[1] = fk1[1];
        if (ch + 1 < 32) SCAN_LOAD(ch + 1);
        f32x4 ws_ = {0.f, 0.f, 0.f, 0.f}, oo = {0.f, 0.f, 0.f, 0.f};
#pragma unroll
        for (int k = 0; k < 4; ++k) {
            const bf16x8 sf = *(const bf16x8*)(ST + fr * QS + k * 32 + fq * 8);
            ws_ = __builtin_amdgcn_mfma_f32_16x16x32_bf16(cw[k], sf, ws_, 0, 0, 0);
            oo = __builtin_amdgcn_mfma_f32_16x16x32_bf16(cq[k], sf, oo, 0, 0, 0);
        }
        const f32x4 vn = cu - ws_;
        store_bf4(VT + fr * 72 + w * 16 + fq * 4, vn);
        __syncthreads();
        const bf16x8 v0 = *(const bf16x8*)(VT + fr * 72 + fq * 8), v1 = *(const bf16x8*)(VT + fr * 72 + 32 + fq * 8);
        oo = __builtin_amdgcn_mfma_f32_16x16x32_bf16(ca[0], v0, oo, 0, 0, 0);
        oo = __builtin_amdgcn_mfma_f32_16x16x32_bf16(ca[1], v1, oo, 0, 0, 0);
        S0 = S0 * ceg; S1 = S1 * ceg;
        S0 = __builtin_amdgcn_mfma_f32_16x16x32_bf16(ck0[0], v0, S0, 0, 0, 0);
        S0 = __builtin_amdgcn_mfma_f32_16x16x32_bf16(ck0[1], v1, S0, 0, 0, 0);
        S1 = __builtin_amdgcn_mfma_f32_16x16x32_bf16(ck1[0], v0, S1, 0, 0, 0);
        S1 = __builtin_amdgcn_mfma_f32_16x16x32_bf16(ck1[1], v1, S1, 0, 0, 0);
        store_bf4(ST + fr * QS + w * 32 + fq * 4, S0);
        store_bf4(ST + fr * QS + w * 32 + 16 + fq * 4, S1);
        {
            float* op = obuf + (size_t)(b * SEQ + ch * 64 + w * 16 + fq * 4) * 1024 + h * 128 + s * 16 + fr;
            op[0] = oo[0]; op[1024] = oo[1]; op[2048] = oo[2]; op[3072] = oo[3];
        }
        __syncthreads();
    }
#undef SCAN_LOAD
    {
        float* dp = p.out + O_DP + ((size_t)bh * 128 + w * 32 + fq * 4) * 128 + s * 16 + fr;
#pragma unroll
        for (int e = 0; e < 4; ++e) { dp[e * 128] = S0[e]; dp[(16 + e) * 128] = S1[e]; }
    }
    __syncthreads();
}

DEV void gdn_sample_item(const Params& p, int item, unsigned char* lds) {
    int tid = threadIdx.x; asm volatile("" : "+v"(tid)); const int lane = tid & 63, wid = tid >> 6;
    const int sb = item >> 3, h = item & 7, half = tid >> 7, c = tid & 127;
    const int r0 = TP + sb * 4;
    const bf16_t* proj = (const bf16_t*)(p.ws + WS_PROJ);
    const float* ab = (const float*)(p.ws + WS_AB);
    float* ksh = (float*)lds;
    float* qsh = ksh + 512;
    float* red = qsh + 512;
    float* red2 = red + 32;
    float* part = red2 + 32;
    float* opart = part + 1024;
    float qv[4], kv[4], vv[4];
#pragma unroll
    for (int m = 0; m < 3; ++m) {
        const int col = m * 1024 + h * 128 + c;
        float x[7], wj[4];
#pragma unroll
        for (int j = 0; j < 3; ++j) x[j] = p.in[6][((size_t)sb * 3 + j) * 3072 + col];
#pragma unroll
        for (int t = 0; t < 4; ++t) x[3 + t] = bf2f(proj[(size_t)(r0 + t) * NPJ + col]);
#pragma unroll
        for (int j = 0; j < 4; ++j) wj[j] = p.in[10][j * 3072 + col];
#pragma unroll
        for (int t = 0; t < 4; ++t) {
            const float y = silu_f(wj[0] * x[t] + wj[1] * x[t + 1] + wj[2] * x[t + 2] + wj[3] * x[t + 3]);
            if (m == 0) qv[t] = y; else if (m == 1) kv[t] = y; else vv[t] = y;
        }
    }
#pragma unroll
    for (int t = 0; t < 4; ++t) {
        const float a = wave_sum(qv[t] * qv[t]), bq = wave_sum(kv[t] * kv[t]);
        if (lane == 0) { red[wid * 8 + t] = a; red[wid * 8 + 4 + t] = bq; }
    }
    __syncthreads();
    float gt[4], bt[4];
#pragma unroll
    for (int t = 0; t < 4; ++t) {
        const float sq = red[(2 * half) * 8 + t] + red[(2 * half + 1) * 8 + t], sk = red[(2 * half) * 8 + 4 + t] + red[(2 * half + 1) * 8 + 4 + t];
        if (half == 0) {
            qsh[t * 128 + c] = qv[t] * rsqrtf(sq + EPS) * 0.08838834764831845f;
            ksh[t * 128 + c] = kv[t] * rsqrtf(sk + EPS);
        }
        const float a = ab[(size_t)(r0 + t) * 16 + h], bb = ab[(size_t)(r0 + t) * 16 + 8 + h];
        const float xx = a + p.in[12][h];
        const float sp = xx > 20.f ? xx : log1pf(__expf(xx));
        gt[t] = __expf(-__expf(p.in[11][h]) * sp);
        bt[t] = 1.f / (1.f + __expf(-bb));
    }
    float S[64];
    const float* sp0 = p.in[5] + ((size_t)(sb * 8 + h) * 128 + half * 64) * 128 + c;
#pragma unroll
    for (int d = 0; d < 64; ++d) S[d] = sp0[(size_t)d * 128];
    __syncthreads();
    float ot[4];
#pragma unroll
    for (int t = 0; t < 4; ++t) {
        const float* kk = ksh + t * 128 + half * 64; const float* qq = qsh + t * 128 + half * 64;
        float kS = 0.f;
#pragma unroll
        for (int d4 = 0; d4 < 16; ++d4) { const f32x4 k4 = *(const f32x4*)(kk + d4 * 4); kS += k4[0] * S[d4 * 4] + k4[1] * S[d4 * 4 + 1] + k4[2] * S[d4 * 4 + 2] + k4[3] * S[d4 * 4 + 3]; }
        part[(t * 2 + half) * 128 + c] = kS;
        __syncthreads();
        kS = part[(t * 2) * 128 + c] + part[(t * 2 + 1) * 128 + c];
        const float eg = gt[t], dl = bt[t] * (vv[t] - eg * kS);
        float o = 0.f;
#pragma unroll
        for (int d4 = 0; d4 < 16; ++d4) {
            const f32x4 k4 = *(const f32x4*)(kk + d4 * 4), q4 = *(const f32x4*)(qq + d4 * 4);
#pragma unroll
            for (int e = 0; e < 4; ++e) { const float sn = eg * S[d4 * 4 + e] + k4[e] * dl; S[d4 * 4 + e] = sn; o += q4[e] * sn; }
        }
        ot[t] = o;
        if (half == 1) opart[t * 128 + c] = o;
    }
    float* dso = p.out + O_DS + ((size_t)(sb * 8 + h) * 128 + half * 64) * 128 + c;
#pragma unroll
    for (int d = 0; d < 64; ++d) dso[(size_t)d * 128] = S[d];
    __syncthreads();
    if (half == 0) {
#pragma unroll
        for (int t = 0; t < 4; ++t) { ot[t] += opart[t * 128 + c]; const float a = wave_sum(ot[t] * ot[t]); if (lane == 0) red2[wid * 4 + t] = a; }
    }
    __syncthreads();
    if (half == 0) {
        bf16_t* mix = (bf16_t*)(p.ws + WS_MIX);
        const float gn = p.in[13][c];
#pragma unroll
        for (int t = 0; t < 4; ++t) {
            const float ms = (red2[t] + red2[4 + t]) * (1.f / 128.f);
            const float z = bf2f(proj[(size_t)(r0 + t) * NPJ + C_ZA + h * 128 + c]);
            mix[(size_t)(r0 + t) * D + h * 128 + c] = f2bf(ot[t] * rsqrtf(ms + EPS) * gn * silu_f(z));
        }
    }
    __syncthreads();
}

DEV void attn_sample_item(const Params& p, int item, unsigned char* lds) {
    int tid = threadIdx.x; asm volatile("" : "+v"(tid)); const int lane = tid & 63, wid = tid >> 6;
    const int sb = item >> 2, hd = item & 3;
    float* qs = (float*)lds;
    float* pm = qs + 2048;
    float* red = pm + 1024;
    const bf16_t* qx = (const bf16_t*)(p.ws + WS_QX);
    for (int i = tid; i < 2048; i += 256) { const int t = i >> 9, d = i & 511; qs[i] = bf2f(qx[(size_t)(TP + sb * 4 + t) * D + hd * 512 + d]) * 0.04419417382415922f; }
    __syncthreads();
    const float* Kc = p.in[3] + ((size_t)sb * 256) * D + hd * 512;
    const float* Vc = p.in[4] + ((size_t)sb * 256) * D + hd * 512;
    {
        const int sub = lane >> 4, l16 = lane & 15;
        for (int it = 0; it < 16; ++it) {
            const int m = wid * 64 + it * 4 + sub;
            const float* kr = Kc + (size_t)m * D;
            f32x4 kv[8];
#pragma unroll
            for (int i = 0; i < 8; ++i) kv[i] = *(const f32x4*)(kr + (i * 16 + l16) * 4);
            float a0 = 0.f, a1 = 0.f, a2 = 0.f, a3 = 0.f;
#pragma unroll
            for (int i = 0; i < 8; ++i) {
                const int d = (i * 16 + l16) * 4;
                const f32x4 q0 = *(const f32x4*)(qs + d), q1 = *(const f32x4*)(qs + 512 + d), q2 = *(const f32x4*)(qs + 1024 + d), q3 = *(const f32x4*)(qs + 1536 + d);
                a0 += kv[i][0] * q0[0] + kv[i][1] * q0[1] + kv[i][2] * q0[2] + kv[i][3] * q0[3];
                a1 += kv[i][0] * q1[0] + kv[i][1] * q1[1] + kv[i][2] * q1[2] + kv[i][3] * q1[3];
                a2 += kv[i][0] * q2[0] + kv[i][1] * q2[1] + kv[i][2] * q2[2] + kv[i][3] * q2[3];
                a3 += kv[i][0] * q3[0] + kv[i][1] * q3[1] + kv[i][2] * q3[2] + kv[i][3] * q3[3];
            }
#pragma unroll
            for (int o = 1; o < 16; o <<= 1) { a0 += __shfl_xor(a0, o); a1 += __shfl_xor(a1, o); a2 += __shfl_xor(a2, o); a3 += __shfl_xor(a3, o); }
            if (l16 == 0) *(f32x4*)(pm + m * 4) = (f32x4){a0, a1, a2, a3};
        }
    }
    __syncthreads();
    {
        const int t = wid;
        float v[4]; float mx = -3.0e38f;
#pragma unroll
        for (int i = 0; i < 4; ++i) { v[i] = pm[(i * 64 + lane) * 4 + t]; mx = fmaxf(mx, v[i]); }
        mx = wave_max(mx);
        float sm = 0.f;
#pragma unroll
        for (int i = 0; i < 4; ++i) { v[i] = __expf(v[i] - mx); sm += v[i]; }
        sm = wave_sum(sm);
        const float inv = 1.f / sm;
#pragma unroll
        for (int i = 0; i < 4; ++i) pm[(i * 64 + lane) * 4 + t] = v[i] * inv;
    }
    __syncthreads();
    {
        f32x4 acc[4][2];
#pragma unroll
        for (int t = 0; t < 4; ++t) { acc[t][0] = (f32x4){0.f, 0.f, 0.f, 0.f}; acc[t][1] = (f32x4){0.f, 0.f, 0.f, 0.f}; }
        for (int m8 = 0; m8 < 8; ++m8) {
            f32x4 va[8], vb[8];
#pragma unroll
            for (int i = 0; i < 8; ++i) { const float* vr = Vc + (size_t)(wid * 64 + m8 * 8 + i) * D; va[i] = *(const f32x4*)(vr + lane * 4); vb[i] = *(const f32x4*)(vr + 256 + lane * 4); }
#pragma unroll
            for (int i = 0; i < 8; ++i) {
                const f32x4 pr = *(const f32x4*)(pm + (wid * 64 + m8 * 8 + i) * 4);
#pragma unroll
                for (int t = 0; t < 4; ++t) { acc[t][0] += va[i] * pr[t]; acc[t][1] += vb[i] * pr[t]; }
            }
        }
#pragma unroll
        for (int t = 0; t < 4; ++t) { *(f32x4*)(red + (wid * 4 + t) * 512 + lane * 4) = acc[t][0]; *(f32x4*)(red + (wid * 4 + t) * 512 + 256 + lane * 4) = acc[t][1]; }
    }
    __syncthreads();
    {
        bf16_t* ctx = (bf16_t*)(p.ws + WS_CTX);
#pragma unroll
        for (int i = 0; i < 2; ++i) {
            const int e = (tid + 256 * i) * 4, t = e >> 9, d = e & 511;
            const f32x4 s = *(const f32x4*)(red + (0 * 4 + t) * 512 + d) + *(const f32x4*)(red + (1 * 4 + t) * 512 + d) + *(const f32x4*)(red + (2 * 4 + t) * 512 + d) + *(const f32x4*)(red + (3 * 4 + t) * 512 + d);
            store_bf4(ctx + (size_t)(TP + sb * 4 + t) * D + hd * 512 + d, s);
        }
    }
    __syncthreads();
}

#ifndef NLAUNCH
#define NLAUNCH 1
#endif
#define GRID_BAR() do { if (NLAUNCH == 1) xcd_barrier(bar); } while (0)
#define IN_PH(k) (p.ph_lo <= (k) && (k) < p.ph_hi)
__global__ void __launch_bounds__(256, 2) hymba_fwd(Params p) {
    __shared__ __attribute__((aligned(16))) unsigned char lds[65536];
    __shared__ uint4 xb_words;
    int tid = threadIdx.x; asm volatile("" : "+v"(tid)); const int lane = tid & 63, wid = tid >> 6;
    const int G = gridDim.x, bid = blockIdx.x;
    if (tid == 0) xb_words = make_uint4(0u, 0u, 0u, 0u);
    __syncthreads();
    XcdBarrier bar; bar.bar = (unsigned*)(p.ws + WS_BAR); bar.x = 0; bar.st = (volatile LAS unsigned*)&xb_words;
    if (NLAUNCH == 1) bar = xcd_barrier_post((unsigned*)(p.ws + WS_BAR), (volatile LAS unsigned*)&xb_words);
    unsigned char* ws = p.ws;
    bf16_t* Wt_in = (bf16_t*)(ws + WS_WIN); bf16_t* Wt_out = (bf16_t*)(ws + WS_WOUT); bf16_t* Wt_cq = (bf16_t*)(ws + WS_WCQ); bf16_t* Wt_co = (bf16_t*)(ws + WS_WCO);
    bf16_t* Wt_ckv = (bf16_t*)(ws + WS_WCKV); bf16_t* Wt_pool = (bf16_t*)(ws + WS_WPOOL);
    bf16_t* hbuf = (bf16_t*)(ws + WS_H); bf16_t* hm = (bf16_t*)(ws + WS_HM); bf16_t* proj = (bf16_t*)(ws + WS_PROJ); float* ab = (float*)(ws + WS_AB);
    bf16_t* mkb = (bf16_t*)(ws + WS_MKB); bf16_t* mvt = (bf16_t*)(ws + WS_MVT); bf16_t* dpl = (bf16_t*)(ws + WS_DPL); bf16_t* mix = (bf16_t*)(ws + WS_MIX);
    float* x1 = (float*)(ws + WS_X1); bf16_t* qx = (bf16_t*)(ws + WS_QX); float* sc = (float*)(ws + WS_SC); bf16_t* pb = (bf16_t*)(ws + WS_PB);
    bf16_t* ctx = (bf16_t*)(ws + WS_CTX); float* x2 = (float*)(ws + WS_X2); float* obuf = (float*)(ws + WS_O);

#ifdef DBG_ZERO_WS
    {
        for (int i = tid; i < 65536 / 16; i += 256) ((uint4*)lds)[i] = make_uint4(0u, 0u, 0u, 0u);
        uint4* wz = (uint4*)(ws + 16384); const size_t n16 = (WS_END - 16384) / 16;
        for (size_t i = (size_t)bid * 256 + tid; i < n16; i += (size_t)G * 256) wz[i] = make_uint4(0u, 0u, 0u, 0u);
    }
    GRID_BAR();
#endif
    if (IN_PH(0)) {
        const int NT_IN = 98 * 32, NT_SQ = 32 * 32;
        const int total = NT_IN + 5 * NT_SQ + 64;
        for (int t = bid; t < total; t += G) {
            if (t < NT_IN) { const int nt = t >> 5, kt = t & 31; transpose_tile(p.in[9], 6160, nt * 64, true, kt * 64, Wt_in + (size_t)nt * 64 * D, D, (float*)lds); }
            else if (t < NT_IN + 5 * NT_SQ) {
                const int u = t - NT_IN, j = u >> 10, v = u & 1023, nt = v >> 5, kt = v & 31;
                const float* src = p.in[j == 0 ? 16 : (j == 1 ? 19 : (j == 2 ? 22 : (j == 3 ? 20 : 21)))];
                bf16_t* dst = j == 0 ? Wt_out : (j == 1 ? Wt_cq : (j == 2 ? Wt_co : (j == 3 ? Wt_ckv : Wt_ckv + (size_t)D * D)));
                transpose_tile(src, D, nt * 64, false, kt * 64, dst + (size_t)nt * 64 * D, D, (float*)lds);
            } else {
                const int u = t - NT_IN - 5 * NT_SQ, g = u >> 4, v = u & 15, nt = v >> 2, kt = v & 3;
                transpose_tile(p.in[14] + (size_t)g * 65536, 256, nt * 64, false, kt * 64, Wt_pool + ((size_t)g * 256 + nt * 64) * 256, 256, (float*)lds);
            }
        }
        for (int r = bid * 4 + wid; r < TT + 1024; r += G * 4) {
            if (r < TP) rmsnorm_row_bf16(p.in[0] + (size_t)r * D, p.in[8], hbuf + (size_t)r * D, lane);
            else if (r < TT) rmsnorm_row_bf16(p.in[1] + (size_t)(r - TP) * D, p.in[8], hbuf + (size_t)r * D, lane);
            else rmsnorm_row_bf16(p.in[2] + (size_t)(r - TT) * D, p.in[17], hm + (size_t)(r - TT) * D, lane);
        }
    }
    GRID_BAR();
    if (IN_PH(1)) {
        const int T1 = 68 * 49, T2 = 8 * 32;
        for (int t = bid; t < T1; t += G) { const int nt = t / 68, mt = t - nt * 68;
            EpiProj e{mt * 128, nt * 128, proj, ab, p.out};
            gemm_tile(hbuf + (size_t)mt * 128 * D, D, Wt_in + (size_t)nt * 128 * D, D, D, lds, e);
        }
        for (int t = (bid + G - (T1 % G)) % G; t < T2; t += G) { const int nt = t >> 3, mt = t & 7;
            EpiMKV e{mt * 128, nt * 128, mkb, mvt, p.out};
            gemm_tile(hm + (size_t)mt * 128 * D, D, Wt_ckv + (size_t)nt * 128 * D, D, D, lds, e);
        }
    }
    GRID_BAR();
    if (IN_PH(2)) {
        for (int t = bid; t < 1024; t += G) gdn_prep_chunk(p, t, lds);
        for (int i = bid * 256 + tid; i < TT * 128; i += G * 256) {
            const int row = i >> 7, c8 = (i & 127) * 8, g = c8 >> 8, win = 2 << g;
            float acc[8] = {0.f, 0.f, 0.f, 0.f, 0.f, 0.f, 0.f, 0.f}, self[8];
            int tloc, cnt; const bool isp = row < TP;
            if (isp) { tloc = row & 2047; cnt = min(win, tloc + 1); } else { tloc = (row - TP) & 3; cnt = win; }
            for (int k = 0; k < win; ++k) {
                const int tt = tloc - k;
                if (tt >= 0) {
                    const uint4 u = *(const uint4*)(proj + (size_t)(row - k) * NPJ + C_U + c8);
                    const float f[8] = {bflo(u.x), bfhi(u.x), bflo(u.y), bfhi(u.y), bflo(u.z), bfhi(u.z), bflo(u.w), bfhi(u.w)};
#pragma unroll
                    for (int e = 0; e < 8; ++e) { acc[e] += f[e]; if (k == 0) self[e] = f[e]; }
                } else if (!isp) {
                    const float* sp = p.in[7] + ((size_t)((row - TP) >> 2) * 15 + (15 + tt)) * 1024 + c8;
                    const f32x4 s0 = *(const f32x4*)sp, s1 = *(const f32x4*)(sp + 4);
                    acc[0] += s0[0]; acc[1] += s0[1]; acc[2] += s0[2]; acc[3] += s0[3]; acc[4] += s1[0]; acc[5] += s1[1]; acc[6] += s1[2]; acc[7] += s1[3];
                }
            }
            const float ic = 1.f / (float)cnt;
            uint4 o; o.x = cvt_pk_bf16(acc[0] * ic - self[0], acc[1] * ic - self[1]); o.y = cvt_pk_bf16(acc[2] * ic - self[2], acc[3] * ic - self[3]);
            o.z = cvt_pk_bf16(acc[4] * ic - self[4], acc[5] * ic - self[5]); o.w = cvt_pk_bf16(acc[6] * ic - self[6], acc[7] * ic - self[7]);
            *(uint4*)(dpl + (size_t)row * 1024 + c8) = o;
        }
        for (int i = bid * 256 + tid; i < SB * 11 * 256; i += G * 256) {
            const int c4 = (i & 255) * 4, rr = (i >> 8) % 11, sb = (i >> 8) / 11;
            *(f32x4*)(p.out + O_PS + ((size_t)sb * 15 + rr) * 1024 + c4) = *(const f32x4*)(p.in[7] + ((size_t)sb * 15 + rr + 4) * 1024 + c4);
        }
    }
    GRID_BAR();
    if (IN_PH(3)) {
        const int NSC = 256, NSM = 1024, NPL = 68 * 8;
        for (int t = bid; t < NSC; t += G) gdn_scan_item(p, t, lds);
        for (int t = (bid + G - (NSC % G)) % G; t < NSM; t += G) gdn_sample_item(p, t, lds);
        for (int t = (bid + G - (NSC % G)) % G; t < NPL; t += G) { const int nt = t / 68, mt = t - nt * 68, g = nt >> 1;
            EpiPool e{mt * 128, nt * 128, proj, p.in[15], mix};
            gemm_tile(dpl + (size_t)mt * 128 * 1024 + g * 256, 1024, Wt_pool + (size_t)nt * 128 * 256, 256, 256, lds, e);
        }
    }
    GRID_BAR();
    if (IN_PH(4)) {
        for (int i = bid * 256 + tid; i < TP * 8 * 16; i += G * 256) {
            const int l16 = i & 15, rh = i >> 4, h = rh & 7, row = rh >> 3;
            const float* op = obuf + (size_t)row * 1024 + h * 128 + l16 * 8;
            const f32x4 a = *(const f32x4*)op, b4 = *(const f32x4*)(op + 4);
            float ss = a[0] * a[0] + a[1] * a[1] + a[2] * a[2] + a[3] * a[3] + b4[0] * b4[0] + b4[1] * b4[1] + b4[2] * b4[2] + b4[3] * b4[3];
            ss += __shfl_xor(ss, 1); ss += __shfl_xor(ss, 2); ss += __shfl_xor(ss, 4); ss += __shfl_xor(ss, 8);
            const float rs = rsqrtf(ss * (1.f / 128.f) + EPS);
            const f32x4 g0 = *(const f32x4*)(p.in[13] + l16 * 8), g1 = *(const f32x4*)(p.in[13] + l16 * 8 + 4);
            const uint4 z = *(const uint4*)(proj + (size_t)row * NPJ + C_ZA + h * 128 + l16 * 8);
            uint4 o;
            o.x = cvt_pk_bf16(a[0] * rs * g0[0] * silu_f(bflo(z.x)), a[1] * rs * g0[1] * silu_f(bfhi(z.x)));
            o.y = cvt_pk_bf16(a[2] * rs * g0[2] * silu_f(bflo(z.y)), a[3] * rs * g0[3] * silu_f(bfhi(z.y)));
            o.z = cvt_pk_bf16(b4[0] * rs * g1[0] * silu_f(bflo(z.z)), b4[1] * rs * g1[1] * silu_f(bfhi(z.z)));
            o.w = cvt_pk_bf16(b4[2] * rs * g1[2] * silu_f(bflo(z.w)), b4[3] * rs * g1[3] * silu_f(bfhi(z.w)));
            *(uint4*)(mix + (size_t)row * D + h * 128 + l16 * 8) = o;
        }
    }
    GRID_BAR();
    if (IN_PH(5)) {
        for (int t = bid; t < 68 * 16; t += G) { const int nt = t / 68, mt = t - nt * 68;
            const float* res = (mt < 64 ? p.in[0] + (size_t)mt * 128 * D : p.in[1] + (size_t)(mt - 64) * 128 * D) + nt * 128;
            EpiResid e{res, x1 + (size_t)mt * 128 * D + nt * 128};
            gemm_tile(mix + (size_t)mt * 128 * D, D, Wt_out + (size_t)nt * 128 * D, D, D, lds, e);
        }
    }
    GRID_BAR();
    if (IN_PH(6))
    for (int r = bid * 4 + wid; r < TT; r += G * 4) rmsnorm_row_bf16(x1 + (size_t)r * D, p.in[18], hbuf + (size_t)r * D, lane);
    GRID_BAR();
    if (IN_PH(7)) {
        for (int t = bid; t < 68 * 16; t += G) { const int nt = t / 68, mt = t - nt * 68;
            EpiBf e{qx + (size_t)mt * 128 * D + nt * 128, D};
            gemm_tile(hbuf + (size_t)mt * 128 * D, D, Wt_cq + (size_t)nt * 128 * D, D, D, lds, e);
        }
    }
    GRID_BAR();
    if (IN_PH(8)) {
        const int NS1 = 16 * 16 * 2;
        for (int t = bid; t < 512; t += G) attn_sample_item(p, t, lds);
        for (int t = bid; t < NS1; t += G) { const int bhd = t >> 5, v = t & 31, mt = v >> 1, nt = v & 1, b = bhd >> 2, hd = bhd & 3;
            EpiF32s e{sc + (size_t)(b * SEQ + mt * 128) * 1024 + hd * 256 + nt * 128, 1024, 0.04419417382415922f};
            gemm_tile(qx + (size_t)(b * SEQ + mt * 128) * D + hd * 512, D, mkb + (size_t)(b * 256 + nt * 128) * D + hd * 512, D, 512, lds, e);
        }
    }
    GRID_BAR();
    if (IN_PH(9))
    for (int r = bid * 4 + wid; r < TP * 4; r += G * 4) {
        const f32x4 v = *(const f32x4*)(sc + (size_t)r * 256 + lane * 4);
        const float mx = wave_max(fmaxf(fmaxf(v[0], v[1]), fmaxf(v[2], v[3])));
        f32x4 e; e[0] = __expf(v[0] - mx); e[1] = __expf(v[1] - mx); e[2] = __expf(v[2] - mx); e[3] = __expf(v[3] - mx);
        const float inv = 1.f / wave_sum(e[0] + e[1] + e[2] + e[3]);
        store_bf4(pb + (size_t)r * 256 + lane * 4, e * inv);
    }
    GRID_BAR();
    if (IN_PH(10)) {
        for (int t = bid; t < 16 * 16 * 4; t += G) { const int bhd = t >> 6, v = t & 63, mt = v >> 2, nt = v & 3, b = bhd >> 2, hd = bhd & 3;
            EpiBf e{ctx + (size_t)(b * SEQ + mt * 128) * D + hd * 512 + nt * 128, D};
            gemm_tile(pb + (size_t)(b * SEQ + mt * 128) * 1024 + hd * 256, 1024, mvt + ((size_t)b * D + hd * 512 + nt * 128) * 256, 256, 256, lds, e);
        }
    }
    GRID_BAR();
    if (IN_PH(11)) {
        for (int t = bid; t < 68 * 16; t += G) { const int nt = t / 68, mt = t - nt * 68;
            EpiResid e{x1 + (size_t)mt * 128 * D + nt * 128, x2 + (size_t)mt * 128 * D + nt * 128};
            gemm_tile(ctx + (size_t)mt * 128 * D, D, Wt_co + (size_t)nt * 128 * D, D, D, lds, e);
        }
    }
    GRID_BAR();
    if (IN_PH(12))
    for (int r = bid * 4 + wid; r < TT; r += G * 4) rmsnorm_row_f32(x2 + (size_t)r * D, p.in[23], p.out + (r < TP ? O_YP + (size_t)r * D : O_YS + (size_t)(r - TP) * D), lane);
}

extern "C" void kernel_launch(void* const* d_in, const int* in_sizes, int n_in, void* d_out, int out_size, void* d_ws, size_t ws_size, hipStream_t stream) {
    static int grid = 0;
    if (grid == 0) {
        if (n_in != 24 || ws_size < WS_END) { fprintf(stderr, "kernel_launch: need 24 inputs and %zu bytes of workspace (got %d, %zu)\n", (size_t)WS_END, n_in, ws_size); grid = -1; return; }
        int dev = 0, cus = 0, per_cu = 0;
        hipGetDevice(&dev);
        hipDeviceGetAttribute(&cus, hipDeviceAttributeMultiprocessorCount, dev);
        if (hipOccupancyMaxActiveBlocksPerMultiprocessor(&per_cu, (const void*)hymba_fwd, 256, 0) != hipSuccess || per_cu < 1) { fprintf(stderr, "kernel_launch: occupancy query failed\n"); grid = -1; return; }
        if (per_cu > 2) per_cu = 2;
        grid = cus * per_cu;
        fprintf(stderr, "kernel_launch: grid %d (%d per CU)\n", grid, per_cu);
    }
    if (grid < 0) return;
    hipMemsetAsync((char*)d_ws + WS_BAR, 0, 16384, stream);
    Params p{};
    for (int i = 0; i < 24; ++i) p.in[i] = (const float*)d_in[i];
    p.out = (float*)d_out; p.ws = (unsigned char*)d_ws;
    if (NLAUNCH == 1) {
        p.ph_lo = 0; p.ph_hi = 13;
        void* args[] = {&p};
        hipError_t e = hipLaunchCooperativeKernel((const void*)hymba_fwd, dim3(grid), dim3(256), args, 0, stream);
        if (e != hipSuccess) fprintf(stderr, "kernel_launch: cooperative launch failed: %s (grid %d)\n", hipGetErrorString(e), grid);
    } else {
        for (int k = 0; k < 13; ++k) { p.ph_lo = k; p.ph_hi = k + 1; hipLaunchKernelGGL(hymba_fwd, dim3(grid), dim3(256), 0, stream, p); }
    }
}
```

```cpp
#include <hip/hip_runtime.h>
#include <hip/hip_cooperative_groups.h>
#include <cstdio>
#include <cstdint>

typedef unsigned short bf16_t;
typedef short bf16x8 __attribute__((ext_vector_type(8)));
typedef float f32x4 __attribute__((ext_vector_type(4)));
#define DEV __device__ __forceinline__
#define LAS __attribute__((address_space(3)))

constexpr int D = 2048, TP = 8192, TS = 512, TT = 8704, SEQ = 2048, NB = 4, SB = 128;
constexpr int NPJ = 6144;
constexpr int C_ZA = 3072, C_U = 4096, C_ZB = 5120;
constexpr int NWIN = 6272;
constexpr float EPS = 1e-6f;
constexpr int LDB = 2112, LDP = 1088, LDM = 288;

constexpr size_t O_YP = 0, O_YS = 16777216, O_MK = 17825792, O_MV = 19922944, O_DP = 22020096, O_CP = 22544384,
                 O_PP = 22581248, O_DS = 22642688, O_CS = 39419904, O_PS = 40599552;

constexpr size_t al256(size_t x) { return (x + 255) & ~(size_t)255; }
constexpr size_t WS_BAR = 0;
constexpr size_t WS_WIN = 16384;
constexpr size_t WS_WOUT = WS_WIN + (size_t)NWIN * LDB * 2;
constexpr size_t WS_WCQ = WS_WOUT + (size_t)D * LDB * 2;
constexpr size_t WS_WCO = WS_WCQ + (size_t)D * LDB * 2;
constexpr size_t WS_WCKV = WS_WCO + (size_t)D * LDB * 2;
constexpr size_t WS_WPOOL = WS_WCKV + (size_t)2 * D * LDB * 2;
constexpr size_t WS_H = WS_WPOOL + (size_t)1024 * LDM * 2;
constexpr size_t WS_HM = WS_H + (size_t)TT * LDB * 2;
constexpr size_t WS_PROJ = WS_HM + (size_t)1024 * LDB * 2;
constexpr size_t WS_AB = WS_PROJ + (size_t)TT * NPJ * 2;
constexpr size_t WS_MKB = WS_AB + (size_t)TT * 16 * 4;
constexpr size_t WS_MVT = WS_MKB + (size_t)1024 * LDB * 2;
constexpr size_t WS_GW = WS_MVT + (size_t)4 * D * LDM * 2;
constexpr size_t WS_GQ = WS_GW + (size_t)1024 * 8192 * 2;
constexpr size_t WS_GKT = WS_GQ + (size_t)1024 * 8192 * 2;
constexpr size_t WS_GA = WS_GKT + (size_t)1024 * 8192 * 2;
constexpr size_t WS_GU = WS_GA + (size_t)1024 * 4096 * 2;
constexpr size_t WS_GE = WS_GU + (size_t)1024 * 8192 * 4;
constexpr size_t WS_O = WS_GE + 4096;
constexpr size_t WS_DPL = WS_O + (size_t)TP * 1024 * 4;
constexpr size_t WS_MIX = WS_DPL + (size_t)TT * LDP * 2;
constexpr size_t WS_X1 = WS_MIX + (size_t)TT * LDB * 2;
constexpr size_t WS_QX = WS_X1 + (size_t)TT * D * 4;
constexpr size_t WS_SC = WS_QX + (size_t)TT * LDB * 2;
constexpr size_t WS_PB = WS_SC + (size_t)TP * 1024 * 4;
constexpr size_t WS_CTX = WS_PB + (size_t)TP * LDP * 2;
constexpr size_t WS_X2 = WS_CTX + (size_t)TT * LDB * 2;
constexpr size_t WS_END = WS_X2 + (size_t)TT * D * 4;

#ifndef LASTP
#define LASTP 99
#endif
struct Params { const float* in[24]; float* out; unsigned char* ws; int ph_lo, ph_hi; };

typedef __bf16 bf16x2_t __attribute__((ext_vector_type(2)));
typedef float f32x2_t __attribute__((ext_vector_type(2)));
DEV unsigned cvt_pk_bf16(float lo, float hi) { const f32x2_t v = {lo, hi}; const bf16x2_t b = __builtin_convertvector(v, bf16x2_t); return __builtin_bit_cast(unsigned, b); }
DEV bf16_t f2bf(float f) { return (bf16_t)(cvt_pk_bf16(f, 0.f) & 0xffffu); }
DEV float bf2f(unsigned b) { return __uint_as_float(b << 16); }
DEV float bflo(unsigned u) { return __uint_as_float(u << 16); }
DEV float bfhi(unsigned u) { return __uint_as_float(u & 0xffff0000u); }
DEV float silu_f(float x) { return x / (1.f + __expf(-x)); }
DEV float wave_sum(float v) {
#pragma unroll
    for (int o = 32; o >= 1; o >>= 1) v += __shfl_xor(v, o);
    return v;
}
DEV float wave_max(float v) {
#pragma unroll
    for (int o = 32; o >= 1; o >>= 1) v = fmaxf(v, __shfl_xor(v, o));
    return v;
}
DEV void store_bf4(bf16_t* p, f32x4 v) { uint2 w; w.x = cvt_pk_bf16(v[0], v[1]); w.y = cvt_pk_bf16(v[2], v[3]); *(uint2*)p = w; }

#define XB_TMO      128
#define XB_XCNT(j)  (256  + 64 * (j))
#define XB_XSUB(j)  (1280 + 64 * (j))
#define XB_XGEN(j)  (2304 + 64 * (j))
#define XB_TOP      3328
#define XB_TOPGEN   3392
#define XCD_BAR_WORDS 3456
#define XB_SPIN_CAP (1u << 22)
DEV unsigned xb_ld(unsigned* p) { return __hip_atomic_load(p, __ATOMIC_RELAXED, __HIP_MEMORY_SCOPE_AGENT); }
DEV unsigned xb_add(unsigned* p, unsigned v) { return __hip_atomic_fetch_add(p, v, __ATOMIC_RELAXED, __HIP_MEMORY_SCOPE_AGENT); }
DEV unsigned xb_xcc_id() { return (unsigned)__builtin_amdgcn_s_getreg((3 << 11) | 20) & 0xFu; }
#define XB_SPIN(cond, bar) do { unsigned _sp = 0; while (cond) { __builtin_amdgcn_s_sleep(1); \
    if ((++_sp & 255u) == 0u) { if (xb_ld(&(bar)[XB_TMO])) break; if (_sp > XB_SPIN_CAP) { atomicAdd(&(bar)[XB_TMO], 1u); break; } } } } while (0)
struct XcdBarrier { unsigned* bar; unsigned x; volatile LAS unsigned* st; };
DEV XcdBarrier xcd_barrier_post(unsigned* bar, volatile LAS unsigned* st) {
    XcdBarrier b; b.bar = bar; b.x = xb_xcc_id(); b.st = st;
    if (threadIdx.x == 0) (void)xb_add(&bar[XB_XCNT(b.x)], 1u);
    return b;
}
DEV void xcd_barrier_complete(unsigned* bar, unsigned x, unsigned& nloc, unsigned& nx) {
    const unsigned G = gridDim.x;
    unsigned sum, cnt, mine, sp = 0u;
    for (;;) {
        sum = 0u; cnt = 0u; mine = 0u;
#pragma unroll
        for (unsigned j = 0; j < 16; ++j) { const unsigned c = xb_ld(&bar[XB_XCNT(j)]); sum += c; cnt += (c > 0u) ? 1u : 0u; mine = (j == x) ? c : mine; }
        if (sum == G) break;
        __builtin_amdgcn_s_sleep(1);
        if ((++sp & 255u) == 0u) { if (xb_ld(&bar[XB_TMO])) break; if (sp > XB_SPIN_CAP) { atomicAdd(&bar[XB_TMO], 1u); break; } }
    }
    nloc = mine > 0u ? mine : 1u; nx = cnt > 0u ? cnt : 1u;
}
DEV void xcd_barrier(const XcdBarrier& b) {
    asm volatile("s_waitcnt vmcnt(0)" ::: "memory");
    __syncthreads();
    if (threadIdx.x == 0) {
        unsigned* bar = b.bar;
        __builtin_amdgcn_s_waitcnt(0);
        unsigned nloc = b.st[0], nx = b.st[1];
        if (nloc == 0u) { xcd_barrier_complete(bar, b.x, nloc, nx); b.st[0] = nloc; b.st[1] = nx; }
        const unsigned old = xb_add(&bar[XB_XSUB(b.x)], 1u);
        const unsigned gen = old / nloc;
        if (old + 1u == (gen + 1u) * nloc) {
            __builtin_amdgcn_fence(__ATOMIC_RELEASE, "agent");
            asm volatile("s_waitcnt vmcnt(0)" ::: "memory");
            const unsigned og = xb_add(&bar[XB_TOP], 1u);
            const unsigned tg = og / nx;
            if (og + 1u == (tg + 1u) * nx) xb_add(&bar[XB_TOPGEN], 1u);
            else XB_SPIN(xb_ld(&bar[XB_TOPGEN]) == tg, bar);
            __builtin_amdgcn_fence(__ATOMIC_ACQUIRE, "agent");
            xb_add(&bar[XB_XGEN(b.x)], 1u);
            asm volatile("s_waitcnt vmcnt(0)" ::: "memory");
        } else {
            XB_SPIN(xb_ld(&bar[XB_XGEN(b.x)]) == gen, bar);
            __builtin_amdgcn_fence(__ATOMIC_ACQUIRE, "agent");
            asm volatile("s_waitcnt vmcnt(0)" ::: "memory");
        }
    }
    __syncthreads();
}

DEV void glds16(const void* gptr, unsigned lds_addr_lane) {
    const unsigned m = __builtin_amdgcn_readfirstlane(lds_addr_lane);
    unsigned keep;
    asm volatile("s_mov_b32 %0, m0\n\ts_mov_b32 m0, %2\n\ts_nop 0\n\tglobal_load_lds_dwordx4 %1, off\n\ts_mov_b32 m0, %0" : "=&s"(keep) : "v"(gptr), "s"(m) : "memory");
}

template <int WT, class Epi>
DEV void gemm_tile(const bf16_t* __restrict__ A, int lda, const bf16_t* __restrict__ Bt, int ldb, int K, unsigned char* lds, const Epi& epi) {
    constexpr int FI = WT / 16;
    constexpr int OPB = 2 * WT * 128;
    constexpr int STB = 2 * OPB;
    int tid = threadIdx.x & 255; asm volatile("" : "+v"(tid)); const int lane = tid & 63, wid = tid >> 6;
    const int wr = wid >> 1, wc = wid & 1, fr = lane & 15, fq = lane >> 4;
    f32x4 acc[FI][FI];
#pragma unroll
    for (int i = 0; i < FI; ++i)
#pragma unroll
        for (int j = 0; j < FI; ++j) acc[i][j] = (f32x4){0.f, 0.f, 0.f, 0.f};
    const int lrow = tid >> 3, lcs = (tid & 7) ^ (lrow & 7);
    const bf16_t* ap = A + (size_t)lrow * lda + lcs * 8;
    const bf16_t* bp = Bt + (size_t)lrow * ldb + lcs * 8;
    const unsigned l3a = (unsigned)(size_t)(LAS unsigned char*)lds;
    const int nk = K >> 6;
#define GLDS_STAGE(st, kt_) do { \
        _Pragma("unroll") for (int i_ = 0; i_ < FI; ++i_) { \
            glds16(ap + (size_t)(32 * i_) * lda + (kt_) * 64, l3a + (st) + tid * 16 + i_ * 4096); \
            glds16(bp + (size_t)(32 * i_) * ldb + (kt_) * 64, l3a + (st) + OPB + tid * 16 + i_ * 4096); } } while (0)
    GLDS_STAGE(0, 0);
    const int aoff = (wr * WT + fr) * 128, boff = OPB + (wc * WT + fr) * 128, sw = fr & 7;
    for (int kt = 0; kt < nk; ++kt) {
        const int cur = (kt & 1) * STB;
        asm volatile("s_waitcnt vmcnt(0)" ::: "memory");
        __syncthreads();
        if (kt + 1 < nk) GLDS_STAGE(cur ^ STB, kt + 1);
#pragma unroll
        for (int kh = 0; kh < 2; ++kh) {
            bf16x8 af[FI], bfr[FI];
            const int ch = ((kh * 4 + fq) ^ sw) << 4;
#pragma unroll
            for (int i = 0; i < FI; ++i) { af[i] = *(const bf16x8*)(lds + cur + aoff + i * 2048 + ch); bfr[i] = *(const bf16x8*)(lds + cur + boff + i * 2048 + ch); }
#pragma unroll
            for (int mi = 0; mi < FI; ++mi)
#pragma unroll
                for (int ni = 0; ni < FI; ++ni) acc[mi][ni] = __builtin_amdgcn_mfma_f32_16x16x32_bf16(bfr[ni], af[mi], acc[mi][ni], 0, 0, 0);
        }
    }
#undef GLDS_STAGE
    __syncthreads();
#pragma unroll
    for (int mi = 0; mi < FI; ++mi)
#pragma unroll
        for (int ni = 0; ni < FI; ++ni) epi(wr * WT + mi * 16 + fr, wc * WT + ni * 16 + fq * 4, acc[mi][ni]);
}

template <class Epi>
DEV void gemm256_tile(const bf16_t* __restrict__ A, int lda, const bf16_t* __restrict__ Bt, int ldb, int K, unsigned char* lds, const Epi& epi) {
    int tid = threadIdx.x; asm volatile("" : "+v"(tid)); const int lane = tid & 63, wid = tid >> 6;
    const int wr = wid >> 2, wc = wid & 3, fr = lane & 15, fq = lane >> 4;
    f32x4 acc[8][4];
#pragma unroll
    for (int i = 0; i < 8; ++i)
#pragma unroll
        for (int j = 0; j < 4; ++j) acc[i][j] = (f32x4){0.f, 0.f, 0.f, 0.f};
    const int lrow = tid >> 3, lcs = (tid & 7) ^ (lrow & 7);
    const bf16_t* ap = A + (size_t)lrow * lda + lcs * 8;
    const bf16_t* bp = Bt + (size_t)lrow * ldb + lcs * 8;
    const unsigned l3a = (unsigned)(size_t)(LAS unsigned char*)lds;
    const int nk = K >> 6;
#define GLDS_STAGE(st, kt_) do { \
        _Pragma("unroll") for (int i_ = 0; i_ < 4; ++i_) { \
            glds16(ap + (size_t)(64 * i_) * lda + (kt_) * 64, l3a + (st) + tid * 16 + i_ * 8192); \
            glds16(bp + (size_t)(64 * i_) * ldb + (kt_) * 64, l3a + (st) + 32768 + tid * 16 + i_ * 8192); } } while (0)
    GLDS_STAGE(0, 0);
    const int aoff = (wr * 128 + fr) * 128, boff = 32768 + (wc * 64 + fr) * 128, sw = fr & 7;
    for (int kt = 0; kt < nk; ++kt) {
        const int cur = (kt & 1) * 65536;
        asm volatile("s_waitcnt vmcnt(0)" ::: "memory");
        __syncthreads();
        if (kt + 1 < nk) GLDS_STAGE(cur ^ 65536, kt + 1);
#pragma unroll
        for (int kh = 0; kh < 2; ++kh) {
            bf16x8 af[8], bfr[4];
            const int ch = ((kh * 4 + fq) ^ sw) << 4;
#pragma unroll
            for (int i = 0; i < 8; ++i) af[i] = *(const bf16x8*)(lds + cur + aoff + i * 2048 + ch);
#pragma unroll
            for (int i = 0; i < 4; ++i) bfr[i] = *(const bf16x8*)(lds + cur + boff + i * 2048 + ch);
#pragma unroll
            for (int mi = 0; mi < 8; ++mi)
#pragma unroll
                for (int ni = 0; ni < 4; ++ni) acc[mi][ni] = __builtin_amdgcn_mfma_f32_16x16x32_bf16(bfr[ni], af[mi], acc[mi][ni], 0, 0, 0);
        }
    }
#undef GLDS_STAGE
    __syncthreads();
#pragma unroll
    for (int mi = 0; mi < 8; ++mi)
#pragma unroll
        for (int ni = 0; ni < 4; ++ni) epi(wr * 128 + mi * 16 + fr, wc * 64 + ni * 16 + fq * 4, acc[mi][ni]);
}

DEV void ab_rows16(const bf16_t* __restrict__ h, const bf16_t* __restrict__ wab, float* __restrict__ ab, int rt, int lane) {
    const int fr = lane & 15, fq = lane >> 4;
    const bf16_t* ap = h + (size_t)(rt * 16 + fr) * LDB + fq * 8;
    const bf16_t* bp = wab + (size_t)fr * LDB + fq * 8;
    f32x4 acc = {0.f, 0.f, 0.f, 0.f};
#pragma unroll 8
    for (int s = 0; s < 64; ++s) {
        const bf16x8 a = *(const bf16x8*)(ap + s * 32), b = *(const bf16x8*)(bp + s * 32);
        acc = __builtin_amdgcn_mfma_f32_16x16x32_bf16(b, a, acc, 0, 0, 0);
    }
    *(f32x4*)(ab + (size_t)(rt * 16 + fr) * 16 + fq * 4) = acc;
}

DEV void tile_map(int L, int nM, int nN, int& pm, int& pn) {
    const int T = nM * nN, q = T >> 3, r = T & 7, xcd = L & 7, off = L >> 3;
    const int w = (xcd < r ? xcd * (q + 1) : r * (q + 1) + (xcd - r) * q) + off;
    const int nig = 8 * nN, gid = w / nig, fm = gid * 8, gsz = (nM - fm) < 8 ? (nM - fm) : 8;
    pm = fm + (w % nig) % gsz; pn = (w % nig) / gsz;
}

struct EpiProj {
    int m0, n0; bf16_t* proj; float* ab; float* out;
    DEV void operator()(int r, int c, f32x4 v) const {
        const int row = m0 + r, col = n0 + c;
        if (col < NPJ) {
            store_bf4(proj + (size_t)row * NPJ + col, v);
            const bool isconv = col < 3072, ispool = (col >= C_U && col < C_ZB);
            if (isconv || ispool) {
                if (row < TP) {
                    const int b = row >> 11, t = row & 2047;
                    if (isconv) { if (t >= 2045) *(f32x4*)(out + O_CP + ((size_t)(b * 3 + (t - 2045))) * 3072 + col) = v; }
                    else { if (t >= 2033) *(f32x4*)(out + O_PP + ((size_t)(b * 15 + (t - 2033))) * 1024 + (col - C_U)) = v; }
                } else {
                    const int sb = (row - TP) >> 2, t = (row - TP) & 3;
                    if (isconv) { if (t >= 1) *(f32x4*)(out + O_CS + ((size_t)(sb * 3 + (t - 1))) * 3072 + col) = v; }
                    else *(f32x4*)(out + O_PS + ((size_t)(sb * 15 + 11 + t)) * 1024 + (col - C_U)) = v;
                }
            }
        } else if (col < NPJ + 16) {
            *(f32x4*)(ab + (size_t)row * 16 + (col - NPJ)) = v;
        }
    }
};
struct EpiMKV {
    int m0, n0; bf16_t* mkb; bf16_t* mvt; float* out;
    DEV void operator()(int r, int c, f32x4 v) const {
        const int row = m0 + r, col = n0 + c;
        if (col < D) {
            *(f32x4*)(out + O_MK + (size_t)row * D + col) = v;
            store_bf4(mkb + (size_t)row * LDB + col, v);
        } else {
            const int cc = col - D, b = row >> 8, m = row & 255;
            *(f32x4*)(out + O_MV + (size_t)row * D + cc) = v;
            bf16_t* p = mvt + ((size_t)b * D + cc) * LDM + m;
            p[0] = f2bf(v[0]); p[LDM] = f2bf(v[1]); p[2 * LDM] = f2bf(v[2]); p[3 * LDM] = f2bf(v[3]);
        }
    }
};
struct EpiPool {
    int m0, n0; const bf16_t* proj; const float* scale; bf16_t* mix;
    DEV void operator()(int r, int c, f32x4 v) const {
        const int row = m0 + r, col = n0 + c;
        const uint2 z = *(const uint2*)(proj + (size_t)row * NPJ + C_ZB + col);
        const f32x4 s = *(const f32x4*)(scale + col);
        f32x4 o;
        o[0] = v[0] * s[0] * silu_f(bflo(z.x)); o[1] = v[1] * s[1] * silu_f(bfhi(z.x));
        o[2] = v[2] * s[2] * silu_f(bflo(z.y)); o[3] = v[3] * s[3] * silu_f(bfhi(z.y));
        store_bf4(mix + (size_t)row * LDB + 1024 + col, o);
    }
};
struct EpiResid {
    const float* res; float* dst;
    DEV void operator()(int r, int c, f32x4 v) const {
        const f32x4 x = *(const f32x4*)(res + (size_t)r * D + c);
        *(f32x4*)(dst + (size_t)r * D + c) = x + v;
    }
};
struct EpiBf {
    bf16_t* dst; int ld;
    DEV void operator()(int r, int c, f32x4 v) const { store_bf4(dst + (size_t)r * ld + c, v); }
};
struct EpiF32s {
    float* dst; int ld; float s;
    DEV void operator()(int r, int c, f32x4 v) const { *(f32x4*)(dst + (size_t)r * ld + c) = v * s; }
};

DEV int win_srccol(int n) { return n < 4096 ? n : (n < 6144 ? n + 16 : (n < 6160 ? 4096 + (n - 6144) : -1)); }
DEV void transpose_tile(const float* __restrict__ src, int ld, int srccol0, bool remap, int k0, bf16_t* __restrict__ dstrow0, int ldd, float* tile) {
    int tid = threadIdx.x & 255; asm volatile("" : "+v"(tid));
    const int tx = tid & 63, ty = tid >> 6;
    const int sc = remap ? win_srccol(srccol0 + tx) : (srccol0 + tx);
#pragma unroll 4
    for (int i = 0; i < 16; ++i) { const int k = ty + 4 * i; tile[k * 65 + tx] = sc >= 0 ? src[(size_t)(k0 + k) * ld + sc] : 0.f; }
    __syncthreads();
    const int c2 = tid & 31, rr = tid >> 5;
#pragma unroll
    for (int i = 0; i < 8; ++i) { const int r = rr + 8 * i; *(unsigned*)(dstrow0 + (size_t)r * ldd + k0 + 2 * c2) = cvt_pk_bf16(tile[(2 * c2) * 65 + r], tile[(2 * c2 + 1) * 65 + r]); }
    __syncthreads();
}
DEV void rmsnorm_row_bf16(const float* __restrict__ x, const float* __restrict__ g, bf16_t* __restrict__ y, int lane) {
    f32x4 v[8]; float ss = 0.f;
#pragma unroll
    for (int i = 0; i < 8; ++i) { v[i] = ((const f32x4*)x)[i * 64 + lane]; ss += v[i][0] * v[i][0] + v[i][1] * v[i][1] + v[i][2] * v[i][2] + v[i][3] * v[i][3]; }
    ss = wave_sum(ss);
    const float rs = rsqrtf(ss * (1.f / 2048.f) + EPS);
#pragma unroll
    for (int i = 0; i < 8; ++i) { const f32x4 gg = ((const f32x4*)g)[i * 64 + lane]; store_bf4(y + (size_t)(i * 64 + lane) * 4, v[i] * rs * gg); }
}
DEV void rmsnorm_row_f32(const float* __restrict__ x, const float* __restrict__ g, float* __restrict__ y, int lane) {
    f32x4 v[8]; float ss = 0.f;
#pragma unroll
    for (int i = 0; i < 8; ++i) { v[i] = ((const f32x4*)x)[i * 64 + lane]; ss += v[i][0] * v[i][0] + v[i][1] * v[i][1] + v[i][2] * v[i][2] + v[i][3] * v[i][3]; }
    ss = wave_sum(ss);
    const float rs = rsqrtf(ss * (1.f / 2048.f) + EPS);
#pragma unroll
    for (int i = 0; i < 8; ++i) { const f32x4 gg = ((const f32x4*)g)[i * 64 + lane]; ((f32x4*)y)[i * 64 + lane] = v[i] * rs * gg; }
}

constexpr int QS = 136;
DEV void gdn_prep_chunk(const Params& p, int item, unsigned char* lds) {
    int tid = threadIdx.x & 255; asm volatile("" : "+v"(tid)); const int lane = tid & 63, wid = tid >> 6;
    const int c = item & 31, h = (item >> 5) & 7, b = item >> 8;
    const int row0 = b * SEQ + c * 64;
    const bf16_t* proj = (const bf16_t*)(p.ws + WS_PROJ);
    const float* ab = (const float*)(p.ws + WS_AB);
    bf16_t* qs = (bf16_t*)lds; bf16_t* ks = qs + 64 * QS; bf16_t* vs = ks + 64 * QS;
    float* lowT = (float*)lds;
    float* gcs = (float*)(lds + 3 * 64 * QS * 2);
    float* bts = gcs + 64;
    bf16_t* gW = (bf16_t*)(p.ws + WS_GW) + (size_t)item * 8192;
    bf16_t* gQ = (bf16_t*)(p.ws + WS_GQ) + (size_t)item * 8192;
    bf16_t* gKT = (bf16_t*)(p.ws + WS_GKT) + (size_t)item * 8192;
    bf16_t* gA = (bf16_t*)(p.ws + WS_GA) + (size_t)item * 4096;
    float* gU = (float*)(p.ws + WS_GU) + (size_t)item * 8192;
    float* gE = (float*)(p.ws + WS_GE) + item;

    if (wid == 3) {
        const float a = ab[(size_t)(row0 + lane) * 16 + h], bb = ab[(size_t)(row0 + lane) * 16 + 8 + h];
        const float xx = a + p.in[12][h];
        const float sp = xx > 20.f ? xx : log1pf(__expf(xx));
        float s = -__expf(p.in[11][h]) * sp;
#pragma unroll
        for (int d = 1; d < 64; d <<= 1) { const float t = __shfl_up(s, d); if (lane >= d) s += t; }
        gcs[lane] = s; bts[lane] = 1.f / (1.f + __expf(-bb));
    } else {
        const int mat = wid, rg = lane >> 4, cv = lane & 15;
        const int colg = mat * 1024 + h * 128 + cv * 8;
        const float* cw = p.in[10];
        float w[4][8];
#pragma unroll
        for (int j = 0; j < 4; ++j) { const f32x4 w0 = *(const f32x4*)(cw + j * 3072 + colg), w1 = *(const f32x4*)(cw + j * 3072 + colg + 4);
            w[j][0] = w0[0]; w[j][1] = w0[1]; w[j][2] = w0[2]; w[j][3] = w0[3]; w[j][4] = w1[0]; w[j][5] = w1[1]; w[j][6] = w1[2]; w[j][7] = w1[3]; }
        const int tl0 = rg * 16;
        uint4 raw[19];
#pragma unroll
        for (int i = 0; i < 19; ++i) {
            const int tl = tl0 - 3 + i;
            if (c * 64 + tl >= 0) raw[i] = *(const uint4*)(proj + (size_t)(row0 + tl) * NPJ + colg);
            else raw[i] = make_uint4(0u, 0u, 0u, 0u);
        }
        bf16_t* dst = (mat == 0 ? qs : (mat == 1 ? ks : vs));
#pragma unroll
        for (int r = 0; r < 16; ++r) {
            float y[8]; float ss = 0.f;
#pragma unroll
            for (int e = 0; e < 8; ++e) {
                float a = 0.f;
#pragma unroll
                for (int j = 0; j < 4; ++j) {
                    const uint4 u = raw[r + j];
                    const unsigned wd = (e < 2 ? u.x : (e < 4 ? u.y : (e < 6 ? u.z : u.w)));
                    const float xv = (e & 1) ? bfhi(wd) : bflo(wd);
                    a += w[j][e] * xv;
                }
                y[e] = silu_f(a); ss += y[e] * y[e];
            }
            if (mat < 2) {
                ss += __shfl_xor(ss, 1); ss += __shfl_xor(ss, 2); ss += __shfl_xor(ss, 4); ss += __shfl_xor(ss, 8);
                float inv = rsqrtf(ss + EPS); if (mat == 0) inv *= 0.08838834764831845f;
#pragma unroll
                for (int e = 0; e < 8; ++e) y[e] *= inv;
            }
            uint4 o; o.x = cvt_pk_bf16(y[0], y[1]); o.y = cvt_pk_bf16(y[2], y[3]); o.z = cvt_pk_bf16(y[4], y[5]); o.w = cvt_pk_bf16(y[6], y[7]);
            *(uint4*)(dst + (tl0 + r) * QS + cv * 8) = o;
        }
    }
    __syncthreads();
    {
        const float glast = gcs[63];
        if (tid == 0) *gE = __expf(glast);
#pragma unroll
        for (int i = 0; i < 4; ++i) {
            const int ci = tid + 256 * i, t = ci >> 4, cc = (ci & 15) * 8;
            const uint4 u = *(const uint4*)(qs + t * QS + cc);
            const float e = __expf(gcs[t]);
            uint4 o; o.x = cvt_pk_bf16(bflo(u.x) * e, bfhi(u.x) * e); o.y = cvt_pk_bf16(bflo(u.y) * e, bfhi(u.y) * e);
            o.z = cvt_pk_bf16(bflo(u.z) * e, bfhi(u.z) * e); o.w = cvt_pk_bf16(bflo(u.w) * e, bfhi(u.w) * e);
            *(uint4*)(gQ + t * 128 + cc) = o;
        }
        const float dk = __expf(glast - gcs[lane]);
#pragma unroll 8
        for (int i = 0; i < 32; ++i) { const int d = wid * 32 + i; gKT[d * 64 + lane] = f2bf(bf2f(ks[lane * QS + d]) * dk); }
    }
    f32x4 kk[4], qk[4];
    {
        const int fr = lane & 15, fq = lane >> 4, it = wid;
        bf16x8 kfi[4], qfi[4];
#pragma unroll
        for (int s = 0; s < 4; ++s) { kfi[s] = *(const bf16x8*)(ks + (it * 16 + fr) * QS + s * 32 + fq * 8); qfi[s] = *(const bf16x8*)(qs + (it * 16 + fr) * QS + s * 32 + fq * 8); }
#pragma unroll
        for (int jt = 0; jt < 4; ++jt) {
            kk[jt] = (f32x4){0.f, 0.f, 0.f, 0.f}; qk[jt] = (f32x4){0.f, 0.f, 0.f, 0.f};
#pragma unroll
            for (int s = 0; s < 4; ++s) {
                const bf16x8 kfj = *(const bf16x8*)(ks + (jt * 16 + fr) * QS + s * 32 + fq * 8);
                kk[jt] = __builtin_amdgcn_mfma_f32_16x16x32_bf16(kfi[s], kfj, kk[jt], 0, 0, 0);
                qk[jt] = __builtin_amdgcn_mfma_f32_16x16x32_bf16(kfj, qfi[s], qk[jt], 0, 0, 0);
            }
        }
    }
    __syncthreads();
    {
        const int fr = lane & 15, fq = lane >> 4, it = wid;
#pragma unroll
        for (int jt = 0; jt < 4; ++jt) {
            const int j = jt * 16 + fr; const float gj = gcs[j];
            f32x4 lv;
#pragma unroll
            for (int e = 0; e < 4; ++e) { const int i = it * 16 + fq * 4 + e; lv[e] = (i > j) ? bts[i] * kk[jt][e] * __expf(gcs[i] - gj) : 0.f; }
            *(f32x4*)(lowT + j * 68 + it * 16 + fq * 4) = lv;
            const int i2 = it * 16 + fr; const float gi = gcs[i2];
            f32x4 av;
#pragma unroll
            for (int e = 0; e < 4; ++e) { const int j2 = jt * 16 + fq * 4 + e; av[e] = (i2 >= j2) ? qk[jt][e] * __expf(gi - gcs[j2]) : 0.f; }
            store_bf4(gA + i2 * 64 + jt * 16 + fq * 4, av);
        }
    }
    __syncthreads();
    {
        const int cc = tid & 127; const bool isw = tid >= 128;
        bf16_t* src = isw ? ks : vs;
#pragma unroll 1
        for (int ib = 0; ib < 4; ++ib) {
            float acc[16];
#pragma unroll
            for (int r = 0; r < 16; ++r) { const int j = ib * 16 + r; float f = bts[j]; if (isw) f *= __expf(gcs[j]); acc[r] = f * bf2f(src[j * QS + cc]); }
            const float* lrow = lowT + ib * 16;
#pragma unroll 2
            for (int j = 0; j < ib * 16; ++j) {
                const float xj = bf2f(src[j * QS + cc]);
                const f32x4 l0 = *(const f32x4*)(lrow + j * 68), l1 = *(const f32x4*)(lrow + j * 68 + 4), l2 = *(const f32x4*)(lrow + j * 68 + 8), l3 = *(const f32x4*)(lrow + j * 68 + 12);
#pragma unroll
                for (int e = 0; e < 4; ++e) { acc[e] -= l0[e] * xj; acc[4 + e] -= l1[e] * xj; acc[8 + e] -= l2[e] * xj; acc[12 + e] -= l3[e] * xj; }
            }
#pragma unroll 1
            for (int r2 = 0; r2 < 15; ++r2) {
                float xj = acc[0];
#pragma unroll
                for (int r = 1; r < 16; ++r) xj = (r2 == r) ? acc[r] : xj;
                const float* lp = lrow + (ib * 16 + r2) * 68;
                const f32x4 l0 = *(const f32x4*)(lp), l1 = *(const f32x4*)(lp + 4), l2 = *(const f32x4*)(lp + 8), l3 = *(const f32x4*)(lp + 12);
#pragma unroll
                for (int e = 0; e < 4; ++e) { acc[e] -= l0[e] * xj; acc[4 + e] -= l1[e] * xj; acc[8 + e] -= l2[e] * xj; acc[12 + e] -= l3[e] * xj; }
            }
#pragma unroll
            for (int r = 0; r < 16; ++r) {
                const int j = ib * 16 + r; const bf16_t xb = f2bf(acc[r]);
                src[j * QS + cc] = xb;
                if (isw) gW[j * 128 + cc] = xb; else gU[j * 128 + cc] = acc[r];
            }
        }
    }
    __syncthreads();
}

#define LDS_BARRIER() do { asm volatile("s_waitcnt lgkmcnt(0)" ::: "memory"); __builtin_amdgcn_s_barrier(); asm volatile("" ::: "memory"); } while (0)
DEV void gdn_scan_item(const Params& p, int item, unsigned char* lds) {
    int tid = threadIdx.x & 255; asm volatile("" : "+v"(tid)); const int lane = tid & 63, w = tid >> 6, fr = lane & 15, fq = lane >> 4;
    const int s = item & 7, bh = item >> 3;
    const int b = bh >> 3, h = bh & 7;
    bf16_t* ST = (bf16_t*)lds;
    bf16_t* VT = ST + 16 * QS;
    const bf16_t* gW = (const bf16_t*)(p.ws + WS_GW) + (size_t)bh * 32 * 8192;
    const bf16_t* gQ = (const bf16_t*)(p.ws + WS_GQ) + (size_t)bh * 32 * 8192;
    const bf16_t* gKT = (const bf16_t*)(p.ws + WS_GKT) + (size_t)bh * 32 * 8192;
    const bf16_t* gA = (const bf16_t*)(p.ws + WS_GA) + (size_t)bh * 32 * 4096;
    const float* gU = (const float*)(p.ws + WS_GU) + (size_t)bh * 32 * 8192;
    const float* gE = (const float*)(p.ws + WS_GE) + bh * 32;
    float* obuf = (float*)(p.ws + WS_O);
    f32x4 S0 = {0.f, 0.f, 0.f, 0.f}, S1 = {0.f, 0.f, 0.f, 0.f};
    for (int i = tid; i < 16 * QS / 2; i += 256) ((unsigned*)ST)[i] = 0u;
    bf16x8 fw[4], fqg[4], fa[2], fk0[2], fk1[2]; f32x4 uu; float eg;
#define SCAN_LOAD(ch) do { \
        const bf16_t* W_ = gW + (size_t)(ch) * 8192 + (w * 16 + fr) * 128 + fq * 8; const bf16_t* Q_ = gQ + (size_t)(ch) * 8192 + (w * 16 + fr) * 128 + fq * 8; \
        _Pragma("unroll") for (int k_ = 0; k_ < 4; ++k_) { fw[k_] = *(const bf16x8*)(W_ + k_ * 32); fqg[k_] = *(const bf16x8*)(Q_ + k_ * 32); } \
        const bf16_t* A_ = gA + (size_t)(ch) * 4096 + (w * 16 + fr) * 64 + fq * 8; fa[0] = *(const bf16x8*)(A_); fa[1] = *(const bf16x8*)(A_ + 32); \
        const bf16_t* K_ = gKT + (size_t)(ch) * 8192 + (w * 32 + fr) * 64 + fq * 8; fk0[0] = *(const bf16x8*)(K_); fk0[1] = *(const bf16x8*)(K_ + 32); \
        fk1[0] = *(const bf16x8*)(K_ + 16 * 64); fk1[1] = *(const bf16x8*)(K_ + 16 * 64 + 32); \
        const float* U_ = gU + (size_t)(ch) * 8192 + (w * 16 + fq * 4) * 128 + s * 16 + fr; uu[0] = U_[0]; uu[1] = U_[128]; uu[2] = U_[256]; uu[3] = U_[384]; \
        eg = gE[ch]; } while (0)
    SCAN_LOAD(0);
    __syncthreads();
    for (int ch = 0; ch < 32; ++ch) {
        bf16x8 cw[4], cq[4], ca[2], ck0[2], ck1[2]; f32x4 cu = uu; const float ceg = eg;
#pragma unroll
        for (int k = 0; k < 4; ++k) { cw[k] = fw[k]; cq[k] = fqg[k]; }
        ca[0] = fa[0]; ca[1] = fa[1]; ck0[0] = fk0[0]; ck0[1] = fk0[1]; ck1[0] = fk1[0]; ck1[1] = fk1[1];
        if (ch + 1 < 32) SCAN_LOAD(ch + 1);
        f32x4 ws_ = {0.f, 0.f, 0.f, 0.f}, oo = {0.f, 0.f, 0.f, 0.f};
#pragma unroll
        for (int k = 0; k < 4; ++k) {
            const bf16x8 sf = *(const bf16x8*)(ST + fr * QS + k * 32 + fq * 8);
            ws_ = __builtin_amdgcn_mfma_f32_16x16x32_bf16(cw[k], sf, ws_, 0, 0, 0);
            oo = __builtin_amdgcn_mfma_f32_16x16x32_bf16(cq[k], sf, oo, 0, 0, 0);
        }
        const f32x4 vn = cu - ws_;
        store_bf4(VT + fr * 72 + w * 16 + fq * 4, vn);
        LDS_BARRIER();
        const bf16x8 v0 = *(const bf16x8*)(VT + fr * 72 + fq * 8), v1 = *(const bf16x8*)(VT + fr * 72 + 32 + fq * 8);
        oo = __builtin_amdgcn_mfma_f32_16x16x32_bf16(ca[0], v0, oo, 0, 0, 0);
        oo = __builtin_amdgcn_mfma_f32_16x16x32_bf16(ca[1], v1, oo, 0, 0, 0);
        S0 = S0 * ceg; S1 = S1 * ceg;
        S0 = __builtin_amdgcn_mfma_f32_16x16x32_bf16(ck0[0], v0, S0, 0, 0, 0);
        S0 = __builtin_amdgcn_mfma_f32_16x16x32_bf16(ck0[1], v1, S0, 0, 0, 0);
        S1 = __builtin_amdgcn_mfma_f32_16x16x32_bf16(ck1[0], v0, S1, 0, 0, 0);
        S1 = __builtin_amdgcn_mfma_f32_16x16x32_bf16(ck1[1], v1, S1, 0, 0, 0);
        store_bf4(ST + fr * QS + w * 32 + fq * 4, S0);
        store_bf4(ST + fr * QS + w * 32 + 16 + fq * 4, S1);
        {
            float* op = obuf + (size_t)(b * SEQ + ch * 64 + w * 16 + fq * 4) * 1024 + h * 128 + s * 16 + fr;
            op[0] = oo[0]; op[1024] = oo[1]; op[2048] = oo[2]; op[3072] = oo[3];
        }
        LDS_BARRIER();
    }
#undef SCAN_LOAD
    {
        float* dp = p.out + O_DP + ((size_t)bh * 128 + w * 32 + fq * 4) * 128 + s * 16 + fr;
#pragma unroll
        for (int e = 0; e < 4; ++e) { dp[e * 128] = S0[e]; dp[(16 + e) * 128] = S1[e]; }
    }
    __syncthreads();
}

DEV void gdn_sample_item(const Params& p, int item, unsigned char* lds) {
    int tid = threadIdx.x & 255; asm volatile("" : "+v"(tid)); const int lane = tid & 63, wid = tid >> 6;
    const int sb = item >> 3, h = item & 7, half = tid >> 7, c = tid & 127;
    const int r0 = TP + sb * 4;
    const bf16_t* proj = (const bf16_t*)(p.ws + WS_PROJ);
    const float* ab = (const float*)(p.ws + WS_AB);
    float* ksh = (float*)lds;
    float* qsh = ksh + 512;
    float* red = qsh + 512;
    float* red2 = red + 32;
    float* part = red2 + 32;
    float* opart = part + 1024;
    float qv[4], kv[4], vv[4];
#pragma unroll
    for (int m = 0; m < 3; ++m) {
        const int col = m * 1024 + h * 128 + c;
        float x[7], wj[4];
#pragma unroll
        for (int j = 0; j < 3; ++j) x[j] = p.in[6][((size_t)sb * 3 + j) * 3072 + col];
#pragma unroll
        for (int t = 0; t < 4; ++t) x[3 + t] = bf2f(proj[(size_t)(r0 + t) * NPJ + col]);
#pragma unroll
        for (int j = 0; j < 4; ++j) wj[j] = p.in[10][j * 3072 + col];
#pragma unroll
        for (int t = 0; t < 4; ++t) {
            const float y = silu_f(wj[0] * x[t] + wj[1] * x[t + 1] + wj[2] * x[t + 2] + wj[3] * x[t + 3]);
            if (m == 0) qv[t] = y; else if (m == 1) kv[t] = y; else vv[t] = y;
        }
    }
#pragma unroll
    for (int t = 0; t < 4; ++t) {
        const float a = wave_sum(qv[t] * qv[t]), bq = wave_sum(kv[t] * kv[t]);
        if (lane == 0) { red[wid * 8 + t] = a; red[wid * 8 + 4 + t] = bq; }
    }
    __syncthreads();
    float gt[4], bt[4];
#pragma unroll
    for (int t = 0; t < 4; ++t) {
        const float sq = red[(2 * half) * 8 + t] + red[(2 * half + 1) * 8 + t], sk = red[(2 * half) * 8 + 4 + t] + red[(2 * half + 1) * 8 + 4 + t];
        if (half == 0) {
            qsh[t * 128 + c] = qv[t] * rsqrtf(sq + EPS) * 0.08838834764831845f;
            ksh[t * 128 + c] = kv[t] * rsqrtf(sk + EPS);
        }
        const float a = ab[(size_t)(r0 + t) * 16 + h], bb = ab[(size_t)(r0 + t) * 16 + 8 + h];
        const float xx = a + p.in[12][h];
        const float sp = xx > 20.f ? xx : log1pf(__expf(xx));
        gt[t] = __expf(-__expf(p.in[11][h]) * sp);
        bt[t] = 1.f / (1.f + __expf(-bb));
    }
    float S[64];
    const float* sp0 = p.in[5] + ((size_t)(sb * 8 + h) * 128 + half * 64) * 128 + c;
#pragma unroll
    for (int d = 0; d < 64; ++d) S[d] = sp0[(size_t)d * 128];
    __syncthreads();
    float ot[4];
#pragma unroll
    for (int t = 0; t < 4; ++t) {
        const float* kk = ksh + t * 128 + half * 64; const float* qq = qsh + t * 128 + half * 64;
        float kS = 0.f;
#pragma unroll
        for (int d4 = 0; d4 < 16; ++d4) { const f32x4 k4 = *(const f32x4*)(kk + d4 * 4); kS += k4[0] * S[d4 * 4] + k4[1] * S[d4 * 4 + 1] + k4[2] * S[d4 * 4 + 2] + k4[3] * S[d4 * 4 + 3]; }
        part[(t * 2 + half) * 128 + c] = kS;
        __syncthreads();
        kS = part[(t * 2) * 128 + c] + part[(t * 2 + 1) * 128 + c];
        const float eg = gt[t], dl = bt[t] * (vv[t] - eg * kS);
        float o = 0.f;
#pragma unroll
        for (int d4 = 0; d4 < 16; ++d4) {
            const f32x4 k4 = *(const f32x4*)(kk + d4 * 4), q4 = *(const f32x4*)(qq + d4 * 4);
#pragma unroll
            for (int e = 0; e < 4; ++e) { const float sn = eg * S[d4 * 4 + e] + k4[e] * dl; S[d4 * 4 + e] = sn; o += q4[e] * sn; }
        }
        ot[t] = o;
        if (half == 1) opart[t * 128 + c] = o;
    }
    float* dso = p.out + O_DS + ((size_t)(sb * 8 + h) * 128 + half * 64) * 128 + c;
#pragma unroll
    for (int d = 0; d < 64; ++d) dso[(size_t)d * 128] = S[d];
    __syncthreads();
    if (half == 0) {
#pragma unroll
        for (int t = 0; t < 4; ++t) { ot[t] += opart[t * 128 + c]; const float a = wave_sum(ot[t] * ot[t]); if (lane == 0) red2[wid * 4 + t] = a; }
    }
    __syncthreads();
    if (half == 0) {
        bf16_t* mix = (bf16_t*)(p.ws + WS_MIX);
        const float gn = p.in[13][c];
#pragma unroll
        for (int t = 0; t < 4; ++t) {
            const float ms = (red2[t] + red2[4 + t]) * (1.f / 128.f);
            const float z = bf2f(proj[(size_t)(r0 + t) * NPJ + C_ZA + h * 128 + c]);
            mix[(size_t)(r0 + t) * LDB + h * 128 + c] = f2bf(ot[t] * rsqrtf(ms + EPS) * gn * silu_f(z));
        }
    }
    __syncthreads();
}

DEV void attn_sample_item(const Params& p, int item, unsigned char* lds) {
    int tid = threadIdx.x & 255; asm volatile("" : "+v"(tid)); const int lane = tid & 63, wid = tid >> 6;
    const int sb = item >> 2, hd = item & 3;
    float* qs = (float*)lds;
    float* pm = qs + 2048;
    float* red = pm + 1024;
    const bf16_t* qx = (const bf16_t*)(p.ws + WS_QX);
    for (int i = tid; i < 2048; i += 256) { const int t = i >> 9, d = i & 511; qs[i] = bf2f(qx[(size_t)(TP + sb * 4 + t) * LDB + hd * 512 + d]) * 0.04419417382415922f; }
    __syncthreads();
    const float* Kc = p.in[3] + ((size_t)sb * 256) * D + hd * 512;
    const float* Vc = p.in[4] + ((size_t)sb * 256) * D + hd * 512;
    {
        const int sub = lane >> 4, l16 = lane & 15;
        for (int it = 0; it < 16; ++it) {
            const int m = wid * 64 + it * 4 + sub;
            const float* kr = Kc + (size_t)m * D;
            f32x4 kv[8];
#pragma unroll
            for (int i = 0; i < 8; ++i) kv[i] = *(const f32x4*)(kr + (i * 16 + l16) * 4);
            float a0 = 0.f, a1 = 0.f, a2 = 0.f, a3 = 0.f;
#pragma unroll
            for (int i = 0; i < 8; ++i) {
                const int d = (i * 16 + l16) * 4;
                const f32x4 q0 = *(const f32x4*)(qs + d), q1 = *(const f32x4*)(qs + 512 + d), q2 = *(const f32x4*)(qs + 1024 + d), q3 = *(const f32x4*)(qs + 1536 + d);
                a0 += kv[i][0] * q0[0] + kv[i][1] * q0[1] + kv[i][2] * q0[2] + kv[i][3] * q0[3];
                a1 += kv[i][0] * q1[0] + kv[i][1] * q1[1] + kv[i][2] * q1[2] + kv[i][3] * q1[3];
                a2 += kv[i][0] * q2[0] + kv[i][1] * q2[1] + kv[i][2] * q2[2] + kv[i][3] * q2[3];
                a3 += kv[i][0] * q3[0] + kv[i][1] * q3[1] + kv[i][2] * q3[2] + kv[i][3] * q3[3];
            }
#pragma unroll
            for (int o = 1; o < 16; o <<= 1) { a0 += __shfl_xor(a0, o); a1 += __shfl_xor(a1, o); a2 += __shfl_xor(a2, o); a3 += __shfl_xor(a3, o); }
            if (l16 == 0) *(f32x4*)(pm + m * 4) = (f32x4){a0, a1, a2, a3};
        }
    }
    __syncthreads();
    {
        const int t = wid;
        float v[4]; float mx = -3.0e38f;
#pragma unroll
        for (int i = 0; i < 4; ++i) { v[i] = pm[(i * 64 + lane) * 4 + t]; mx = fmaxf(mx, v[i]); }
        mx = wave_max(mx);
        float sm = 0.f;
#pragma unroll
        for (int i = 0; i < 4; ++i) { v[i] = __expf(v[i] - mx); sm += v[i]; }
        sm = wave_sum(sm);
        const float inv = 1.f / sm;
#pragma unroll
        for (int i = 0; i < 4; ++i) pm[(i * 64 + lane) * 4 + t] = v[i] * inv;
    }
    __syncthreads();
    {
        f32x4 acc[4][2];
#pragma unroll
        for (int t = 0; t < 4; ++t) { acc[t][0] = (f32x4){0.f, 0.f, 0.f, 0.f}; acc[t][1] = (f32x4){0.f, 0.f, 0.f, 0.f}; }
        for (int m8 = 0; m8 < 8; ++m8) {
            f32x4 va[8], vb[8];
#pragma unroll
            for (int i = 0; i < 8; ++i) { const float* vr = Vc + (size_t)(wid * 64 + m8 * 8 + i) * D; va[i] = *(const f32x4*)(vr + lane * 4); vb[i] = *(const f32x4*)(vr + 256 + lane * 4); }
#pragma unroll
            for (int i = 0; i < 8; ++i) {
                const f32x4 pr = *(const f32x4*)(pm + (wid * 64 + m8 * 8 + i) * 4);
#pragma unroll
                for (int t = 0; t < 4; ++t) { acc[t][0] += va[i] * pr[t]; acc[t][1] += vb[i] * pr[t]; }
            }
        }
#pragma unroll
        for (int t = 0; t < 4; ++t) { *(f32x4*)(red + (wid * 4 + t) * 512 + lane * 4) = acc[t][0]; *(f32x4*)(red + (wid * 4 + t) * 512 + 256 + lane * 4) = acc[t][1]; }
    }
    __syncthreads();
    {
        bf16_t* ctx = (bf16_t*)(p.ws + WS_CTX);
#pragma unroll
        for (int i = 0; i < 2; ++i) {
            const int e = (tid + 256 * i) * 4, t = e >> 9, d = e & 511;
            const f32x4 s = *(const f32x4*)(red + (0 * 4 + t) * 512 + d) + *(const f32x4*)(red + (1 * 4 + t) * 512 + d) + *(const f32x4*)(red + (2 * 4 + t) * 512 + d) + *(const f32x4*)(red + (3 * 4 + t) * 512 + d);
            store_bf4(ctx + (size_t)(TP + sb * 4 + t) * LDB + hd * 512 + d, s);
        }
    }
    __syncthreads();
}

template <int WIN>
DEV void pool_d_prompt(const bf16_t* __restrict__ proj, bf16_t* __restrict__ dpl, int row, int c8) {
    const int tloc = row & 2047;
    uint4 u[WIN];
#pragma unroll
    for (int k = 0; k < WIN; ++k) u[k] = (tloc - k >= 0) ? *(const uint4*)(proj + (size_t)(row - k) * NPJ + C_U + c8) : make_uint4(0u, 0u, 0u, 0u);
    float acc[8] = {0.f, 0.f, 0.f, 0.f, 0.f, 0.f, 0.f, 0.f};
#pragma unroll
    for (int k = 0; k < WIN; ++k) { acc[0] += bflo(u[k].x); acc[1] += bfhi(u[k].x); acc[2] += bflo(u[k].y); acc[3] += bfhi(u[k].y); acc[4] += bflo(u[k].z); acc[5] += bfhi(u[k].z); acc[6] += bflo(u[k].w); acc[7] += bfhi(u[k].w); }
    const float ic = 1.f / (float)min(WIN, tloc + 1);
    uint4 o;
    o.x = cvt_pk_bf16(acc[0] * ic - bflo(u[0].x), acc[1] * ic - bfhi(u[0].x)); o.y = cvt_pk_bf16(acc[2] * ic - bflo(u[0].y), acc[3] * ic - bfhi(u[0].y));
    o.z = cvt_pk_bf16(acc[4] * ic - bflo(u[0].z), acc[5] * ic - bfhi(u[0].z)); o.w = cvt_pk_bf16(acc[6] * ic - bflo(u[0].w), acc[7] * ic - bfhi(u[0].w));
    *(uint4*)(dpl + (size_t)row * LDP + c8) = o;
}

#ifndef REP0
#define REP0 1
#endif
#ifndef REP1
#define REP1 1
#endif
#ifndef REP2
#define REP2 1
#endif
#ifndef REP3
#define REP3 1
#endif
#ifndef REP4
#define REP4 1
#endif
#ifndef REP5
#define REP5 1
#endif
#ifndef REP6
#define REP6 1
#endif
#ifndef REP7
#define REP7 1
#endif
#ifndef REP8
#define REP8 1
#endif
#ifndef REP9
#define REP9 1
#endif
#ifndef REP10
#define REP10 1
#endif
#ifndef REP11
#define REP11 1
#endif
#ifndef REP12
#define REP12 1
#endif
#ifndef NLAUNCH
#define NLAUNCH 1
#endif
#define GRID_BAR() do { if (NLAUNCH == 1) xcd_barrier(bar); } while (0)
#define IN_PH(k) (p.ph_lo <= (k) && (k) < p.ph_hi)
__global__ void __launch_bounds__(512) hymba_fwd(Params p) {
    __shared__ __attribute__((aligned(16))) unsigned char lds[131072];
    __shared__ uint4 xb_words;
    int tid = threadIdx.x; asm volatile("" : "+v"(tid)); const int lane = tid & 63, wid = tid >> 6;
    const int vb = __builtin_amdgcn_readfirstlane(tid >> 8);
    unsigned char* vlds = lds + vb * 65536;
    const int G = gridDim.x, bid = blockIdx.x, VG = 2 * G, vbid = 2 * bid + vb;
    if (tid == 0) xb_words = make_uint4(0u, 0u, 0u, 0u);
    __syncthreads();
    XcdBarrier bar; bar.bar = (unsigned*)(p.ws + WS_BAR); bar.x = 0; bar.st = (volatile LAS unsigned*)&xb_words;
    if (NLAUNCH == 1) bar = xcd_barrier_post((unsigned*)(p.ws + WS_BAR), (volatile LAS unsigned*)&xb_words);
    unsigned char* ws = p.ws;
    bf16_t* Wt_in = (bf16_t*)(ws + WS_WIN); bf16_t* Wt_out = (bf16_t*)(ws + WS_WOUT); bf16_t* Wt_cq = (bf16_t*)(ws + WS_WCQ); bf16_t* Wt_co = (bf16_t*)(ws + WS_WCO);
    bf16_t* Wt_ckv = (bf16_t*)(ws + WS_WCKV); bf16_t* Wt_pool = (bf16_t*)(ws + WS_WPOOL);
    bf16_t* hbuf = (bf16_t*)(ws + WS_H); bf16_t* hm = (bf16_t*)(ws + WS_HM); bf16_t* proj = (bf16_t*)(ws + WS_PROJ); float* ab = (float*)(ws + WS_AB);
    bf16_t* mkb = (bf16_t*)(ws + WS_MKB); bf16_t* mvt = (bf16_t*)(ws + WS_MVT); bf16_t* dpl = (bf16_t*)(ws + WS_DPL); bf16_t* mix = (bf16_t*)(ws + WS_MIX);
    float* x1 = (float*)(ws + WS_X1); bf16_t* qx = (bf16_t*)(ws + WS_QX); float* sc = (float*)(ws + WS_SC); bf16_t* pb = (bf16_t*)(ws + WS_PB);
    bf16_t* ctx = (bf16_t*)(ws + WS_CTX); float* x2 = (float*)(ws + WS_X2); float* obuf = (float*)(ws + WS_O);
#define VLOOP(t, N) for (int t##0_ = 2 * bid, t = min(t##0_ + vb, (N) - 1); t##0_ < (N); t##0_ += VG, t = min(t##0_ + vb, (N) - 1))

    if (IN_PH(0)) {
        const int NT_IN = 98 * 32, NT_SQ = 32 * 32;
        const int total = NT_IN + 5 * NT_SQ + 64;
        VLOOP(t, total) {
            if (t < NT_IN) { const int nt = t >> 5, kt = t & 31; transpose_tile(p.in[9], 6160, nt * 64, true, kt * 64, Wt_in + (size_t)nt * 64 * LDB, LDB, (float*)vlds); }
            else if (t < NT_IN + 5 * NT_SQ) {
                const int u = t - NT_IN, j = u >> 10, v = u & 1023, nt = v >> 5, kt = v & 31;
                const float* src = p.in[j == 0 ? 16 : (j == 1 ? 19 : (j == 2 ? 22 : (j == 3 ? 20 : 21)))];
                bf16_t* dst = j == 0 ? Wt_out : (j == 1 ? Wt_cq : (j == 2 ? Wt_co : (j == 3 ? Wt_ckv : Wt_ckv + (size_t)D * LDB)));
                transpose_tile(src, D, nt * 64, false, kt * 64, dst + (size_t)nt * 64 * LDB, LDB, (float*)vlds);
            } else {
                const int u = t - NT_IN - 5 * NT_SQ, g = u >> 4, v = u & 15, nt = v >> 2, kt = v & 3;
                transpose_tile(p.in[14] + (size_t)g * 65536, 256, nt * 64, false, kt * 64, Wt_pool + ((size_t)g * 256 + nt * 64) * LDM, LDM, (float*)vlds);
            }
        }
        for (int r = bid * 8 + wid; r < TT + 1024; r += G * 8) {
            if (r < TP) rmsnorm_row_bf16(p.in[0] + (size_t)r * D, p.in[8], hbuf + (size_t)r * LDB, lane);
            else if (r < TT) rmsnorm_row_bf16(p.in[1] + (size_t)(r - TP) * D, p.in[8], hbuf + (size_t)r * LDB, lane);
            else rmsnorm_row_bf16(p.in[2] + (size_t)(r - TT) * D, p.in[17], hm + (size_t)(r - TT) * LDB, lane);
        }
    }
    GRID_BAR();
    if (IN_PH(1)) {
        for (int t = bid; t < 32 * 24; t += G) { int nt, mt; tile_map(t, 32, 24, mt, nt);
            EpiProj e{mt * 256, nt * 256, proj, ab, p.out};
            gemm256_tile(hbuf + (size_t)mt * 256 * LDB, LDB, Wt_in + (size_t)nt * 256 * LDB, LDB, D, lds, e);
        }
        VLOOP(t, 4 * 48 + 256) {
            if (t < 192) { const int mt = t & 3, nt = t >> 2;
                EpiProj e{TP + mt * 128, nt * 128, proj, ab, p.out};
                gemm_tile<64>(hbuf + (size_t)(TP + mt * 128) * LDB, LDB, Wt_in + (size_t)nt * 128 * LDB, LDB, D, vlds, e);
            } else { const int u = t - 192, mt = u & 7, nt = u >> 3;
                EpiMKV e{mt * 128, nt * 128, mkb, mvt, p.out};
                gemm_tile<64>(hm + (size_t)mt * 128 * LDB, LDB, Wt_ckv + (size_t)nt * 128 * LDB, LDB, D, vlds, e);
            }
        }
        for (int rt = bid * 8 + wid; rt < TT / 16; rt += G * 8) ab_rows16(hbuf, Wt_in + (size_t)NPJ * LDB, ab, rt, lane);
    }
    GRID_BAR();
    if (IN_PH(2)) {
        VLOOP(t, 1024) gdn_prep_chunk(p, t, vlds);
        for (int i = bid * 512 + tid; i < TP * 128; i += G * 512) {
            const int row = i >> 7, c8 = (i & 127) * 8, g = c8 >> 8;
            if (g == 0) pool_d_prompt<2>(proj, dpl, row, c8); else if (g == 1) pool_d_prompt<4>(proj, dpl, row, c8);
            else if (g == 2) pool_d_prompt<8>(proj, dpl, row, c8); else pool_d_prompt<16>(proj, dpl, row, c8);
        }
        for (int i = TP * 128 + bid * 512 + tid; i < TT * 128; i += G * 512) {
            const int row = i >> 7, c8 = (i & 127) * 8, g = c8 >> 8, win = 2 << g;
            float acc[8] = {0.f, 0.f, 0.f, 0.f, 0.f, 0.f, 0.f, 0.f}, self[8];
            const int tloc = (row - TP) & 3;
            for (int k = 0; k < win; ++k) {
                const int tt = tloc - k;
                if (tt >= 0) {
                    const uint4 u = *(const uint4*)(proj + (size_t)(row - k) * NPJ + C_U + c8);
                    const float f[8] = {bflo(u.x), bfhi(u.x), bflo(u.y), bfhi(u.y), bflo(u.z), bfhi(u.z), bflo(u.w), bfhi(u.w)};
#pragma unroll
                    for (int e = 0; e < 8; ++e) { acc[e] += f[e]; if (k == 0) self[e] = f[e]; }
                } else {
                    const float* sp = p.in[7] + ((size_t)((row - TP) >> 2) * 15 + (15 + tt)) * 1024 + c8;
                    const f32x4 s0 = *(const f32x4*)sp, s1 = *(const f32x4*)(sp + 4);
                    acc[0] += s0[0]; acc[1] += s0[1]; acc[2] += s0[2]; acc[3] += s0[3]; acc[4] += s1[0]; acc[5] += s1[1]; acc[6] += s1[2]; acc[7] += s1[3];
                }
            }
            const float ic = 1.f / (float)win;
            uint4 o; o.x = cvt_pk_bf16(acc[0] * ic - self[0], acc[1] * ic - self[1]); o.y = cvt_pk_bf16(acc[2] * ic - self[2], acc[3] * ic - self[3]);
            o.z = cvt_pk_bf16(acc[4] * ic - self[4], acc[5] * ic - self[5]); o.w = cvt_pk_bf16(acc[6] * ic - self[6], acc[7] * ic - self[7]);
            *(uint4*)(dpl + (size_t)row * LDP + c8) = o;
        }
        for (int i = bid * 512 + tid; i < SB * 11 * 256; i += G * 512) {
            const int c4 = (i & 255) * 4, rr = (i >> 8) % 11, sb = (i >> 8) / 11;
            *(f32x4*)(p.out + O_PS + ((size_t)sb * 15 + rr) * 1024 + c4) = *(const f32x4*)(p.in[7] + ((size_t)sb * 15 + rr + 4) * 1024 + c4);
        }
    }
    GRID_BAR();
    if (IN_PH(3)) {
        const int NSC = 256, NSM = 1024, NPL = 68 * 8;
        const int nsb = G >> 1;
        if (bid < nsb) {
            for (int t0 = 2 * bid; t0 < NSC; t0 += 2 * nsb) gdn_scan_item(p, min(t0 + vb, NSC - 1), vlds);
        } else {
            const int ob = bid - nsb, no = G - nsb;
            for (int t0 = 2 * ob; t0 < NSM; t0 += 2 * no) gdn_sample_item(p, min(t0 + vb, NSM - 1), vlds);
            for (int t0 = 2 * ob; t0 < NPL; t0 += 2 * no) { const int t = min(t0 + vb, NPL - 1); int nt, mt; tile_map(t, 68, 8, mt, nt); const int g = nt >> 1;
                EpiPool e{mt * 128, nt * 128, proj, p.in[15], mix};
                gemm_tile<64>(dpl + (size_t)mt * 128 * LDP + g * 256, LDP, Wt_pool + (size_t)nt * 128 * LDM, LDM, 256, vlds, e);
            }
        }
    }
    GRID_BAR();
    if (IN_PH(4)) {
        for (int i = bid * 512 + tid; i < TP * 8 * 16; i += G * 512) {
            const int l16 = i & 15, rh = i >> 4, h = rh & 7, row = rh >> 3;
            const float* op = obuf + (size_t)row * 1024 + h * 128 + l16 * 8;
            const f32x4 a = *(const f32x4*)op, b4 = *(const f32x4*)(op + 4);
            float ss = a[0] * a[0] + a[1] * a[1] + a[2] * a[2] + a[3] * a[3] + b4[0] * b4[0] + b4[1] * b4[1] + b4[2] * b4[2] + b4[3] * b4[3];
            ss += __shfl_xor(ss, 1); ss += __shfl_xor(ss, 2); ss += __shfl_xor(ss, 4); ss += __shfl_xor(ss, 8);
            const float rs = rsqrtf(ss * (1.f / 128.f) + EPS);
            const f32x4 g0 = *(const f32x4*)(p.in[13] + l16 * 8), g1 = *(const f32x4*)(p.in[13] + l16 * 8 + 4);
            const uint4 z = *(const uint4*)(proj + (size_t)row * NPJ + C_ZA + h * 128 + l16 * 8);
            uint4 o;
            o.x = cvt_pk_bf16(a[0] * rs * g0[0] * silu_f(bflo(z.x)), a[1] * rs * g0[1] * silu_f(bfhi(z.x)));
            o.y = cvt_pk_bf16(a[2] * rs * g0[2] * silu_f(bflo(z.y)), a[3] * rs * g0[3] * silu_f(bfhi(z.y)));
            o.z = cvt_pk_bf16(b4[0] * rs * g1[0] * silu_f(bflo(z.z)), b4[1] * rs * g1[1] * silu_f(bfhi(z.z)));
            o.w = cvt_pk_bf16(b4[2] * rs * g1[2] * silu_f(bflo(z.w)), b4[3] * rs * g1[3] * silu_f(bfhi(z.w)));
            *(uint4*)(mix + (size_t)row * LDB + h * 128 + l16 * 8) = o;
        }
    }
    GRID_BAR();
    if (IN_PH(5)) {
        for (int t = bid; t < 32 * 8; t += G) { int nt, mt; tile_map(t, 32, 8, mt, nt);
            EpiResid e{p.in[0] + (size_t)mt * 256 * D + nt * 256, x1 + (size_t)mt * 256 * D + nt * 256};
            gemm256_tile(mix + (size_t)mt * 256 * LDB, LDB, Wt_out + (size_t)nt * 256 * LDB, LDB, D, lds, e);
        }
        VLOOP(t, 8 * 32) { const int mt = t & 7, nt = t >> 3;
            EpiResid e{p.in[1] + (size_t)mt * 64 * D + nt * 64, x1 + (size_t)(TP + mt * 64) * D + nt * 64};
            gemm_tile<32>(mix + (size_t)(TP + mt * 64) * LDB, LDB, Wt_out + (size_t)nt * 64 * LDB, LDB, D, vlds, e);
        }
    }
    GRID_BAR();
    if (IN_PH(6))
    for (int r = bid * 8 + wid; r < TT; r += G * 8) rmsnorm_row_bf16(x1 + (size_t)r * D, p.in[18], hbuf + (size_t)r * LDB, lane);
    GRID_BAR();
    if (IN_PH(7)) {
        for (int t = bid; t < 32 * 8; t += G) { int nt, mt; tile_map(t, 32, 8, mt, nt);
            EpiBf e{qx + (size_t)mt * 256 * LDB + nt * 256, LDB};
            gemm256_tile(hbuf + (size_t)mt * 256 * LDB, LDB, Wt_cq + (size_t)nt * 256 * LDB, LDB, D, lds, e);
        }
        VLOOP(t, 8 * 32) { const int mt = t & 7, nt = t >> 3;
            EpiBf e{qx + (size_t)(TP + mt * 64) * LDB + nt * 64, LDB};
            gemm_tile<32>(hbuf + (size_t)(TP + mt * 64) * LDB, LDB, Wt_cq + (size_t)nt * 64 * LDB, LDB, D, vlds, e);
        }
    }
    GRID_BAR();
    if (IN_PH(8)) {
        const int NS1 = 16 * 16 * 2;
        VLOOP(t, 512) attn_sample_item(p, t, vlds);
        VLOOP(t, NS1) { const int bhd = t >> 5, v = t & 31, mt = v >> 1, nt = v & 1, b = bhd >> 2, hd = bhd & 3;
            EpiF32s e{sc + (size_t)(b * SEQ + mt * 128) * 1024 + hd * 256 + nt * 128, 1024, 0.04419417382415922f};
            gemm_tile<64>(qx + (size_t)(b * SEQ + mt * 128) * LDB + hd * 512, LDB, mkb + (size_t)(b * 256 + nt * 128) * LDB + hd * 512, LDB, 512, vlds, e);
        }
    }
    GRID_BAR();
    if (IN_PH(9))
    for (int r = bid * 8 + wid; r < TP * 4; r += G * 8) {
        const f32x4 v = *(const f32x4*)(sc + (size_t)r * 256 + lane * 4);
        const float mx = wave_max(fmaxf(fmaxf(v[0], v[1]), fmaxf(v[2], v[3])));
        f32x4 e; e[0] = __expf(v[0] - mx); e[1] = __expf(v[1] - mx); e[2] = __expf(v[2] - mx); e[3] = __expf(v[3] - mx);
        const float inv = 1.f / wave_sum(e[0] + e[1] + e[2] + e[3]);
        store_bf4(pb + (size_t)(r >> 2) * LDP + (r & 3) * 256 + lane * 4, e * inv);
    }
    GRID_BAR();
    if (IN_PH(10)) {
        VLOOP(t, 16 * 16 * 4) { const int bhd = t >> 6, v = t & 63, mt = v >> 2, nt = v & 3, b = bhd >> 2, hd = bhd & 3;
            EpiBf e{ctx + (size_t)(b * SEQ + mt * 128) * LDB + hd * 512 + nt * 128, LDB};
            gemm_tile<64>(pb + (size_t)(b * SEQ + mt * 128) * LDP + hd * 256, LDP, mvt + ((size_t)b * D + hd * 512 + nt * 128) * LDM, LDM, 256, vlds, e);
        }
    }
    GRID_BAR();
    if (IN_PH(11)) {
        for (int t = bid; t < 32 * 8; t += G) { int nt, mt; tile_map(t, 32, 8, mt, nt);
            EpiResid e{x1 + (size_t)mt * 256 * D + nt * 256, x2 + (size_t)mt * 256 * D + nt * 256};
            gemm256_tile(ctx + (size_t)mt * 256 * LDB, LDB, Wt_co + (size_t)nt * 256 * LDB, LDB, D, lds, e);
        }
        VLOOP(t, 8 * 32) { const int mt = t & 7, nt = t >> 3;
            EpiResid e{x1 + (size_t)(TP + mt * 64) * D + nt * 64, x2 + (size_t)(TP + mt * 64) * D + nt * 64};
            gemm_tile<32>(ctx + (size_t)(TP + mt * 64) * LDB, LDB, Wt_co + (size_t)nt * 64 * LDB, LDB, D, vlds, e);
        }
    }
    GRID_BAR();
    if (IN_PH(12))
    for (int r = bid * 8 + wid; r < TT; r += G * 8) rmsnorm_row_f32(x2 + (size_t)r * D, p.in[23], p.out + (r < TP ? O_YP + (size_t)r * D : O_YS + (size_t)(r - TP) * D), lane);
}

extern "C" void kernel_launch(void* const* d_in, const int* in_sizes, int n_in, void* d_out, int out_size, void* d_ws, size_t ws_size, hipStream_t stream) {
    static int grid = 0;
    if (grid == 0) {
        if (n_in != 24 || ws_size < WS_END) { fprintf(stderr, "kernel_launch: need 24 inputs and %zu bytes of workspace (got %d, %zu)\n", (size_t)WS_END, n_in, ws_size); grid = -1; return; }
        int dev = 0, cus = 0, per_cu = 0;
        hipGetDevice(&dev);
        hipDeviceGetAttribute(&cus, hipDeviceAttributeMultiprocessorCount, dev);
        if (hipOccupancyMaxActiveBlocksPerMultiprocessor(&per_cu, (const void*)hymba_fwd, 512, 0) != hipSuccess || per_cu < 1) { fprintf(stderr, "kernel_launch: occupancy query failed\n"); grid = -1; return; }
        if (per_cu > 1) per_cu = 1;
        grid = cus * per_cu;
        fprintf(stderr, "kernel_launch: grid %d (%d per CU)\n", grid, per_cu);
    }
    if (grid < 0) return;
    hipMemsetAsync((char*)d_ws + WS_BAR, 0, 16384, stream);
    Params p{};
    for (int i = 0; i < 24; ++i) p.in[i] = (const float*)d_in[i];
    p.out = (float*)d_out; p.ws = (unsigned char*)d_ws;
    if (NLAUNCH == 1) {
        p.ph_lo = 0; p.ph_hi = 13;
        void* args[] = {&p};
        hipError_t e = hipLaunchCooperativeKernel((const void*)hymba_fwd, dim3(grid), dim3(512), args, 0, stream);
        if (e != hipSuccess) fprintf(stderr, "kernel_launch: cooperative launch failed: %s (grid %d)\n", hipGetErrorString(e), grid);
    } else {
        for (int k = 0; k < 13; ++k) { p.ph_lo = k; p.ph_hi = k + 1; hipLaunchKernelGGL(hymba_fwd, dim3(grid), dim3(512), 0, stream, p); }
    }
}
```

```cpp
#include <hip/hip_runtime.h>
#include <hip/hip_cooperative_groups.h>
#include <cstdio>
#include <cstdint>

typedef unsigned short bf16_t;
typedef short bf16x8 __attribute__((ext_vector_type(8)));
typedef float f32x4 __attribute__((ext_vector_type(4)));
#define DEV __device__ __forceinline__
#define LAS __attribute__((address_space(3)))

constexpr int D = 2048, TP = 8192, TS = 512, TT = 8704, SEQ = 2048, NB = 4, SB = 128;
constexpr int NPJ = 6144;
constexpr int C_ZA = 3072, C_U = 4096, C_ZB = 5120;
constexpr int NWIN = 6272;
constexpr float EPS = 1e-6f;
constexpr int LDB = 2112, LDP = 1088, LDM = 288;

constexpr size_t O_YP = 0, O_YS = 16777216, O_MK = 17825792, O_MV = 19922944, O_DP = 22020096, O_CP = 22544384,
                 O_PP = 22581248, O_DS = 22642688, O_CS = 39419904, O_PS = 40599552;

constexpr size_t al256(size_t x) { return (x + 255) & ~(size_t)255; }
constexpr size_t WS_BAR = 0;
constexpr size_t WS_WIN = 16384;
constexpr size_t WS_WOUT = WS_WIN + (size_t)NWIN * LDB * 2;
constexpr size_t WS_WCQ = WS_WOUT + (size_t)D * LDB * 2;
constexpr size_t WS_WCO = WS_WCQ + (size_t)D * LDB * 2;
constexpr size_t WS_WCKV = WS_WCO + (size_t)D * LDB * 2;
constexpr size_t WS_WPOOL = WS_WCKV + (size_t)2 * D * LDB * 2;
constexpr size_t WS_H = WS_WPOOL + (size_t)1024 * LDM * 2;
constexpr size_t WS_HM = WS_H + (size_t)TT * LDB * 2;
constexpr size_t WS_PROJ = WS_HM + (size_t)1024 * LDB * 2;
constexpr size_t WS_AB = WS_PROJ + (size_t)TT * NPJ * 2;
constexpr size_t WS_MKB = WS_AB + (size_t)TT * 16 * 4;
constexpr size_t WS_MVT = WS_MKB + (size_t)1024 * LDB * 2;
constexpr size_t WS_GW = WS_MVT + (size_t)4 * D * LDM * 2;
constexpr size_t WS_GQ = WS_GW + (size_t)1024 * 8192 * 2;
constexpr size_t WS_GKT = WS_GQ + (size_t)1024 * 8192 * 2;
constexpr size_t WS_GA = WS_GKT + (size_t)1024 * 8192 * 2;
constexpr size_t WS_GU = WS_GA + (size_t)1024 * 4096 * 2;
constexpr size_t WS_GE = WS_GU + (size_t)1024 * 8192 * 4;
constexpr size_t WS_O = WS_GE + 4096;
constexpr size_t WS_DPL = WS_O + (size_t)TP * 1024 * 4;
constexpr size_t WS_MIX = WS_DPL + (size_t)TT * LDP * 2;
constexpr size_t WS_X1 = WS_MIX + (size_t)TT * LDB * 2;
constexpr size_t WS_QX = WS_X1 + (size_t)TT * D * 4;
constexpr size_t WS_SC = WS_QX + (size_t)TT * LDB * 2;
constexpr size_t WS_PB = WS_SC + (size_t)TP * 1024 * 4;
constexpr size_t WS_CTX = WS_PB + (size_t)TP * LDP * 2;
constexpr size_t WS_X2 = WS_CTX + (size_t)TT * LDB * 2;
constexpr size_t WS_END = WS_X2 + (size_t)TT * D * 4;

#ifndef LASTP
#define LASTP 99
#endif
struct Params { const float* in[24]; float* out; unsigned char* ws; int ph_lo, ph_hi; };

typedef __bf16 bf16x2_t __attribute__((ext_vector_type(2)));
typedef float f32x2_t __attribute__((ext_vector_type(2)));
DEV unsigned cvt_pk_bf16(float lo, float hi) { const f32x2_t v = {lo, hi}; const bf16x2_t b = __builtin_convertvector(v, bf16x2_t); return __builtin_bit_cast(unsigned, b); }
DEV bf16_t f2bf(float f) { return (bf16_t)(cvt_pk_bf16(f, 0.f) & 0xffffu); }
DEV float bf2f(unsigned b) { return __uint_as_float(b << 16); }
DEV float bflo(unsigned u) { return __uint_as_float(u << 16); }
DEV float bfhi(unsigned u) { return __uint_as_float(u & 0xffff0000u); }
DEV float silu_f(float x) { return x / (1.f + __expf(-x)); }
DEV float wave_sum(float v) {
#pragma unroll
    for (int o = 32; o >= 1; o >>= 1) v += __shfl_xor(v, o);
    return v;
}
DEV float wave_max(float v) {
#pragma unroll
    for (int o = 32; o >= 1; o >>= 1) v = fmaxf(v, __shfl_xor(v, o));
    return v;
}
DEV void store_bf4(bf16_t* p, f32x4 v) { uint2 w; w.x = cvt_pk_bf16(v[0], v[1]); w.y = cvt_pk_bf16(v[2], v[3]); *(uint2*)p = w; }

#define XB_TMO      128
#define XB_XCNT(j)  (256  + 64 * (j))
#define XB_XSUB(j)  (1280 + 64 * (j))
#define XB_XGEN(j)  (2304 + 64 * (j))
#define XB_TOP      3328
#define XB_TOPGEN   3392
#define XCD_BAR_WORDS 3456
#define XB_SPIN_CAP (1u << 22)
DEV unsigned xb_ld(unsigned* p) { return __hip_atomic_load(p, __ATOMIC_RELAXED, __HIP_MEMORY_SCOPE_AGENT); }
DEV unsigned xb_add(unsigned* p, unsigned v) { return __hip_atomic_fetch_add(p, v, __ATOMIC_RELAXED, __HIP_MEMORY_SCOPE_AGENT); }
DEV unsigned xb_xcc_id() { return (unsigned)__builtin_amdgcn_s_getreg((3 << 11) | 20) & 0xFu; }
#define XB_SPIN(cond, bar) do { unsigned _sp = 0; while (cond) { __builtin_amdgcn_s_sleep(1); \
    if ((++_sp & 255u) == 0u) { if (xb_ld(&(bar)[XB_TMO])) break; if (_sp > XB_SPIN_CAP) { atomicAdd(&(bar)[XB_TMO], 1u); break; } } } } while (0)
struct XcdBarrier { unsigned* bar; unsigned x; volatile LAS unsigned* st; };
DEV XcdBarrier xcd_barrier_post(unsigned* bar, volatile LAS unsigned* st) {
    XcdBarrier b; b.bar = bar; b.x = xb_xcc_id(); b.st = st;
    if (threadIdx.x == 0) (void)xb_add(&bar[XB_XCNT(b.x)], 1u);
    return b;
}
DEV void xcd_barrier_complete(unsigned* bar, unsigned x, unsigned& nloc, unsigned& nx) {
    const unsigned G = gridDim.x;
    unsigned sum, cnt, mine, sp = 0u;
    for (;;) {
        sum = 0u; cnt = 0u; mine = 0u;
#pragma unroll
        for (unsigned j = 0; j < 16; ++j) { const unsigned c = xb_ld(&bar[XB_XCNT(j)]); sum += c; cnt += (c > 0u) ? 1u : 0u; mine = (j == x) ? c : mine; }
        if (sum == G) break;
        __builtin_amdgcn_s_sleep(1);
        if ((++sp & 255u) == 0u) { if (xb_ld(&bar[XB_TMO])) break; if (sp > XB_SPIN_CAP) { atomicAdd(&bar[XB_TMO], 1u); break; } }
    }
    nloc = mine > 0u ? mine : 1u; nx = cnt > 0u ? cnt : 1u;
}
DEV void xcd_barrier(const XcdBarrier& b) {
    asm volatile("s_waitcnt vmcnt(0)" ::: "memory");
    __syncthreads();
    if (threadIdx.x == 0) {
        unsigned* bar = b.bar;
        __builtin_amdgcn_s_waitcnt(0);
        unsigned nloc = b.st[0], nx = b.st[1];
        if (nloc == 0u) { xcd_barrier_complete(bar, b.x, nloc, nx); b.st[0] = nloc; b.st[1] = nx; }
        const unsigned old = xb_add(&bar[XB_XSUB(b.x)], 1u);
        const unsigned gen = old / nloc;
        if (old + 1u == (gen + 1u) * nloc) {
            __builtin_amdgcn_fence(__ATOMIC_RELEASE, "agent");
            asm volatile("s_waitcnt vmcnt(0)" ::: "memory");
            const unsigned og = xb_add(&bar[XB_TOP], 1u);
            const unsigned tg = og / nx;
            if (og + 1u == (tg + 1u) * nx) xb_add(&bar[XB_TOPGEN], 1u);
            else XB_SPIN(xb_ld(&bar[XB_TOPGEN]) == tg, bar);
            __builtin_amdgcn_fence(__ATOMIC_ACQUIRE, "agent");
            xb_add(&bar[XB_XGEN(b.x)], 1u);
            asm volatile("s_waitcnt vmcnt(0)" ::: "memory");
        } else {
            XB_SPIN(xb_ld(&bar[XB_XGEN(b.x)]) == gen, bar);
            __builtin_amdgcn_fence(__ATOMIC_ACQUIRE, "agent");
            asm volatile("s_waitcnt vmcnt(0)" ::: "memory");
        }
    }
    __syncthreads();
}

DEV void glds16(const void* gptr, unsigned lds_addr_lane) {
    const unsigned m = __builtin_amdgcn_readfirstlane(lds_addr_lane);
    unsigned keep;
    asm volatile("s_mov_b32 %0, m0\n\ts_mov_b32 m0, %2\n\ts_nop 0\n\tglobal_load_lds_dwordx4 %1, off\n\ts_mov_b32 m0, %0" : "=&s"(keep) : "v"(gptr), "s"(m) : "memory");
}

template <int WT, class Epi>
DEV void gemm_tile(const bf16_t* __restrict__ A, int lda, const bf16_t* __restrict__ Bt, int ldb, int K, unsigned char* lds, const Epi& epi) {
    constexpr int FI = WT / 16;
    constexpr int OPB = 2 * WT * 128;
    constexpr int STB = 2 * OPB;
    int tid = threadIdx.x & 255; asm volatile("" : "+v"(tid)); const int lane = tid & 63, wid = tid >> 6;
    const int wr = wid >> 1, wc = wid & 1, fr = lane & 15, fq = lane >> 4;
    f32x4 acc[FI][FI];
#pragma unroll
    for (int i = 0; i < FI; ++i)
#pragma unroll
        for (int j = 0; j < FI; ++j) acc[i][j] = (f32x4){0.f, 0.f, 0.f, 0.f};
    const int lrow = tid >> 3, lcs = (tid & 7) ^ (lrow & 7);
    const bf16_t* ap = A + (size_t)lrow * lda + lcs * 8;
    const bf16_t* bp = Bt + (size_t)lrow * ldb + lcs * 8;
    const unsigned l3a = (unsigned)(size_t)(LAS unsigned char*)lds;
    const int nk = K >> 6;
#define GLDS_STAGE(st, kt_) do { \
        _Pragma("unroll") for (int i_ = 0; i_ < FI; ++i_) { \
            glds16(ap + (size_t)(32 * i_) * lda + (kt_) * 64, l3a + (st) + tid * 16 + i_ * 4096); \
            glds16(bp + (size_t)(32 * i_) * ldb + (kt_) * 64, l3a + (st) + OPB + tid * 16 + i_ * 4096); } } while (0)
    constexpr int NSTG = 65536 / STB;
#pragma unroll
    for (int s_ = 0; s_ < NSTG - 1; ++s_) if (s_ < nk) GLDS_STAGE(s_ * STB, s_);
    const int aoff = (wr * WT + fr) * 128, boff = OPB + (wc * WT + fr) * 128, sw = fr & 7;
    int cur = 0, nxt = (NSTG - 1) * STB;
    for (int kt = 0; kt < nk; ++kt) {
        if (NSTG == 4 && kt + 2 < nk) { if (FI == 2) asm volatile("s_waitcnt vmcnt(8)" ::: "memory"); else asm volatile("s_waitcnt vmcnt(0)" ::: "memory"); }
        else asm volatile("s_waitcnt vmcnt(0)" ::: "memory");
        __syncthreads();
        if (kt + NSTG - 1 < nk) GLDS_STAGE(nxt, kt + NSTG - 1);
#pragma unroll
        for (int kh = 0; kh < 2; ++kh) {
            bf16x8 af[FI], bfr[FI];
            const int ch = ((kh * 4 + fq) ^ sw) << 4;
#pragma unroll
            for (int i = 0; i < FI; ++i) { af[i] = *(const bf16x8*)(lds + cur + aoff + i * 2048 + ch); bfr[i] = *(const bf16x8*)(lds + cur + boff + i * 2048 + ch); }
#pragma unroll
            for (int mi = 0; mi < FI; ++mi)
#pragma unroll
                for (int ni = 0; ni < FI; ++ni) acc[mi][ni] = __builtin_amdgcn_mfma_f32_16x16x32_bf16(bfr[ni], af[mi], acc[mi][ni], 0, 0, 0);
        }
        nxt = cur; cur += STB; if (cur == NSTG * STB) cur = 0;
    }
#undef GLDS_STAGE
    __syncthreads();
#pragma unroll
    for (int mi = 0; mi < FI; ++mi)
#pragma unroll
        for (int ni = 0; ni < FI; ++ni) epi(wr * WT + mi * 16 + fr, wc * WT + ni * 16 + fq * 4, acc[mi][ni]);
}

template <class Epi>
DEV void gemm256_tile(const bf16_t* __restrict__ A, int lda, const bf16_t* __restrict__ Bt, int ldb, int K, unsigned char* lds, const Epi& epi) {
    int tid = threadIdx.x; asm volatile("" : "+v"(tid)); const int lane = tid & 63, wid = tid >> 6;
    const int wr = wid >> 2, wc = wid & 3, fr = lane & 15, fq = lane >> 4;
    f32x4 acc[8][4];
#pragma unroll
    for (int i = 0; i < 8; ++i)
#pragma unroll
        for (int j = 0; j < 4; ++j) acc[i][j] = (f32x4){0.f, 0.f, 0.f, 0.f};
    const int lrow = tid >> 3, lcs = (tid & 7) ^ (lrow & 7);
    const bf16_t* ap = A + (size_t)lrow * lda + lcs * 8;
    const bf16_t* bp = Bt + (size_t)lrow * ldb + lcs * 8;
    const unsigned l3a = (unsigned)(size_t)(LAS unsigned char*)lds;
    const int nk = K >> 6;
#define GLDS_STAGE(st, kt_) do { \
        _Pragma("unroll") for (int i_ = 0; i_ < 4; ++i_) { \
            glds16(ap + (size_t)(64 * i_) * lda + (kt_) * 64, l3a + (st) + tid * 16 + i_ * 8192); \
            glds16(bp + (size_t)(64 * i_) * ldb + (kt_) * 64, l3a + (st) + 32768 + tid * 16 + i_ * 8192); } } while (0)
    GLDS_STAGE(0, 0);
    const int aoff = (wr * 128 + fr) * 128, boff = 32768 + (wc * 64 + fr) * 128, sw = fr & 7;
    for (int kt = 0; kt < nk; ++kt) {
        const int cur = (kt & 1) * 65536;
        asm volatile("s_waitcnt vmcnt(0)" ::: "memory");
        __syncthreads();
        if (kt + 1 < nk) GLDS_STAGE(cur ^ 65536, kt + 1);
#pragma unroll
        for (int kh = 0; kh < 2; ++kh) {
            bf16x8 bfr[4];
            const int ch = ((kh * 4 + fq) ^ sw) << 4;
#pragma unroll
            for (int i = 0; i < 4; ++i) bfr[i] = *(const bf16x8*)(lds + cur + boff + i * 2048 + ch);
#pragma unroll
            for (int mh = 0; mh < 2; ++mh) {
                bf16x8 af[4];
#pragma unroll
                for (int i = 0; i < 4; ++i) af[i] = *(const bf16x8*)(lds + cur + aoff + (mh * 4 + i) * 2048 + ch);
#pragma unroll
                for (int mi = 0; mi < 4; ++mi)
#pragma unroll
                    for (int ni = 0; ni < 4; ++ni) acc[mh * 4 + mi][ni] = __builtin_amdgcn_mfma_f32_16x16x32_bf16(bfr[ni], af[mi], acc[mh * 4 + mi][ni], 0, 0, 0);
            }
        }
    }
#undef GLDS_STAGE
    __syncthreads();
#pragma unroll
    for (int mi = 0; mi < 8; ++mi)
#pragma unroll
        for (int ni = 0; ni < 4; ++ni) epi(wr * 128 + mi * 16 + fr, wc * 64 + ni * 16 + fq * 4, acc[mi][ni]);
}

DEV void ab_rows16(const bf16_t* __restrict__ h, const bf16_t* __restrict__ wab, float* __restrict__ ab, int rt, int lane) {
    const int fr = lane & 15, fq = lane >> 4;
    const bf16_t* ap = h + (size_t)(rt * 16 + fr) * LDB + fq * 8;
    const bf16_t* bp = wab + (size_t)fr * LDB + fq * 8;
    f32x4 acc = {0.f, 0.f, 0.f, 0.f};
#pragma unroll 8
    for (int s = 0; s < 64; ++s) {
        const bf16x8 a = *(const bf16x8*)(ap + s * 32), b = *(const bf16x8*)(bp + s * 32);
        acc = __builtin_amdgcn_mfma_f32_16x16x32_bf16(b, a, acc, 0, 0, 0);
    }
    *(f32x4*)(ab + (size_t)(rt * 16 + fr) * 16 + fq * 4) = acc;
}

DEV void tile_map(int L, int nM, int nN, int& pm, int& pn) {
    const int T = nM * nN, q = T >> 3, r = T & 7, xcd = L & 7, off = L >> 3;
    const int w = (xcd < r ? xcd * (q + 1) : r * (q + 1) + (xcd - r) * q) + off;
    const int nig = 8 * nN, gid = w / nig, fm = gid * 8, gsz = (nM - fm) < 8 ? (nM - fm) : 8;
    pm = fm + (w % nig) % gsz; pn = (w % nig) / gsz;
}

struct EpiProj {
    int m0, n0; bf16_t* proj; float* ab; float* out;
    DEV void operator()(int r, int c, f32x4 v) const {
        const int row = m0 + r, col = n0 + c;
        if (col < NPJ) {
            store_bf4(proj + (size_t)row * NPJ + col, v);
            const bool isconv = col < 3072, ispool = (col >= C_U && col < C_ZB);
            if (isconv || ispool) {
                if (row < TP) {
                    const int b = row >> 11, t = row & 2047;
                    if (isconv) { if (t >= 2045) *(f32x4*)(out + O_CP + ((size_t)(b * 3 + (t - 2045))) * 3072 + col) = v; }
                    else { if (t >= 2033) *(f32x4*)(out + O_PP + ((size_t)(b * 15 + (t - 2033))) * 1024 + (col - C_U)) = v; }
                } else {
                    const int sb = (row - TP) >> 2, t = (row - TP) & 3;
                    if (isconv) { if (t >= 1) *(f32x4*)(out + O_CS + ((size_t)(sb * 3 + (t - 1))) * 3072 + col) = v; }
                    else *(f32x4*)(out + O_PS + ((size_t)(sb * 15 + 11 + t)) * 1024 + (col - C_U)) = v;
                }
            }
        } else if (col < NPJ + 16) {
            *(f32x4*)(ab + (size_t)row * 16 + (col - NPJ)) = v;
        }
    }
};
struct EpiMKV {
    int m0, n0; bf16_t* mkb; bf16_t* mvt; float* out;
    DEV void operator()(int r, int c, f32x4 v) const {
        const int row = m0 + r, col = n0 + c;
        if (col < D) {
            *(f32x4*)(out + O_MK + (size_t)row * D + col) = v;
            store_bf4(mkb + (size_t)row * LDB + col, v);
        } else {
            const int cc = col - D, b = row >> 8, m = row & 255;
            *(f32x4*)(out + O_MV + (size_t)row * D + cc) = v;
            bf16_t* p = mvt + ((size_t)b * D + cc) * LDM + m;
            p[0] = f2bf(v[0]); p[LDM] = f2bf(v[1]); p[2 * LDM] = f2bf(v[2]); p[3 * LDM] = f2bf(v[3]);
        }
    }
};
struct EpiPool {
    int m0, n0; const bf16_t* proj; const float* scale; bf16_t* mix;
    DEV void operator()(int r, int c, f32x4 v) const {
        const int row = m0 + r, col = n0 + c;
        const uint2 z = *(const uint2*)(proj + (size_t)row * NPJ + C_ZB + col);
        const f32x4 s = *(const f32x4*)(scale + col);
        f32x4 o;
        o[0] = v[0] * s[0] * silu_f(bflo(z.x)); o[1] = v[1] * s[1] * silu_f(bfhi(z.x));
        o[2] = v[2] * s[2] * silu_f(bflo(z.y)); o[3] = v[3] * s[3] * silu_f(bfhi(z.y));
        store_bf4(mix + (size_t)row * LDB + 1024 + col, o);
    }
};
struct EpiResid {
    const float* res; float* dst;
    DEV void operator()(int r, int c, f32x4 v) const {
        const f32x4 x = *(const f32x4*)(res + (size_t)r * D + c);
        *(f32x4*)(dst + (size_t)r * D + c) = x + v;
    }
};
struct EpiBf {
    bf16_t* dst; int ld;
    DEV void operator()(int r, int c, f32x4 v) const { store_bf4(dst + (size_t)r * ld + c, v); }
};
struct EpiF32s {
    float* dst; int ld; float s;
    DEV void operator()(int r, int c, f32x4 v) const { *(f32x4*)(dst + (size_t)r * ld + c) = v * s; }
};

DEV int win_srccol(int n) { return n < 4096 ? n : (n < 6144 ? n + 16 : (n < 6160 ? 4096 + (n - 6144) : -1)); }
DEV void transpose_tile(const float* __restrict__ src, int ld, int srccol0, bool remap, int k0, bf16_t* __restrict__ dstrow0, int ldd, float* tile) {
    int tid = threadIdx.x & 255; asm volatile("" : "+v"(tid));
    const int tx = tid & 63, ty = tid >> 6;
    const int sc = remap ? win_srccol(srccol0 + tx) : (srccol0 + tx);
    float tv[16];
#pragma unroll
    for (int i = 0; i < 16; ++i) tv[i] = sc >= 0 ? src[(size_t)(k0 + ty + 4 * i) * ld + sc] : 0.f;
#pragma unroll
    for (int i = 0; i < 16; ++i) tile[(ty + 4 * i) * 65 + tx] = tv[i];
    __syncthreads();
    const int c2 = tid & 31, rr = tid >> 5;
#pragma unroll
    for (int i = 0; i < 8; ++i) { const int r = rr + 8 * i; *(unsigned*)(dstrow0 + (size_t)r * ldd + k0 + 2 * c2) = cvt_pk_bf16(tile[(2 * c2) * 65 + r], tile[(2 * c2 + 1) * 65 + r]); }
    __syncthreads();
}
DEV void rmsnorm_row_bf16(const float* __restrict__ x, const float* __restrict__ g, bf16_t* __restrict__ y, int lane) {
    f32x4 v[8]; float ss = 0.f;
#pragma unroll
    for (int i = 0; i < 8; ++i) { v[i] = ((const f32x4*)x)[i * 64 + lane]; ss += v[i][0] * v[i][0] + v[i][1] * v[i][1] + v[i][2] * v[i][2] + v[i][3] * v[i][3]; }
    ss = wave_sum(ss);
    const float rs = rsqrtf(ss * (1.f / 2048.f) + EPS);
#pragma unroll
    for (int i = 0; i < 8; ++i) { const f32x4 gg = ((const f32x4*)g)[i * 64 + lane]; store_bf4(y + (size_t)(i * 64 + lane) * 4, v[i] * rs * gg); }
}
DEV void rmsnorm_row_f32(const float* __restrict__ x, const float* __restrict__ g, float* __restrict__ y, int lane) {
    f32x4 v[8]; float ss = 0.f;
#pragma unroll
    for (int i = 0; i < 8; ++i) { v[i] = ((const f32x4*)x)[i * 64 + lane]; ss += v[i][0] * v[i][0] + v[i][1] * v[i][1] + v[i][2] * v[i][2] + v[i][3] * v[i][3]; }
    ss = wave_sum(ss);
    const float rs = rsqrtf(ss * (1.f / 2048.f) + EPS);
#pragma unroll
    for (int i = 0; i < 8; ++i) { const f32x4 gg = ((const f32x4*)g)[i * 64 + lane]; ((f32x4*)y)[i * 64 + lane] = v[i] * rs * gg; }
}

constexpr int QS = 136;
DEV void gdn_prep_chunk(const Params& p, int item, unsigned char* lds) {
    int tid = threadIdx.x & 255; asm volatile("" : "+v"(tid)); const int lane = tid & 63, wid = tid >> 6;
    const int c = item & 31, h = (item >> 5) & 7, b = item >> 8;
    const int row0 = b * SEQ + c * 64;
    const bf16_t* proj = (const bf16_t*)(p.ws + WS_PROJ);
    const float* ab = (const float*)(p.ws + WS_AB);
    bf16_t* qs = (bf16_t*)lds; bf16_t* ks = qs + 64 * QS; bf16_t* vs = ks + 64 * QS;
    float* lowT = (float*)lds;
    float* gcs = (float*)(lds + 3 * 64 * QS * 2);
    float* bts = gcs + 64;
    bf16_t* gW = (bf16_t*)(p.ws + WS_GW) + (size_t)item * 8192;
    bf16_t* gQ = (bf16_t*)(p.ws + WS_GQ) + (size_t)item * 8192;
    bf16_t* gKT = (bf16_t*)(p.ws + WS_GKT) + (size_t)item * 8192;
    bf16_t* gA = (bf16_t*)(p.ws + WS_GA) + (size_t)item * 4096;
    float* gU = (float*)(p.ws + WS_GU) + (size_t)item * 8192;
    float* gE = (float*)(p.ws + WS_GE) + item;

    if (wid == 3) {
        const float a = ab[(size_t)(row0 + lane) * 16 + h], bb = ab[(size_t)(row0 + lane) * 16 + 8 + h];
        const float xx = a + p.in[12][h];
        const float sp = xx > 20.f ? xx : log1pf(__expf(xx));
        float s = -__expf(p.in[11][h]) * sp;
#pragma unroll
        for (int d = 1; d < 64; d <<= 1) { const float t = __shfl_up(s, d); if (lane >= d) s += t; }
        gcs[lane] = s; bts[lane] = 1.f / (1.f + __expf(-bb));
    } else {
        const int mat = wid, rg = lane >> 4, cv = lane & 15;
        const int colg = mat * 1024 + h * 128 + cv * 8;
        const float* cw = p.in[10];
        float w[4][8];
#pragma unroll
        for (int j = 0; j < 4; ++j) { const f32x4 w0 = *(const f32x4*)(cw + j * 3072 + colg), w1 = *(const f32x4*)(cw + j * 3072 + colg + 4);
            w[j][0] = w0[0]; w[j][1] = w0[1]; w[j][2] = w0[2]; w[j][3] = w0[3]; w[j][4] = w1[0]; w[j][5] = w1[1]; w[j][6] = w1[2]; w[j][7] = w1[3]; }
        const int tl0 = rg * 16;
        uint4 raw[19];
#pragma unroll
        for (int i = 0; i < 19; ++i) {
            const int tl = tl0 - 3 + i;
            if (c * 64 + tl >= 0) raw[i] = *(const uint4*)(proj + (size_t)(row0 + tl) * NPJ + colg);
            else raw[i] = make_uint4(0u, 0u, 0u, 0u);
        }
        bf16_t* dst = (mat == 0 ? qs : (mat == 1 ? ks : vs));
#pragma unroll
        for (int r = 0; r < 16; ++r) {
            float y[8]; float ss = 0.f;
#pragma unroll
            for (int e = 0; e < 8; ++e) {
                float a = 0.f;
#pragma unroll
                for (int j = 0; j < 4; ++j) {
                    const uint4 u = raw[r + j];
                    const unsigned wd = (e < 2 ? u.x : (e < 4 ? u.y : (e < 6 ? u.z : u.w)));
                    const float xv = (e & 1) ? bfhi(wd) : bflo(wd);
                    a += w[j][e] * xv;
                }
                y[e] = silu_f(a); ss += y[e] * y[e];
            }
            if (mat < 2) {
                ss += __shfl_xor(ss, 1); ss += __shfl_xor(ss, 2); ss += __shfl_xor(ss, 4); ss += __shfl_xor(ss, 8);
                float inv = rsqrtf(ss + EPS); if (mat == 0) inv *= 0.08838834764831845f;
#pragma unroll
                for (int e = 0; e < 8; ++e) y[e] *= inv;
            }
            uint4 o; o.x = cvt_pk_bf16(y[0], y[1]); o.y = cvt_pk_bf16(y[2], y[3]); o.z = cvt_pk_bf16(y[4], y[5]); o.w = cvt_pk_bf16(y[6], y[7]);
            *(uint4*)(dst + (tl0 + r) * QS + cv * 8) = o;
        }
    }
    __syncthreads();
    {
        const float glast = gcs[63];
        if (tid == 0) *gE = __expf(glast);
#pragma unroll
        for (int i = 0; i < 4; ++i) {
            const int ci = tid + 256 * i, t = ci >> 4, cc = (ci & 15) * 8;
            const uint4 u = *(const uint4*)(qs + t * QS + cc);
            const float e = __expf(gcs[t]);
            uint4 o; o.x = cvt_pk_bf16(bflo(u.x) * e, bfhi(u.x) * e); o.y = cvt_pk_bf16(bflo(u.y) * e, bfhi(u.y) * e);
            o.z = cvt_pk_bf16(bflo(u.z) * e, bfhi(u.z) * e); o.w = cvt_pk_bf16(bflo(u.w) * e, bfhi(u.w) * e);
            *(uint4*)(gQ + t * 128 + cc) = o;
        }
        const float dk = __expf(glast - gcs[lane]);
#pragma unroll 8
        for (int i = 0; i < 32; ++i) { const int d = wid * 32 + i; gKT[d * 64 + lane] = f2bf(bf2f(ks[lane * QS + d]) * dk); }
    }
    f32x4 kk[4], qk[4];
    {
        const int fr = lane & 15, fq = lane >> 4, it = wid;
        bf16x8 kfi[4], qfi[4];
#pragma unroll
        for (int s = 0; s < 4; ++s) { kfi[s] = *(const bf16x8*)(ks + (it * 16 + fr) * QS + s * 32 + fq * 8); qfi[s] = *(const bf16x8*)(qs + (it * 16 + fr) * QS + s * 32 + fq * 8); }
#pragma unroll
        for (int jt = 0; jt < 4; ++jt) {
            kk[jt] = (f32x4){0.f, 0.f, 0.f, 0.f}; qk[jt] = (f32x4){0.f, 0.f, 0.f, 0.f};
#pragma unroll
            for (int s = 0; s < 4; ++s) {
                const bf16x8 kfj = *(const bf16x8*)(ks + (jt * 16 + fr) * QS + s * 32 + fq * 8);
                kk[jt] = __builtin_amdgcn_mfma_f32_16x16x32_bf16(kfi[s], kfj, kk[jt], 0, 0, 0);
                qk[jt] = __builtin_amdgcn_mfma_f32_16x16x32_bf16(kfj, qfi[s], qk[jt], 0, 0, 0);
            }
        }
    }
    __syncthreads();
    {
        const int fr = lane & 15, fq = lane >> 4, it = wid;
#pragma unroll
        for (int jt = 0; jt < 4; ++jt) {
            const int j = jt * 16 + fr; const float gj = gcs[j];
            f32x4 lv;
#pragma unroll
            for (int e = 0; e < 4; ++e) { const int i = it * 16 + fq * 4 + e; lv[e] = (i > j) ? bts[i] * kk[jt][e] * __expf(gcs[i] - gj) : 0.f; }
            *(f32x4*)(lowT + j * 68 + it * 16 + fq * 4) = lv;
            const int i2 = it * 16 + fr; const float gi = gcs[i2];
            f32x4 av;
#pragma unroll
            for (int e = 0; e < 4; ++e) { const int j2 = jt * 16 + fq * 4 + e; av[e] = (i2 >= j2) ? qk[jt][e] * __expf(gi - gcs[j2]) : 0.f; }
            store_bf4(gA + i2 * 64 + jt * 16 + fq * 4, av);
        }
    }
    __syncthreads();
    {
        const int cc = tid & 127; const bool isw = tid >= 128;
        bf16_t* src = isw ? ks : vs;
#pragma unroll 1
        for (int ib = 0; ib < 4; ++ib) {
            float acc[16];
#pragma unroll
            for (int r = 0; r < 16; ++r) { const int j = ib * 16 + r; float f = bts[j]; if (isw) f *= __expf(gcs[j]); acc[r] = f * bf2f(src[j * QS + cc]); }
            const float* lrow = lowT + ib * 16;
#pragma unroll 2
            for (int j = 0; j < ib * 16; ++j) {
                const float xj = bf2f(src[j * QS + cc]);
                const f32x4 l0 = *(const f32x4*)(lrow + j * 68), l1 = *(const f32x4*)(lrow + j * 68 + 4), l2 = *(const f32x4*)(lrow + j * 68 + 8), l3 = *(const f32x4*)(lrow + j * 68 + 12);
#pragma unroll
                for (int e = 0; e < 4; ++e) { acc[e] -= l0[e] * xj; acc[4 + e] -= l1[e] * xj; acc[8 + e] -= l2[e] * xj; acc[12 + e] -= l3[e] * xj; }
            }
#pragma unroll 1
            for (int r2 = 0; r2 < 15; ++r2) {
                float xj = acc[0];
#pragma unroll
                for (int r = 1; r < 16; ++r) xj = (r2 == r) ? acc[r] : xj;
                const float* lp = lrow + (ib * 16 + r2) * 68;
                const f32x4 l0 = *(const f32x4*)(lp), l1 = *(const f32x4*)(lp + 4), l2 = *(const f32x4*)(lp + 8), l3 = *(const f32x4*)(lp + 12);
#pragma unroll
                for (int e = 0; e < 4; ++e) { acc[e] -= l0[e] * xj; acc[4 + e] -= l1[e] * xj; acc[8 + e] -= l2[e] * xj; acc[12 + e] -= l3[e] * xj; }
            }
#pragma unroll
            for (int r = 0; r < 16; ++r) {
                const int j = ib * 16 + r; const bf16_t xb = f2bf(acc[r]);
                src[j * QS + cc] = xb;
                if (isw) gW[j * 128 + cc] = xb; else gU[j * 128 + cc] = acc[r];
            }
        }
    }
    __syncthreads();
}

#define LDS_BARRIER() do { asm volatile("s_waitcnt lgkmcnt(0)" ::: "memory"); __builtin_amdgcn_s_barrier(); asm volatile("" ::: "memory"); } while (0)
DEV void gdn_scan_item(const Params& p, int item, unsigned char* lds) {
    int tid = threadIdx.x & 255; asm volatile("" : "+v"(tid)); const int lane = tid & 63, w = tid >> 6, fr = lane & 15, fq = lane >> 4;
    const int s = item & 7, bh = item >> 3;
    const int b = bh >> 3, h = bh & 7;
    bf16_t* ST = (bf16_t*)lds;
    bf16_t* VT = ST + 16 * QS;
    const bf16_t* gW = (const bf16_t*)(p.ws + WS_GW) + (size_t)bh * 32 * 8192;
    const bf16_t* gQ = (const bf16_t*)(p.ws + WS_GQ) + (size_t)bh * 32 * 8192;
    const bf16_t* gKT = (const bf16_t*)(p.ws + WS_GKT) + (size_t)bh * 32 * 8192;
    const bf16_t* gA = (const bf16_t*)(p.ws + WS_GA) + (size_t)bh * 32 * 4096;
    const float* gU = (const float*)(p.ws + WS_GU) + (size_t)bh * 32 * 8192;
    const float* gE = (const float*)(p.ws + WS_GE) + bh * 32;
    float* obuf = (float*)(p.ws + WS_O);
    f32x4 S0 = {0.f, 0.f, 0.f, 0.f}, S1 = {0.f, 0.f, 0.f, 0.f};
    for (int i = tid; i < 16 * QS / 2; i += 256) ((unsigned*)ST)[i] = 0u;
    bf16x8 fw[4], fqg[4], fa[2], fk0[2], fk1[2]; f32x4 uu; float eg;
#define SCAN_LOAD(ch) do { \
        const bf16_t* W_ = gW + (size_t)(ch) * 8192 + (w * 16 + fr) * 128 + fq * 8; const bf16_t* Q_ = gQ + (size_t)(ch) * 8192 + (w * 16 + fr) * 128 + fq * 8; \
        _Pragma("unroll") for (int k_ = 0; k_ < 4; ++k_) { fw[k_] = *(const bf16x8*)(W_ + k_ * 32); fqg[k_] = *(const bf16x8*)(Q_ + k_ * 32); } \
        const bf16_t* A_ = gA + (size_t)(ch) * 4096 + (w * 16 + fr) * 64 + fq * 8; fa[0] = *(const bf16x8*)(A_); fa[1] = *(const bf16x8*)(A_ + 32); \
        const bf16_t* K_ = gKT + (size_t)(ch) * 8192 + (w * 32 + fr) * 64 + fq * 8; fk0[0] = *(const bf16x8*)(K_); fk0[1] = *(const bf16x8*)(K_ + 32); \
        fk1[0] = *(const bf16x8*)(K_ + 16 * 64); fk1[1] = *(const bf16x8*)(K_ + 16 * 64 + 32); \
        const float* U_ = gU + (size_t)(ch) * 8192 + (w * 16 + fq * 4) * 128 + s * 16 + fr; uu[0] = U_[0]; uu[1] = U_[128]; uu[2] = U_[256]; uu[3] = U_[384]; \
        eg = gE[ch]; } while (0)
    SCAN_LOAD(0);
    __syncthreads();
    for (int ch = 0; ch < 32; ++ch) {
        bf16x8 cw[4], cq[4], ca[2], ck0[2], ck1[2]; f32x4 cu = uu; const float ceg = eg;
#pragma unroll
        for (int k = 0; k < 4; ++k) { cw[k] = fw[k]; cq[k] = fqg[k]; }
        ca[0] = fa[0]; ca[1] = fa[1]; ck0[0] = fk0[0]; ck0[1] = fk0[1]; ck1[0] = fk1[0]; ck1[1] = fk1[1];
        if (ch + 1 < 32) SCAN_LOAD(ch + 1);
        f32x4 ws_ = {0.f, 0.f, 0.f, 0.f}, oo = {0.f, 0.f, 0.f, 0.f};
#pragma unroll
        for (int k = 0; k < 4; ++k) {
            const bf16x8 sf = *(const bf16x8*)(ST + fr * QS + k * 32 + fq * 8);
            ws_ = __builtin_amdgcn_mfma_f32_16x16x32_bf16(cw[k], sf, ws_, 0, 0, 0);
            oo = __builtin_amdgcn_mfma_f32_16x16x32_bf16(cq[k], sf, oo, 0, 0, 0);
        }
        const f32x4 vn = cu - ws_;
        store_bf4(VT + fr * 72 + w * 16 + fq * 4, vn);
        LDS_BARRIER();
        const bf16x8 v0 = *(const bf16x8*)(VT + fr * 72 + fq * 8), v1 = *(const bf16x8*)(VT + fr * 72 + 32 + fq * 8);
        oo = __builtin_amdgcn_mfma_f32_16x16x32_bf16(ca[0], v0, oo, 0, 0, 0);
        oo = __builtin_amdgcn_mfma_f32_16x16x32_bf16(ca[1], v1, oo, 0, 0, 0);
        S0 = S0 * ceg; S1 = S1 * ceg;
        S0 = __builtin_amdgcn_mfma_f32_16x16x32_bf16(ck0[0], v0, S0, 0, 0, 0);
        S0 = __builtin_amdgcn_mfma_f32_16x16x32_bf16(ck0[1], v1, S0, 0, 0, 0);
        S1 = __builtin_amdgcn_mfma_f32_16x16x32_bf16(ck1[0], v0, S1, 0, 0, 0);
        S1 = __builtin_amdgcn_mfma_f32_16x16x32_bf16(ck1[1], v1, S1, 0, 0, 0);
        store_bf4(ST + fr * QS + w * 32 + fq * 4, S0);
        store_bf4(ST + fr * QS + w * 32 + 16 + fq * 4, S1);
        {
            float* op = obuf + (size_t)(b * SEQ + ch * 64 + w * 16 + fq * 4) * 1024 + h * 128 + s * 16 + fr;
            op[0] = oo[0]; op[1024] = oo[1]; op[2048] = oo[2]; op[3072] = oo[3];
        }
        LDS_BARRIER();
    }
#undef SCAN_LOAD
    {
        float* dp = p.out + O_DP + ((size_t)bh * 128 + w * 32 + fq * 4) * 128 + s * 16 + fr;
#pragma unroll
        for (int e = 0; e < 4; ++e) { dp[e * 128] = S0[e]; dp[(16 + e) * 128] = S1[e]; }
    }
    __syncthreads();
}

DEV void gdn_sample_item(const Params& p, int item, unsigned char* lds) {
    int tid = threadIdx.x & 255; asm volatile("" : "+v"(tid)); const int lane = tid & 63, wid = tid >> 6;
    const int sb = item >> 3, h = item & 7, half = tid >> 7, c = tid & 127;
    const int r0 = TP + sb * 4;
    const bf16_t* proj = (const bf16_t*)(p.ws + WS_PROJ);
    const float* ab = (const float*)(p.ws + WS_AB);
    float* ksh = (float*)lds;
    float* qsh = ksh + 512;
    float* red = qsh + 512;
    float* red2 = red + 32;
    float* part = red2 + 32;
    float* opart = part + 1024;
    float qv[4], kv[4], vv[4];
#pragma unroll
    for (int m = 0; m < 3; ++m) {
        const int col = m * 1024 + h * 128 + c;
        float x[7], wj[4];
#pragma unroll
        for (int j = 0; j < 3; ++j) x[j] = p.in[6][((size_t)sb * 3 + j) * 3072 + col];
#pragma unroll
        for (int t = 0; t < 4; ++t) x[3 + t] = bf2f(proj[(size_t)(r0 + t) * NPJ + col]);
#pragma unroll
        for (int j = 0; j < 4; ++j) wj[j] = p.in[10][j * 3072 + col];
#pragma unroll
        for (int t = 0; t < 4; ++t) {
            const float y = silu_f(wj[0] * x[t] + wj[1] * x[t + 1] + wj[2] * x[t + 2] + wj[3] * x[t + 3]);
            if (m == 0) qv[t] = y; else if (m == 1) kv[t] = y; else vv[t] = y;
        }
    }
#pragma unroll
    for (int t = 0; t < 4; ++t) {
        const float a = wave_sum(qv[t] * qv[t]), bq = wave_sum(kv[t] * kv[t]);
        if (lane == 0) { red[wid * 8 + t] = a; red[wid * 8 + 4 + t] = bq; }
    }
    __syncthreads();
    float gt[4], bt[4];
#pragma unroll
    for (int t = 0; t < 4; ++t) {
        const float sq = red[(2 * half) * 8 + t] + red[(2 * half + 1) * 8 + t], sk = red[(2 * half) * 8 + 4 + t] + red[(2 * half + 1) * 8 + 4 + t];
        if (half == 0) {
            qsh[t * 128 + c] = qv[t] * rsqrtf(sq + EPS) * 0.08838834764831845f;
            ksh[t * 128 + c] = kv[t] * rsqrtf(sk + EPS);
        }
        const float a = ab[(size_t)(r0 + t) * 16 + h], bb = ab[(size_t)(r0 + t) * 16 + 8 + h];
        const float xx = a + p.in[12][h];
        const float sp = xx > 20.f ? xx : log1pf(__expf(xx));
        gt[t] = __expf(-__expf(p.in[11][h]) * sp);
        bt[t] = 1.f / (1.f + __expf(-bb));
    }
    float S[64];
    const float* sp0 = p.in[5] + ((size_t)(sb * 8 + h) * 128 + half * 64) * 128 + c;
#pragma unroll
    for (int d = 0; d < 64; ++d) S[d] = __builtin_nontemporal_load(sp0 + (size_t)d * 128);
    __syncthreads();
    float ot[4];
#pragma unroll
    for (int t = 0; t < 4; ++t) {
        const float* kk = ksh + t * 128 + half * 64; const float* qq = qsh + t * 128 + half * 64;
        float kS = 0.f;
#pragma unroll
        for (int d4 = 0; d4 < 16; ++d4) { const f32x4 k4 = *(const f32x4*)(kk + d4 * 4); kS += k4[0] * S[d4 * 4] + k4[1] * S[d4 * 4 + 1] + k4[2] * S[d4 * 4 + 2] + k4[3] * S[d4 * 4 + 3]; }
        part[(t * 2 + half) * 128 + c] = kS;
        __syncthreads();
        kS = part[(t * 2) * 128 + c] + part[(t * 2 + 1) * 128 + c];
        const float eg = gt[t], dl = bt[t] * (vv[t] - eg * kS);
        float o = 0.f;
#pragma unroll
        for (int d4 = 0; d4 < 16; ++d4) {
            const f32x4 k4 = *(const f32x4*)(kk + d4 * 4), q4 = *(const f32x4*)(qq + d4 * 4);
#pragma unroll
            for (int e = 0; e < 4; ++e) { const float sn = eg * S[d4 * 4 + e] + k4[e] * dl; S[d4 * 4 + e] = sn; o += q4[e] * sn; }
        }
        ot[t] = o;
        if (half == 1) opart[t * 128 + c] = o;
    }
    float* dso = p.out + O_DS + ((size_t)(sb * 8 + h) * 128 + half * 64) * 128 + c;
#pragma unroll
    for (int d = 0; d < 64; ++d) __builtin_nontemporal_store(S[d], dso + (size_t)d * 128);
    __syncthreads();
    if (half == 0) {
#pragma unroll
        for (int t = 0; t < 4; ++t) { ot[t] += opart[t * 128 + c]; const float a = wave_sum(ot[t] * ot[t]); if (lane == 0) red2[wid * 4 + t] = a; }
    }
    __syncthreads();
    if (half == 0) {
        bf16_t* mix = (bf16_t*)(p.ws + WS_MIX);
        const float gn = p.in[13][c];
#pragma unroll
        for (int t = 0; t < 4; ++t) {
            const float ms = (red2[t] + red2[4 + t]) * (1.f / 128.f);
            const float z = bf2f(proj[(size_t)(r0 + t) * NPJ + C_ZA + h * 128 + c]);
            mix[(size_t)(r0 + t) * LDB + h * 128 + c] = f2bf(ot[t] * rsqrtf(ms + EPS) * gn * silu_f(z));
        }
    }
    __syncthreads();
}

DEV void attn_sample_item(const Params& p, int item, unsigned char* lds) {
    int tid = threadIdx.x & 255; asm volatile("" : "+v"(tid)); const int lane = tid & 63, wid = tid >> 6;
    const int sb = item >> 2, hd = item & 3;
    float* qs = (float*)lds;
    float* pm = qs + 2048;
    float* red = pm + 1024;
    const bf16_t* qx = (const bf16_t*)(p.ws + WS_QX);
    for (int i = tid; i < 2048; i += 256) { const int t = i >> 9, d = i & 511; qs[i] = bf2f(qx[(size_t)(TP + sb * 4 + t) * LDB + hd * 512 + d]) * 0.04419417382415922f; }
    __syncthreads();
    const float* Kc = p.in[3] + ((size_t)sb * 256) * D + hd * 512;
    const float* Vc = p.in[4] + ((size_t)sb * 256) * D + hd * 512;
    {
        const int sub = lane >> 4, l16 = lane & 15;
        for (int it = 0; it < 16; it += 2) {
            const int m = wid * 64 + it * 4 + sub;
            const float* kr = Kc + (size_t)m * D;
            f32x4 kv[8], kw[8];
#pragma unroll
            for (int i = 0; i < 8; ++i) { kv[i] = __builtin_nontemporal_load((const f32x4*)(kr + (i * 16 + l16) * 4)); kw[i] = __builtin_nontemporal_load((const f32x4*)(kr + 4 * D + (i * 16 + l16) * 4)); }
            float a0 = 0.f, a1 = 0.f, a2 = 0.f, a3 = 0.f, c0 = 0.f, c1 = 0.f, c2 = 0.f, c3 = 0.f;
#pragma unroll
            for (int i = 0; i < 8; ++i) {
                const int d = (i * 16 + l16) * 4;
                const f32x4 q0 = *(const f32x4*)(qs + d), q1 = *(const f32x4*)(qs + 512 + d), q2 = *(const f32x4*)(qs + 1024 + d), q3 = *(const f32x4*)(qs + 1536 + d);
                a0 += kv[i][0] * q0[0] + kv[i][1] * q0[1] + kv[i][2] * q0[2] + kv[i][3] * q0[3];
                a1 += kv[i][0] * q1[0] + kv[i][1] * q1[1] + kv[i][2] * q1[2] + kv[i][3] * q1[3];
                a2 += kv[i][0] * q2[0] + kv[i][1] * q2[1] + kv[i][2] * q2[2] + kv[i][3] * q2[3];
                a3 += kv[i][0] * q3[0] + kv[i][1] * q3[1] + kv[i][2] * q3[2] + kv[i][3] * q3[3];
                c0 += kw[i][0] * q0[0] + kw[i][1] * q0[1] + kw[i][2] * q0[2] + kw[i][3] * q0[3];
                c1 += kw[i][0] * q1[0] + kw[i][1] * q1[1] + kw[i][2] * q1[2] + kw[i][3] * q1[3];
                c2 += kw[i][0] * q2[0] + kw[i][1] * q2[1] + kw[i][2] * q2[2] + kw[i][3] * q2[3];
                c3 += kw[i][0] * q3[0] + kw[i][1] * q3[1] + kw[i][2] * q3[2] + kw[i][3] * q3[3];
            }
#pragma unroll
            for (int o = 1; o < 16; o <<= 1) { a0 += __shfl_xor(a0, o); a1 += __shfl_xor(a1, o); a2 += __shfl_xor(a2, o); a3 += __shfl_xor(a3, o);
                                               c0 += __shfl_xor(c0, o); c1 += __shfl_xor(c1, o); c2 += __shfl_xor(c2, o); c3 += __shfl_xor(c3, o); }
            if (l16 == 0) { *(f32x4*)(pm + m * 4) = (f32x4){a0, a1, a2, a3}; *(f32x4*)(pm + (m + 4) * 4) = (f32x4){c0, c1, c2, c3}; }
        }
    }
    __syncthreads();
    {
        const int t = wid;
        float v[4]; float mx = -3.0e38f;
#pragma unroll
        for (int i = 0; i < 4; ++i) { v[i] = pm[(i * 64 + lane) * 4 + t]; mx = fmaxf(mx, v[i]); }
        mx = wave_max(mx);
        float sm = 0.f;
#pragma unroll
        for (int i = 0; i < 4; ++i) { v[i] = __expf(v[i] - mx); sm += v[i]; }
        sm = wave_sum(sm);
        const float inv = 1.f / sm;
#pragma unroll
        for (int i = 0; i < 4; ++i) pm[(i * 64 + lane) * 4 + t] = v[i] * inv;
    }
    __syncthreads();
    {
        f32x4 acc[4][2];
#pragma unroll
        for (int t = 0; t < 4; ++t) { acc[t][0] = (f32x4){0.f, 0.f, 0.f, 0.f}; acc[t][1] = (f32x4){0.f, 0.f, 0.f, 0.f}; }
        for (int m16 = 0; m16 < 4; ++m16) {
            f32x4 va[16], vb[16];
#pragma unroll
            for (int i = 0; i < 16; ++i) { const float* vr = Vc + (size_t)(wid * 64 + m16 * 16 + i) * D; va[i] = __builtin_nontemporal_load((const f32x4*)(vr + lane * 4)); vb[i] = __builtin_nontemporal_load((const f32x4*)(vr + 256 + lane * 4)); }
#pragma unroll
            for (int i = 0; i < 16; ++i) {
                const f32x4 pr = *(const f32x4*)(pm + (wid * 64 + m16 * 16 + i) * 4);
#pragma unroll
                for (int t = 0; t < 4; ++t) { acc[t][0] += va[i] * pr[t]; acc[t][1] += vb[i] * pr[t]; }
            }
        }
#pragma unroll
        for (int t = 0; t < 4; ++t) { *(f32x4*)(red + (wid * 4 + t) * 512 + lane * 4) = acc[t][0]; *(f32x4*)(red + (wid * 4 + t) * 512 + 256 + lane * 4) = acc[t][1]; }
    }
    __syncthreads();
    {
        bf16_t* ctx = (bf16_t*)(p.ws + WS_CTX);
#pragma unroll
        for (int i = 0; i < 2; ++i) {
            const int e = (tid + 256 * i) * 4, t = e >> 9, d = e & 511;
            const f32x4 s = *(const f32x4*)(red + (0 * 4 + t) * 512 + d) + *(const f32x4*)(red + (1 * 4 + t) * 512 + d) + *(const f32x4*)(red + (2 * 4 + t) * 512 + d) + *(const f32x4*)(red + (3 * 4 + t) * 512 + d);
            store_bf4(ctx + (size_t)(TP + sb * 4 + t) * LDB + hd * 512 + d, s);
        }
    }
    __syncthreads();
}

template <int WIN>
DEV void pool_d_prompt(const bf16_t* __restrict__ proj, bf16_t* __restrict__ dpl, int row, int c8) {
    const int tloc = row & 2047;
    uint4 u[WIN];
#pragma unroll
    for (int k = 0; k < WIN; ++k) u[k] = (tloc - k >= 0) ? *(const uint4*)(proj + (size_t)(row - k) * NPJ + C_U + c8) : make_uint4(0u, 0u, 0u, 0u);
    float acc[8] = {0.f, 0.f, 0.f, 0.f, 0.f, 0.f, 0.f, 0.f};
#pragma unroll
    for (int k = 0; k < WIN; ++k) { acc[0] += bflo(u[k].x); acc[1] += bfhi(u[k].x); acc[2] += bflo(u[k].y); acc[3] += bfhi(u[k].y); acc[4] += bflo(u[k].z); acc[5] += bfhi(u[k].z); acc[6] += bflo(u[k].w); acc[7] += bfhi(u[k].w); }
    const float ic = 1.f / (float)min(WIN, tloc + 1);
    uint4 o;
    o.x = cvt_pk_bf16(acc[0] * ic - bflo(u[0].x), acc[1] * ic - bfhi(u[0].x)); o.y = cvt_pk_bf16(acc[2] * ic - bflo(u[0].y), acc[3] * ic - bfhi(u[0].y));
    o.z = cvt_pk_bf16(acc[4] * ic - bflo(u[0].z), acc[5] * ic - bfhi(u[0].z)); o.w = cvt_pk_bf16(acc[6] * ic - bflo(u[0].w), acc[7] * ic - bfhi(u[0].w));
    *(uint4*)(dpl + (size_t)row * LDP + c8) = o;
}

#ifndef REP0
#define REP0 1
#endif
#ifndef REP1
#define REP1 1
#endif
#ifndef REP2
#define REP2 1
#endif
#ifndef REP3
#define REP3 1
#endif
#ifndef REP4
#define REP4 1
#endif
#ifndef REP5
#define REP5 1
#endif
#ifndef REP6
#define REP6 1
#endif
#ifndef REP7
#define REP7 1
#endif
#ifndef REP8
#define REP8 1
#endif
#ifndef REP9
#define REP9 1
#endif
#ifndef REP10
#define REP10 1
#endif
#ifndef REP11
#define REP11 1
#endif
#ifndef REP12
#define REP12 1
#endif
#ifndef NLAUNCH
#define NLAUNCH 1
#endif
#define GRID_BAR() do { if (NLAUNCH == 1) xcd_barrier(bar); } while (0)
#define IN_PH(k) (p.ph_lo <= (k) && (k) < p.ph_hi)
__global__ void __launch_bounds__(512) hymba_fwd(Params p) {
    __shared__ __attribute__((aligned(16))) unsigned char lds[131072];
    __shared__ uint4 xb_words;
    int tid = threadIdx.x; asm volatile("" : "+v"(tid)); const int lane = tid & 63, wid = tid >> 6;
    const int vb = __builtin_amdgcn_readfirstlane(tid >> 8);
    unsigned char* vlds = lds + vb * 65536;
    const int G = gridDim.x, bid = blockIdx.x, VG = 2 * G, vbid = 2 * bid + vb;
    if (tid == 0) xb_words = make_uint4(0u, 0u, 0u, 0u);
    __syncthreads();
    XcdBarrier bar; bar.bar = (unsigned*)(p.ws + WS_BAR); bar.x = 0; bar.st = (volatile LAS unsigned*)&xb_words;
    if (NLAUNCH == 1) bar = xcd_barrier_post((unsigned*)(p.ws + WS_BAR), (volatile LAS unsigned*)&xb_words);
    unsigned char* ws = p.ws;
    bf16_t* Wt_in = (bf16_t*)(ws + WS_WIN); bf16_t* Wt_out = (bf16_t*)(ws + WS_WOUT); bf16_t* Wt_cq = (bf16_t*)(ws + WS_WCQ); bf16_t* Wt_co = (bf16_t*)(ws + WS_WCO);
    bf16_t* Wt_ckv = (bf16_t*)(ws + WS_WCKV); bf16_t* Wt_pool = (bf16_t*)(ws + WS_WPOOL);
    bf16_t* hbuf = (bf16_t*)(ws + WS_H); bf16_t* hm = (bf16_t*)(ws + WS_HM); bf16_t* proj = (bf16_t*)(ws + WS_PROJ); float* ab = (float*)(ws + WS_AB);
    bf16_t* mkb = (bf16_t*)(ws + WS_MKB); bf16_t* mvt = (bf16_t*)(ws + WS_MVT); bf16_t* dpl = (bf16_t*)(ws + WS_DPL); bf16_t* mix = (bf16_t*)(ws + WS_MIX);
    float* x1 = (float*)(ws + WS_X1); bf16_t* qx = (bf16_t*)(ws + WS_QX); float* sc = (float*)(ws + WS_SC); bf16_t* pb = (bf16_t*)(ws + WS_PB);
    bf16_t* ctx = (bf16_t*)(ws + WS_CTX); float* x2 = (float*)(ws + WS_X2); float* obuf = (float*)(ws + WS_O);
#define VLOOP(t, N) for (int t##0_ = 2 * bid, t = min(t##0_ + vb, (N) - 1); t##0_ < (N); t##0_ += VG, t = min(t##0_ + vb, (N) - 1))

    if (IN_PH(0)) {
        const int NT_IN = 98 * 32, NT_SQ = 32 * 32;
        const int total = NT_IN + 5 * NT_SQ + 64;
        VLOOP(t, total) {
            if (t < NT_IN) { const int nt = t >> 5, kt = t & 31; transpose_tile(p.in[9], 6160, nt * 64, true, kt * 64, Wt_in + (size_t)nt * 64 * LDB, LDB, (float*)vlds); }
            else if (t < NT_IN + 5 * NT_SQ) {
                const int u = t - NT_IN, j = u >> 10, v = u & 1023, nt = v >> 5, kt = v & 31;
                const float* src = p.in[j == 0 ? 16 : (j == 1 ? 19 : (j == 2 ? 22 : (j == 3 ? 20 : 21)))];
                bf16_t* dst = j == 0 ? Wt_out : (j == 1 ? Wt_cq : (j == 2 ? Wt_co : (j == 3 ? Wt_ckv : Wt_ckv + (size_t)D * LDB)));
                transpose_tile(src, D, nt * 64, false, kt * 64, dst + (size_t)nt * 64 * LDB, LDB, (float*)vlds);
            } else {
                const int u = t - NT_IN - 5 * NT_SQ, g = u >> 4, v = u & 15, nt = v >> 2, kt = v & 3;
                transpose_tile(p.in[14] + (size_t)g * 65536, 256, nt * 64, false, kt * 64, Wt_pool + ((size_t)g * 256 + nt * 64) * LDM, LDM, (float*)vlds);
            }
        }
        for (int r = bid * 8 + wid; r < TT + 1024; r += G * 8) {
            if (r < TP) rmsnorm_row_bf16(p.in[0] + (size_t)r * D, p.in[8], hbuf + (size_t)r * LDB, lane);
            else if (r < TT) rmsnorm_row_bf16(p.in[1] + (size_t)(r - TP) * D, p.in[8], hbuf + (size_t)r * LDB, lane);
            else rmsnorm_row_bf16(p.in[2] + (size_t)(r - TT) * D, p.in[17], hm + (size_t)(r - TT) * LDB, lane);
        }
    }
    GRID_BAR();
    if (IN_PH(1)) {
        for (int t = bid; t < 32 * 24; t += G) { int nt, mt; tile_map(t, 32, 24, mt, nt);
            EpiProj e{mt * 256, nt * 256, proj, ab, p.out};
            gemm256_tile(hbuf + (size_t)mt * 256 * LDB, LDB, Wt_in + (size_t)nt * 256 * LDB, LDB, D, lds, e);
        }
        VLOOP(t, 4 * 48 + 256) {
            if (t < 192) { const int mt = t & 3, nt = t >> 2;
                EpiProj e{TP + mt * 128, nt * 128, proj, ab, p.out};
                gemm_tile<64>(hbuf + (size_t)(TP + mt * 128) * LDB, LDB, Wt_in + (size_t)nt * 128 * LDB, LDB, D, vlds, e);
            } else { const int u = t - 192, mt = u & 7, nt = u >> 3;
                EpiMKV e{mt * 128, nt * 128, mkb, mvt, p.out};
                gemm_tile<64>(hm + (size_t)mt * 128 * LDB, LDB, Wt_ckv + (size_t)nt * 128 * LDB, LDB, D, vlds, e);
            }
        }
        for (int rt = bid * 8 + wid; rt < TT / 16; rt += G * 8) ab_rows16(hbuf, Wt_in + (size_t)NPJ * LDB, ab, rt, lane);
    }
    GRID_BAR();
    if (IN_PH(2)) {
        VLOOP(t, 1024) gdn_prep_chunk(p, t, vlds);
        for (int i = bid * 512 + tid; i < TP * 128; i += G * 512) {
            const int row = i >> 7, c8 = (i & 127) * 8, g = c8 >> 8;
            if (g == 0) pool_d_prompt<2>(proj, dpl, row, c8); else if (g == 1) pool_d_prompt<4>(proj, dpl, row, c8);
            else if (g == 2) pool_d_prompt<8>(proj, dpl, row, c8); else pool_d_prompt<16>(proj, dpl, row, c8);
        }
        for (int i = TP * 128 + bid * 512 + tid; i < TT * 128; i += G * 512) {
            const int row = i >> 7, c8 = (i & 127) * 8, g = c8 >> 8, win = 2 << g;
            float acc[8] = {0.f, 0.f, 0.f, 0.f, 0.f, 0.f, 0.f, 0.f}, self[8];
            const int tloc = (row - TP) & 3;
            for (int k = 0; k < win; ++k) {
                const int tt = tloc - k;
                if (tt >= 0) {
                    const uint4 u = *(const uint4*)(proj + (size_t)(row - k) * NPJ + C_U + c8);
                    const float f[8] = {bflo(u.x), bfhi(u.x), bflo(u.y), bfhi(u.y), bflo(u.z), bfhi(u.z), bflo(u.w), bfhi(u.w)};
#pragma unroll
                    for (int e = 0; e < 8; ++e) { acc[e] += f[e]; if (k == 0) self[e] = f[e]; }
                } else {
                    const float* sp = p.in[7] + ((size_t)((row - TP) >> 2) * 15 + (15 + tt)) * 1024 + c8;
                    const f32x4 s0 = *(const f32x4*)sp, s1 = *(const f32x4*)(sp + 4);
                    acc[0] += s0[0]; acc[1] += s0[1]; acc[2] += s0[2]; acc[3] += s0[3]; acc[4] += s1[0]; acc[5] += s1[1]; acc[6] += s1[2]; acc[7] += s1[3];
                }
            }
            const float ic = 1.f / (float)win;
            uint4 o; o.x = cvt_pk_bf16(acc[0] * ic - self[0], acc[1] * ic - self[1]); o.y = cvt_pk_bf16(acc[2] * ic - self[2], acc[3] * ic - self[3]);
            o.z = cvt_pk_bf16(acc[4] * ic - self[4], acc[5] * ic - self[5]); o.w = cvt_pk_bf16(acc[6] * ic - self[6], acc[7] * ic - self[7]);
            *(uint4*)(dpl + (size_t)row * LDP + c8) = o;
        }
        for (int i = bid * 512 + tid; i < SB * 11 * 256; i += G * 512) {
            const int c4 = (i & 255) * 4, rr = (i >> 8) % 11, sb = (i >> 8) / 11;
            *(f32x4*)(p.out + O_PS + ((size_t)sb * 15 + rr) * 1024 + c4) = *(const f32x4*)(p.in[7] + ((size_t)sb * 15 + rr + 4) * 1024 + c4);
        }
    }
    GRID_BAR();
    if (IN_PH(3)) {
        const int NSC = 256, NSM = 1024, NPL = 68 * 8;
        const int nsb = G >> 1;
        if (bid < nsb) {
            if (G == 256) {
                const int x = bid & 7, j = bid >> 3;
                gdn_scan_item(p, ((x * 4 + (j >> 2)) << 3) | ((j & 3) << 1) | vb, vlds);
            } else
            for (int t0 = 2 * bid; t0 < NSC; t0 += 2 * nsb) gdn_scan_item(p, min(t0 + vb, NSC - 1), vlds);
        } else {
            const int ob = bid - nsb, no = G - nsb;
            for (int t0 = 2 * ob; t0 < NSM; t0 += 2 * no) gdn_sample_item(p, min(t0 + vb, NSM - 1), vlds);
            for (int t0 = 2 * ob; t0 < NPL; t0 += 2 * no) { const int t = min(t0 + vb, NPL - 1); int nt, mt; tile_map(t, 68, 8, mt, nt); const int g = nt >> 1;
                EpiPool e{mt * 128, nt * 128, proj, p.in[15], mix};
                gemm_tile<64>(dpl + (size_t)mt * 128 * LDP + g * 256, LDP, Wt_pool + (size_t)nt * 128 * LDM, LDM, 256, vlds, e);
            }
        }
    }
    GRID_BAR();
    if (IN_PH(4)) {
        for (int i = bid * 512 + tid; i < TP * 8 * 16; i += G * 512) {
            const int l16 = i & 15, rh = i >> 4, h = rh & 7, row = rh >> 3;
            const float* op = obuf + (size_t)row * 1024 + h * 128 + l16 * 8;
            const f32x4 a = *(const f32x4*)op, b4 = *(const f32x4*)(op + 4);
            float ss = a[0] * a[0] + a[1] * a[1] + a[2] * a[2] + a[3] * a[3] + b4[0] * b4[0] + b4[1] * b4[1] + b4[2] * b4[2] + b4[3] * b4[3];
            ss += __shfl_xor(ss, 1); ss += __shfl_xor(ss, 2); ss += __shfl_xor(ss, 4); ss += __shfl_xor(ss, 8);
            const float rs = rsqrtf(ss * (1.f / 128.f) + EPS);
            const f32x4 g0 = *(const f32x4*)(p.in[13] + l16 * 8), g1 = *(const f32x4*)(p.in[13] + l16 * 8 + 4);
            const uint4 z = *(const uint4*)(proj + (size_t)row * NPJ + C_ZA + h * 128 + l16 * 8);
            uint4 o;
            o.x = cvt_pk_bf16(a[0] * rs * g0[0] * silu_f(bflo(z.x)), a[1] * rs * g0[1] * silu_f(bfhi(z.x)));
            o.y = cvt_pk_bf16(a[2] * rs * g0[2] * silu_f(bflo(z.y)), a[3] * rs * g0[3] * silu_f(bfhi(z.y)));
            o.z = cvt_pk_bf16(b4[0] * rs * g1[0] * silu_f(bflo(z.z)), b4[1] * rs * g1[1] * silu_f(bfhi(z.z)));
            o.w = cvt_pk_bf16(b4[2] * rs * g1[2] * silu_f(bflo(z.w)), b4[3] * rs * g1[3] * silu_f(bfhi(z.w)));
            *(uint4*)(mix + (size_t)row * LDB + h * 128 + l16 * 8) = o;
        }
    }
    GRID_BAR();
    if (IN_PH(5)) {
        for (int t = bid; t < 32 * 8; t += G) { int nt, mt; tile_map(t, 32, 8, mt, nt);
            EpiResid e{p.in[0] + (size_t)mt * 256 * D + nt * 256, x1 + (size_t)mt * 256 * D + nt * 256};
            gemm256_tile(mix + (size_t)mt * 256 * LDB, LDB, Wt_out + (size_t)nt * 256 * LDB, LDB, D, lds, e);
        }
        VLOOP(t, 8 * 32) { const int mt = t & 7, nt = t >> 3;
            EpiResid e{p.in[1] + (size_t)mt * 64 * D + nt * 64, x1 + (size_t)(TP + mt * 64) * D + nt * 64};
            gemm_tile<32>(mix + (size_t)(TP + mt * 64) * LDB, LDB, Wt_out + (size_t)nt * 64 * LDB, LDB, D, vlds, e);
        }
    }
    GRID_BAR();
    if (IN_PH(6))
    for (int r = bid * 8 + wid; r < TT; r += G * 8) rmsnorm_row_bf16(x1 + (size_t)r * D, p.in[18], hbuf + (size_t)r * LDB, lane);
    GRID_BAR();
    if (IN_PH(7)) {
        VLOOP(t, 8 * 32) { const int mt = t & 7, nt = t >> 3;
            EpiBf e{qx + (size_t)(TP + mt * 64) * LDB + nt * 64, LDB};
            gemm_tile<32>(hbuf + (size_t)(TP + mt * 64) * LDB, LDB, Wt_cq + (size_t)nt * 64 * LDB, LDB, D, vlds, e);
        }
    }
    GRID_BAR();
    if (IN_PH(7)) {
        const int ng = G >> 1;
        if (bid < ng) {
            for (int t = bid; t < 32 * 8; t += ng) { int nt, mt; tile_map(t, 32, 8, mt, nt);
                EpiBf e{qx + (size_t)mt * 256 * LDB + nt * 256, LDB};
                gemm256_tile(hbuf + (size_t)mt * 256 * LDB, LDB, Wt_cq + (size_t)nt * 256 * LDB, LDB, D, lds, e);
            }
        } else {
            const int ob = bid - ng, no = G - ng;
            for (int t0 = 2 * ob; t0 < 512; t0 += 2 * no) attn_sample_item(p, min(t0 + vb, 511), vlds);
        }
    }
    GRID_BAR();
    if (IN_PH(8)) {
        const int NS1 = 16 * 16 * 2;
        VLOOP(t, NS1) { const int bhd = t >> 5, v = t & 31, mt = v >> 1, nt = v & 1, b = bhd >> 2, hd = bhd & 3;
            EpiF32s e{sc + (size_t)(b * SEQ + mt * 128) * 1024 + hd * 256 + nt * 128, 1024, 0.04419417382415922f};
            gemm_tile<64>(qx + (size_t)(b * SEQ + mt * 128) * LDB + hd * 512, LDB, mkb + (size_t)(b * 256 + nt * 128) * LDB + hd * 512, LDB, 512, vlds, e);
        }
    }
    GRID_BAR();
    if (IN_PH(9))
    for (int r = bid * 8 + wid; r < TP * 4; r += G * 8) {
        const f32x4 v = *(const f32x4*)(sc + (size_t)r * 256 + lane * 4);
        const float mx = wave_max(fmaxf(fmaxf(v[0], v[1]), fmaxf(v[2], v[3])));
        f32x4 e; e[0] = __expf(v[0] - mx); e[1] = __expf(v[1] - mx); e[2] = __expf(v[2] - mx); e[3] = __expf(v[3] - mx);
        const float inv = 1.f / wave_sum(e[0] + e[1] + e[2] + e[3]);
        store_bf4(pb + (size_t)(r >> 2) * LDP + (r & 3) * 256 + lane * 4, e * inv);
    }
    GRID_BAR();
    if (IN_PH(10)) {
        VLOOP(t, 16 * 16 * 4) { const int bhd = t >> 6, v = t & 63, mt = v >> 2, nt = v & 3, b = bhd >> 2, hd = bhd & 3;
            EpiBf e{ctx + (size_t)(b * SEQ + mt * 128) * LDB + hd * 512 + nt * 128, LDB};
            gemm_tile<64>(pb + (size_t)(b * SEQ + mt * 128) * LDP + hd * 256, LDP, mvt + ((size_t)b * D + hd * 512 + nt * 128) * LDM, LDM, 256, vlds, e);
        }
    }
    GRID_BAR();
    if (IN_PH(11)) {
        for (int t = bid; t < 32 * 8; t += G) { int nt, mt; tile_map(t, 32, 8, mt, nt);
            EpiResid e{x1 + (size_t)mt * 256 * D + nt * 256, x2 + (size_t)mt * 256 * D + nt * 256};
            gemm256_tile(ctx + (size_t)mt * 256 * LDB, LDB, Wt_co + (size_t)nt * 256 * LDB, LDB, D, lds, e);
        }
        VLOOP(t, 8 * 32) { const int mt = t & 7, nt = t >> 3;
            EpiResid e{x1 + (size_t)(TP + mt * 64) * D + nt * 64, x2 + (size_t)(TP + mt * 64) * D + nt * 64};
            gemm_tile<32>(ctx + (size_t)(TP + mt * 64) * LDB, LDB, Wt_co + (size_t)nt * 64 * LDB, LDB, D, vlds, e);
        }
    }
    GRID_BAR();
    if (IN_PH(12))
    for (int r = bid * 8 + wid; r < TT; r += G * 8) rmsnorm_row_f32(x2 + (size_t)r * D, p.in[23], p.out + (r < TP ? O_YP + (size_t)r * D : O_YS + (size_t)(r - TP) * D), lane);
}

extern "C" void kernel_launch(void* const* d_in, const int* in_sizes, int n_in, void* d_out, int out_size, void* d_ws, size_t ws_size, hipStream_t stream) {
    static int grid = 0;
    if (grid == 0) {
        if (n_in != 24 || ws_size < WS_END) { fprintf(stderr, "kernel_launch: need 24 inputs and %zu bytes of workspace (got %d, %zu)\n", (size_t)WS_END, n_in, ws_size); grid = -1; return; }
        int dev = 0, cus = 0, per_cu = 0;
        hipGetDevice(&dev);
        hipDeviceGetAttribute(&cus, hipDeviceAttributeMultiprocessorCount, dev);
        if (hipOccupancyMaxActiveBlocksPerMultiprocessor(&per_cu, (const void*)hymba_fwd, 512, 0) != hipSuccess || per_cu < 1) { fprintf(stderr, "kernel_launch: occupancy query failed\n"); grid = -1; return; }
        if (per_cu > 1) per_cu = 1;
        grid = cus * per_cu;
        fprintf(stderr, "kernel_launch: grid %d (%d per CU)\n", grid, per_cu);
    }
    if (grid < 0) return;
    hipMemsetAsync((char*)d_ws + WS_BAR, 0, 16384, stream);
    Params p{};
    for (int i = 0; i < 24; ++i) p.in[i] = (const float*)d_in[i];
    p.out = (float*)d_out; p.ws = (unsigned char*)d_ws;
    if (NLAUNCH == 1) {
        p.ph_lo = 0; p.ph_hi = 13;
        void* args[] = {&p};
        hipError_t e = hipLaunchCooperativeKernel((const void*)hymba_fwd, dim3(grid), dim3(512), args, 0, stream);
        if (e != hipSuccess) fprintf(stderr, "kernel_launch: cooperative launch failed: %s (grid %d)\n", hipGetErrorString(e), grid);
    } else {
        for (int k = 0; k < 13; ++k) { p.ph_lo = k; p.ph_hi = k + 1; hipLaunchKernelGGL(hymba_fwd, dim3(grid), dim3(512), 0, stream, p); }
    }
}
```

```cpp
#include <hip/hip_runtime.h>
#include <hip/hip_cooperative_groups.h>
#include <cstdio>
#include <cstdint>

typedef unsigned short bf16_t;
typedef short bf16x8 __attribute__((ext_vector_type(8)));
typedef float f32x4 __attribute__((ext_vector_type(4)));
#define DEV __device__ __forceinline__
#define LAS __attribute__((address_space(3)))

constexpr int D = 2048, TP = 8192, TS = 512, TT = 8704, SEQ = 2048, NB = 4, SB = 128;
constexpr int NPJ = 6144;
constexpr int C_ZA = 3072, C_U = 4096, C_ZB = 5120;
constexpr int NWIN = 6272;
constexpr float EPS = 1e-6f;
constexpr int LDB = 2112, LDP = 1088, LDM = 288;

constexpr size_t O_YP = 0, O_YS = 16777216, O_MK = 17825792, O_MV = 19922944, O_DP = 22020096, O_CP = 22544384,
                 O_PP = 22581248, O_DS = 22642688, O_CS = 39419904, O_PS = 40599552;

constexpr size_t al256(size_t x) { return (x + 255) & ~(size_t)255; }
constexpr size_t WS_BAR = 0;
constexpr size_t WS_WIN = 16384;
constexpr size_t WS_WOUT = WS_WIN + (size_t)NWIN * LDB * 2;
constexpr size_t WS_WCQ = WS_WOUT + (size_t)D * LDB * 2;
constexpr size_t WS_WCO = WS_WCQ + (size_t)D * LDB * 2;
constexpr size_t WS_WCKV = WS_WCO + (size_t)D * LDB * 2;
constexpr size_t WS_WPOOL = WS_WCKV + (size_t)2 * D * LDB * 2;
constexpr size_t WS_H = WS_WPOOL + (size_t)1024 * LDM * 2;
constexpr size_t WS_HM = WS_H + (size_t)TT * LDB * 2;
constexpr size_t WS_PROJ = WS_HM + (size_t)1024 * LDB * 2;
constexpr size_t WS_AB = WS_PROJ + (size_t)TT * NPJ * 2;
constexpr size_t WS_MKB = WS_AB + (size_t)TT * 16 * 4;
constexpr size_t WS_MVT = WS_MKB + (size_t)1024 * LDB * 2;
constexpr size_t WS_GW = WS_MVT + (size_t)4 * D * LDM * 2;
constexpr size_t WS_GQ = WS_GW + (size_t)1024 * 8192 * 2;
constexpr size_t WS_GKT = WS_GQ + (size_t)1024 * 8192 * 2;
constexpr size_t WS_GA = WS_GKT + (size_t)1024 * 8192 * 2;
constexpr size_t WS_GU = WS_GA + (size_t)1024 * 4096 * 2;
constexpr size_t WS_GE = WS_GU + (size_t)1024 * 8192 * 4;
constexpr size_t WS_O = WS_GE + 4096;
constexpr size_t WS_DPL = WS_O + (size_t)TP * 1024 * 4;
constexpr size_t WS_MIX = WS_DPL + (size_t)TT * LDP * 2;
constexpr size_t WS_X1 = WS_MIX + (size_t)TT * LDB * 2;
constexpr size_t WS_QX = WS_X1 + (size_t)TT * D * 4;
constexpr size_t WS_SC = WS_QX + (size_t)TT * LDB * 2;
constexpr size_t WS_PB = WS_SC + (size_t)TP * 1024 * 4;
constexpr size_t WS_CTX = WS_PB + (size_t)TP * LDP * 2;
constexpr size_t WS_X2 = WS_CTX + (size_t)TT * LDB * 2;
constexpr size_t WS_END = WS_X2 + (size_t)TT * D * 4;

#ifndef LASTP
#define LASTP 99
#endif
struct Params { const float* in[24]; float* out; unsigned char* ws; int ph_lo, ph_hi; };

typedef __bf16 bf16x2_t __attribute__((ext_vector_type(2)));
typedef float f32x2_t __attribute__((ext_vector_type(2)));
DEV unsigned cvt_pk_bf16(float lo, float hi) { const f32x2_t v = {lo, hi}; const bf16x2_t b = __builtin_convertvector(v, bf16x2_t); return __builtin_bit_cast(unsigned, b); }
DEV bf16_t f2bf(float f) { return (bf16_t)(cvt_pk_bf16(f, 0.f) & 0xffffu); }
DEV float bf2f(unsigned b) { return __uint_as_float(b << 16); }
DEV float bflo(unsigned u) { return __uint_as_float(u << 16); }
DEV float bfhi(unsigned u) { return __uint_as_float(u & 0xffff0000u); }
DEV float silu_f(float x) { return x / (1.f + __expf(-x)); }
DEV float wave_sum(float v) {
#pragma unroll
    for (int o = 32; o >= 1; o >>= 1) v += __shfl_xor(v, o);
    return v;
}
DEV float wave_max(float v) {
#pragma unroll
    for (int o = 32; o >= 1; o >>= 1) v = fmaxf(v, __shfl_xor(v, o));
    return v;
}
DEV void store_bf4(bf16_t* p, f32x4 v) { uint2 w; w.x = cvt_pk_bf16(v[0], v[1]); w.y = cvt_pk_bf16(v[2], v[3]); *(uint2*)p = w; }

#define XB_TMO      128
#define XB_XCNT(j)  (256  + 64 * (j))
#define XB_XSUB(j)  (1280 + 64 * (j))
#define XB_XGEN(j)  (2304 + 64 * (j))
#define XB_TOP      3328
#define XB_TOPGEN   3392
#define XCD_BAR_WORDS 3456
#define XB_SPIN_CAP (1u << 22)
DEV unsigned xb_ld(unsigned* p) { return __hip_atomic_load(p, __ATOMIC_RELAXED, __HIP_MEMORY_SCOPE_AGENT); }
DEV unsigned xb_add(unsigned* p, unsigned v) { return __hip_atomic_fetch_add(p, v, __ATOMIC_RELAXED, __HIP_MEMORY_SCOPE_AGENT); }
DEV unsigned xb_xcc_id() { return (unsigned)__builtin_amdgcn_s_getreg((3 << 11) | 20) & 0xFu; }
#define XB_SPIN(cond, bar) do { unsigned _sp = 0; while (cond) { __builtin_amdgcn_s_sleep(1); \
    if ((++_sp & 255u) == 0u) { if (xb_ld(&(bar)[XB_TMO])) break; if (_sp > XB_SPIN_CAP) { atomicAdd(&(bar)[XB_TMO], 1u); break; } } } } while (0)
struct XcdBarrier { unsigned* bar; unsigned x; volatile LAS unsigned* st; };
DEV XcdBarrier xcd_barrier_post(unsigned* bar, volatile LAS unsigned* st) {
    XcdBarrier b; b.bar = bar; b.x = xb_xcc_id(); b.st = st;
    if (threadIdx.x == 0) (void)xb_add(&bar[XB_XCNT(b.x)], 1u);
    return b;
}
DEV void xcd_barrier_complete(unsigned* bar, unsigned x, unsigned& nloc, unsigned& nx) {
    const unsigned G = gridDim.x;
    unsigned sum, cnt, mine, sp = 0u;
    for (;;) {
        sum = 0u; cnt = 0u; mine = 0u;
#pragma unroll
        for (unsigned j = 0; j < 16; ++j) { const unsigned c = xb_ld(&bar[XB_XCNT(j)]); sum += c; cnt += (c > 0u) ? 1u : 0u; mine = (j == x) ? c : mine; }
        if (sum == G) break;
        __builtin_amdgcn_s_sleep(1);
        if ((++sp & 255u) == 0u) { if (xb_ld(&bar[XB_TMO])) break; if (sp > XB_SPIN_CAP) { atomicAdd(&bar[XB_TMO], 1u); break; } }
    }
    nloc = mine > 0u ? mine : 1u; nx = cnt > 0u ? cnt : 1u;
}
DEV void xcd_barrier(const XcdBarrier& b) {
    asm volatile("s_waitcnt vmcnt(0)" ::: "memory");
    __syncthreads();
    if (threadIdx.x == 0) {
        unsigned* bar = b.bar;
        __builtin_amdgcn_s_waitcnt(0);
        unsigned nloc = b.st[0], nx = b.st[1];
        if (nloc == 0u) { xcd_barrier_complete(bar, b.x, nloc, nx); b.st[0] = nloc; b.st[1] = nx; }
        const unsigned old = xb_add(&bar[XB_XSUB(b.x)], 1u);
        const unsigned gen = old / nloc;
        if (old + 1u == (gen + 1u) * nloc) {
            __builtin_amdgcn_fence(__ATOMIC_RELEASE, "agent");
            asm volatile("s_waitcnt vmcnt(0)" ::: "memory");
            const unsigned og = xb_add(&bar[XB_TOP], 1u);
            const unsigned tg = og / nx;
            if (og + 1u == (tg + 1u) * nx) xb_add(&bar[XB_TOPGEN], 1u);
            else XB_SPIN(xb_ld(&bar[XB_TOPGEN]) == tg, bar);
            __builtin_amdgcn_fence(__ATOMIC_ACQUIRE, "agent");
            xb_add(&bar[XB_XGEN(b.x)], 1u);
            asm volatile("s_waitcnt vmcnt(0)" ::: "memory");
        } else {
            XB_SPIN(xb_ld(&bar[XB_XGEN(b.x)]) == gen, bar);
            __builtin_amdgcn_fence(__ATOMIC_ACQUIRE, "agent");
            asm volatile("s_waitcnt vmcnt(0)" ::: "memory");
        }
    }
    __syncthreads();
}

DEV void glds16(const void* gptr, unsigned lds_addr_lane) {
    const unsigned m = __builtin_amdgcn_readfirstlane(lds_addr_lane);
    unsigned keep;
    asm volatile("s_mov_b32 %0, m0\n\ts_mov_b32 m0, %2\n\ts_nop 0\n\tglobal_load_lds_dwordx4 %1, off\n\ts_mov_b32 m0, %0" : "=&s"(keep) : "v"(gptr), "s"(m) : "memory");
}

template <int WT, class Epi>
DEV void gemm_tile(const bf16_t* __restrict__ A, int lda, const bf16_t* __restrict__ Bt, int ldb, int K, unsigned char* lds, const Epi& epi) {
    constexpr int FI = WT / 16;
    constexpr int OPB = 2 * WT * 128;
    constexpr int STB = 2 * OPB;
    int tid = threadIdx.x & 255; asm volatile("" : "+v"(tid)); const int lane = tid & 63, wid = tid >> 6;
    const int wr = wid >> 1, wc = wid & 1, fr = lane & 15, fq = lane >> 4;
    f32x4 acc[FI][FI];
#pragma unroll
    for (int i = 0; i < FI; ++i)
#pragma unroll
        for (int j = 0; j < FI; ++j) acc[i][j] = (f32x4){0.f, 0.f, 0.f, 0.f};
    const int lrow = tid >> 3, lcs = (tid & 7) ^ (lrow & 7);
    const bf16_t* ap = A + (size_t)lrow * lda + lcs * 8;
    const bf16_t* bp = Bt + (size_t)lrow * ldb + lcs * 8;
    const unsigned l3a = (unsigned)(size_t)(LAS unsigned char*)lds;
    const int nk = K >> 6;
#define GLDS_STAGE(st, kt_) do { \
        _Pragma("unroll") for (int i_ = 0; i_ < FI; ++i_) { \
            glds16(ap + (size_t)(32 * i_) * lda + (kt_) * 64, l3a + (st) + tid * 16 + i_ * 4096); \
            glds16(bp + (size_t)(32 * i_) * ldb + (kt_) * 64, l3a + (st) + OPB + tid * 16 + i_ * 4096); } } while (0)
    constexpr int NSTG = 65536 / STB;
#pragma unroll
    for (int s_ = 0; s_ < NSTG - 1; ++s_) if (s_ < nk) GLDS_STAGE(s_ * STB, s_);
    const int aoff = (wr * WT + fr) * 128, boff = OPB + (wc * WT + fr) * 128, sw = fr & 7;
    int cur = 0, nxt = (NSTG - 1) * STB;
    for (int kt = 0; kt < nk; ++kt) {
        if (NSTG == 4 && kt + 2 < nk) { if (FI == 2) asm volatile("s_waitcnt vmcnt(8)" ::: "memory"); else asm volatile("s_waitcnt vmcnt(0)" ::: "memory"); }
        else asm volatile("s_waitcnt vmcnt(0)" ::: "memory");
        __syncthreads();
        if (kt + NSTG - 1 < nk) GLDS_STAGE(nxt, kt + NSTG - 1);
#pragma unroll
        for (int kh = 0; kh < 2; ++kh) {
            bf16x8 af[FI], bfr[FI];
            const int ch = ((kh * 4 + fq) ^ sw) << 4;
#pragma unroll
            for (int i = 0; i < FI; ++i) { af[i] = *(const bf16x8*)(lds + cur + aoff + i * 2048 + ch); bfr[i] = *(const bf16x8*)(lds + cur + boff + i * 2048 + ch); }
#pragma unroll
            for (int mi = 0; mi < FI; ++mi)
#pragma unroll
                for (int ni = 0; ni < FI; ++ni) acc[mi][ni] = __builtin_amdgcn_mfma_f32_16x16x32_bf16(bfr[ni], af[mi], acc[mi][ni], 0, 0, 0);
        }
        nxt = cur; cur += STB; if (cur == NSTG * STB) cur = 0;
    }
#undef GLDS_STAGE
    __syncthreads();
#pragma unroll
    for (int mi = 0; mi < FI; ++mi)
#pragma unroll
        for (int ni = 0; ni < FI; ++ni) epi(wr * WT + mi * 16 + fr, wc * WT + ni * 16 + fq * 4, acc[mi][ni]);
}

template <class Epi>
DEV void gemm256_tile(const bf16_t* __restrict__ A, int lda, const bf16_t* __restrict__ Bt, int ldb, int K, unsigned char* lds, const Epi& epi) {
    int tid = threadIdx.x; asm volatile("" : "+v"(tid)); const int lane = tid & 63, wid = tid >> 6;
    const int wr = wid >> 2, wc = wid & 3, fr = lane & 15, fq = lane >> 4;
    f32x4 acc[8][4];
#pragma unroll
    for (int i = 0; i < 8; ++i)
#pragma unroll
        for (int j = 0; j < 4; ++j) acc[i][j] = (f32x4){0.f, 0.f, 0.f, 0.f};
    const int lrow = tid >> 3, lcs = (tid & 7) ^ (lrow & 7);
    const bf16_t* ap = A + (size_t)lrow * lda + lcs * 8;
    const bf16_t* bp = Bt + (size_t)lrow * ldb + lcs * 8;
    const unsigned l3a = (unsigned)(size_t)(LAS unsigned char*)lds;
    const int nk = K >> 6;
#define GLDS_STAGE(st, kt_) do { \
        _Pragma("unroll") for (int i_ = 0; i_ < 4; ++i_) { \
            glds16(ap + (size_t)(64 * i_) * lda + (kt_) * 64, l3a + (st) + tid * 16 + i_ * 8192); \
            glds16(bp + (size_t)(64 * i_) * ldb + (kt_) * 64, l3a + (st) + 32768 + tid * 16 + i_ * 8192); } } while (0)
    GLDS_STAGE(0, 0);
    const int aoff = (wr * 128 + fr) * 128, boff = 32768 + (wc * 64 + fr) * 128, sw = fr & 7;
    for (int kt = 0; kt < nk; ++kt) {
        const int cur = (kt & 1) * 65536;
        asm volatile("s_waitcnt vmcnt(0)" ::: "memory");
        __syncthreads();
        if (kt + 1 < nk) GLDS_STAGE(cur ^ 65536, kt + 1);
#pragma unroll
        for (int kh = 0; kh < 2; ++kh) {
            bf16x8 bfr[4];
            const int ch = ((kh * 4 + fq) ^ sw) << 4;
#pragma unroll
            for (int i = 0; i < 4; ++i) bfr[i] = *(const bf16x8*)(lds + cur + boff + i * 2048 + ch);
#pragma unroll
            for (int mh = 0; mh < 2; ++mh) {
                bf16x8 af[4];
#pragma unroll
                for (int i = 0; i < 4; ++i) af[i] = *(const bf16x8*)(lds + cur + aoff + (mh * 4 + i) * 2048 + ch);
#pragma unroll
                for (int mi = 0; mi < 4; ++mi)
#pragma unroll
                    for (int ni = 0; ni < 4; ++ni) acc[mh * 4 + mi][ni] = __builtin_amdgcn_mfma_f32_16x16x32_bf16(bfr[ni], af[mi], acc[mh * 4 + mi][ni], 0, 0, 0);
            }
        }
    }
#undef GLDS_STAGE
    __syncthreads();
#pragma unroll
    for (int mi = 0; mi < 8; ++mi)
#pragma unroll
        for (int ni = 0; ni < 4; ++ni) epi(wr * 128 + mi * 16 + fr, wc * 64 + ni * 16 + fq * 4, acc[mi][ni]);
}

DEV void ab_rows16(const bf16_t* __restrict__ h, const bf16_t* __restrict__ wab, float* __restrict__ ab, int rt, int lane) {
    const int fr = lane & 15, fq = lane >> 4;
    const bf16_t* ap = h + (size_t)(rt * 16 + fr) * LDB + fq * 8;
    const bf16_t* bp = wab + (size_t)fr * LDB + fq * 8;
    f32x4 acc = {0.f, 0.f, 0.f, 0.f};
#pragma unroll 8
    for (int s = 0; s < 64; ++s) {
        const bf16x8 a = *(const bf16x8*)(ap + s * 32), b = *(const bf16x8*)(bp + s * 32);
        acc = __builtin_amdgcn_mfma_f32_16x16x32_bf16(b, a, acc, 0, 0, 0);
    }
    *(f32x4*)(ab + (size_t)(rt * 16 + fr) * 16 + fq * 4) = acc;
}

DEV void tile_map(int L, int nM, int nN, int& pm, int& pn) {
    const int T = nM * nN, q = T >> 3, r = T & 7, xcd = L & 7, off = L >> 3;
    const int w = (xcd < r ? xcd * (q + 1) : r * (q + 1) + (xcd - r) * q) + off;
    const int nig = 8 * nN, gid = w / nig, fm = gid * 8, gsz = (nM - fm) < 8 ? (nM - fm) : 8;
    pm = fm + (w % nig) % gsz; pn = (w % nig) / gsz;
}

struct EpiProj {
    int m0, n0; bf16_t* proj; float* ab; float* out;
    DEV void operator()(int r, int c, f32x4 v) const {
        const int row = m0 + r, col = n0 + c;
        if (col < NPJ) {
            store_bf4(proj + (size_t)row * NPJ + col, v);
            const bool isconv = col < 3072, ispool = (col >= C_U && col < C_ZB);
            if (isconv || ispool) {
                if (row < TP) {
                    const int b = row >> 11, t = row & 2047;
                    if (isconv) { if (t >= 2045) *(f32x4*)(out + O_CP + ((size_t)(b * 3 + (t - 2045))) * 3072 + col) = v; }
                    else { if (t >= 2033) *(f32x4*)(out + O_PP + ((size_t)(b * 15 + (t - 2033))) * 1024 + (col - C_U)) = v; }
                } else {
                    const int sb = (row - TP) >> 2, t = (row - TP) & 3;
                    if (isconv) { if (t >= 1) *(f32x4*)(out + O_CS + ((size_t)(sb * 3 + (t - 1))) * 3072 + col) = v; }
                    else *(f32x4*)(out + O_PS + ((size_t)(sb * 15 + 11 + t)) * 1024 + (col - C_U)) = v;
                }
            }
        } else if (col < NPJ + 16) {
            *(f32x4*)(ab + (size_t)row * 16 + (col - NPJ)) = v;
        }
    }
};
struct EpiMKV {
    int m0, n0; bf16_t* mkb; bf16_t* mvt; float* out;
    DEV void operator()(int r, int c, f32x4 v) const {
        const int row = m0 + r, col = n0 + c;
        if (col < D) {
            *(f32x4*)(out + O_MK + (size_t)row * D + col) = v;
            store_bf4(mkb + (size_t)row * LDB + col, v);
        } else {
            const int cc = col - D, b = row >> 8, m = row & 255;
            *(f32x4*)(out + O_MV + (size_t)row * D + cc) = v;
            bf16_t* p = mvt + ((size_t)b * D + cc) * LDM + m;
            p[0] = f2bf(v[0]); p[LDM] = f2bf(v[1]); p[2 * LDM] = f2bf(v[2]); p[3 * LDM] = f2bf(v[3]);
        }
    }
};
struct EpiPool {
    int m0, n0; const bf16_t* proj; const float* scale; bf16_t* mix;
    DEV void operator()(int r, int c, f32x4 v) const {
        const int row = m0 + r, col = n0 + c;
        const uint2 z = *(const uint2*)(proj + (size_t)row * NPJ + C_ZB + col);
        const f32x4 s = *(const f32x4*)(scale + col);
        f32x4 o;
        o[0] = v[0] * s[0] * silu_f(bflo(z.x)); o[1] = v[1] * s[1] * silu_f(bfhi(z.x));
        o[2] = v[2] * s[2] * silu_f(bflo(z.y)); o[3] = v[3] * s[3] * silu_f(bfhi(z.y));
        store_bf4(mix + (size_t)row * LDB + 1024 + col, o);
    }
};
struct EpiResid {
    const float* res; bf16_t* dst;
    DEV void operator()(int r, int c, f32x4 v) const {
        const f32x4 x = __builtin_nontemporal_load((const f32x4*)(res + (size_t)r * D + c));
        store_bf4(dst + (size_t)r * LDB + c, x + v);
    }
};
struct EpiResidB {
    const bf16_t* res; bf16_t* dst;
    DEV void operator()(int r, int c, f32x4 v) const {
        const uint2 u = *(const uint2*)(res + (size_t)r * LDB + c);
        f32x4 x; x[0] = bflo(u.x); x[1] = bfhi(u.x); x[2] = bflo(u.y); x[3] = bfhi(u.y);
        store_bf4(dst + (size_t)r * LDB + c, x + v);
    }
};
struct EpiBf {
    bf16_t* dst; int ld;
    DEV void operator()(int r, int c, f32x4 v) const { store_bf4(dst + (size_t)r * ld + c, v); }
};
struct EpiF32s {
    float* dst; int ld; float s;
    DEV void operator()(int r, int c, f32x4 v) const { *(f32x4*)(dst + (size_t)r * ld + c) = v * s; }
};

DEV int win_srccol(int n) { return n < 4096 ? n : (n < 6144 ? n + 16 : (n < 6160 ? 4096 + (n - 6144) : -1)); }
DEV void transpose_tile(const float* __restrict__ src, int ld, int srccol0, bool remap, int k0, bf16_t* __restrict__ dstrow0, int ldd, float* tile) {
    int tid = threadIdx.x & 255; asm volatile("" : "+v"(tid));
    const int tx = tid & 63, ty = tid >> 6;
    const int sc = remap ? win_srccol(srccol0 + tx) : (srccol0 + tx);
    float tv[32];
#pragma unroll
    for (int i = 0; i < 32; ++i) tv[i] = sc >= 0 ? __builtin_nontemporal_load(src + (size_t)(k0 + ty + 4 * i) * ld + sc) : 0.f;
#pragma unroll
    for (int i = 0; i < 32; ++i) tile[(ty + 4 * i) * 65 + tx] = tv[i];
    __syncthreads();
#pragma unroll
    for (int i = 0; i < 16; ++i) { const int r = ty + 4 * i; *(unsigned*)(dstrow0 + (size_t)r * ldd + k0 + 2 * tx) = cvt_pk_bf16(tile[(2 * tx) * 65 + r], tile[(2 * tx + 1) * 65 + r]); }
    __syncthreads();
}
DEV void rmsnorm_row_bf16(const float* __restrict__ x, const float* __restrict__ g, bf16_t* __restrict__ y, int lane) {
    f32x4 v[8]; float ss = 0.f;
#pragma unroll
    for (int i = 0; i < 8; ++i) { v[i] = ((const f32x4*)x)[i * 64 + lane]; ss += v[i][0] * v[i][0] + v[i][1] * v[i][1] + v[i][2] * v[i][2] + v[i][3] * v[i][3]; }
    ss = wave_sum(ss);
    const float rs = rsqrtf(ss * (1.f / 2048.f) + EPS);
#pragma unroll
    for (int i = 0; i < 8; ++i) { const f32x4 gg = ((const f32x4*)g)[i * 64 + lane]; store_bf4(y + (size_t)(i * 64 + lane) * 4, v[i] * rs * gg); }
}
template <bool OUT_F32>
DEV void rmsnorm_row_from_bf16(const bf16_t* __restrict__ x, const float* __restrict__ g, void* __restrict__ y, int lane) {
    float v[4][8]; float ss = 0.f;
#pragma unroll
    for (int i = 0; i < 4; ++i) { const uint4 u = ((const uint4*)x)[i * 64 + lane];
        v[i][0] = bflo(u.x); v[i][1] = bfhi(u.x); v[i][2] = bflo(u.y); v[i][3] = bfhi(u.y); v[i][4] = bflo(u.z); v[i][5] = bfhi(u.z); v[i][6] = bflo(u.w); v[i][7] = bfhi(u.w);
#pragma unroll
        for (int e = 0; e < 8; ++e) ss += v[i][e] * v[i][e]; }
    ss = wave_sum(ss);
    const float rs = rsqrtf(ss * (1.f / 2048.f) + EPS);
#pragma unroll
    for (int i = 0; i < 4; ++i) {
        const f32x4 g0 = ((const f32x4*)g)[(i * 64 + lane) * 2], g1 = ((const f32x4*)g)[(i * 64 + lane) * 2 + 1];
        const f32x4 o0 = (f32x4){v[i][0], v[i][1], v[i][2], v[i][3]} * rs * g0, o1 = (f32x4){v[i][4], v[i][5], v[i][6], v[i][7]} * rs * g1;
        if (OUT_F32) { __builtin_nontemporal_store(o0, (f32x4*)y + (i * 64 + lane) * 2); __builtin_nontemporal_store(o1, (f32x4*)y + (i * 64 + lane) * 2 + 1); }
        else { uint4 w; w.x = cvt_pk_bf16(o0[0], o0[1]); w.y = cvt_pk_bf16(o0[2], o0[3]); w.z = cvt_pk_bf16(o1[0], o1[1]); w.w = cvt_pk_bf16(o1[2], o1[3]); ((uint4*)y)[i * 64 + lane] = w; }
    }
}
DEV void rmsnorm_row_f32(const float* __restrict__ x, const float* __restrict__ g, float* __restrict__ y, int lane) {
    f32x4 v[8]; float ss = 0.f;
#pragma unroll
    for (int i = 0; i < 8; ++i) { v[i] = ((const f32x4*)x)[i * 64 + lane]; ss += v[i][0] * v[i][0] + v[i][1] * v[i][1] + v[i][2] * v[i][2] + v[i][3] * v[i][3]; }
    ss = wave_sum(ss);
    const float rs = rsqrtf(ss * (1.f / 2048.f) + EPS);
#pragma unroll
    for (int i = 0; i < 8; ++i) { const f32x4 gg = ((const f32x4*)g)[i * 64 + lane]; __builtin_nontemporal_store(v[i] * rs * gg, (f32x4*)y + i * 64 + lane); }
}

constexpr int QS = 136;
DEV void gdn_prep_chunk(const Params& p, int item, unsigned char* lds) {
    int tid = threadIdx.x & 255; asm volatile("" : "+v"(tid)); const int lane = tid & 63, wid = tid >> 6;
    const int c = item & 31, h = (item >> 5) & 7, b = item >> 8;
    const int row0 = b * SEQ + c * 64;
    const bf16_t* proj = (const bf16_t*)(p.ws + WS_PROJ);
    const float* ab = (const float*)(p.ws + WS_AB);
    bf16_t* qs = (bf16_t*)lds; bf16_t* ks = qs + 64 * QS; bf16_t* vs = ks + 64 * QS;
    float* lowT = (float*)lds;
    float* gcs = (float*)(lds + 3 * 64 * QS * 2);
    float* bts = gcs + 64;
    bf16_t* gW = (bf16_t*)(p.ws + WS_GW) + (size_t)item * 8192;
    bf16_t* gQ = (bf16_t*)(p.ws + WS_GQ) + (size_t)item * 8192;
    bf16_t* gKT = (bf16_t*)(p.ws + WS_GKT) + (size_t)item * 8192;
    bf16_t* gA = (bf16_t*)(p.ws + WS_GA) + (size_t)item * 4096;
    float* gU = (float*)(p.ws + WS_GU) + (size_t)item * 8192;
    float* gE = (float*)(p.ws + WS_GE) + item;

    if (wid == 3) {
        const float a = ab[(size_t)(row0 + lane) * 16 + h], bb = ab[(size_t)(row0 + lane) * 16 + 8 + h];
        const float xx = a + p.in[12][h];
        const float sp = xx > 20.f ? xx : log1pf(__expf(xx));
        float s = -__expf(p.in[11][h]) * sp;
#pragma unroll
        for (int d = 1; d < 64; d <<= 1) { const float t = __shfl_up(s, d); if (lane >= d) s += t; }
        gcs[lane] = s; bts[lane] = 1.f / (1.f + __expf(-bb));
    } else {
        const int mat = wid, rg = lane >> 4, cv = lane & 15;
        const int colg = mat * 1024 + h * 128 + cv * 8;
        const float* cw = p.in[10];
        float w[4][8];
#pragma unroll
        for (int j = 0; j < 4; ++j) { const f32x4 w0 = *(const f32x4*)(cw + j * 3072 + colg), w1 = *(const f32x4*)(cw + j * 3072 + colg + 4);
            w[j][0] = w0[0]; w[j][1] = w0[1]; w[j][2] = w0[2]; w[j][3] = w0[3]; w[j][4] = w1[0]; w[j][5] = w1[1]; w[j][6] = w1[2]; w[j][7] = w1[3]; }
        const int tl0 = rg * 16;
        uint4 raw[19];
#pragma unroll
        for (int i = 0; i < 19; ++i) {
            const int tl = tl0 - 3 + i;
            if (c * 64 + tl >= 0) raw[i] = *(const uint4*)(proj + (size_t)(row0 + tl) * NPJ + colg);
            else raw[i] = make_uint4(0u, 0u, 0u, 0u);
        }
        bf16_t* dst = (mat == 0 ? qs : (mat == 1 ? ks : vs));
#pragma unroll
        for (int r = 0; r < 16; ++r) {
            float y[8]; float ss = 0.f;
#pragma unroll
            for (int e = 0; e < 8; ++e) {
                float a = 0.f;
#pragma unroll
                for (int j = 0; j < 4; ++j) {
                    const uint4 u = raw[r + j];
                    const unsigned wd = (e < 2 ? u.x : (e < 4 ? u.y : (e < 6 ? u.z : u.w)));
                    const float xv = (e & 1) ? bfhi(wd) : bflo(wd);
                    a += w[j][e] * xv;
                }
                y[e] = silu_f(a); ss += y[e] * y[e];
            }
            if (mat < 2) {
                ss += __shfl_xor(ss, 1); ss += __shfl_xor(ss, 2); ss += __shfl_xor(ss, 4); ss += __shfl_xor(ss, 8);
                float inv = rsqrtf(ss + EPS); if (mat == 0) inv *= 0.08838834764831845f;
#pragma unroll
                for (int e = 0; e < 8; ++e) y[e] *= inv;
            }
            uint4 o; o.x = cvt_pk_bf16(y[0], y[1]); o.y = cvt_pk_bf16(y[2], y[3]); o.z = cvt_pk_bf16(y[4], y[5]); o.w = cvt_pk_bf16(y[6], y[7]);
            *(uint4*)(dst + (tl0 + r) * QS + cv * 8) = o;
        }
    }
    __syncthreads();
    {
        const float glast = gcs[63];
        if (tid == 0) *gE = __expf(glast);
#pragma unroll
        for (int i = 0; i < 4; ++i) {
            const int ci = tid + 256 * i, t = ci >> 4, cc = (ci & 15) * 8;
            const uint4 u = *(const uint4*)(qs + t * QS + cc);
            const float e = __expf(gcs[t]);
            uint4 o; o.x = cvt_pk_bf16(bflo(u.x) * e, bfhi(u.x) * e); o.y = cvt_pk_bf16(bflo(u.y) * e, bfhi(u.y) * e);
            o.z = cvt_pk_bf16(bflo(u.z) * e, bfhi(u.z) * e); o.w = cvt_pk_bf16(bflo(u.w) * e, bfhi(u.w) * e);
            *(uint4*)(gQ + t * 128 + cc) = o;
        }
        const float dk = __expf(glast - gcs[lane]);
#pragma unroll 8
        for (int i = 0; i < 32; ++i) { const int d = wid * 32 + i; gKT[d * 64 + lane] = f2bf(bf2f(ks[lane * QS + d]) * dk); }
    }
    f32x4 kk[4], qk[4];
    {
        const int fr = lane & 15, fq = lane >> 4, it = wid;
        bf16x8 kfi[4], qfi[4];
#pragma unroll
        for (int s = 0; s < 4; ++s) { kfi[s] = *(const bf16x8*)(ks + (it * 16 + fr) * QS + s * 32 + fq * 8); qfi[s] = *(const bf16x8*)(qs + (it * 16 + fr) * QS + s * 32 + fq * 8); }
#pragma unroll
        for (int jt = 0; jt < 4; ++jt) {
            kk[jt] = (f32x4){0.f, 0.f, 0.f, 0.f}; qk[jt] = (f32x4){0.f, 0.f, 0.f, 0.f};
#pragma unroll
            for (int s = 0; s < 4; ++s) {
                const bf16x8 kfj = *(const bf16x8*)(ks + (jt * 16 + fr) * QS + s * 32 + fq * 8);
                kk[jt] = __builtin_amdgcn_mfma_f32_16x16x32_bf16(kfi[s], kfj, kk[jt], 0, 0, 0);
                qk[jt] = __builtin_amdgcn_mfma_f32_16x16x32_bf16(kfj, qfi[s], qk[jt], 0, 0, 0);
            }
        }
    }
    __syncthreads();
    {
        const int fr = lane & 15, fq = lane >> 4, it = wid;
#pragma unroll
        for (int jt = 0; jt < 4; ++jt) {
            const int j = jt * 16 + fr; const float gj = gcs[j];
            f32x4 lv;
#pragma unroll
            for (int e = 0; e < 4; ++e) { const int i = it * 16 + fq * 4 + e; lv[e] = (i > j) ? bts[i] * kk[jt][e] * __expf(gcs[i] - gj) : 0.f; }
            *(f32x4*)(lowT + j * 68 + it * 16 + fq * 4) = lv;
            const int i2 = it * 16 + fr; const float gi = gcs[i2];
            f32x4 av;
#pragma unroll
            for (int e = 0; e < 4; ++e) { const int j2 = jt * 16 + fq * 4 + e; av[e] = (i2 >= j2) ? qk[jt][e] * __expf(gi - gcs[j2]) : 0.f; }
            store_bf4(gA + i2 * 64 + jt * 16 + fq * 4, av);
        }
    }
    __syncthreads();
    {
        const int cc = tid & 127; const bool isw = tid >= 128;
        bf16_t* src = isw ? ks : vs;
#pragma unroll 1
        for (int ib = 0; ib < 4; ++ib) {
            float acc[16];
#pragma unroll
            for (int r = 0; r < 16; ++r) { const int j = ib * 16 + r; float f = bts[j]; if (isw) f *= __expf(gcs[j]); acc[r] = f * bf2f(src[j * QS + cc]); }
            const float* lrow = lowT + ib * 16;
#pragma unroll 2
            for (int j = 0; j < ib * 16; ++j) {
                const float xj = bf2f(src[j * QS + cc]);
                const f32x4 l0 = *(const f32x4*)(lrow + j * 68), l1 = *(const f32x4*)(lrow + j * 68 + 4), l2 = *(const f32x4*)(lrow + j * 68 + 8), l3 = *(const f32x4*)(lrow + j * 68 + 12);
#pragma unroll
                for (int e = 0; e < 4; ++e) { acc[e] -= l0[e] * xj; acc[4 + e] -= l1[e] * xj; acc[8 + e] -= l2[e] * xj; acc[12 + e] -= l3[e] * xj; }
            }
#pragma unroll 1
            for (int r2 = 0; r2 < 15; ++r2) {
                float xj = acc[0];
#pragma unroll
                for (int r = 1; r < 16; ++r) xj = (r2 == r) ? acc[r] : xj;
                const float* lp = lrow + (ib * 16 + r2) * 68;
                const f32x4 l0 = *(const f32x4*)(lp), l1 = *(const f32x4*)(lp + 4), l2 = *(const f32x4*)(lp + 8), l3 = *(const f32x4*)(lp + 12);
#pragma unroll
                for (int e = 0; e < 4; ++e) { acc[e] -= l0[e] * xj; acc[4 + e] -= l1[e] * xj; acc[8 + e] -= l2[e] * xj; acc[12 + e] -= l3[e] * xj; }
            }
#pragma unroll
            for (int r = 0; r < 16; ++r) {
                const int j = ib * 16 + r; const bf16_t xb = f2bf(acc[r]);
                src[j * QS + cc] = xb;
                if (isw) gW[j * 128 + cc] = xb; else gU[j * 128 + cc] = acc[r];
            }
        }
    }
    __syncthreads();
}

#define LDS_BARRIER() do { asm volatile("s_waitcnt lgkmcnt(0)" ::: "memory"); __builtin_amdgcn_s_barrier(); asm volatile("" ::: "memory"); } while (0)
DEV void gdn_scan_item(const Params& p, int item, unsigned char* lds) {
    int tid = threadIdx.x & 255; asm volatile("" : "+v"(tid)); const int lane = tid & 63, w = tid >> 6, fr = lane & 15, fq = lane >> 4;
    const int s = item & 7, bh = item >> 3;
    const int b = bh >> 3, h = bh & 7;
    bf16_t* ST = (bf16_t*)lds;
    bf16_t* VT = ST + 16 * QS;
    const bf16_t* gW = (const bf16_t*)(p.ws + WS_GW) + (size_t)bh * 32 * 8192;
    const bf16_t* gQ = (const bf16_t*)(p.ws + WS_GQ) + (size_t)bh * 32 * 8192;
    const bf16_t* gKT = (const bf16_t*)(p.ws + WS_GKT) + (size_t)bh * 32 * 8192;
    const bf16_t* gA = (const bf16_t*)(p.ws + WS_GA) + (size_t)bh * 32 * 4096;
    const float* gU = (const float*)(p.ws + WS_GU) + (size_t)bh * 32 * 8192;
    const float* gE = (const float*)(p.ws + WS_GE) + bh * 32;
    float* obuf = (float*)(p.ws + WS_O);
    f32x4 S0 = {0.f, 0.f, 0.f, 0.f}, S1 = {0.f, 0.f, 0.f, 0.f};
    for (int i = tid; i < 16 * QS / 2; i += 256) ((unsigned*)ST)[i] = 0u;
    bf16x8 fw[4], fqg[4], fa[2], fk0[2], fk1[2]; f32x4 uu; float eg;
#define SCAN_LOAD(ch) do { \
        const bf16_t* W_ = gW + (size_t)(ch) * 8192 + (w * 16 + fr) * 128 + fq * 8; const bf16_t* Q_ = gQ + (size_t)(ch) * 8192 + (w * 16 + fr) * 128 + fq * 8; \
        _Pragma("unroll") for (int k_ = 0; k_ < 4; ++k_) { fw[k_] = *(const bf16x8*)(W_ + k_ * 32); fqg[k_] = *(const bf16x8*)(Q_ + k_ * 32); } \
        const bf16_t* A_ = gA + (size_t)(ch) * 4096 + (w * 16 + fr) * 64 + fq * 8; fa[0] = *(const bf16x8*)(A_); fa[1] = *(const bf16x8*)(A_ + 32); \
        const bf16_t* K_ = gKT + (size_t)(ch) * 8192 + (w * 32 + fr) * 64 + fq * 8; fk0[0] = *(const bf16x8*)(K_); fk0[1] = *(const bf16x8*)(K_ + 32); \
        fk1[0] = *(const bf16x8*)(K_ + 16 * 64); fk1[1] = *(const bf16x8*)(K_ + 16 * 64 + 32); \
        const float* U_ = gU + (size_t)(ch) * 8192 + (w * 16 + fq * 4) * 128 + s * 16 + fr; uu[0] = U_[0]; uu[1] = U_[128]; uu[2] = U_[256]; uu[3] = U_[384]; \
        eg = gE[ch]; } while (0)
    SCAN_LOAD(0);
    __syncthreads();
    for (int ch = 0; ch < 32; ++ch) {
        bf16x8 cw[4], cq[4], ca[2], ck0[2], ck1[2]; f32x4 cu = uu; const float ceg = eg;
#pragma unroll
        for (int k = 0; k < 4; ++k) { cw[k] = fw[k]; cq[k] = fqg[k]; }
        ca[0] = fa[0]; ca[1] = fa[1]; ck0[0] = fk0[0]; ck0[1] = fk0[1]; ck1[0] = fk1[0]; ck1[1] = fk1[1];
        if (ch + 1 < 32) SCAN_LOAD(ch + 1);
        f32x4 ws_ = {0.f, 0.f, 0.f, 0.f}, oo = {0.f, 0.f, 0.f, 0.f};
#pragma unroll
        for (int k = 0; k < 4; ++k) {
            const bf16x8 sf = *(const bf16x8*)(ST + fr * QS + k * 32 + fq * 8);
            ws_ = __builtin_amdgcn_mfma_f32_16x16x32_bf16(cw[k], sf, ws_, 0, 0, 0);
            oo = __builtin_amdgcn_mfma_f32_16x16x32_bf16(cq[k], sf, oo, 0, 0, 0);
        }
        const f32x4 vn = cu - ws_;
        store_bf4(VT + fr * 72 + w * 16 + fq * 4, vn);
        LDS_BARRIER();
        const bf16x8 v0 = *(const bf16x8*)(VT + fr * 72 + fq * 8), v1 = *(const bf16x8*)(VT + fr * 72 + 32 + fq * 8);
        oo = __builtin_amdgcn_mfma_f32_16x16x32_bf16(ca[0], v0, oo, 0, 0, 0);
        oo = __builtin_amdgcn_mfma_f32_16x16x32_bf16(ca[1], v1, oo, 0, 0, 0);
        S0 = S0 * ceg; S1 = S1 * ceg;
        S0 = __builtin_amdgcn_mfma_f32_16x16x32_bf16(ck0[0], v0, S0, 0, 0, 0);
        S0 = __builtin_amdgcn_mfma_f32_16x16x32_bf16(ck0[1], v1, S0, 0, 0, 0);
        S1 = __builtin_amdgcn_mfma_f32_16x16x32_bf16(ck1[0], v0, S1, 0, 0, 0);
        S1 = __builtin_amdgcn_mfma_f32_16x16x32_bf16(ck1[1], v1, S1, 0, 0, 0);
        store_bf4(ST + fr * QS + w * 32 + fq * 4, S0);
        store_bf4(ST + fr * QS + w * 32 + 16 + fq * 4, S1);
        {
            float* op = obuf + (size_t)(b * SEQ + ch * 64 + w * 16 + fq * 4) * 1024 + h * 128 + s * 16 + fr;
            op[0] = oo[0]; op[1024] = oo[1]; op[2048] = oo[2]; op[3072] = oo[3];
        }
        LDS_BARRIER();
    }
#undef SCAN_LOAD
    {
        float* dp = p.out + O_DP + ((size_t)bh * 128 + w * 32 + fq * 4) * 128 + s * 16 + fr;
#pragma unroll
        for (int e = 0; e < 4; ++e) { dp[e * 128] = S0[e]; dp[(16 + e) * 128] = S1[e]; }
    }
    __syncthreads();
}

DEV void gdn_sample_item(const Params& p, int item, unsigned char* lds) {
    int tid = threadIdx.x & 255; asm volatile("" : "+v"(tid)); const int lane = tid & 63, wid = tid >> 6;
    const int sb = item >> 3, h = item & 7, half = tid >> 7, c = tid & 127;
    const int r0 = TP + sb * 4;
    const bf16_t* proj = (const bf16_t*)(p.ws + WS_PROJ);
    const float* ab = (const float*)(p.ws + WS_AB);
    float* ksh = (float*)lds;
    float* qsh = ksh + 512;
    float* red = qsh + 512;
    float* red2 = red + 32;
    float* part = red2 + 32;
    float* opart = part + 1024;
    float qv[4], kv[4], vv[4];
#pragma unroll
    for (int m = 0; m < 3; ++m) {
        const int col = m * 1024 + h * 128 + c;
        float x[7], wj[4];
#pragma unroll
        for (int j = 0; j < 3; ++j) x[j] = p.in[6][((size_t)sb * 3 + j) * 3072 + col];
#pragma unroll
        for (int t = 0; t < 4; ++t) x[3 + t] = bf2f(proj[(size_t)(r0 + t) * NPJ + col]);
#pragma unroll
        for (int j = 0; j < 4; ++j) wj[j] = p.in[10][j * 3072 + col];
#pragma unroll
        for (int t = 0; t < 4; ++t) {
            const float y = silu_f(wj[0] * x[t] + wj[1] * x[t + 1] + wj[2] * x[t + 2] + wj[3] * x[t + 3]);
            if (m == 0) qv[t] = y; else if (m == 1) kv[t] = y; else vv[t] = y;
        }
    }
#pragma unroll
    for (int t = 0; t < 4; ++t) {
        const float a = wave_sum(qv[t] * qv[t]), bq = wave_sum(kv[t] * kv[t]);
        if (lane == 0) { red[wid * 8 + t] = a; red[wid * 8 + 4 + t] = bq; }
    }
    __syncthreads();
    float gt[4], bt[4];
#pragma unroll
    for (int t = 0; t < 4; ++t) {
        const float sq = red[(2 * half) * 8 + t] + red[(2 * half + 1) * 8 + t], sk = red[(2 * half) * 8 + 4 + t] + red[(2 * half + 1) * 8 + 4 + t];
        if (half == 0) {
            qsh[t * 128 + c] = qv[t] * rsqrtf(sq + EPS) * 0.08838834764831845f;
            ksh[t * 128 + c] = kv[t] * rsqrtf(sk + EPS);
        }
        const float a = ab[(size_t)(r0 + t) * 16 + h], bb = ab[(size_t)(r0 + t) * 16 + 8 + h];
        const float xx = a + p.in[12][h];
        const float sp = xx > 20.f ? xx : log1pf(__expf(xx));
        gt[t] = __expf(-__expf(p.in[11][h]) * sp);
        bt[t] = 1.f / (1.f + __expf(-bb));
    }
    float S[64];
    const float* sp0 = p.in[5] + ((size_t)(sb * 8 + h) * 128 + half * 64) * 128 + c;
#pragma unroll
    for (int d = 0; d < 64; ++d) S[d] = __builtin_nontemporal_load(sp0 + (size_t)d * 128);
    __syncthreads();
    float ot[4];
#pragma unroll
    for (int t = 0; t < 4; ++t) {
        const float* kk = ksh + t * 128 + half * 64; const float* qq = qsh + t * 128 + half * 64;
        float kS = 0.f;
#pragma unroll
        for (int d4 = 0; d4 < 16; ++d4) { const f32x4 k4 = *(const f32x4*)(kk + d4 * 4); kS += k4[0] * S[d4 * 4] + k4[1] * S[d4 * 4 + 1] + k4[2] * S[d4 * 4 + 2] + k4[3] * S[d4 * 4 + 3]; }
        part[(t * 2 + half) * 128 + c] = kS;
        __syncthreads();
        kS = part[(t * 2) * 128 + c] + part[(t * 2 + 1) * 128 + c];
        const float eg = gt[t], dl = bt[t] * (vv[t] - eg * kS);
        float o = 0.f;
#pragma unroll
        for (int d4 = 0; d4 < 16; ++d4) {
            const f32x4 k4 = *(const f32x4*)(kk + d4 * 4), q4 = *(const f32x4*)(qq + d4 * 4);
#pragma unroll
            for (int e = 0; e < 4; ++e) { const float sn = eg * S[d4 * 4 + e] + k4[e] * dl; S[d4 * 4 + e] = sn; o += q4[e] * sn; }
        }
        ot[t] = o;
        if (half == 1) opart[t * 128 + c] = o;
    }
    float* dso = p.out + O_DS + ((size_t)(sb * 8 + h) * 128 + half * 64) * 128 + c;
#pragma unroll
    for (int d = 0; d < 64; ++d) __builtin_nontemporal_store(S[d], dso + (size_t)d * 128);
    __syncthreads();
    if (half == 0) {
#pragma unroll
        for (int t = 0; t < 4; ++t) { ot[t] += opart[t * 128 + c]; const float a = wave_sum(ot[t] * ot[t]); if (lane == 0) red2[wid * 4 + t] = a; }
    }
    __syncthreads();
    if (half == 0) {
        bf16_t* mix = (bf16_t*)(p.ws + WS_MIX);
        const float gn = p.in[13][c];
#pragma unroll
        for (int t = 0; t < 4; ++t) {
            const float ms = (red2[t] + red2[4 + t]) * (1.f / 128.f);
            const float z = bf2f(proj[(size_t)(r0 + t) * NPJ + C_ZA + h * 128 + c]);
            mix[(size_t)(r0 + t) * LDB + h * 128 + c] = f2bf(ot[t] * rsqrtf(ms + EPS) * gn * silu_f(z));
        }
    }
    __syncthreads();
}

DEV void attn_sample_item(const Params& p, int item, unsigned char* lds) {
    int tid = threadIdx.x & 255; asm volatile("" : "+v"(tid)); const int lane = tid & 63, wid = tid >> 6;
    const int sb = item >> 2, hd = item & 3;
    float* qs = (float*)lds;
    float* pm = qs + 2048;
    float* red = pm + 1024;
    const bf16_t* qx = (const bf16_t*)(p.ws + WS_QX);
    for (int i = tid; i < 2048; i += 256) { const int t = i >> 9, d = i & 511; qs[i] = bf2f(qx[(size_t)(TP + sb * 4 + t) * LDB + hd * 512 + d]) * 0.04419417382415922f; }
    __syncthreads();
    const float* Kc = p.in[3] + ((size_t)sb * 256) * D + hd * 512;
    const float* Vc = p.in[4] + ((size_t)sb * 256) * D + hd * 512;
    {
        const int sub = lane >> 4, l16 = lane & 15;
        f32x4 kv[8];
        {
            const float* kr = Kc + (size_t)(wid * 64 + sub) * D;
#pragma unroll
            for (int i = 0; i < 8; ++i) kv[i] = __builtin_nontemporal_load((const f32x4*)(kr + (i * 16 + l16) * 4));
        }
        for (int it = 0; it < 16; ++it) {
            const int m = wid * 64 + it * 4 + sub;
            f32x4 cv[8];
#pragma unroll
            for (int i = 0; i < 8; ++i) cv[i] = kv[i];
            if (it + 1 < 16) {
                const float* kr = Kc + (size_t)(m + 4) * D;
#pragma unroll
                for (int i = 0; i < 8; ++i) kv[i] = __builtin_nontemporal_load((const f32x4*)(kr + (i * 16 + l16) * 4));
            }
            float a0 = 0.f, a1 = 0.f, a2 = 0.f, a3 = 0.f;
#pragma unroll
            for (int i = 0; i < 8; ++i) {
                const int d = (i * 16 + l16) * 4;
                const f32x4 q0 = *(const f32x4*)(qs + d), q1 = *(const f32x4*)(qs + 512 + d), q2 = *(const f32x4*)(qs + 1024 + d), q3 = *(const f32x4*)(qs + 1536 + d);
                a0 += cv[i][0] * q0[0] + cv[i][1] * q0[1] + cv[i][2] * q0[2] + cv[i][3] * q0[3];
                a1 += cv[i][0] * q1[0] + cv[i][1] * q1[1] + cv[i][2] * q1[2] + cv[i][3] * q1[3];
                a2 += cv[i][0] * q2[0] + cv[i][1] * q2[1] + cv[i][2] * q2[2] + cv[i][3] * q2[3];
                a3 += cv[i][0] * q3[0] + cv[i][1] * q3[1] + cv[i][2] * q3[2] + cv[i][3] * q3[3];
            }
#pragma unroll
            for (int o = 1; o < 16; o <<= 1) { a0 += __shfl_xor(a0, o); a1 += __shfl_xor(a1, o); a2 += __shfl_xor(a2, o); a3 += __shfl_xor(a3, o); }
            if (l16 == 0) *(f32x4*)(pm + m * 4) = (f32x4){a0, a1, a2, a3};
        }
    }
    __syncthreads();
    {
        const int t = wid;
        float v[4]; float mx = -3.0e38f;
#pragma unroll
        for (int i = 0; i < 4; ++i) { v[i] = pm[(i * 64 + lane) * 4 + t]; mx = fmaxf(mx, v[i]); }
        mx = wave_max(mx);
        float sm = 0.f;
#pragma unroll
        for (int i = 0; i < 4; ++i) { v[i] = __expf(v[i] - mx); sm += v[i]; }
        sm = wave_sum(sm);
        const float inv = 1.f / sm;
#pragma unroll
        for (int i = 0; i < 4; ++i) pm[(i * 64 + lane) * 4 + t] = v[i] * inv;
    }
    __syncthreads();
    {
        f32x4 acc[4][2];
#pragma unroll
        for (int t = 0; t < 4; ++t) { acc[t][0] = (f32x4){0.f, 0.f, 0.f, 0.f}; acc[t][1] = (f32x4){0.f, 0.f, 0.f, 0.f}; }
        f32x4 va[4], vb[4];
#pragma unroll
        for (int i = 0; i < 4; ++i) { const float* vr = Vc + (size_t)(wid * 64 + i) * D; va[i] = __builtin_nontemporal_load((const f32x4*)(vr + lane * 4)); vb[i] = __builtin_nontemporal_load((const f32x4*)(vr + 256 + lane * 4)); }
        for (int m4 = 0; m4 < 16; ++m4) {
            f32x4 ca[4], cb[4];
#pragma unroll
            for (int i = 0; i < 4; ++i) { ca[i] = va[i]; cb[i] = vb[i]; }
            if (m4 + 1 < 16) {
#pragma unroll
                for (int i = 0; i < 4; ++i) { const float* vr = Vc + (size_t)(wid * 64 + (m4 + 1) * 4 + i) * D; va[i] = __builtin_nontemporal_load((const f32x4*)(vr + lane * 4)); vb[i] = __builtin_nontemporal_load((const f32x4*)(vr + 256 + lane * 4)); }
            }
#pragma unroll
            for (int i = 0; i < 4; ++i) {
                const f32x4 pr = *(const f32x4*)(pm + (wid * 64 + m4 * 4 + i) * 4);
#pragma unroll
                for (int t = 0; t < 4; ++t) { acc[t][0] += ca[i] * pr[t]; acc[t][1] += cb[i] * pr[t]; }
            }
        }
#pragma unroll
        for (int t = 0; t < 4; ++t) { *(f32x4*)(red + (wid * 4 + t) * 512 + lane * 4) = acc[t][0]; *(f32x4*)(red + (wid * 4 + t) * 512 + 256 + lane * 4) = acc[t][1]; }
    }
    __syncthreads();
    {
        bf16_t* ctx = (bf16_t*)(p.ws + WS_CTX);
#pragma unroll
        for (int i = 0; i < 2; ++i) {
            const int e = (tid + 256 * i) * 4, t = e >> 9, d = e & 511;
            const f32x4 s = *(const f32x4*)(red + (0 * 4 + t) * 512 + d) + *(const f32x4*)(red + (1 * 4 + t) * 512 + d) + *(const f32x4*)(red + (2 * 4 + t) * 512 + d) + *(const f32x4*)(red + (3 * 4 + t) * 512 + d);
            store_bf4(ctx + (size_t)(TP + sb * 4 + t) * LDB + hd * 512 + d, s);
        }
    }
    __syncthreads();
}

template <int WIN>
DEV void pool_d_prompt(const bf16_t* __restrict__ proj, bf16_t* __restrict__ dpl, int row, int c8) {
    const int tloc = row & 2047;
    uint4 u[WIN];
#pragma unroll
    for (int k = 0; k < WIN; ++k) u[k] = (tloc - k >= 0) ? *(const uint4*)(proj + (size_t)(row - k) * NPJ + C_U + c8) : make_uint4(0u, 0u, 0u, 0u);
    float acc[8] = {0.f, 0.f, 0.f, 0.f, 0.f, 0.f, 0.f, 0.f};
#pragma unroll
    for (int k = 0; k < WIN; ++k) { acc[0] += bflo(u[k].x); acc[1] += bfhi(u[k].x); acc[2] += bflo(u[k].y); acc[3] += bfhi(u[k].y); acc[4] += bflo(u[k].z); acc[5] += bfhi(u[k].z); acc[6] += bflo(u[k].w); acc[7] += bfhi(u[k].w); }
    const float ic = 1.f / (float)min(WIN, tloc + 1);
    uint4 o;
    o.x = cvt_pk_bf16(acc[0] * ic - bflo(u[0].x), acc[1] * ic - bfhi(u[0].x)); o.y = cvt_pk_bf16(acc[2] * ic - bflo(u[0].y), acc[3] * ic - bfhi(u[0].y));
    o.z = cvt_pk_bf16(acc[4] * ic - bflo(u[0].z), acc[5] * ic - bfhi(u[0].z)); o.w = cvt_pk_bf16(acc[6] * ic - bflo(u[0].w), acc[7] * ic - bfhi(u[0].w));
    *(uint4*)(dpl + (size_t)row * LDP + c8) = o;
}

#ifndef REP0
#define REP0 1
#endif
#ifndef REP1
#define REP1 1
#endif
#ifndef REP2
#define REP2 1
#endif
#ifndef REP3
#define REP3 1
#endif
#ifndef REP4
#define REP4 1
#endif
#ifndef REP5
#define REP5 1
#endif
#ifndef REP6
#define REP6 1
#endif
#ifndef REP7
#define REP7 1
#endif
#ifndef REP8
#define REP8 1
#endif
#ifndef REP9
#define REP9 1
#endif
#ifndef REP10
#define REP10 1
#endif
#ifndef REP11
#define REP11 1
#endif
#ifndef REP12
#define REP12 1
#endif
#ifndef NLAUNCH
#define NLAUNCH 1
#endif
#define GRID_BAR() do { if (NLAUNCH == 1) xcd_barrier(bar); } while (0)
#define IN_PH(k) (p.ph_lo <= (k) && (k) < p.ph_hi)
__global__ void __launch_bounds__(512) hymba_fwd(Params p) {
    __shared__ __attribute__((aligned(16))) unsigned char lds[131072];
    __shared__ uint4 xb_words;
    int tid = threadIdx.x; asm volatile("" : "+v"(tid)); const int lane = tid & 63, wid = tid >> 6;
    const int vb = __builtin_amdgcn_readfirstlane(tid >> 8);
    unsigned char* vlds = lds + vb * 65536;
    const int G = gridDim.x, bid = blockIdx.x, VG = 2 * G, vbid = 2 * bid + vb;
    if (tid == 0) xb_words = make_uint4(0u, 0u, 0u, 0u);
    __syncthreads();
    XcdBarrier bar; bar.bar = (unsigned*)(p.ws + WS_BAR); bar.x = 0; bar.st = (volatile LAS unsigned*)&xb_words;
    if (NLAUNCH == 1) bar = xcd_barrier_post((unsigned*)(p.ws + WS_BAR), (volatile LAS unsigned*)&xb_words);
    unsigned char* ws = p.ws;
    bf16_t* Wt_in = (bf16_t*)(ws + WS_WIN); bf16_t* Wt_out = (bf16_t*)(ws + WS_WOUT); bf16_t* Wt_cq = (bf16_t*)(ws + WS_WCQ); bf16_t* Wt_co = (bf16_t*)(ws + WS_WCO);
    bf16_t* Wt_ckv = (bf16_t*)(ws + WS_WCKV); bf16_t* Wt_pool = (bf16_t*)(ws + WS_WPOOL);
    bf16_t* hbuf = (bf16_t*)(ws + WS_H); bf16_t* hm = (bf16_t*)(ws + WS_HM); bf16_t* proj = (bf16_t*)(ws + WS_PROJ); float* ab = (float*)(ws + WS_AB);
    bf16_t* mkb = (bf16_t*)(ws + WS_MKB); bf16_t* mvt = (bf16_t*)(ws + WS_MVT); bf16_t* dpl = (bf16_t*)(ws + WS_DPL); bf16_t* mix = (bf16_t*)(ws + WS_MIX);
    bf16_t* x1 = (bf16_t*)(ws + WS_X1); bf16_t* qx = (bf16_t*)(ws + WS_QX); float* sc = (float*)(ws + WS_SC); bf16_t* pb = (bf16_t*)(ws + WS_PB);
    bf16_t* ctx = (bf16_t*)(ws + WS_CTX); bf16_t* x2 = (bf16_t*)(ws + WS_X2); float* obuf = (float*)(ws + WS_O);
#define VLOOP(t, N) for (int t##0_ = 2 * bid, t = min(t##0_ + vb, (N) - 1); t##0_ < (N); t##0_ += VG, t = min(t##0_ + vb, (N) - 1))

    if (IN_PH(0)) {
        const int NT_IN = 98 * 16, NT_SQ = 32 * 16;
        const int total = NT_IN + 5 * NT_SQ + 32;
        VLOOP(t, total) {
            if (t < NT_IN) { const int nt = t >> 4, kt = t & 15; transpose_tile(p.in[9], 6160, nt * 64, true, kt * 128, Wt_in + (size_t)nt * 64 * LDB, LDB, (float*)vlds); }
            else if (t < NT_IN + 5 * NT_SQ) {
                const int u = t - NT_IN, j = u >> 9, v = u & 511, nt = v >> 4, kt = v & 15;
                const float* src = p.in[j == 0 ? 16 : (j == 1 ? 19 : (j == 2 ? 22 : (j == 3 ? 20 : 21)))];
                bf16_t* dst = j == 0 ? Wt_out : (j == 1 ? Wt_cq : (j == 2 ? Wt_co : (j == 3 ? Wt_ckv : Wt_ckv + (size_t)D * LDB)));
                transpose_tile(src, D, nt * 64, false, kt * 128, dst + (size_t)nt * 64 * LDB, LDB, (float*)vlds);
            } else {
                const int u = t - NT_IN - 5 * NT_SQ, g = u >> 3, v = u & 7, nt = v >> 1, kt = v & 1;
                transpose_tile(p.in[14] + (size_t)g * 65536, 256, nt * 64, false, kt * 128, Wt_pool + ((size_t)g * 256 + nt * 64) * LDM, LDM, (float*)vlds);
            }
        }
        for (int r = bid * 8 + wid; r < TT + 1024; r += G * 8) {
            if (r < TP) rmsnorm_row_bf16(p.in[0] + (size_t)r * D, p.in[8], hbuf + (size_t)r * LDB, lane);
            else if (r < TT) rmsnorm_row_bf16(p.in[1] + (size_t)(r - TP) * D, p.in[8], hbuf + (size_t)r * LDB, lane);
            else rmsnorm_row_bf16(p.in[2] + (size_t)(r - TT) * D, p.in[17], hm + (size_t)(r - TT) * LDB, lane);
        }
    }
    GRID_BAR();
    if (IN_PH(1)) {
        for (int t = bid; t < 32 * 24; t += G) { int nt, mt; tile_map(t, 32, 24, mt, nt);
            EpiProj e{mt * 256, nt * 256, proj, ab, p.out};
            gemm256_tile(hbuf + (size_t)mt * 256 * LDB, LDB, Wt_in + (size_t)nt * 256 * LDB, LDB, D, lds, e);
        }
        VLOOP(t, 4 * 48 + 256) {
            if (t < 192) { const int mt = t & 3, nt = t >> 2;
                EpiProj e{TP + mt * 128, nt * 128, proj, ab, p.out};
                gemm_tile<64>(hbuf + (size_t)(TP + mt * 128) * LDB, LDB, Wt_in + (size_t)nt * 128 * LDB, LDB, D, vlds, e);
            } else { const int u = t - 192, mt = u & 7, nt = u >> 3;
                EpiMKV e{mt * 128, nt * 128, mkb, mvt, p.out};
                gemm_tile<64>(hm + (size_t)mt * 128 * LDB, LDB, Wt_ckv + (size_t)nt * 128 * LDB, LDB, D, vlds, e);
            }
        }
        for (int rt = bid * 8 + wid; rt < TT / 16; rt += G * 8) ab_rows16(hbuf, Wt_in + (size_t)NPJ * LDB, ab, rt, lane);
    }
    GRID_BAR();
    if (IN_PH(2)) {
        VLOOP(t, 1024) gdn_prep_chunk(p, t, vlds);
        for (int i = bid * 512 + tid; i < TP * 128; i += G * 512) {
            const int row = i >> 7, c8 = (i & 127) * 8, g = c8 >> 8;
            if (g == 0) pool_d_prompt<2>(proj, dpl, row, c8); else if (g == 1) pool_d_prompt<4>(proj, dpl, row, c8);
            else if (g == 2) pool_d_prompt<8>(proj, dpl, row, c8); else pool_d_prompt<16>(proj, dpl, row, c8);
        }
        for (int i = TP * 128 + bid * 512 + tid; i < TT * 128; i += G * 512) {
            const int row = i >> 7, c8 = (i & 127) * 8, g = c8 >> 8, win = 2 << g;
            float acc[8] = {0.f, 0.f, 0.f, 0.f, 0.f, 0.f, 0.f, 0.f}, self[8];
            const int tloc = (row - TP) & 3;
            for (int k = 0; k < win; ++k) {
                const int tt = tloc - k;
                if (tt >= 0) {
                    const uint4 u = *(const uint4*)(proj + (size_t)(row - k) * NPJ + C_U + c8);
                    const float f[8] = {bflo(u.x), bfhi(u.x), bflo(u.y), bfhi(u.y), bflo(u.z), bfhi(u.z), bflo(u.w), bfhi(u.w)};
#pragma unroll
                    for (int e = 0; e < 8; ++e) { acc[e] += f[e]; if (k == 0) self[e] = f[e]; }
                } else {
                    const float* sp = p.in[7] + ((size_t)((row - TP) >> 2) * 15 + (15 + tt)) * 1024 + c8;
                    const f32x4 s0 = *(const f32x4*)sp, s1 = *(const f32x4*)(sp + 4);
                    acc[0] += s0[0]; acc[1] += s0[1]; acc[2] += s0[2]; acc[3] += s0[3]; acc[4] += s1[0]; acc[5] += s1[1]; acc[6] += s1[2]; acc[7] += s1[3];
                }
            }
            const float ic = 1.f / (float)win;
            uint4 o; o.x = cvt_pk_bf16(acc[0] * ic - self[0], acc[1] * ic - self[1]); o.y = cvt_pk_bf16(acc[2] * ic - self[2], acc[3] * ic - self[3]);
            o.z = cvt_pk_bf16(acc[4] * ic - self[4], acc[5] * ic - self[5]); o.w = cvt_pk_bf16(acc[6] * ic - self[6], acc[7] * ic - self[7]);
            *(uint4*)(dpl + (size_t)row * LDP + c8) = o;
        }
        for (int i = bid * 512 + tid; i < SB * 11 * 256; i += G * 512) {
            const int c4 = (i & 255) * 4, rr = (i >> 8) % 11, sb = (i >> 8) / 11;
            *(f32x4*)(p.out + O_PS + ((size_t)sb * 15 + rr) * 1024 + c4) = *(const f32x4*)(p.in[7] + ((size_t)sb * 15 + rr + 4) * 1024 + c4);
        }
    }
    GRID_BAR();
    if (IN_PH(3)) {
        const int NSC = 256, NSM = 1024, NPL = 68 * 8;
        const int nsb = G >> 1;
        if (bid < nsb) {
            if (G == 256) {
                const int x = bid & 7, j = bid >> 3;
                gdn_scan_item(p, ((x * 4 + (j >> 2)) << 3) | ((j & 3) << 1) | vb, vlds);
            } else
            for (int t0 = 2 * bid; t0 < NSC; t0 += 2 * nsb) gdn_scan_item(p, min(t0 + vb, NSC - 1), vlds);
        } else {
            const int ob = bid - nsb, no = G - nsb;
            for (int t0 = 2 * ob; t0 < NSM; t0 += 2 * no) gdn_sample_item(p, min(t0 + vb, NSM - 1), vlds);
            for (int t0 = 2 * ob; t0 < NPL; t0 += 2 * no) { const int t = min(t0 + vb, NPL - 1); int nt, mt; tile_map(t, 68, 8, mt, nt); const int g = nt >> 1;
                EpiPool e{mt * 128, nt * 128, proj, p.in[15], mix};
                gemm_tile<64>(dpl + (size_t)mt * 128 * LDP + g * 256, LDP, Wt_pool + (size_t)nt * 128 * LDM, LDM, 256, vlds, e);
            }
        }
    }
    GRID_BAR();
    if (IN_PH(4)) {
        for (int i = bid * 512 + tid; i < TP * 8 * 16; i += G * 512) {
            const int l16 = i & 15, rh = i >> 4, h = rh & 7, row = rh >> 3;
            const float* op = obuf + (size_t)row * 1024 + h * 128 + l16 * 8;
            const f32x4 a = *(const f32x4*)op, b4 = *(const f32x4*)(op + 4);
            float ss = a[0] * a[0] + a[1] * a[1] + a[2] * a[2] + a[3] * a[3] + b4[0] * b4[0] + b4[1] * b4[1] + b4[2] * b4[2] + b4[3] * b4[3];
            ss += __shfl_xor(ss, 1); ss += __shfl_xor(ss, 2); ss += __shfl_xor(ss, 4); ss += __shfl_xor(ss, 8);
            const float rs = rsqrtf(ss * (1.f / 128.f) + EPS);
            const f32x4 g0 = *(const f32x4*)(p.in[13] + l16 * 8), g1 = *(const f32x4*)(p.in[13] + l16 * 8 + 4);
            const uint4 z = *(const uint4*)(proj + (size_t)row * NPJ + C_ZA + h * 128 + l16 * 8);
            uint4 o;
            o.x = cvt_pk_bf16(a[0] * rs * g0[0] * silu_f(bflo(z.x)), a[1] * rs * g0[1] * silu_f(bfhi(z.x)));
            o.y = cvt_pk_bf16(a[2] * rs * g0[2] * silu_f(bflo(z.y)), a[3] * rs * g0[3] * silu_f(bfhi(z.y)));
            o.z = cvt_pk_bf16(b4[0] * rs * g1[0] * silu_f(bflo(z.z)), b4[1] * rs * g1[1] * silu_f(bfhi(z.z)));
            o.w = cvt_pk_bf16(b4[2] * rs * g1[2] * silu_f(bflo(z.w)), b4[3] * rs * g1[3] * silu_f(bfhi(z.w)));
            *(uint4*)(mix + (size_t)row * LDB + h * 128 + l16 * 8) = o;
        }
    }
    GRID_BAR();
    if (IN_PH(5)) {
        for (int t = bid; t < 32 * 8; t += G) { int nt, mt; tile_map(t, 32, 8, mt, nt);
            EpiResid e{p.in[0] + (size_t)mt * 256 * D + nt * 256, x1 + (size_t)mt * 256 * LDB + nt * 256};
            gemm256_tile(mix + (size_t)mt * 256 * LDB, LDB, Wt_out + (size_t)nt * 256 * LDB, LDB, D, lds, e);
        }
        VLOOP(t, 8 * 32) { const int mt = t & 7, nt = t >> 3;
            EpiResid e{p.in[1] + (size_t)mt * 64 * D + nt * 64, x1 + (size_t)(TP + mt * 64) * LDB + nt * 64};
            gemm_tile<32>(mix + (size_t)(TP + mt * 64) * LDB, LDB, Wt_out + (size_t)nt * 64 * LDB, LDB, D, vlds, e);
        }
    }
    GRID_BAR();
    if (IN_PH(6))
    for (int r = bid * 8 + wid; r < TT; r += G * 8) rmsnorm_row_from_bf16<false>(x1 + (size_t)r * LDB, p.in[18], hbuf + (size_t)r * LDB, lane);
    GRID_BAR();
    if (IN_PH(7)) {
        VLOOP(t, 8 * 32) { const int mt = t & 7, nt = t >> 3;
            EpiBf e{qx + (size_t)(TP + mt * 64) * LDB + nt * 64, LDB};
            gemm_tile<32>(hbuf + (size_t)(TP + mt * 64) * LDB, LDB, Wt_cq + (size_t)nt * 64 * LDB, LDB, D, vlds, e);
        }
    }
    GRID_BAR();
    if (IN_PH(7)) {
        const int ng = G >> 1;
        if (bid < ng) {
            for (int t = bid; t < 32 * 8; t += ng) { int nt, mt; tile_map(t, 32, 8, mt, nt);
                EpiBf e{qx + (size_t)mt * 256 * LDB + nt * 256, LDB};
                gemm256_tile(hbuf + (size_t)mt * 256 * LDB, LDB, Wt_cq + (size_t)nt * 256 * LDB, LDB, D, lds, e);
            }
        } else {
            const int ob = bid - ng, no = G - ng;
            for (int t0 = 2 * ob; t0 < 512; t0 += 2 * no) attn_sample_item(p, min(t0 + vb, 511), vlds);
        }
    }
    GRID_BAR();
    if (IN_PH(8)) {
        const int NS1 = 16 * 16 * 2;
        VLOOP(t, NS1) { const int bhd = t >> 5, v = t & 31, mt = v >> 1, nt = v & 1, b = bhd >> 2, hd = bhd & 3;
            EpiF32s e{sc + (size_t)(b * SEQ + mt * 128) * 1024 + hd * 256 + nt * 128, 1024, 0.04419417382415922f};
            gemm_tile<64>(qx + (size_t)(b * SEQ + mt * 128) * LDB + hd * 512, LDB, mkb + (size_t)(b * 256 + nt * 128) * LDB + hd * 512, LDB, 512, vlds, e);
        }
    }
    GRID_BAR();
    if (IN_PH(9))
    for (int r = bid * 8 + wid; r < TP * 4; r += G * 8) {
        const f32x4 v = *(const f32x4*)(sc + (size_t)r * 256 + lane * 4);
        const float mx = wave_max(fmaxf(fmaxf(v[0], v[1]), fmaxf(v[2], v[3])));
        f32x4 e; e[0] = __expf(v[0] - mx); e[1] = __expf(v[1] - mx); e[2] = __expf(v[2] - mx); e[3] = __expf(v[3] - mx);
        const float inv = 1.f / wave_sum(e[0] + e[1] + e[2] + e[3]);
        store_bf4(pb + (size_t)(r >> 2) * LDP + (r & 3) * 256 + lane * 4, e * inv);
    }
    GRID_BAR();
    if (IN_PH(10)) {
        VLOOP(t, 16 * 16 * 4) { const int bhd = t >> 6, v = t & 63, mt = v >> 2, nt = v & 3, b = bhd >> 2, hd = bhd & 3;
            EpiBf e{ctx + (size_t)(b * SEQ + mt * 128) * LDB + hd * 512 + nt * 128, LDB};
            gemm_tile<64>(pb + (size_t)(b * SEQ + mt * 128) * LDP + hd * 256, LDP, mvt + ((size_t)b * D + hd * 512 + nt * 128) * LDM, LDM, 256, vlds, e);
        }
    }
    GRID_BAR();
    if (IN_PH(11)) {
        for (int t = bid; t < 32 * 8; t += G) { int nt, mt; tile_map(t, 32, 8, mt, nt);
            EpiResidB e{x1 + (size_t)mt * 256 * LDB + nt * 256, x2 + (size_t)mt * 256 * LDB + nt * 256};
            gemm256_tile(ctx + (size_t)mt * 256 * LDB, LDB, Wt_co + (size_t)nt * 256 * LDB, LDB, D, lds, e);
        }
        VLOOP(t, 8 * 32) { const int mt = t & 7, nt = t >> 3;
            EpiResidB e{x1 + (size_t)(TP + mt * 64) * LDB + nt * 64, x2 + (size_t)(TP + mt * 64) * LDB + nt * 64};
            gemm_tile<32>(ctx + (size_t)(TP + mt * 64) * LDB, LDB, Wt_co + (size_t)nt * 64 * LDB, LDB, D, vlds, e);
        }
    }
    GRID_BAR();
    if (IN_PH(12))
    for (int r = bid * 8 + wid; r < TT; r += G * 8) rmsnorm_row_from_bf16<true>(x2 + (size_t)r * LDB, p.in[23], p.out + (r < TP ? O_YP + (size_t)r * D : O_YS + (size_t)(r - TP) * D), lane);
}

extern "C" void kernel_launch(void* const* d_in, const int* in_sizes, int n_in, void* d_out, int out_size, void* d_ws, size_t ws_size, hipStream_t stream) {
    static int grid = 0;
    if (grid == 0) {
        if (n_in != 24 || ws_size < WS_END) { fprintf(stderr, "kernel_launch: need 24 inputs and %zu bytes of workspace (got %d, %zu)\n", (size_t)WS_END, n_in, ws_size); grid = -1; return; }
        int dev = 0, cus = 0, per_cu = 0;
        hipGetDevice(&dev);
        hipDeviceGetAttribute(&cus, hipDeviceAttributeMultiprocessorCount, dev);
        if (hipOccupancyMaxActiveBlocksPerMultiprocessor(&per_cu, (const void*)hymba_fwd, 512, 0) != hipSuccess || per_cu < 1) { fprintf(stderr, "kernel_launch: occupancy query failed\n"); grid = -1; return; }
        if (per_cu > 1) per_cu = 1;
        grid = cus * per_cu;
        fprintf(stderr, "kernel_launch: grid %d (%d per CU)\n", grid, per_cu);
    }
    if (grid < 0) return;
    hipMemsetAsync((char*)d_ws + WS_BAR, 0, 16384, stream);
    Params p{};
    for (int i = 0; i < 24; ++i) p.in[i] = (const float*)d_in[i];
    p.out = (float*)d_out; p.ws = (unsigned char*)d_ws;
    if (NLAUNCH == 1) {
        p.ph_lo = 0; p.ph_hi = 13;
        void* args[] = {&p};
        hipError_t e = hipLaunchCooperativeKernel((const void*)hymba_fwd, dim3(grid), dim3(512), args, 0, stream);
        if (e != hipSuccess) fprintf(stderr, "kernel_launch: cooperative launch failed: %s (grid %d)\n", hipGetErrorString(e), grid);
    } else {
        for (int k = 0; k < 13; ++k) { p.ph_lo = k; p.ph_hi = k + 1; hipLaunchKernelGGL(hymba_fwd, dim3(grid), dim3(512), 0, stream, p); }
    }
}
```

```cpp
#include <hip/hip_runtime.h>
#include <hip/hip_cooperative_groups.h>
#include <cstdio>
#include <cstdint>

typedef unsigned short bf16_t;
typedef short bf16x8 __attribute__((ext_vector_type(8)));
typedef float f32x4 __attribute__((ext_vector_type(4)));
#define DEV __device__ __forceinline__
#define LAS __attribute__((address_space(3)))

constexpr int D = 2048, TP = 8192, TS = 512, TT = 8704, SEQ = 2048, NB = 4, SB = 128;
constexpr int NPJ = 6144;
constexpr int C_ZA = 3072, C_U = 4096, C_ZB = 5120;
constexpr int NWIN = 6272;
constexpr float EPS = 1e-6f;
constexpr int LDB = 2112, LDP = 1088, LDM = 288;

constexpr size_t O_YP = 0, O_YS = 16777216, O_MK = 17825792, O_MV = 19922944, O_DP = 22020096, O_CP = 22544384,
                 O_PP = 22581248, O_DS = 22642688, O_CS = 39419904, O_PS = 40599552;

constexpr size_t al256(size_t x) { return (x + 255) & ~(size_t)255; }
constexpr size_t WS_BAR = 0;
constexpr size_t WS_WIN = 16384;
constexpr size_t WS_WOUT = WS_WIN + (size_t)NWIN * LDB * 2;
constexpr size_t WS_WCQ = WS_WOUT + (size_t)D * LDB * 2;
constexpr size_t WS_WCO = WS_WCQ + (size_t)D * LDB * 2;
constexpr size_t WS_WCKV = WS_WCO + (size_t)D * LDB * 2;
constexpr size_t WS_WPOOL = WS_WCKV + (size_t)2 * D * LDB * 2;
constexpr size_t WS_H = WS_WPOOL + (size_t)1024 * LDM * 2;
constexpr size_t WS_HM = WS_H + (size_t)TT * LDB * 2;
constexpr size_t WS_PROJ = WS_HM + (size_t)1024 * LDB * 2;
constexpr size_t WS_AB = WS_PROJ + (size_t)TT * NPJ * 2;
constexpr size_t WS_MKB = WS_AB + (size_t)TT * 16 * 4;
constexpr size_t WS_MVT = WS_MKB + (size_t)1024 * LDB * 2;
constexpr size_t WS_GW = WS_MVT + (size_t)4 * D * LDM * 2;
constexpr size_t WS_GQ = WS_GW + (size_t)1024 * 8192 * 2;
constexpr size_t WS_GKT = WS_GQ + (size_t)1024 * 8192 * 2;
constexpr size_t WS_GA = WS_GKT + (size_t)1024 * 8192 * 2;
constexpr size_t WS_GU = WS_GA + (size_t)1024 * 4096 * 2;
constexpr size_t WS_GE = WS_GU + (size_t)1024 * 8192 * 4;
constexpr size_t WS_O = WS_GE + 4096;
constexpr size_t WS_DPL = WS_O + (size_t)TP * 1024 * 4;
constexpr size_t WS_MIX = WS_DPL + (size_t)TT * LDP * 2;
constexpr size_t WS_X1 = WS_MIX + (size_t)TT * LDB * 2;
constexpr size_t WS_QX = WS_X1 + (size_t)TT * D * 4;
constexpr size_t WS_SC = WS_QX + (size_t)TT * LDB * 2;
constexpr size_t WS_PB = WS_SC + (size_t)TP * 1024 * 4;
constexpr size_t WS_CTX = WS_PB + (size_t)TP * LDP * 2;
constexpr size_t WS_X2 = WS_CTX + (size_t)TT * LDB * 2;
constexpr size_t WS_END = WS_X2 + (size_t)TT * D * 4;

#ifndef LASTP
#define LASTP 99
#endif
struct Params { const float* in[24]; float* out; unsigned char* ws; int ph_lo, ph_hi; };

typedef __bf16 bf16x2_t __attribute__((ext_vector_type(2)));
typedef float f32x2_t __attribute__((ext_vector_type(2)));
DEV unsigned cvt_pk_bf16(float lo, float hi) { const f32x2_t v = {lo, hi}; const bf16x2_t b = __builtin_convertvector(v, bf16x2_t); return __builtin_bit_cast(unsigned, b); }
DEV bf16_t f2bf(float f) { return (bf16_t)(cvt_pk_bf16(f, 0.f) & 0xffffu); }
DEV float bf2f(unsigned b) { return __uint_as_float(b << 16); }
DEV float bflo(unsigned u) { return __uint_as_float(u << 16); }
DEV float bfhi(unsigned u) { return __uint_as_float(u & 0xffff0000u); }
DEV float silu_f(float x) { return x / (1.f + __expf(-x)); }
DEV float wave_sum(float v) {
#pragma unroll
    for (int o = 32; o >= 1; o >>= 1) v += __shfl_xor(v, o);
    return v;
}
DEV float wave_max(float v) {
#pragma unroll
    for (int o = 32; o >= 1; o >>= 1) v = fmaxf(v, __shfl_xor(v, o));
    return v;
}
DEV void store_bf4(bf16_t* p, f32x4 v) { uint2 w; w.x = cvt_pk_bf16(v[0], v[1]); w.y = cvt_pk_bf16(v[2], v[3]); *(uint2*)p = w; }

#define XB_TMO      128
#define XB_XCNT(j)  (256  + 64 * (j))
#define XB_XSUB(j)  (1280 + 64 * (j))
#define XB_XGEN(j)  (2304 + 64 * (j))
#define XB_TOP      3328
#define XB_TOPGEN   3392
#define XCD_BAR_WORDS 3456
#define XB_SPIN_CAP (1u << 22)
DEV unsigned xb_ld(unsigned* p) { return __hip_atomic_load(p, __ATOMIC_RELAXED, __HIP_MEMORY_SCOPE_AGENT); }
DEV unsigned xb_add(unsigned* p, unsigned v) { return __hip_atomic_fetch_add(p, v, __ATOMIC_RELAXED, __HIP_MEMORY_SCOPE_AGENT); }
DEV unsigned xb_xcc_id() { return (unsigned)__builtin_amdgcn_s_getreg((3 << 11) | 20) & 0xFu; }
#define XB_SPIN(cond, bar) do { unsigned _sp = 0; while (cond) { __builtin_amdgcn_s_sleep(1); \
    if ((++_sp & 255u) == 0u) { if (xb_ld(&(bar)[XB_TMO])) break; if (_sp > XB_SPIN_CAP) { atomicAdd(&(bar)[XB_TMO], 1u); break; } } } } while (0)
struct XcdBarrier { unsigned* bar; unsigned x; volatile LAS unsigned* st; };
DEV XcdBarrier xcd_barrier_post(unsigned* bar, volatile LAS unsigned* st) {
    XcdBarrier b; b.bar = bar; b.x = xb_xcc_id(); b.st = st;
    if (threadIdx.x == 0) (void)xb_add(&bar[XB_XCNT(b.x)], 1u);
    return b;
}
DEV void xcd_barrier_complete(unsigned* bar, unsigned x, unsigned& nloc, unsigned& nx) {
    const unsigned G = gridDim.x;
    unsigned sum, cnt, mine, sp = 0u;
    for (;;) {
        sum = 0u; cnt = 0u; mine = 0u;
#pragma unroll
        for (unsigned j = 0; j < 16; ++j) { const unsigned c = xb_ld(&bar[XB_XCNT(j)]); sum += c; cnt += (c > 0u) ? 1u : 0u; mine = (j == x) ? c : mine; }
        if (sum == G) break;
        __builtin_amdgcn_s_sleep(1);
        if ((++sp & 255u) == 0u) { if (xb_ld(&bar[XB_TMO])) break; if (sp > XB_SPIN_CAP) { atomicAdd(&bar[XB_TMO], 1u); break; } }
    }
    nloc = mine > 0u ? mine : 1u; nx = cnt > 0u ? cnt : 1u;
}
DEV void xcd_barrier(const XcdBarrier& b) {
    asm volatile("s_waitcnt vmcnt(0)" ::: "memory");
    __syncthreads();
    if (threadIdx.x == 0) {
        unsigned* bar = b.bar;
        __builtin_amdgcn_s_waitcnt(0);
        unsigned nloc = b.st[0], nx = b.st[1];
        if (nloc == 0u) { xcd_barrier_complete(bar, b.x, nloc, nx); b.st[0] = nloc; b.st[1] = nx; }
        const unsigned old = xb_add(&bar[XB_XSUB(b.x)], 1u);
        const unsigned gen = old / nloc;
        if (old + 1u == (gen + 1u) * nloc) {
            __builtin_amdgcn_fence(__ATOMIC_RELEASE, "agent");
            asm volatile("s_waitcnt vmcnt(0)" ::: "memory");
            const unsigned og = xb_add(&bar[XB_TOP], 1u);
            const unsigned tg = og / nx;
            if (og + 1u == (tg + 1u) * nx) xb_add(&bar[XB_TOPGEN], 1u);
            else XB_SPIN(xb_ld(&bar[XB_TOPGEN]) == tg, bar);
            __builtin_amdgcn_fence(__ATOMIC_ACQUIRE, "agent");
            xb_add(&bar[XB_XGEN(b.x)], 1u);
            asm volatile("s_waitcnt vmcnt(0)" ::: "memory");
        } else {
            XB_SPIN(xb_ld(&bar[XB_XGEN(b.x)]) == gen, bar);
            __builtin_amdgcn_fence(__ATOMIC_ACQUIRE, "agent");
            asm volatile("s_waitcnt vmcnt(0)" ::: "memory");
        }
    }
    __syncthreads();
}

DEV void glds16(const void* gptr, unsigned lds_addr_lane) {
    const unsigned m = __builtin_amdgcn_readfirstlane(lds_addr_lane);
    unsigned keep;
    asm volatile("s_mov_b32 %0, m0\n\ts_mov_b32 m0, %2\n\ts_nop 0\n\tglobal_load_lds_dwordx4 %1, off\n\ts_mov_b32 m0, %0" : "=&s"(keep) : "v"(gptr), "s"(m) : "memory");
}

template <int WT, class Epi>
DEV void gemm_tile(const bf16_t* __restrict__ A, int lda, const bf16_t* __restrict__ Bt, int ldb, int K, unsigned char* lds, const Epi& epi) {
    constexpr int FI = WT / 16;
    constexpr int OPB = 2 * WT * 128;
    constexpr int STB = 2 * OPB;
    int tid = threadIdx.x & 255; asm volatile("" : "+v"(tid)); const int lane = tid & 63, wid = tid >> 6;
    const int wr = wid >> 1, wc = wid & 1, fr = lane & 15, fq = lane >> 4;
    f32x4 acc[FI][FI];
#pragma unroll
    for (int i = 0; i < FI; ++i)
#pragma unroll
        for (int j = 0; j < FI; ++j) acc[i][j] = (f32x4){0.f, 0.f, 0.f, 0.f};
    const int lrow = tid >> 3, lcs = (tid & 7) ^ (lrow & 7);
    const bf16_t* ap = A + (size_t)lrow * lda + lcs * 8;
    const bf16_t* bp = Bt + (size_t)lrow * ldb + lcs * 8;
    const unsigned l3a = (unsigned)(size_t)(LAS unsigned char*)lds;
    const int nk = K >> 6;
#define GLDS_STAGE(st, kt_) do { \
        _Pragma("unroll") for (int i_ = 0; i_ < FI; ++i_) { \
            glds16(ap + (size_t)(32 * i_) * lda + (kt_) * 64, l3a + (st) + tid * 16 + i_ * 4096); \
            glds16(bp + (size_t)(32 * i_) * ldb + (kt_) * 64, l3a + (st) + OPB + tid * 16 + i_ * 4096); } } while (0)
    constexpr int NSTG = 65536 / STB;
#pragma unroll
    for (int s_ = 0; s_ < NSTG - 1; ++s_) if (s_ < nk) GLDS_STAGE(s_ * STB, s_);
    const int aoff = (wr * WT + fr) * 128, boff = OPB + (wc * WT + fr) * 128, sw = fr & 7;
    int cur = 0, nxt = (NSTG - 1) * STB;
    for (int kt = 0; kt < nk; ++kt) {
        if (NSTG == 4 && kt + 2 < nk) { if (FI == 2) asm volatile("s_waitcnt vmcnt(8)" ::: "memory"); else asm volatile("s_waitcnt vmcnt(0)" ::: "memory"); }
        else asm volatile("s_waitcnt vmcnt(0)" ::: "memory");
        __syncthreads();
        if (kt + NSTG - 1 < nk) GLDS_STAGE(nxt, kt + NSTG - 1);
#pragma unroll
        for (int kh = 0; kh < 2; ++kh) {
            bf16x8 af[FI], bfr[FI];
            const int ch = ((kh * 4 + fq) ^ sw) << 4;
#pragma unroll
            for (int i = 0; i < FI; ++i) { af[i] = *(const bf16x8*)(lds + cur + aoff + i * 2048 + ch); bfr[i] = *(const bf16x8*)(lds + cur + boff + i * 2048 + ch); }
#pragma unroll
            for (int mi = 0; mi < FI; ++mi)
#pragma unroll
                for (int ni = 0; ni < FI; ++ni) acc[mi][ni] = __builtin_amdgcn_mfma_f32_16x16x32_bf16(bfr[ni], af[mi], acc[mi][ni], 0, 0, 0);
        }
        nxt = cur; cur += STB; if (cur == NSTG * STB) cur = 0;
    }
#undef GLDS_STAGE
    __syncthreads();
#pragma unroll
    for (int mi = 0; mi < FI; ++mi)
#pragma unroll
        for (int ni = 0; ni < FI; ++ni) epi(wr * WT + mi * 16 + fr, wc * WT + ni * 16 + fq * 4, acc[mi][ni]);
}

template <class Epi>
DEV void gemm256_tile(const bf16_t* __restrict__ A, int lda, const bf16_t* __restrict__ Bt, int ldb, int K, unsigned char* lds, const Epi& epi) {
    int tid = threadIdx.x; asm volatile("" : "+v"(tid)); const int lane = tid & 63, wid = tid >> 6;
    const int wr = wid >> 2, wc = wid & 3, fr = lane & 15, fq = lane >> 4;
    f32x4 acc[8][4];
#pragma unroll
    for (int i = 0; i < 8; ++i)
#pragma unroll
        for (int j = 0; j < 4; ++j) acc[i][j] = (f32x4){0.f, 0.f, 0.f, 0.f};
    const int lrow = tid >> 3, lcs = (tid & 7) ^ (lrow & 7);
    const bf16_t* ap = A + (size_t)lrow * lda + lcs * 8;
    const bf16_t* bp = Bt + (size_t)lrow * ldb + lcs * 8;
    const unsigned l3a = (unsigned)(size_t)(LAS unsigned char*)lds;
    const int nk = K >> 6;
#define GLDS_STAGE(st, kt_) do { \
        _Pragma("unroll") for (int i_ = 0; i_ < 4; ++i_) { \
            glds16(ap + (size_t)(64 * i_) * lda + (kt_) * 64, l3a + (st) + tid * 16 + i_ * 8192); \
            glds16(bp + (size_t)(64 * i_) * ldb + (kt_) * 64, l3a + (st) + 32768 + tid * 16 + i_ * 8192); } } while (0)
    GLDS_STAGE(0, 0);
    const int aoff = (wr * 128 + fr) * 128, boff = 32768 + (wc * 64 + fr) * 128, sw = fr & 7;
    for (int kt = 0; kt < nk; ++kt) {
        const int cur = (kt & 1) * 65536;
        asm volatile("s_waitcnt vmcnt(0)" ::: "memory");
        __syncthreads();
        if (kt + 1 < nk) GLDS_STAGE(cur ^ 65536, kt + 1);
#pragma unroll
        for (int kh = 0; kh < 2; ++kh) {
            bf16x8 bfr[4];
            const int ch = ((kh * 4 + fq) ^ sw) << 4;
#pragma unroll
            for (int i = 0; i < 4; ++i) bfr[i] = *(const bf16x8*)(lds + cur + boff + i * 2048 + ch);
#pragma unroll
            for (int mh = 0; mh < 2; ++mh) {
                bf16x8 af[4];
#pragma unroll
                for (int i = 0; i < 4; ++i) af[i] = *(const bf16x8*)(lds + cur + aoff + (mh * 4 + i) * 2048 + ch);
#pragma unroll
                for (int mi = 0; mi < 4; ++mi)
#pragma unroll
                    for (int ni = 0; ni < 4; ++ni) acc[mh * 4 + mi][ni] = __builtin_amdgcn_mfma_f32_16x16x32_bf16(bfr[ni], af[mi], acc[mh * 4 + mi][ni], 0, 0, 0);
            }
        }
    }
#undef GLDS_STAGE
    __syncthreads();
#pragma unroll
    for (int mi = 0; mi < 8; ++mi)
#pragma unroll
        for (int ni = 0; ni < 4; ++ni) epi(wr * 128 + mi * 16 + fr, wc * 64 + ni * 16 + fq * 4, acc[mi][ni]);
}

DEV void ab_rows16(const bf16_t* __restrict__ h, const bf16_t* __restrict__ wab, float* __restrict__ ab, int rt, int lane) {
    const int fr = lane & 15, fq = lane >> 4;
    const bf16_t* ap = h + (size_t)(rt * 16 + fr) * LDB + fq * 8;
    const bf16_t* bp = wab + (size_t)fr * LDB + fq * 8;
    f32x4 acc = {0.f, 0.f, 0.f, 0.f};
#pragma unroll 8
    for (int s = 0; s < 64; ++s) {
        const bf16x8 a = *(const bf16x8*)(ap + s * 32), b = *(const bf16x8*)(bp + s * 32);
        acc = __builtin_amdgcn_mfma_f32_16x16x32_bf16(b, a, acc, 0, 0, 0);
    }
    *(f32x4*)(ab + (size_t)(rt * 16 + fr) * 16 + fq * 4) = acc;
}

DEV void tile_map(int L, int nM, int nN, int& pm, int& pn) {
    const int T = nM * nN, q = T >> 3, r = T & 7, xcd = L & 7, off = L >> 3;
    const int w = (xcd < r ? xcd * (q + 1) : r * (q + 1) + (xcd - r) * q) + off;
    const int nig = 8 * nN, gid = w / nig, fm = gid * 8, gsz = (nM - fm) < 8 ? (nM - fm) : 8;
    pm = fm + (w % nig) % gsz; pn = (w % nig) / gsz;
}

struct EpiProj {
    int m0, n0; bf16_t* proj; float* ab; float* out;
    DEV void operator()(int r, int c, f32x4 v) const {
        const int row = m0 + r, col = n0 + c;
        if (col < NPJ) {
            store_bf4(proj + (size_t)row * NPJ + col, v);
            const bool isconv = col < 3072, ispool = (col >= C_U && col < C_ZB);
            if (isconv || ispool) {
                if (row < TP) {
                    const int b = row >> 11, t = row & 2047;
                    if (isconv) { if (t >= 2045) *(f32x4*)(out + O_CP + ((size_t)(b * 3 + (t - 2045))) * 3072 + col) = v; }
                    else { if (t >= 2033) *(f32x4*)(out + O_PP + ((size_t)(b * 15 + (t - 2033))) * 1024 + (col - C_U)) = v; }
                } else {
                    const int sb = (row - TP) >> 2, t = (row - TP) & 3;
                    if (isconv) { if (t >= 1) *(f32x4*)(out + O_CS + ((size_t)(sb * 3 + (t - 1))) * 3072 + col) = v; }
                    else *(f32x4*)(out + O_PS + ((size_t)(sb * 15 + 11 + t)) * 1024 + (col - C_U)) = v;
                }
            }
        } else if (col < NPJ + 16) {
            *(f32x4*)(ab + (size_t)row * 16 + (col - NPJ)) = v;
        }
    }
};
struct EpiMKV {
    int m0, n0; bf16_t* mkb; bf16_t* mvt; float* out;
    DEV void operator()(int r, int c, f32x4 v) const {
        const int row = m0 + r, col = n0 + c;
        if (col < D) {
            *(f32x4*)(out + O_MK + (size_t)row * D + col) = v;
            store_bf4(mkb + (size_t)row * LDB + col, v);
        } else {
            const int cc = col - D, b = row >> 8, m = row & 255;
            *(f32x4*)(out + O_MV + (size_t)row * D + cc) = v;
            bf16_t* p = mvt + ((size_t)b * D + cc) * LDM + m;
            p[0] = f2bf(v[0]); p[LDM] = f2bf(v[1]); p[2 * LDM] = f2bf(v[2]); p[3 * LDM] = f2bf(v[3]);
        }
    }
};
struct EpiPool {
    int m0, n0; const bf16_t* proj; const float* scale; bf16_t* mix;
    DEV void operator()(int r, int c, f32x4 v) const {
        const int row = m0 + r, col = n0 + c;
        const uint2 z = *(const uint2*)(proj + (size_t)row * NPJ + C_ZB + col);
        const f32x4 s = *(const f32x4*)(scale + col);
        f32x4 o;
        o[0] = v[0] * s[0] * silu_f(bflo(z.x)); o[1] = v[1] * s[1] * silu_f(bfhi(z.x));
        o[2] = v[2] * s[2] * silu_f(bflo(z.y)); o[3] = v[3] * s[3] * silu_f(bfhi(z.y));
        store_bf4(mix + (size_t)row * LDB + 1024 + col, o);
    }
};
struct EpiResid {
    const float* res; bf16_t* dst;
    DEV void operator()(int r, int c, f32x4 v) const {
        const f32x4 x = __builtin_nontemporal_load((const f32x4*)(res + (size_t)r * D + c));
        store_bf4(dst + (size_t)r * LDB + c, x + v);
    }
};
struct EpiResidB {
    const bf16_t* res; bf16_t* dst;
    DEV void operator()(int r, int c, f32x4 v) const {
        const uint2 u = *(const uint2*)(res + (size_t)r * LDB + c);
        f32x4 x; x[0] = bflo(u.x); x[1] = bfhi(u.x); x[2] = bflo(u.y); x[3] = bfhi(u.y);
        store_bf4(dst + (size_t)r * LDB + c, x + v);
    }
};
struct EpiBf {
    bf16_t* dst; int ld;
    DEV void operator()(int r, int c, f32x4 v) const { store_bf4(dst + (size_t)r * ld + c, v); }
};
struct EpiF32s {
    float* dst; int ld; float s;
    DEV void operator()(int r, int c, f32x4 v) const { *(f32x4*)(dst + (size_t)r * ld + c) = v * s; }
};

DEV int win_srccol(int n) { return n < 4096 ? n : (n < 6144 ? n + 16 : (n < 6160 ? 4096 + (n - 6144) : -1)); }
DEV void transpose_tile(const float* __restrict__ src, int ld, int srccol0, bool remap, int k0, bf16_t* __restrict__ dstrow0, int ldd, float* tile) {
    int tid = threadIdx.x & 255; asm volatile("" : "+v"(tid));
    const int tx = tid & 63, ty = tid >> 6;
    const int sc = remap ? win_srccol(srccol0 + tx) : (srccol0 + tx);
    float tv[32];
#pragma unroll
    for (int i = 0; i < 32; ++i) tv[i] = sc >= 0 ? __builtin_nontemporal_load(src + (size_t)(k0 + ty + 4 * i) * ld + sc) : 0.f;
#pragma unroll
    for (int i = 0; i < 32; ++i) tile[(ty + 4 * i) * 65 + tx] = tv[i];
    __syncthreads();
#pragma unroll
    for (int i = 0; i < 16; ++i) { const int r = ty + 4 * i; *(unsigned*)(dstrow0 + (size_t)r * ldd + k0 + 2 * tx) = cvt_pk_bf16(tile[(2 * tx) * 65 + r], tile[(2 * tx + 1) * 65 + r]); }
    __syncthreads();
}
DEV void rmsnorm_row_bf16(const float* __restrict__ x, const float* __restrict__ g, bf16_t* __restrict__ y, int lane) {
    f32x4 v[8]; float ss = 0.f;
#pragma unroll
    for (int i = 0; i < 8; ++i) { v[i] = ((const f32x4*)x)[i * 64 + lane]; ss += v[i][0] * v[i][0] + v[i][1] * v[i][1] + v[i][2] * v[i][2] + v[i][3] * v[i][3]; }
    ss = wave_sum(ss);
    const float rs = rsqrtf(ss * (1.f / 2048.f) + EPS);
#pragma unroll
    for (int i = 0; i < 8; ++i) { const f32x4 gg = ((const f32x4*)g)[i * 64 + lane]; store_bf4(y + (size_t)(i * 64 + lane) * 4, v[i] * rs * gg); }
}
template <bool OUT_F32>
DEV void rmsnorm_row_from_bf16(const bf16_t* __restrict__ x, const float* __restrict__ g, void* __restrict__ y, int lane) {
    float v[4][8]; float ss = 0.f;
#pragma unroll
    for (int i = 0; i < 4; ++i) { const uint4 u = ((const uint4*)x)[i * 64 + lane];
        v[i][0] = bflo(u.x); v[i][1] = bfhi(u.x); v[i][2] = bflo(u.y); v[i][3] = bfhi(u.y); v[i][4] = bflo(u.z); v[i][5] = bfhi(u.z); v[i][6] = bflo(u.w); v[i][7] = bfhi(u.w);
#pragma unroll
        for (int e = 0; e < 8; ++e) ss += v[i][e] * v[i][e]; }
    ss = wave_sum(ss);
    const float rs = rsqrtf(ss * (1.f / 2048.f) + EPS);
#pragma unroll
    for (int i = 0; i < 4; ++i) {
        const f32x4 g0 = ((const f32x4*)g)[(i * 64 + lane) * 2], g1 = ((const f32x4*)g)[(i * 64 + lane) * 2 + 1];
        const f32x4 o0 = (f32x4){v[i][0], v[i][1], v[i][2], v[i][3]} * rs * g0, o1 = (f32x4){v[i][4], v[i][5], v[i][6], v[i][7]} * rs * g1;
        if (OUT_F32) { __builtin_nontemporal_store(o0, (f32x4*)y + (i * 64 + lane) * 2); __builtin_nontemporal_store(o1, (f32x4*)y + (i * 64 + lane) * 2 + 1); }
        else { uint4 w; w.x = cvt_pk_bf16(o0[0], o0[1]); w.y = cvt_pk_bf16(o0[2], o0[3]); w.z = cvt_pk_bf16(o1[0], o1[1]); w.w = cvt_pk_bf16(o1[2], o1[3]); ((uint4*)y)[i * 64 + lane] = w; }
    }
}
DEV void rmsnorm_row_f32(const float* __restrict__ x, const float* __restrict__ g, float* __restrict__ y, int lane) {
    f32x4 v[8]; float ss = 0.f;
#pragma unroll
    for (int i = 0; i < 8; ++i) { v[i] = ((const f32x4*)x)[i * 64 + lane]; ss += v[i][0] * v[i][0] + v[i][1] * v[i][1] + v[i][2] * v[i][2] + v[i][3] * v[i][3]; }
    ss = wave_sum(ss);
    const float rs = rsqrtf(ss * (1.f / 2048.f) + EPS);
#pragma unroll
    for (int i = 0; i < 8; ++i) { const f32x4 gg = ((const f32x4*)g)[i * 64 + lane]; __builtin_nontemporal_store(v[i] * rs * gg, (f32x4*)y + i * 64 + lane); }
}

constexpr int QS = 136;
DEV void gdn_prep_chunk(const Params& p, int item, unsigned char* lds) {
    int tid = threadIdx.x & 255; asm volatile("" : "+v"(tid)); const int lane = tid & 63, wid = tid >> 6;
    const int c = item & 31, h = (item >> 5) & 7, b = item >> 8;
    const int row0 = b * SEQ + c * 64;
    const bf16_t* proj = (const bf16_t*)(p.ws + WS_PROJ);
    const float* ab = (const float*)(p.ws + WS_AB);
    bf16_t* qs = (bf16_t*)lds; bf16_t* ks = qs + 64 * QS; bf16_t* vs = ks + 64 * QS;
    float* lowT = (float*)lds;
    float* gcs = (float*)(lds + 3 * 64 * QS * 2);
    float* bts = gcs + 64;
    bf16_t* gW = (bf16_t*)(p.ws + WS_GW) + (size_t)item * 8192;
    bf16_t* gQ = (bf16_t*)(p.ws + WS_GQ) + (size_t)item * 8192;
    bf16_t* gKT = (bf16_t*)(p.ws + WS_GKT) + (size_t)item * 8192;
    bf16_t* gA = (bf16_t*)(p.ws + WS_GA) + (size_t)item * 4096;
    float* gU = (float*)(p.ws + WS_GU) + (size_t)item * 8192;
    float* gE = (float*)(p.ws + WS_GE) + item;

    if (wid == 3) {
        const float a = ab[(size_t)(row0 + lane) * 16 + h], bb = ab[(size_t)(row0 + lane) * 16 + 8 + h];
        const float xx = a + p.in[12][h];
        const float sp = xx > 20.f ? xx : log1pf(__expf(xx));
        float s = -__expf(p.in[11][h]) * sp;
#pragma unroll
        for (int d = 1; d < 64; d <<= 1) { const float t = __shfl_up(s, d); if (lane >= d) s += t; }
        gcs[lane] = s; bts[lane] = 1.f / (1.f + __expf(-bb));
    } else {
        const int mat = wid, rg = lane >> 4, cv = lane & 15;
        const int colg = mat * 1024 + h * 128 + cv * 8;
        const float* cw = p.in[10];
        float w[4][8];
#pragma unroll
        for (int j = 0; j < 4; ++j) { const f32x4 w0 = *(const f32x4*)(cw + j * 3072 + colg), w1 = *(const f32x4*)(cw + j * 3072 + colg + 4);
            w[j][0] = w0[0]; w[j][1] = w0[1]; w[j][2] = w0[2]; w[j][3] = w0[3]; w[j][4] = w1[0]; w[j][5] = w1[1]; w[j][6] = w1[2]; w[j][7] = w1[3]; }
        const int tl0 = rg * 16;
        uint4 raw[19];
#pragma unroll
        for (int i = 0; i < 19; ++i) {
            const int tl = tl0 - 3 + i;
            if (c * 64 + tl >= 0) raw[i] = *(const uint4*)(proj + (size_t)(row0 + tl) * NPJ + colg);
            else raw[i] = make_uint4(0u, 0u, 0u, 0u);
        }
        bf16_t* dst = (mat == 0 ? qs : (mat == 1 ? ks : vs));
#pragma unroll
        for (int r = 0; r < 16; ++r) {
            float y[8]; float ss = 0.f;
#pragma unroll
            for (int e = 0; e < 8; ++e) {
                float a = 0.f;
#pragma unroll
                for (int j = 0; j < 4; ++j) {
                    const uint4 u = raw[r + j];
                    const unsigned wd = (e < 2 ? u.x : (e < 4 ? u.y : (e < 6 ? u.z : u.w)));
                    const float xv = (e & 1) ? bfhi(wd) : bflo(wd);
                    a += w[j][e] * xv;
                }
                y[e] = silu_f(a); ss += y[e] * y[e];
            }
            if (mat < 2) {
                ss += __shfl_xor(ss, 1); ss += __shfl_xor(ss, 2); ss += __shfl_xor(ss, 4); ss += __shfl_xor(ss, 8);
                float inv = rsqrtf(ss + EPS); if (mat == 0) inv *= 0.08838834764831845f;
#pragma unroll
                for (int e = 0; e < 8; ++e) y[e] *= inv;
            }
            uint4 o; o.x = cvt_pk_bf16(y[0], y[1]); o.y = cvt_pk_bf16(y[2], y[3]); o.z = cvt_pk_bf16(y[4], y[5]); o.w = cvt_pk_bf16(y[6], y[7]);
            *(uint4*)(dst + (tl0 + r) * QS + cv * 8) = o;
        }
    }
    __syncthreads();
    {
        const float glast = gcs[63];
        if (tid == 0) *gE = __expf(glast);
#pragma unroll
        for (int i = 0; i < 4; ++i) {
            const int ci = tid + 256 * i, t = ci >> 4, cc = (ci & 15) * 8;
            const uint4 u = *(const uint4*)(qs + t * QS + cc);
            const float e = __expf(gcs[t]);
            uint4 o; o.x = cvt_pk_bf16(bflo(u.x) * e, bfhi(u.x) * e); o.y = cvt_pk_bf16(bflo(u.y) * e, bfhi(u.y) * e);
            o.z = cvt_pk_bf16(bflo(u.z) * e, bfhi(u.z) * e); o.w = cvt_pk_bf16(bflo(u.w) * e, bfhi(u.w) * e);
            *(uint4*)(gQ + t * 128 + cc) = o;
        }
        const float dk = __expf(glast - gcs[lane]);
#pragma unroll 8
        for (int i = 0; i < 32; ++i) { const int d = wid * 32 + i; gKT[d * 64 + lane] = f2bf(bf2f(ks[lane * QS + d]) * dk); }
    }
    f32x4 kk[4], qk[4];
    {
        const int fr = lane & 15, fq = lane >> 4, it = wid;
        bf16x8 kfi[4], qfi[4];
#pragma unroll
        for (int s = 0; s < 4; ++s) { kfi[s] = *(const bf16x8*)(ks + (it * 16 + fr) * QS + s * 32 + fq * 8); qfi[s] = *(const bf16x8*)(qs + (it * 16 + fr) * QS + s * 32 + fq * 8); }
#pragma unroll
        for (int jt = 0; jt < 4; ++jt) {
            kk[jt] = (f32x4){0.f, 0.f, 0.f, 0.f}; qk[jt] = (f32x4){0.f, 0.f, 0.f, 0.f};
#pragma unroll
            for (int s = 0; s < 4; ++s) {
                const bf16x8 kfj = *(const bf16x8*)(ks + (jt * 16 + fr) * QS + s * 32 + fq * 8);
                kk[jt] = __builtin_amdgcn_mfma_f32_16x16x32_bf16(kfi[s], kfj, kk[jt], 0, 0, 0);
                qk[jt] = __builtin_amdgcn_mfma_f32_16x16x32_bf16(kfj, qfi[s], qk[jt], 0, 0, 0);
            }
        }
    }
    __syncthreads();
    {
        const int fr = lane & 15, fq = lane >> 4, it = wid;
#pragma unroll
        for (int jt = 0; jt < 4; ++jt) {
            const int j = jt * 16 + fr; const float gj = gcs[j];
            f32x4 lv;
#pragma unroll
            for (int e = 0; e < 4; ++e) { const int i = it * 16 + fq * 4 + e; lv[e] = (i > j) ? bts[i] * kk[jt][e] * __expf(gcs[i] - gj) : 0.f; }
            *(f32x4*)(lowT + j * 68 + it * 16 + fq * 4) = lv;
            const int i2 = it * 16 + fr; const float gi = gcs[i2];
            f32x4 av;
#pragma unroll
            for (int e = 0; e < 4; ++e) { const int j2 = jt * 16 + fq * 4 + e; av[e] = (i2 >= j2) ? qk[jt][e] * __expf(gi - gcs[j2]) : 0.f; }
            store_bf4(gA + i2 * 64 + jt * 16 + fq * 4, av);
        }
    }
    __syncthreads();
    {
        const int cc = tid & 127; const bool isw = tid >= 128;
        bf16_t* src = isw ? ks : vs;
#pragma unroll 1
        for (int ib = 0; ib < 4; ++ib) {
            f32x2_t acc[8];
#pragma unroll
            for (int r = 0; r < 16; ++r) { const int j = ib * 16 + r; float f = bts[j]; if (isw) f *= __expf(gcs[j]); acc[r >> 1][r & 1] = f * bf2f(src[j * QS + cc]); }
            const float* lrow = lowT + ib * 16;
#pragma unroll 4
            for (int j = 0; j < ib * 16; ++j) {
                const float xj = -bf2f(src[j * QS + cc]); const f32x2_t nx = {xj, xj};
                const f32x4 l0 = *(const f32x4*)(lrow + j * 68), l1 = *(const f32x4*)(lrow + j * 68 + 4), l2 = *(const f32x4*)(lrow + j * 68 + 8), l3 = *(const f32x4*)(lrow + j * 68 + 12);
                acc[0] += (f32x2_t){l0[0], l0[1]} * nx; acc[1] += (f32x2_t){l0[2], l0[3]} * nx; acc[2] += (f32x2_t){l1[0], l1[1]} * nx; acc[3] += (f32x2_t){l1[2], l1[3]} * nx;
                acc[4] += (f32x2_t){l2[0], l2[1]} * nx; acc[5] += (f32x2_t){l2[2], l2[3]} * nx; acc[6] += (f32x2_t){l3[0], l3[1]} * nx; acc[7] += (f32x2_t){l3[2], l3[3]} * nx;
            }
#pragma unroll
            for (int r2 = 0; r2 < 15; ++r2) {
                asm volatile("" ::: "memory");
                const float xj = -acc[r2 >> 1][r2 & 1]; const f32x2_t nx = {xj, xj};
                const float* lp = lrow + (ib * 16 + r2) * 68;
#pragma unroll
                for (int q = (r2 + 1) >> 2; q < 4; ++q) {
                    const f32x4 l = *(const f32x4*)(lp + q * 4);
                    acc[2 * q] += (f32x2_t){l[0], l[1]} * nx; acc[2 * q + 1] += (f32x2_t){l[2], l[3]} * nx;
                }
            }
#pragma unroll
            for (int r = 0; r < 16; ++r) {
                const int j = ib * 16 + r; const float xv = acc[r >> 1][r & 1]; const bf16_t xb = f2bf(xv);
                src[j * QS + cc] = xb;
                if (isw) gW[j * 128 + cc] = xb; else gU[j * 128 + cc] = xv;
            }
        }
    }
    __syncthreads();
}

#define LDS_BARRIER() do { asm volatile("s_waitcnt lgkmcnt(0)" ::: "memory"); __builtin_amdgcn_s_barrier(); asm volatile("" ::: "memory"); } while (0)
DEV void gdn_scan_item(const Params& p, int item, unsigned char* lds) {
    int tid = threadIdx.x & 255; asm volatile("" : "+v"(tid)); const int lane = tid & 63, w = tid >> 6, fr = lane & 15, fq = lane >> 4;
    const int s = item & 7, bh = item >> 3;
    const int b = bh >> 3, h = bh & 7;
    bf16_t* ST = (bf16_t*)lds;
    bf16_t* VT = ST + 16 * QS;
    const bf16_t* gW = (const bf16_t*)(p.ws + WS_GW) + (size_t)bh * 32 * 8192;
    const bf16_t* gQ = (const bf16_t*)(p.ws + WS_GQ) + (size_t)bh * 32 * 8192;
    const bf16_t* gKT = (const bf16_t*)(p.ws + WS_GKT) + (size_t)bh * 32 * 8192;
    const bf16_t* gA = (const bf16_t*)(p.ws + WS_GA) + (size_t)bh * 32 * 4096;
    const float* gU = (const float*)(p.ws + WS_GU) + (size_t)bh * 32 * 8192;
    const float* gE = (const float*)(p.ws + WS_GE) + bh * 32;
    float* obuf = (float*)(p.ws + WS_O);
    f32x4 S0 = {0.f, 0.f, 0.f, 0.f}, S1 = {0.f, 0.f, 0.f, 0.f};
    for (int i = tid; i < 16 * QS / 2; i += 256) ((unsigned*)ST)[i] = 0u;
    bf16x8 fw[4], fqg[4], fa[2], fk0[2], fk1[2]; f32x4 uu; float eg;
#define SCAN_LOAD(ch) do { \
        const bf16_t* W_ = gW + (size_t)(ch) * 8192 + (w * 16 + fr) * 128 + fq * 8; const bf16_t* Q_ = gQ + (size_t)(ch) * 8192 + (w * 16 + fr) * 128 + fq * 8; \
        _Pragma("unroll") for (int k_ = 0; k_ < 4; ++k_) { fw[k_] = *(const bf16x8*)(W_ + k_ * 32); fqg[k_] = *(const bf16x8*)(Q_ + k_ * 32); } \
        const bf16_t* A_ = gA + (size_t)(ch) * 4096 + (w * 16 + fr) * 64 + fq * 8; fa[0] = *(const bf16x8*)(A_); fa[1] = *(const bf16x8*)(A_ + 32); \
        const bf16_t* K_ = gKT + (size_t)(ch) * 8192 + (w * 32 + fr) * 64 + fq * 8; fk0[0] = *(const bf16x8*)(K_); fk0[1] = *(const bf16x8*)(K_ + 32); \
        fk1[0] = *(const bf16x8*)(K_ + 16 * 64); fk1[1] = *(const bf16x8*)(K_ + 16 * 64 + 32); \
        const float* U_ = gU + (size_t)(ch) * 8192 + (w * 16 + fq * 4) * 128 + s * 16 + fr; uu[0] = U_[0]; uu[1] = U_[128]; uu[2] = U_[256]; uu[3] = U_[384]; \
        eg = gE[ch]; } while (0)
    SCAN_LOAD(0);
    __syncthreads();
    for (int ch = 0; ch < 32; ++ch) {
        bf16x8 cw[4], cq[4], ca[2], ck0[2], ck1[2]; f32x4 cu = uu; const float ceg = eg;
#pragma unroll
        for (int k = 0; k < 4; ++k) { cw[k] = fw[k]; cq[k] = fqg[k]; }
        ca[0] = fa[0]; ca[1] = fa[1]; ck0[0] = fk0[0]; ck0[1] = fk0[1]; ck1[0] = fk1[0]; ck1[1] = fk1[1];
        if (ch + 1 < 32) SCAN_LOAD(ch + 1);
        f32x4 ws_ = {0.f, 0.f, 0.f, 0.f}, oo = {0.f, 0.f, 0.f, 0.f};
#pragma unroll
        for (int k = 0; k < 4; ++k) {
            const bf16x8 sf = *(const bf16x8*)(ST + fr * QS + k * 32 + fq * 8);
            ws_ = __builtin_amdgcn_mfma_f32_16x16x32_bf16(cw[k], sf, ws_, 0, 0, 0);
            oo = __builtin_amdgcn_mfma_f32_16x16x32_bf16(cq[k], sf, oo, 0, 0, 0);
        }
        const f32x4 vn = cu - ws_;
        store_bf4(VT + fr * 72 + w * 16 + fq * 4, vn);
        LDS_BARRIER();
        const bf16x8 v0 = *(const bf16x8*)(VT + fr * 72 + fq * 8), v1 = *(const bf16x8*)(VT + fr * 72 + 32 + fq * 8);
        oo = __builtin_amdgcn_mfma_f32_16x16x32_bf16(ca[0], v0, oo, 0, 0, 0);
        oo = __builtin_amdgcn_mfma_f32_16x16x32_bf16(ca[1], v1, oo, 0, 0, 0);
        S0 = S0 * ceg; S1 = S1 * ceg;
        S0 = __builtin_amdgcn_mfma_f32_16x16x32_bf16(ck0[0], v0, S0, 0, 0, 0);
        S0 = __builtin_amdgcn_mfma_f32_16x16x32_bf16(ck0[1], v1, S0, 0, 0, 0);
        S1 = __builtin_amdgcn_mfma_f32_16x16x32_bf16(ck1[0], v0, S1, 0, 0, 0);
        S1 = __builtin_amdgcn_mfma_f32_16x16x32_bf16(ck1[1], v1, S1, 0, 0, 0);
        store_bf4(ST + fr * QS + w * 32 + fq * 4, S0);
        store_bf4(ST + fr * QS + w * 32 + 16 + fq * 4, S1);
        {
            float* op = obuf + (size_t)(b * SEQ + ch * 64 + w * 16 + fq * 4) * 1024 + h * 128 + s * 16 + fr;
            op[0] = oo[0]; op[1024] = oo[1]; op[2048] = oo[2]; op[3072] = oo[3];
        }
        LDS_BARRIER();
    }
#undef SCAN_LOAD
    {
        float* dp = p.out + O_DP + ((size_t)bh * 128 + w * 32 + fq * 4) * 128 + s * 16 + fr;
#pragma unroll
        for (int e = 0; e < 4; ++e) { dp[e * 128] = S0[e]; dp[(16 + e) * 128] = S1[e]; }
    }
    __syncthreads();
}

DEV void gdn_sample_item(const Params& p, int item, unsigned char* lds) {
    int tid = threadIdx.x & 255; asm volatile("" : "+v"(tid)); const int lane = tid & 63, wid = tid >> 6;
    const int sb = item >> 3, h = item & 7, half = tid >> 7, c = tid & 127;
    const int r0 = TP + sb * 4;
    const bf16_t* proj = (const bf16_t*)(p.ws + WS_PROJ);
    const float* ab = (const float*)(p.ws + WS_AB);
    float* ksh = (float*)lds;
    float* qsh = ksh + 512;
    float* red = qsh + 512;
    float* red2 = red + 32;
    float* part = red2 + 32;
    float* opart = part + 1024;
    float qv[4], kv[4], vv[4];
#pragma unroll
    for (int m = 0; m < 3; ++m) {
        const int col = m * 1024 + h * 128 + c;
        float x[7], wj[4];
#pragma unroll
        for (int j = 0; j < 3; ++j) x[j] = p.in[6][((size_t)sb * 3 + j) * 3072 + col];
#pragma unroll
        for (int t = 0; t < 4; ++t) x[3 + t] = bf2f(proj[(size_t)(r0 + t) * NPJ + col]);
#pragma unroll
        for (int j = 0; j < 4; ++j) wj[j] = p.in[10][j * 3072 + col];
#pragma unroll
        for (int t = 0; t < 4; ++t) {
            const float y = silu_f(wj[0] * x[t] + wj[1] * x[t + 1] + wj[2] * x[t + 2] + wj[3] * x[t + 3]);
            if (m == 0) qv[t] = y; else if (m == 1) kv[t] = y; else vv[t] = y;
        }
    }
#pragma unroll
    for (int t = 0; t < 4; ++t) {
        const float a = wave_sum(qv[t] * qv[t]), bq = wave_sum(kv[t] * kv[t]);
        if (lane == 0) { red[wid * 8 + t] = a; red[wid * 8 + 4 + t] = bq; }
    }
    __syncthreads();
    float gt[4], bt[4];
#pragma unroll
    for (int t = 0; t < 4; ++t) {
        const float sq = red[(2 * half) * 8 + t] + red[(2 * half + 1) * 8 + t], sk = red[(2 * half) * 8 + 4 + t] + red[(2 * half + 1) * 8 + 4 + t];
        if (half == 0) {
            qsh[t * 128 + c] = qv[t] * rsqrtf(sq + EPS) * 0.08838834764831845f;
            ksh[t * 128 + c] = kv[t] * rsqrtf(sk + EPS);
        }
        const float a = ab[(size_t)(r0 + t) * 16 + h], bb = ab[(size_t)(r0 + t) * 16 + 8 + h];
        const float xx = a + p.in[12][h];
        const float sp = xx > 20.f ? xx : log1pf(__expf(xx));
        gt[t] = __expf(-__expf(p.in[11][h]) * sp);
        bt[t] = 1.f / (1.f + __expf(-bb));
    }
    float S[64];
    const float* sp0 = p.in[5] + ((size_t)(sb * 8 + h) * 128 + half * 64) * 128 + c;
#pragma unroll
    for (int d = 0; d < 64; ++d) S[d] = __builtin_nontemporal_load(sp0 + (size_t)d * 128);
    __syncthreads();
    float ot[4];
#pragma unroll
    for (int t = 0; t < 4; ++t) {
        const float* kk = ksh + t * 128 + half * 64; const float* qq = qsh + t * 128 + half * 64;
        float kS = 0.f;
#pragma unroll
        for (int d4 = 0; d4 < 16; ++d4) { const f32x4 k4 = *(const f32x4*)(kk + d4 * 4); kS += k4[0] * S[d4 * 4] + k4[1] * S[d4 * 4 + 1] + k4[2] * S[d4 * 4 + 2] + k4[3] * S[d4 * 4 + 3]; }
        part[(t * 2 + half) * 128 + c] = kS;
        __syncthreads();
        kS = part[(t * 2) * 128 + c] + part[(t * 2 + 1) * 128 + c];
        const float eg = gt[t], dl = bt[t] * (vv[t] - eg * kS);
        float o = 0.f;
#pragma unroll
        for (int d4 = 0; d4 < 16; ++d4) {
            const f32x4 k4 = *(const f32x4*)(kk + d4 * 4), q4 = *(const f32x4*)(qq + d4 * 4);
#pragma unroll
            for (int e = 0; e < 4; ++e) { const float sn = eg * S[d4 * 4 + e] + k4[e] * dl; S[d4 * 4 + e] = sn; o += q4[e] * sn; }
        }
        ot[t] = o;
        if (half == 1) opart[t * 128 + c] = o;
    }
    float* dso = p.out + O_DS + ((size_t)(sb * 8 + h) * 128 + half * 64) * 128 + c;
#pragma unroll
    for (int d = 0; d < 64; ++d) __builtin_nontemporal_store(S[d], dso + (size_t)d * 128);
    __syncthreads();
    if (half == 0) {
#pragma unroll
        for (int t = 0; t < 4; ++t) { ot[t] += opart[t * 128 + c]; const float a = wave_sum(ot[t] * ot[t]); if (lane == 0) red2[wid * 4 + t] = a; }
    }
    __syncthreads();
    if (half == 0) {
        bf16_t* mix = (bf16_t*)(p.ws + WS_MIX);
        const float gn = p.in[13][c];
#pragma unroll
        for (int t = 0; t < 4; ++t) {
            const float ms = (red2[t] + red2[4 + t]) * (1.f / 128.f);
            const float z = bf2f(proj[(size_t)(r0 + t) * NPJ + C_ZA + h * 128 + c]);
            mix[(size_t)(r0 + t) * LDB + h * 128 + c] = f2bf(ot[t] * rsqrtf(ms + EPS) * gn * silu_f(z));
        }
    }
    __syncthreads();
}

DEV void attn_sample_item(const Params& p, int item, unsigned char* lds) {
    int tid = threadIdx.x & 255; asm volatile("" : "+v"(tid)); const int lane = tid & 63, wid = tid >> 6;
    const int sb = item >> 2, hd = item & 3;
    float* qs = (float*)lds;
    float* pm = qs + 2048;
    float* red = pm + 1024;
    const bf16_t* qx = (const bf16_t*)(p.ws + WS_QX);
    for (int i = tid; i < 2048; i += 256) { const int t = i >> 9, d = i & 511; qs[i] = bf2f(qx[(size_t)(TP + sb * 4 + t) * LDB + hd * 512 + d]) * 0.04419417382415922f; }
    __syncthreads();
    const float* Kc = p.in[3] + ((size_t)sb * 256) * D + hd * 512;
    const float* Vc = p.in[4] + ((size_t)sb * 256) * D + hd * 512;
    {
        const int sub = lane >> 4, l16 = lane & 15;
        f32x4 kv[8];
        {
            const float* kr = Kc + (size_t)(wid * 64 + sub) * D;
#pragma unroll
            for (int i = 0; i < 8; ++i) kv[i] = __builtin_nontemporal_load((const f32x4*)(kr + (i * 16 + l16) * 4));
        }
        for (int it = 0; it < 16; ++it) {
            const int m = wid * 64 + it * 4 + sub;
            f32x4 cv[8];
#pragma unroll
            for (int i = 0; i < 8; ++i) cv[i] = kv[i];
            if (it + 1 < 16) {
                const float* kr = Kc + (size_t)(m + 4) * D;
#pragma unroll
                for (int i = 0; i < 8; ++i) kv[i] = __builtin_nontemporal_load((const f32x4*)(kr + (i * 16 + l16) * 4));
            }
            float a0 = 0.f, a1 = 0.f, a2 = 0.f, a3 = 0.f;
#pragma unroll
            for (int i = 0; i < 8; ++i) {
                const int d = (i * 16 + l16) * 4;
                const f32x4 q0 = *(const f32x4*)(qs + d), q1 = *(const f32x4*)(qs + 512 + d), q2 = *(const f32x4*)(qs + 1024 + d), q3 = *(const f32x4*)(qs + 1536 + d);
                a0 += cv[i][0] * q0[0] + cv[i][1] * q0[1] + cv[i][2] * q0[2] + cv[i][3] * q0[3];
                a1 += cv[i][0] * q1[0] + cv[i][1] * q1[1] + cv[i][2] * q1[2] + cv[i][3] * q1[3];
                a2 += cv[i][0] * q2[0] + cv[i][1] * q2[1] + cv[i][2] * q2[2] + cv[i][3] * q2[3];
                a3 += cv[i][0] * q3[0] + cv[i][1] * q3[1] + cv[i][2] * q3[2] + cv[i][3] * q3[3];
            }
#pragma unroll
            for (int o = 1; o < 16; o <<= 1) { a0 += __shfl_xor(a0, o); a1 += __shfl_xor(a1, o); a2 += __shfl_xor(a2, o); a3 += __shfl_xor(a3, o); }
            if (l16 == 0) *(f32x4*)(pm + m * 4) = (f32x4){a0, a1, a2, a3};
        }
    }
    __syncthreads();
    {
        const int t = wid;
        float v[4]; float mx = -3.0e38f;
#pragma unroll
        for (int i = 0; i < 4; ++i) { v[i] = pm[(i * 64 + lane) * 4 + t]; mx = fmaxf(mx, v[i]); }
        mx = wave_max(mx);
        float sm = 0.f;
#pragma unroll
        for (int i = 0; i < 4; ++i) { v[i] = __expf(v[i] - mx); sm += v[i]; }
        sm = wave_sum(sm);
        const float inv = 1.f / sm;
#pragma unroll
        for (int i = 0; i < 4; ++i) pm[(i * 64 + lane) * 4 + t] = v[i] * inv;
    }
    __syncthreads();
    {
        f32x4 acc[4][2];
#pragma unroll
        for (int t = 0; t < 4; ++t) { acc[t][0] = (f32x4){0.f, 0.f, 0.f, 0.f}; acc[t][1] = (f32x4){0.f, 0.f, 0.f, 0.f}; }
        f32x4 va[4], vb[4];
#pragma unroll
        for (int i = 0; i < 4; ++i) { const float* vr = Vc + (size_t)(wid * 64 + i) * D; va[i] = __builtin_nontemporal_load((const f32x4*)(vr + lane * 4)); vb[i] = __builtin_nontemporal_load((const f32x4*)(vr + 256 + lane * 4)); }
        for (int m4 = 0; m4 < 16; ++m4) {
            f32x4 ca[4], cb[4];
#pragma unroll
            for (int i = 0; i < 4; ++i) { ca[i] = va[i]; cb[i] = vb[i]; }
            if (m4 + 1 < 16) {
#pragma unroll
                for (int i = 0; i < 4; ++i) { const float* vr = Vc + (size_t)(wid * 64 + (m4 + 1) * 4 + i) * D; va[i] = __builtin_nontemporal_load((const f32x4*)(vr + lane * 4)); vb[i] = __builtin_nontemporal_load((const f32x4*)(vr + 256 + lane * 4)); }
            }
#pragma unroll
            for (int i = 0; i < 4; ++i) {
                const f32x4 pr = *(const f32x4*)(pm + (wid * 64 + m4 * 4 + i) * 4);
#pragma unroll
                for (int t = 0; t < 4; ++t) { acc[t][0] += ca[i] * pr[t]; acc[t][1] += cb[i] * pr[t]; }
            }
        }
#pragma unroll
        for (int t = 0; t < 4; ++t) { *(f32x4*)(red + (wid * 4 + t) * 512 + lane * 4) = acc[t][0]; *(f32x4*)(red + (wid * 4 + t) * 512 + 256 + lane * 4) = acc[t][1]; }
    }
    __syncthreads();
    {
        bf16_t* ctx = (bf16_t*)(p.ws + WS_CTX);
#pragma unroll
        for (int i = 0; i < 2; ++i) {
            const int e = (tid + 256 * i) * 4, t = e >> 9, d = e & 511;
            const f32x4 s = *(const f32x4*)(red + (0 * 4 + t) * 512 + d) + *(const f32x4*)(red + (1 * 4 + t) * 512 + d) + *(const f32x4*)(red + (2 * 4 + t) * 512 + d) + *(const f32x4*)(red + (3 * 4 + t) * 512 + d);
            store_bf4(ctx + (size_t)(TP + sb * 4 + t) * LDB + hd * 512 + d, s);
        }
    }
    __syncthreads();
}

template <int WIN>
DEV void pool_d_prompt(const bf16_t* __restrict__ proj, bf16_t* __restrict__ dpl, int row, int c8) {
    const int tloc = row & 2047;
    uint4 u[WIN];
#pragma unroll
    for (int k = 0; k < WIN; ++k) u[k] = (tloc - k >= 0) ? *(const uint4*)(proj + (size_t)(row - k) * NPJ + C_U + c8) : make_uint4(0u, 0u, 0u, 0u);
    float acc[8] = {0.f, 0.f, 0.f, 0.f, 0.f, 0.f, 0.f, 0.f};
#pragma unroll
    for (int k = 0; k < WIN; ++k) { acc[0] += bflo(u[k].x); acc[1] += bfhi(u[k].x); acc[2] += bflo(u[k].y); acc[3] += bfhi(u[k].y); acc[4] += bflo(u[k].z); acc[5] += bfhi(u[k].z); acc[6] += bflo(u[k].w); acc[7] += bfhi(u[k].w); }
    const float ic = 1.f / (float)min(WIN, tloc + 1);
    uint4 o;
    o.x = cvt_pk_bf16(acc[0] * ic - bflo(u[0].x), acc[1] * ic - bfhi(u[0].x)); o.y = cvt_pk_bf16(acc[2] * ic - bflo(u[0].y), acc[3] * ic - bfhi(u[0].y));
    o.z = cvt_pk_bf16(acc[4] * ic - bflo(u[0].z), acc[5] * ic - bfhi(u[0].z)); o.w = cvt_pk_bf16(acc[6] * ic - bflo(u[0].w), acc[7] * ic - bfhi(u[0].w));
    *(uint4*)(dpl + (size_t)row * LDP + c8) = o;
}

#ifndef REP0
#define REP0 1
#endif
#ifndef REP1
#define REP1 1
#endif
#ifndef REP2
#define REP2 1
#endif
#ifndef REP3
#define REP3 1
#endif
#ifndef REP4
#define REP4 1
#endif
#ifndef REP5
#define REP5 1
#endif
#ifndef REP6
#define REP6 1
#endif
#ifndef REP7
#define REP7 1
#endif
#ifndef REP8
#define REP8 1
#endif
#ifndef REP9
#define REP9 1
#endif
#ifndef REP10
#define REP10 1
#endif
#ifndef REP11
#define REP11 1
#endif
#ifndef REP12
#define REP12 1
#endif
#ifndef NLAUNCH
#define NLAUNCH 1
#endif
#define GRID_BAR() do { if (NLAUNCH == 1) xcd_barrier(bar); } while (0)
#define IN_PH(k) (p.ph_lo <= (k) && (k) < p.ph_hi)
__global__ void __launch_bounds__(512) hymba_fwd(Params p) {
    __shared__ __attribute__((aligned(16))) unsigned char lds[131072];
    __shared__ uint4 xb_words;
    int tid = threadIdx.x; asm volatile("" : "+v"(tid)); const int lane = tid & 63, wid = tid >> 6;
    const int vb = __builtin_amdgcn_readfirstlane(tid >> 8);
    unsigned char* vlds = lds + vb * 65536;
    const int G = gridDim.x, bid = blockIdx.x, VG = 2 * G, vbid = 2 * bid + vb;
    if (tid == 0) xb_words = make_uint4(0u, 0u, 0u, 0u);
    __syncthreads();
    XcdBarrier bar; bar.bar = (unsigned*)(p.ws + WS_BAR); bar.x = 0; bar.st = (volatile LAS unsigned*)&xb_words;
    if (NLAUNCH == 1) bar = xcd_barrier_post((unsigned*)(p.ws + WS_BAR), (volatile LAS unsigned*)&xb_words);
    unsigned char* ws = p.ws;
    bf16_t* Wt_in = (bf16_t*)(ws + WS_WIN); bf16_t* Wt_out = (bf16_t*)(ws + WS_WOUT); bf16_t* Wt_cq = (bf16_t*)(ws + WS_WCQ); bf16_t* Wt_co = (bf16_t*)(ws + WS_WCO);
    bf16_t* Wt_ckv = (bf16_t*)(ws + WS_WCKV); bf16_t* Wt_pool = (bf16_t*)(ws + WS_WPOOL);
    bf16_t* hbuf = (bf16_t*)(ws + WS_H); bf16_t* hm = (bf16_t*)(ws + WS_HM); bf16_t* proj = (bf16_t*)(ws + WS_PROJ); float* ab = (float*)(ws + WS_AB);
    bf16_t* mkb = (bf16_t*)(ws + WS_MKB); bf16_t* mvt = (bf16_t*)(ws + WS_MVT); bf16_t* dpl = (bf16_t*)(ws + WS_DPL); bf16_t* mix = (bf16_t*)(ws + WS_MIX);
    bf16_t* x1 = (bf16_t*)(ws + WS_X1); bf16_t* qx = (bf16_t*)(ws + WS_QX); float* sc = (float*)(ws + WS_SC); bf16_t* pb = (bf16_t*)(ws + WS_PB);
    bf16_t* ctx = (bf16_t*)(ws + WS_CTX); bf16_t* x2 = (bf16_t*)(ws + WS_X2); float* obuf = (float*)(ws + WS_O);
#define VLOOP(t, N) for (int t##0_ = 2 * bid, t = min(t##0_ + vb, (N) - 1); t##0_ < (N); t##0_ += VG, t = min(t##0_ + vb, (N) - 1))

    if (IN_PH(0)) {
        const int NT_IN = 98 * 16, NT_SQ = 32 * 16;
        const int total = NT_IN + 5 * NT_SQ + 32;
        VLOOP(t, total) {
            if (t < NT_IN) { const int nt = t >> 4, kt = t & 15; transpose_tile(p.in[9], 6160, nt * 64, true, kt * 128, Wt_in + (size_t)nt * 64 * LDB, LDB, (float*)vlds); }
            else if (t < NT_IN + 5 * NT_SQ) {
                const int u = t - NT_IN, j = u >> 9, v = u & 511, nt = v >> 4, kt = v & 15;
                const float* src = p.in[j == 0 ? 16 : (j == 1 ? 19 : (j == 2 ? 22 : (j == 3 ? 20 : 21)))];
                bf16_t* dst = j == 0 ? Wt_out : (j == 1 ? Wt_cq : (j == 2 ? Wt_co : (j == 3 ? Wt_ckv : Wt_ckv + (size_t)D * LDB)));
                transpose_tile(src, D, nt * 64, false, kt * 128, dst + (size_t)nt * 64 * LDB, LDB, (float*)vlds);
            } else {
                const int u = t - NT_IN - 5 * NT_SQ, g = u >> 3, v = u & 7, nt = v >> 1, kt = v & 1;
                transpose_tile(p.in[14] + (size_t)g * 65536, 256, nt * 64, false, kt * 128, Wt_pool + ((size_t)g * 256 + nt * 64) * LDM, LDM, (float*)vlds);
            }
        }
        for (int r = bid * 8 + wid; r < TT + 1024; r += G * 8) {
            if (r < TP) rmsnorm_row_bf16(p.in[0] + (size_t)r * D, p.in[8], hbuf + (size_t)r * LDB, lane);
            else if (r < TT) rmsnorm_row_bf16(p.in[1] + (size_t)(r - TP) * D, p.in[8], hbuf + (size_t)r * LDB, lane);
            else rmsnorm_row_bf16(p.in[2] + (size_t)(r - TT) * D, p.in[17], hm + (size_t)(r - TT) * LDB, lane);
        }
    }
    GRID_BAR();
    if (IN_PH(1)) {
        for (int t = bid; t < 32 * 24; t += G) { int nt, mt; tile_map(t, 32, 24, mt, nt);
            EpiProj e{mt * 256, nt * 256, proj, ab, p.out};
            gemm256_tile(hbuf + (size_t)mt * 256 * LDB, LDB, Wt_in + (size_t)nt * 256 * LDB, LDB, D, lds, e);
        }
        VLOOP(t, 4 * 48 + 256) {
            if (t < 192) { const int mt = t & 3, nt = t >> 2;
                EpiProj e{TP + mt * 128, nt * 128, proj, ab, p.out};
                gemm_tile<64>(hbuf + (size_t)(TP + mt * 128) * LDB, LDB, Wt_in + (size_t)nt * 128 * LDB, LDB, D, vlds, e);
            } else { const int u = t - 192, mt = u & 7, nt = u >> 3;
                EpiMKV e{mt * 128, nt * 128, mkb, mvt, p.out};
                gemm_tile<64>(hm + (size_t)mt * 128 * LDB, LDB, Wt_ckv + (size_t)nt * 128 * LDB, LDB, D, vlds, e);
            }
        }
        for (int rt = bid * 8 + wid; rt < TT / 16; rt += G * 8) ab_rows16(hbuf, Wt_in + (size_t)NPJ * LDB, ab, rt, lane);
    }
    GRID_BAR();
    if (IN_PH(2)) {
        VLOOP(t, 1024) gdn_prep_chunk(p, t, vlds);
        for (int i = bid * 512 + tid; i < TP * 128; i += G * 512) {
            const int row = i >> 7, c8 = (i & 127) * 8, g = c8 >> 8;
            if (g == 0) pool_d_prompt<2>(proj, dpl, row, c8); else if (g == 1) pool_d_prompt<4>(proj, dpl, row, c8);
            else if (g == 2) pool_d_prompt<8>(proj, dpl, row, c8); else pool_d_prompt<16>(proj, dpl, row, c8);
        }
        for (int i = TP * 128 + bid * 512 + tid; i < TT * 128; i += G * 512) {
            const int row = i >> 7, c8 = (i & 127) * 8, g = c8 >> 8, win = 2 << g;
            float acc[8] = {0.f, 0.f, 0.f, 0.f, 0.f, 0.f, 0.f, 0.f}, self[8];
            const int tloc = (row - TP) & 3;
            for (int k = 0; k < win; ++k) {
                const int tt = tloc - k;
                if (tt >= 0) {
                    const uint4 u = *(const uint4*)(proj + (size_t)(row - k) * NPJ + C_U + c8);
                    const float f[8] = {bflo(u.x), bfhi(u.x), bflo(u.y), bfhi(u.y), bflo(u.z), bfhi(u.z), bflo(u.w), bfhi(u.w)};
#pragma unroll
                    for (int e = 0; e < 8; ++e) { acc[e] += f[e]; if (k == 0) self[e] = f[e]; }
                } else {
                    const float* sp = p.in[7] + ((size_t)((row - TP) >> 2) * 15 + (15 + tt)) * 1024 + c8;
                    const f32x4 s0 = *(const f32x4*)sp, s1 = *(const f32x4*)(sp + 4);
                    acc[0] += s0[0]; acc[1] += s0[1]; acc[2] += s0[2]; acc[3] += s0[3]; acc[4] += s1[0]; acc[5] += s1[1]; acc[6] += s1[2]; acc[7] += s1[3];
                }
            }
            const float ic = 1.f / (float)win;
            uint4 o; o.x = cvt_pk_bf16(acc[0] * ic - self[0], acc[1] * ic - self[1]); o.y = cvt_pk_bf16(acc[2] * ic - self[2], acc[3] * ic - self[3]);
            o.z = cvt_pk_bf16(acc[4] * ic - self[4], acc[5] * ic - self[5]); o.w = cvt_pk_bf16(acc[6] * ic - self[6], acc[7] * ic - self[7]);
            *(uint4*)(dpl + (size_t)row * LDP + c8) = o;
        }
        for (int i = bid * 512 + tid; i < SB * 11 * 256; i += G * 512) {
            const int c4 = (i & 255) * 4, rr = (i >> 8) % 11, sb = (i >> 8) / 11;
            *(f32x4*)(p.out + O_PS + ((size_t)sb * 15 + rr) * 1024 + c4) = *(const f32x4*)(p.in[7] + ((size_t)sb * 15 + rr + 4) * 1024 + c4);
        }
    }
    GRID_BAR();
    if (IN_PH(3)) {
        const int NSC = 256, NSM = 1024, NPL = 68 * 8;
        const int nsb = G >> 1;
        if (bid < nsb) {
            if (G == 256) {
                const int x = bid & 7, j = bid >> 3;
                gdn_scan_item(p, ((x * 4 + (j >> 2)) << 3) | ((j & 3) << 1) | vb, vlds);
            } else
            for (int t0 = 2 * bid; t0 < NSC; t0 += 2 * nsb) gdn_scan_item(p, min(t0 + vb, NSC - 1), vlds);
        } else {
            const int ob = bid - nsb, no = G - nsb;
            for (int t0 = 2 * ob; t0 < NSM; t0 += 2 * no) gdn_sample_item(p, min(t0 + vb, NSM - 1), vlds);
            for (int t0 = 2 * ob; t0 < NPL; t0 += 2 * no) { const int t = min(t0 + vb, NPL - 1); int nt, mt; tile_map(t, 68, 8, mt, nt); const int g = nt >> 1;
                EpiPool e{mt * 128, nt * 128, proj, p.in[15], mix};
                gemm_tile<64>(dpl + (size_t)mt * 128 * LDP + g * 256, LDP, Wt_pool + (size_t)nt * 128 * LDM, LDM, 256, vlds, e);
            }
        }
    }
    GRID_BAR();
    if (IN_PH(4)) {
        for (int i = bid * 512 + tid; i < TP * 8 * 16; i += G * 512) {
            const int l16 = i & 15, rh = i >> 4, h = rh & 7, row = rh >> 3;
            const float* op = obuf + (size_t)row * 1024 + h * 128 + l16 * 8;
            const f32x4 a = *(const f32x4*)op, b4 = *(const f32x4*)(op + 4);
            float ss = a[0] * a[0] + a[1] * a[1] + a[2] * a[2] + a[3] * a[3] + b4[0] * b4[0] + b4[1] * b4[1] + b4[2] * b4[2] + b4[3] * b4[3];
            ss += __shfl_xor(ss, 1); ss += __shfl_xor(ss, 2); ss += __shfl_xor(ss, 4); ss += __shfl_xor(ss, 8);
            const float rs = rsqrtf(ss * (1.f / 128.f) + EPS);
            const f32x4 g0 = *(const f32x4*)(p.in[13] + l16 * 8), g1 = *(const f32x4*)(p.in[13] + l16 * 8 + 4);
            const uint4 z = *(const uint4*)(proj + (size_t)row * NPJ + C_ZA + h * 128 + l16 * 8);
            uint4 o;
            o.x = cvt_pk_bf16(a[0] * rs * g0[0] * silu_f(bflo(z.x)), a[1] * rs * g0[1] * silu_f(bfhi(z.x)));
            o.y = cvt_pk_bf16(a[2] * rs * g0[2] * silu_f(bflo(z.y)), a[3] * rs * g0[3] * silu_f(bfhi(z.y)));
            o.z = cvt_pk_bf16(b4[0] * rs * g1[0] * silu_f(bflo(z.z)), b4[1] * rs * g1[1] * silu_f(bfhi(z.z)));
            o.w = cvt_pk_bf16(b4[2] * rs * g1[2] * silu_f(bflo(z.w)), b4[3] * rs * g1[3] * silu_f(bfhi(z.w)));
            *(uint4*)(mix + (size_t)row * LDB + h * 128 + l16 * 8) = o;
        }
    }
    GRID_BAR();
    if (IN_PH(5)) {
        for (int t = bid; t < 32 * 8; t += G) { int nt, mt; tile_map(t, 32, 8, mt, nt);
            EpiResid e{p.in[0] + (size_t)mt * 256 * D + nt * 256, x1 + (size_t)mt * 256 * LDB + nt * 256};
            gemm256_tile(mix + (size_t)mt * 256 * LDB, LDB, Wt_out + (size_t)nt * 256 * LDB, LDB, D, lds, e);
        }
        VLOOP(t, 8 * 32) { const int mt = t & 7, nt = t >> 3;
            EpiResid e{p.in[1] + (size_t)mt * 64 * D + nt * 64, x1 + (size_t)(TP + mt * 64) * LDB + nt * 64};
            gemm_tile<32>(mix + (size_t)(TP + mt * 64) * LDB, LDB, Wt_out + (size_t)nt * 64 * LDB, LDB, D, vlds, e);
        }
    }
    GRID_BAR();
    if (IN_PH(6))
    for (int r = bid * 8 + wid; r < TT; r += G * 8) rmsnorm_row_from_bf16<false>(x1 + (size_t)r * LDB, p.in[18], hbuf + (size_t)r * LDB, lane);
    GRID_BAR();
    if (IN_PH(7)) {
        VLOOP(t, 8 * 32) { const int mt = t & 7, nt = t >> 3;
            EpiBf e{qx + (size_t)(TP + mt * 64) * LDB + nt * 64, LDB};
            gemm_tile<32>(hbuf + (size_t)(TP + mt * 64) * LDB, LDB, Wt_cq + (size_t)nt * 64 * LDB, LDB, D, vlds, e);
        }
    }
    GRID_BAR();
    if (IN_PH(7)) {
        const int ng = G >> 1;
        if (bid < ng) {
            for (int t = bid; t < 32 * 8; t += ng) { int nt, mt; tile_map(t, 32, 8, mt, nt);
                EpiBf e{qx + (size_t)mt * 256 * LDB + nt * 256, LDB};
                gemm256_tile(hbuf + (size_t)mt * 256 * LDB, LDB, Wt_cq + (size_t)nt * 256 * LDB, LDB, D, lds, e);
            }
        } else {
            const int ob = bid - ng, no = G - ng;
            for (int t0 = 2 * ob; t0 < 512; t0 += 2 * no) attn_sample_item(p, min(t0 + vb, 511), vlds);
        }
    }
    GRID_BAR();
    if (IN_PH(8)) {
        const int NS1 = 16 * 16 * 2;
        VLOOP(t, NS1) { const int bhd = t >> 5, v = t & 31, mt = v >> 1, nt = v & 1, b = bhd >> 2, hd = bhd & 3;
            EpiF32s e{sc + (size_t)(b * SEQ + mt * 128) * 1024 + hd * 256 + nt * 128, 1024, 0.04419417382415922f};
            gemm_tile<64>(qx + (size_t)(b * SEQ + mt * 128) * LDB + hd * 512, LDB, mkb + (size_t)(b * 256 + nt * 128) * LDB + hd * 512, LDB, 512, vlds, e);
        }
    }
    GRID_BAR();
    if (IN_PH(9))
    for (int r = bid * 8 + wid; r < TP * 4; r += G * 8) {
        const f32x4 v = *(const f32x4*)(sc + (size_t)r * 256 + lane * 4);
        const float mx = wave_max(fmaxf(fmaxf(v[0], v[1]), fmaxf(v[2], v[3])));
        f32x4 e; e[0] = __expf(v[0] - mx); e[1] = __expf(v[1] - mx); e[2] = __expf(v[2] - mx); e[3] = __expf(v[3] - mx);
        const float inv = 1.f / wave_sum(e[0] + e[1] + e[2] + e[3]);
        store_bf4(pb + (size_t)(r >> 2) * LDP + (r & 3) * 256 + lane * 4, e * inv);
    }
    GRID_BAR();
    if (IN_PH(10)) {
        VLOOP(t, 16 * 16 * 4) { const int bhd = t >> 6, v = t & 63, mt = v >> 2, nt = v & 3, b = bhd >> 2, hd = bhd & 3;
            EpiBf e{ctx + (size_t)(b * SEQ + mt * 128) * LDB + hd * 512 + nt * 128, LDB};
            gemm_tile<64>(pb + (size_t)(b * SEQ + mt * 128) * LDP + hd * 256, LDP, mvt + ((size_t)b * D + hd * 512 + nt * 128) * LDM, LDM, 256, vlds, e);
        }
    }
    GRID_BAR();
    if (IN_PH(11)) {
        for (int t = bid; t < 32 * 8; t += G) { int nt, mt; tile_map(t, 32, 8, mt, nt);
            EpiResidB e{x1 + (size_t)mt * 256 * LDB + nt * 256, x2 + (size_t)mt * 256 * LDB + nt * 256};
            gemm256_tile(ctx + (size_t)mt * 256 * LDB, LDB, Wt_co + (size_t)nt * 256 * LDB, LDB, D, lds, e);
        }
        VLOOP(t, 8 * 32) { const int mt = t & 7, nt = t >> 3;
            EpiResidB e{x1 + (size_t)(TP + mt * 64) * LDB + nt * 64, x2 + (size_t)(TP + mt * 64) * LDB + nt * 64};
            gemm_tile<32>(ctx + (size_t)(TP + mt * 64) * LDB, LDB, Wt_co + (size_t)nt * 64 * LDB, LDB, D, vlds, e);
        }
    }
    GRID_BAR();
    if (IN_PH(12))
    for (int r = bid * 8 + wid; r < TT; r += G * 8) rmsnorm_row_from_bf16<true>(x2 + (size_t)r * LDB, p.in[23], p.out + (r < TP ? O_YP + (size_t)r * D : O_YS + (size_t)(r - TP) * D), lane);
}

extern "C" void kernel_launch(void* const* d_in, const int* in_sizes, int n_in, void* d_out, int out_size, void* d_ws, size_t ws_size, hipStream_t stream) {
    static int grid = 0;
    if (grid == 0) {
        if (n_in != 24 || ws_size < WS_END) { fprintf(stderr, "kernel_launch: need 24 inputs and %zu bytes of workspace (got %d, %zu)\n", (size_t)WS_END, n_in, ws_size); grid = -1; return; }
        int dev = 0, cus = 0, per_cu = 0;
        hipGetDevice(&dev);
        hipDeviceGetAttribute(&cus, hipDeviceAttributeMultiprocessorCount, dev);
        if (hipOccupancyMaxActiveBlocksPerMultiprocessor(&per_cu, (const void*)hymba_fwd, 512, 0) != hipSuccess || per_cu < 1) { fprintf(stderr, "kernel_launch: occupancy query failed\n"); grid = -1; return; }
        if (per_cu > 1) per_cu = 1;
        grid = cus * per_cu;
        fprintf(stderr, "kernel_launch: grid %d (%d per CU)\n", grid, per_cu);
    }
    if (grid < 0) return;
    hipMemsetAsync((char*)d_ws + WS_BAR, 0, 16384, stream);
    Params p{};
    for (int i = 0; i < 24; ++i) p.in[i] = (const float*)d_in[i];
    p.out = (float*)d_out; p.ws = (unsigned char*)d_ws;
    if (NLAUNCH == 1) {
        p.ph_lo = 0; p.ph_hi = 13;
        void* args[] = {&p};
        hipError_t e = hipLaunchCooperativeKernel((const void*)hymba_fwd, dim3(grid), dim3(512), args, 0, stream);
        if (e != hipSuccess) fprintf(stderr, "kernel_launch: cooperative launch failed: %s (grid %d)\n", hipGetErrorString(e), grid);
    } else {
        for (int k = 0; k < 13; ++k) { p.ph_lo = k; p.ph_hi = k + 1; hipLaunchKernelGGL(hymba_fwd, dim3(grid), dim3(512), 0, stream, p); }
    }
}
```

```cpp
#include <hip/hip_runtime.h>
#include <hip/hip_cooperative_groups.h>
#include <cstdio>
#include <cstdint>

typedef unsigned short bf16_t;
typedef short bf16x8 __attribute__((ext_vector_type(8)));
typedef float f32x4 __attribute__((ext_vector_type(4)));
#define DEV __device__ __forceinline__
#define LAS __attribute__((address_space(3)))

constexpr int D = 2048, TP = 8192, TS = 512, TT = 8704, SEQ = 2048, NB = 4, SB = 128;
constexpr int NPJ = 6144;
constexpr int C_ZA = 3072, C_U = 4096, C_ZB = 5120;
constexpr int NWIN = 6272;
constexpr float EPS = 1e-6f;
constexpr int LDB = 2112, LDP = 1088, LDM = 288;

constexpr size_t O_YP = 0, O_YS = 16777216, O_MK = 17825792, O_MV = 19922944, O_DP = 22020096, O_CP = 22544384,
                 O_PP = 22581248, O_DS = 22642688, O_CS = 39419904, O_PS = 40599552;

constexpr size_t al256(size_t x) { return (x + 255) & ~(size_t)255; }
constexpr size_t WS_BAR = 0;
constexpr size_t WS_WIN = 16384;
constexpr size_t WS_WOUT = WS_WIN + (size_t)NWIN * LDB * 2;
constexpr size_t WS_WCQ = WS_WOUT + (size_t)D * LDB * 2;
constexpr size_t WS_WCO = WS_WCQ + (size_t)D * LDB * 2;
constexpr size_t WS_WCKV = WS_WCO + (size_t)D * LDB * 2;
constexpr size_t WS_WPOOL = WS_WCKV + (size_t)2 * D * LDB * 2;
constexpr size_t WS_H = WS_WPOOL + (size_t)1024 * LDM * 2;
constexpr size_t WS_HM = WS_H + (size_t)TT * LDB * 2;
constexpr size_t WS_PROJ = WS_HM + (size_t)1024 * LDB * 2;
constexpr size_t WS_AB = WS_PROJ + (size_t)TT * NPJ * 2;
constexpr size_t WS_MKB = WS_AB + (size_t)TT * 16 * 4;
constexpr size_t WS_MVT = WS_MKB + (size_t)1024 * LDB * 2;
constexpr size_t WS_GW = WS_MVT + (size_t)4 * D * LDM * 2;
constexpr size_t WS_GQ = WS_GW + (size_t)1024 * 8192 * 2;
constexpr size_t WS_GKT = WS_GQ + (size_t)1024 * 8192 * 2;
constexpr size_t WS_GA = WS_GKT + (size_t)1024 * 8192 * 2;
constexpr size_t WS_GU = WS_GA + (size_t)1024 * 4096 * 2;
constexpr size_t WS_GE = WS_GU + (size_t)1024 * 8192 * 4;
constexpr size_t WS_O = WS_GE + 4096;
constexpr size_t WS_DPL = WS_O + (size_t)TP * 1024 * 4;
constexpr size_t WS_MIX = WS_DPL + (size_t)TT * LDP * 2;
constexpr size_t WS_X1 = WS_MIX + (size_t)TT * LDB * 2;
constexpr size_t WS_QX = WS_X1 + (size_t)TT * D * 4;
constexpr size_t WS_SC = WS_QX + (size_t)TT * LDB * 2;
constexpr size_t WS_PB = WS_SC + (size_t)TP * 1024 * 4;
constexpr size_t WS_CTX = WS_PB + (size_t)TP * LDP * 2;
constexpr size_t WS_X2 = WS_CTX + (size_t)TT * LDB * 2;
constexpr size_t WS_END = WS_X2 + (size_t)TT * D * 4;

#ifndef LASTP
#define LASTP 99
#endif
struct Params { const float* in[24]; float* out; unsigned char* ws; int ph_lo, ph_hi; };

typedef __bf16 bf16x2_t __attribute__((ext_vector_type(2)));
typedef float f32x2_t __attribute__((ext_vector_type(2)));
DEV unsigned cvt_pk_bf16(float lo, float hi) { const f32x2_t v = {lo, hi}; const bf16x2_t b = __builtin_convertvector(v, bf16x2_t); return __builtin_bit_cast(unsigned, b); }
DEV bf16_t f2bf(float f) { return (bf16_t)(cvt_pk_bf16(f, 0.f) & 0xffffu); }
DEV float bf2f(unsigned b) { return __uint_as_float(b << 16); }
DEV float bflo(unsigned u) { return __uint_as_float(u << 16); }
DEV float bfhi(unsigned u) { return __uint_as_float(u & 0xffff0000u); }
DEV float silu_f(float x) { return x / (1.f + __expf(-x)); }
DEV float wave_sum(float v) {
#pragma unroll
    for (int o = 32; o >= 1; o >>= 1) v += __shfl_xor(v, o);
    return v;
}
DEV float wave_max(float v) {
#pragma unroll
    for (int o = 32; o >= 1; o >>= 1) v = fmaxf(v, __shfl_xor(v, o));
    return v;
}
DEV void store_bf4(bf16_t* p, f32x4 v) { uint2 w; w.x = cvt_pk_bf16(v[0], v[1]); w.y = cvt_pk_bf16(v[2], v[3]); *(uint2*)p = w; }

#define XB_TMO      128
#define XB_XCNT(j)  (256  + 64 * (j))
#define XB_XSUB(j)  (1280 + 64 * (j))
#define XB_XGEN(j)  (2304 + 64 * (j))
#define XB_TOP      3328
#define XB_TOPGEN   3392
#define XCD_BAR_WORDS 3456
#define XB_SPIN_CAP (1u << 22)
DEV unsigned xb_ld(unsigned* p) { return __hip_atomic_load(p, __ATOMIC_RELAXED, __HIP_MEMORY_SCOPE_AGENT); }
DEV unsigned xb_add(unsigned* p, unsigned v) { return __hip_atomic_fetch_add(p, v, __ATOMIC_RELAXED, __HIP_MEMORY_SCOPE_AGENT); }
DEV unsigned xb_xcc_id() { return (unsigned)__builtin_amdgcn_s_getreg((3 << 11) | 20) & 0xFu; }
#define XB_SPIN(cond, bar) do { unsigned _sp = 0; while (cond) { __builtin_amdgcn_s_sleep(1); \
    if ((++_sp & 255u) == 0u) { if (xb_ld(&(bar)[XB_TMO])) break; if (_sp > XB_SPIN_CAP) { atomicAdd(&(bar)[XB_TMO], 1u); break; } } } } while (0)
struct XcdBarrier { unsigned* bar; unsigned x; volatile LAS unsigned* st; };
DEV XcdBarrier xcd_barrier_post(unsigned* bar, volatile LAS unsigned* st) {
    XcdBarrier b; b.bar = bar; b.x = xb_xcc_id(); b.st = st;
    if (threadIdx.x == 0) (void)xb_add(&bar[XB_XCNT(b.x)], 1u);
    return b;
}
DEV void xcd_barrier_complete(unsigned* bar, unsigned x, unsigned& nloc, unsigned& nx) {
    const unsigned G = gridDim.x;
    unsigned sum, cnt, mine, sp = 0u;
    for (;;) {
        sum = 0u; cnt = 0u; mine = 0u;
#pragma unroll
        for (unsigned j = 0; j < 16; ++j) { const unsigned c = xb_ld(&bar[XB_XCNT(j)]); sum += c; cnt += (c > 0u) ? 1u : 0u; mine = (j == x) ? c : mine; }
        if (sum == G) break;
        __builtin_amdgcn_s_sleep(1);
        if ((++sp & 255u) == 0u) { if (xb_ld(&bar[XB_TMO])) break; if (sp > XB_SPIN_CAP) { atomicAdd(&bar[XB_TMO], 1u); break; } }
    }
    nloc = mine > 0u ? mine : 1u; nx = cnt > 0u ? cnt : 1u;
}
DEV void xcd_barrier(const XcdBarrier& b) {
    asm volatile("s_waitcnt vmcnt(0)" ::: "memory");
    __syncthreads();
    if (threadIdx.x == 0) {
        unsigned* bar = b.bar;
        __builtin_amdgcn_s_waitcnt(0);
        unsigned nloc = b.st[0], nx = b.st[1];
        if (nloc == 0u) { xcd_barrier_complete(bar, b.x, nloc, nx); b.st[0] = nloc; b.st[1] = nx; }
        const unsigned old = xb_add(&bar[XB_XSUB(b.x)], 1u);
        const unsigned gen = old / nloc;
        if (old + 1u == (gen + 1u) * nloc) {
            __builtin_amdgcn_fence(__ATOMIC_RELEASE, "agent");
            asm volatile("s_waitcnt vmcnt(0)" ::: "memory");
            const unsigned og = xb_add(&bar[XB_TOP], 1u);
            const unsigned tg = og / nx;
            if (og + 1u == (tg + 1u) * nx) xb_add(&bar[XB_TOPGEN], 1u);
            else XB_SPIN(xb_ld(&bar[XB_TOPGEN]) == tg, bar);
            __builtin_amdgcn_fence(__ATOMIC_ACQUIRE, "agent");
            xb_add(&bar[XB_XGEN(b.x)], 1u);
            asm volatile("s_waitcnt vmcnt(0)" ::: "memory");
        } else {
            XB_SPIN(xb_ld(&bar[XB_XGEN(b.x)]) == gen, bar);
            __builtin_amdgcn_fence(__ATOMIC_ACQUIRE, "agent");
            asm volatile("s_waitcnt vmcnt(0)" ::: "memory");
        }
    }
    __syncthreads();
}

DEV void glds16(const void* gptr, unsigned lds_addr_lane) {
    const unsigned m = __builtin_amdgcn_readfirstlane(lds_addr_lane);
    unsigned keep;
    asm volatile("s_mov_b32 %0, m0\n\ts_mov_b32 m0, %2\n\ts_nop 0\n\tglobal_load_lds_dwordx4 %1, off\n\ts_mov_b32 m0, %0" : "=&s"(keep) : "v"(gptr), "s"(m) : "memory");
}

template <int WT, class Epi>
DEV void gemm_tile(const bf16_t* __restrict__ A, int lda, const bf16_t* __restrict__ Bt, int ldb, int K, unsigned char* lds, const Epi& epi) {
    constexpr int FI = WT / 16;
    constexpr int OPB = 2 * WT * 128;
    constexpr int STB = 2 * OPB;
    int tid = threadIdx.x & 255; asm volatile("" : "+v"(tid)); const int lane = tid & 63, wid = tid >> 6;
    const int wr = wid >> 1, wc = wid & 1, fr = lane & 15, fq = lane >> 4;
    f32x4 acc[FI][FI];
#pragma unroll
    for (int i = 0; i < FI; ++i)
#pragma unroll
        for (int j = 0; j < FI; ++j) acc[i][j] = (f32x4){0.f, 0.f, 0.f, 0.f};
    const int lrow = tid >> 3, lcs = (tid & 7) ^ (lrow & 7);
    const bf16_t* ap = A + (size_t)lrow * lda + lcs * 8;
    const bf16_t* bp = Bt + (size_t)lrow * ldb + lcs * 8;
    const unsigned l3a = (unsigned)(size_t)(LAS unsigned char*)lds;
    const int nk = K >> 6;
#define GLDS_STAGE(st, kt_) do { \
        _Pragma("unroll") for (int i_ = 0; i_ < FI; ++i_) { \
            glds16(ap + (size_t)(32 * i_) * lda + (kt_) * 64, l3a + (st) + tid * 16 + i_ * 4096); \
            glds16(bp + (size_t)(32 * i_) * ldb + (kt_) * 64, l3a + (st) + OPB + tid * 16 + i_ * 4096); } } while (0)
    constexpr int NSTG = 65536 / STB;
#pragma unroll
    for (int s_ = 0; s_ < NSTG - 1; ++s_) if (s_ < nk) GLDS_STAGE(s_ * STB, s_);
    const int aoff = (wr * WT + fr) * 128, boff = OPB + (wc * WT + fr) * 128, sw = fr & 7;
    int cur = 0, nxt = (NSTG - 1) * STB;
    for (int kt = 0; kt < nk; ++kt) {
        if (NSTG == 4 && kt + 2 < nk) { if (FI == 2) asm volatile("s_waitcnt vmcnt(8)" ::: "memory"); else asm volatile("s_waitcnt vmcnt(0)" ::: "memory"); }
        else asm volatile("s_waitcnt vmcnt(0)" ::: "memory");
        __syncthreads();
        if (kt + NSTG - 1 < nk) GLDS_STAGE(nxt, kt + NSTG - 1);
#pragma unroll
        for (int kh = 0; kh < 2; ++kh) {
            bf16x8 af[FI], bfr[FI];
            const int ch = ((kh * 4 + fq) ^ sw) << 4;
#pragma unroll
            for (int i = 0; i < FI; ++i) { af[i] = *(const bf16x8*)(lds + cur + aoff + i * 2048 + ch); bfr[i] = *(const bf16x8*)(lds + cur + boff + i * 2048 + ch); }
#pragma unroll
            for (int mi = 0; mi < FI; ++mi)
#pragma unroll
                for (int ni = 0; ni < FI; ++ni) acc[mi][ni] = __builtin_amdgcn_mfma_f32_16x16x32_bf16(bfr[ni], af[mi], acc[mi][ni], 0, 0, 0);
        }
        nxt = cur; cur += STB; if (cur == NSTG * STB) cur = 0;
    }
#undef GLDS_STAGE
    __syncthreads();
#pragma unroll
    for (int mi = 0; mi < FI; ++mi)
#pragma unroll
        for (int ni = 0; ni < FI; ++ni) epi(wr * WT + mi * 16 + fr, wc * WT + ni * 16 + fq * 4, acc[mi][ni]);
}

template <class Epi>
DEV void gemm256_tile(const bf16_t* __restrict__ A, int lda, const bf16_t* __restrict__ Bt, int ldb, int K, unsigned char* lds, const Epi& epi) {
    int tid = threadIdx.x; asm volatile("" : "+v"(tid)); const int lane = tid & 63, wid = tid >> 6;
    const int wr = wid >> 2, wc = wid & 3, fr = lane & 15, fq = lane >> 4;
    f32x4 acc[8][4];
#pragma unroll
    for (int i = 0; i < 8; ++i)
#pragma unroll
        for (int j = 0; j < 4; ++j) acc[i][j] = (f32x4){0.f, 0.f, 0.f, 0.f};
    const int lrow = tid >> 3, lcs = (tid & 7) ^ (lrow & 7);
    const bf16_t* ap = A + (size_t)lrow * lda + lcs * 8;
    const bf16_t* bp = Bt + (size_t)lrow * ldb + lcs * 8;
    const unsigned l3a = (unsigned)(size_t)(LAS unsigned char*)lds;
    const int nk = K >> 6;
#define GLDS_STAGE(st, kt_) do { \
        _Pragma("unroll") for (int i_ = 0; i_ < 4; ++i_) { \
            glds16(ap + (size_t)(64 * i_) * lda + (kt_) * 64, l3a + (st) + tid * 16 + i_ * 8192); \
            glds16(bp + (size_t)(64 * i_) * ldb + (kt_) * 64, l3a + (st) + 32768 + tid * 16 + i_ * 8192); } } while (0)
    GLDS_STAGE(0, 0);
    const int aoff = (wr * 128 + fr) * 128, boff = 32768 + (wc * 64 + fr) * 128, sw = fr & 7;
    for (int kt = 0; kt < nk; ++kt) {
        const int cur = (kt & 1) * 65536;
        asm volatile("s_waitcnt vmcnt(0)" ::: "memory");
        __syncthreads();
        if (kt + 1 < nk) GLDS_STAGE(cur ^ 65536, kt + 1);
#pragma unroll
        for (int kh = 0; kh < 2; ++kh) {
            bf16x8 bfr[4];
            const int ch = ((kh * 4 + fq) ^ sw) << 4;
#pragma unroll
            for (int i = 0; i < 4; ++i) bfr[i] = *(const bf16x8*)(lds + cur + boff + i * 2048 + ch);
#pragma unroll
            for (int mh = 0; mh < 2; ++mh) {
                bf16x8 af[4];
#pragma unroll
                for (int i = 0; i < 4; ++i) af[i] = *(const bf16x8*)(lds + cur + aoff + (mh * 4 + i) * 2048 + ch);
#pragma unroll
                for (int mi = 0; mi < 4; ++mi)
#pragma unroll
                    for (int ni = 0; ni < 4; ++ni) acc[mh * 4 + mi][ni] = __builtin_amdgcn_mfma_f32_16x16x32_bf16(bfr[ni], af[mi], acc[mh * 4 + mi][ni], 0, 0, 0);
            }
        }
    }
#undef GLDS_STAGE
    __syncthreads();
#pragma unroll
    for (int mi = 0; mi < 8; ++mi)
#pragma unroll
        for (int ni = 0; ni < 4; ++ni) epi(wr * 128 + mi * 16 + fr, wc * 64 + ni * 16 + fq * 4, acc[mi][ni]);
}

DEV void ab_rows16(const bf16_t* __restrict__ h, const bf16_t* __restrict__ wab, float* __restrict__ ab, int rt, int lane) {
    const int fr = lane & 15, fq = lane >> 4;
    const bf16_t* ap = h + (size_t)(rt * 16 + fr) * LDB + fq * 8;
    const bf16_t* bp = wab + (size_t)fr * LDB + fq * 8;
    f32x4 acc = {0.f, 0.f, 0.f, 0.f};
#pragma unroll 8
    for (int s = 0; s < 64; ++s) {
        const bf16x8 a = *(const bf16x8*)(ap + s * 32), b = *(const bf16x8*)(bp + s * 32);
        acc = __builtin_amdgcn_mfma_f32_16x16x32_bf16(b, a, acc, 0, 0, 0);
    }
    *(f32x4*)(ab + (size_t)(rt * 16 + fr) * 16 + fq * 4) = acc;
}

DEV void tile_map(int L, int nM, int nN, int& pm, int& pn) {
    const int T = nM * nN, q = T >> 3, r = T & 7, xcd = L & 7, off = L >> 3;
    const int w = (xcd < r ? xcd * (q + 1) : r * (q + 1) + (xcd - r) * q) + off;
    const int nig = 8 * nN, gid = w / nig, fm = gid * 8, gsz = (nM - fm) < 8 ? (nM - fm) : 8;
    pm = fm + (w % nig) % gsz; pn = (w % nig) / gsz;
}

struct EpiProj {
    int m0, n0; bf16_t* proj; float* ab; float* out;
    DEV void operator()(int r, int c, f32x4 v) const {
        const int row = m0 + r, col = n0 + c;
        if (col < NPJ) {
            store_bf4(proj + (size_t)row * NPJ + col, v);
            const bool isconv = col < 3072, ispool = (col >= C_U && col < C_ZB);
            if (isconv || ispool) {
                if (row < TP) {
                    const int b = row >> 11, t = row & 2047;
                    if (isconv) { if (t >= 2045) *(f32x4*)(out + O_CP + ((size_t)(b * 3 + (t - 2045))) * 3072 + col) = v; }
                    else { if (t >= 2033) *(f32x4*)(out + O_PP + ((size_t)(b * 15 + (t - 2033))) * 1024 + (col - C_U)) = v; }
                } else {
                    const int sb = (row - TP) >> 2, t = (row - TP) & 3;
                    if (isconv) { if (t >= 1) *(f32x4*)(out + O_CS + ((size_t)(sb * 3 + (t - 1))) * 3072 + col) = v; }
                    else *(f32x4*)(out + O_PS + ((size_t)(sb * 15 + 11 + t)) * 1024 + (col - C_U)) = v;
                }
            }
        } else if (col < NPJ + 16) {
            *(f32x4*)(ab + (size_t)row * 16 + (col - NPJ)) = v;
        }
    }
};
struct EpiMKV {
    int m0, n0; bf16_t* mkb; bf16_t* mvt; float* out;
    DEV void operator()(int r, int c, f32x4 v) const {
        const int row = m0 + r, col = n0 + c;
        if (col < D) {
            *(f32x4*)(out + O_MK + (size_t)row * D + col) = v;
            store_bf4(mkb + (size_t)row * LDB + col, v);
        } else {
            const int cc = col - D, b = row >> 8, m = row & 255;
            *(f32x4*)(out + O_MV + (size_t)row * D + cc) = v;
            bf16_t* p = mvt + ((size_t)b * D + cc) * LDM + m;
            p[0] = f2bf(v[0]); p[LDM] = f2bf(v[1]); p[2 * LDM] = f2bf(v[2]); p[3 * LDM] = f2bf(v[3]);
        }
    }
};
struct EpiPool {
    int m0, n0; const bf16_t* proj; const float* scale; bf16_t* mix;
    DEV void operator()(int r, int c, f32x4 v) const {
        const int row = m0 + r, col = n0 + c;
        const uint2 z = *(const uint2*)(proj + (size_t)row * NPJ + C_ZB + col);
        const f32x4 s = *(const f32x4*)(scale + col);
        f32x4 o;
        o[0] = v[0] * s[0] * silu_f(bflo(z.x)); o[1] = v[1] * s[1] * silu_f(bfhi(z.x));
        o[2] = v[2] * s[2] * silu_f(bflo(z.y)); o[3] = v[3] * s[3] * silu_f(bfhi(z.y));
        store_bf4(mix + (size_t)row * LDB + 1024 + col, o);
    }
};
struct EpiResid {
    const float* res; bf16_t* dst;
    DEV void operator()(int r, int c, f32x4 v) const {
        const f32x4 x = __builtin_nontemporal_load((const f32x4*)(res + (size_t)r * D + c));
        store_bf4(dst + (size_t)r * LDB + c, x + v);
    }
};
struct EpiResidB {
    const bf16_t* res; bf16_t* dst;
    DEV void operator()(int r, int c, f32x4 v) const {
        const uint2 u = *(const uint2*)(res + (size_t)r * LDB + c);
        f32x4 x; x[0] = bflo(u.x); x[1] = bfhi(u.x); x[2] = bflo(u.y); x[3] = bfhi(u.y);
        store_bf4(dst + (size_t)r * LDB + c, x + v);
    }
};
struct EpiBf {
    bf16_t* dst; int ld;
    DEV void operator()(int r, int c, f32x4 v) const { store_bf4(dst + (size_t)r * ld + c, v); }
};
struct EpiF32s {
    float* dst; int ld; float s;
    DEV void operator()(int r, int c, f32x4 v) const { *(f32x4*)(dst + (size_t)r * ld + c) = v * s; }
};

DEV int win_srccol(int n) { return n < 4096 ? n : (n < 6144 ? n + 16 : (n < 6160 ? 4096 + (n - 6144) : -1)); }
DEV void transpose_tile(const float* __restrict__ src, int ld, int srccol0, bool remap, int k0, bf16_t* __restrict__ dstrow0, int ldd, float* tile) {
    int tid = threadIdx.x & 255; asm volatile("" : "+v"(tid));
    const int tx = tid & 63, ty = tid >> 6;
    const int sc = remap ? win_srccol(srccol0 + tx) : (srccol0 + tx);
    float tv[32];
#pragma unroll
    for (int i = 0; i < 32; ++i) tv[i] = sc >= 0 ? __builtin_nontemporal_load(src + (size_t)(k0 + ty + 4 * i) * ld + sc) : 0.f;
#pragma unroll
    for (int i = 0; i < 32; ++i) tile[(ty + 4 * i) * 65 + tx] = tv[i];
    __syncthreads();
#pragma unroll
    for (int i = 0; i < 16; ++i) { const int r = ty + 4 * i; *(unsigned*)(dstrow0 + (size_t)r * ldd + k0 + 2 * tx) = cvt_pk_bf16(tile[(2 * tx) * 65 + r], tile[(2 * tx + 1) * 65 + r]); }
    __syncthreads();
}
DEV void rmsnorm_row_bf16(const float* __restrict__ x, const float* __restrict__ g, bf16_t* __restrict__ y, int lane) {
    f32x4 v[8]; float ss = 0.f;
#pragma unroll
    for (int i = 0; i < 8; ++i) { v[i] = ((const f32x4*)x)[i * 64 + lane]; ss += v[i][0] * v[i][0] + v[i][1] * v[i][1] + v[i][2] * v[i][2] + v[i][3] * v[i][3]; }
    ss = wave_sum(ss);
    const float rs = rsqrtf(ss * (1.f / 2048.f) + EPS);
#pragma unroll
    for (int i = 0; i < 8; ++i) { const f32x4 gg = ((const f32x4*)g)[i * 64 + lane]; store_bf4(y + (size_t)(i * 64 + lane) * 4, v[i] * rs * gg); }
}
template <bool OUT_F32>
DEV void rmsnorm_row_from_bf16(const bf16_t* __restrict__ x, const float* __restrict__ g, void* __restrict__ y, int lane) {
    float v[4][8]; float ss = 0.f;
#pragma unroll
    for (int i = 0; i < 4; ++i) { const uint4 u = ((const uint4*)x)[i * 64 + lane];
        v[i][0] = bflo(u.x); v[i][1] = bfhi(u.x); v[i][2] = bflo(u.y); v[i][3] = bfhi(u.y); v[i][4] = bflo(u.z); v[i][5] = bfhi(u.z); v[i][6] = bflo(u.w); v[i][7] = bfhi(u.w);
#pragma unroll
        for (int e = 0; e < 8; ++e) ss += v[i][e] * v[i][e]; }
    ss = wave_sum(ss);
    const float rs = rsqrtf(ss * (1.f / 2048.f) + EPS);
#pragma unroll
    for (int i = 0; i < 4; ++i) {
        const f32x4 g0 = ((const f32x4*)g)[(i * 64 + lane) * 2], g1 = ((const f32x4*)g)[(i * 64 + lane) * 2 + 1];
        const f32x4 o0 = (f32x4){v[i][0], v[i][1], v[i][2], v[i][3]} * rs * g0, o1 = (f32x4){v[i][4], v[i][5], v[i][6], v[i][7]} * rs * g1;
        if (OUT_F32) { __builtin_nontemporal_store(o0, (f32x4*)y + (i * 64 + lane) * 2); __builtin_nontemporal_store(o1, (f32x4*)y + (i * 64 + lane) * 2 + 1); }
        else { uint4 w; w.x = cvt_pk_bf16(o0[0], o0[1]); w.y = cvt_pk_bf16(o0[2], o0[3]); w.z = cvt_pk_bf16(o1[0], o1[1]); w.w = cvt_pk_bf16(o1[2], o1[3]); ((uint4*)y)[i * 64 + lane] = w; }
    }
}
DEV void rmsnorm_row_f32(const float* __restrict__ x, const float* __restrict__ g, float* __restrict__ y, int lane) {
    f32x4 v[8]; float ss = 0.f;
#pragma unroll
    for (int i = 0; i < 8; ++i) { v[i] = ((const f32x4*)x)[i * 64 + lane]; ss += v[i][0] * v[i][0] + v[i][1] * v[i][1] + v[i][2] * v[i][2] + v[i][3] * v[i][3]; }
    ss = wave_sum(ss);
    const float rs = rsqrtf(ss * (1.f / 2048.f) + EPS);
#pragma unroll
    for (int i = 0; i < 8; ++i) { const f32x4 gg = ((const f32x4*)g)[i * 64 + lane]; __builtin_nontemporal_store(v[i] * rs * gg, (f32x4*)y + i * 64 + lane); }
}

constexpr int QS = 136;
DEV void gdn_prep_chunk(const Params& p, int item, unsigned char* lds) {
    int tid = threadIdx.x & 255; asm volatile("" : "+v"(tid)); const int lane = tid & 63, wid = tid >> 6;
    const int c = item & 31, h = (item >> 5) & 7, b = item >> 8;
    const int row0 = b * SEQ + c * 64;
    const bf16_t* proj = (const bf16_t*)(p.ws + WS_PROJ);
    const float* ab = (const float*)(p.ws + WS_AB);
    bf16_t* qs = (bf16_t*)lds; bf16_t* ks = qs + 64 * QS; bf16_t* vs = ks + 64 * QS;
    float* lowT = (float*)lds;
    float* gcs = (float*)(lds + 3 * 64 * QS * 2);
    float* bts = gcs + 64;
    bf16_t* gW = (bf16_t*)(p.ws + WS_GW) + (size_t)item * 8192;
    bf16_t* gQ = (bf16_t*)(p.ws + WS_GQ) + (size_t)item * 8192;
    bf16_t* gKT = (bf16_t*)(p.ws + WS_GKT) + (size_t)item * 8192;
    bf16_t* gA = (bf16_t*)(p.ws + WS_GA) + (size_t)item * 4096;
    float* gU = (float*)(p.ws + WS_GU) + (size_t)item * 8192;
    float* gE = (float*)(p.ws + WS_GE) + item;

    if (wid == 3) {
        const float a = ab[(size_t)(row0 + lane) * 16 + h], bb = ab[(size_t)(row0 + lane) * 16 + 8 + h];
        const float xx = a + p.in[12][h];
        const float sp = xx > 20.f ? xx : log1pf(__expf(xx));
        float s = -__expf(p.in[11][h]) * sp;
#pragma unroll
        for (int d = 1; d < 64; d <<= 1) { const float t = __shfl_up(s, d); if (lane >= d) s += t; }
        gcs[lane] = s; bts[lane] = 1.f / (1.f + __expf(-bb));
    } else {
        const int mat = wid, rg = lane >> 4, cv = lane & 15;
        const int colg = mat * 1024 + h * 128 + cv * 8;
        const float* cw = p.in[10];
        float w[4][8];
#pragma unroll
        for (int j = 0; j < 4; ++j) { const f32x4 w0 = *(const f32x4*)(cw + j * 3072 + colg), w1 = *(const f32x4*)(cw + j * 3072 + colg + 4);
            w[j][0] = w0[0]; w[j][1] = w0[1]; w[j][2] = w0[2]; w[j][3] = w0[3]; w[j][4] = w1[0]; w[j][5] = w1[1]; w[j][6] = w1[2]; w[j][7] = w1[3]; }
        const int tl0 = rg * 16;
        uint4 raw[19];
#pragma unroll
        for (int i = 0; i < 19; ++i) {
            const int tl = tl0 - 3 + i;
            if (c * 64 + tl >= 0) raw[i] = *(const uint4*)(proj + (size_t)(row0 + tl) * NPJ + colg);
            else raw[i] = make_uint4(0u, 0u, 0u, 0u);
        }
        bf16_t* dst = (mat == 0 ? qs : (mat == 1 ? ks : vs));
#pragma unroll
        for (int r = 0; r < 16; ++r) {
            float y[8]; float ss = 0.f;
#pragma unroll
            for (int e = 0; e < 8; ++e) {
                float a = 0.f;
#pragma unroll
                for (int j = 0; j < 4; ++j) {
                    const uint4 u = raw[r + j];
                    const unsigned wd = (e < 2 ? u.x : (e < 4 ? u.y : (e < 6 ? u.z : u.w)));
                    const float xv = (e & 1) ? bfhi(wd) : bflo(wd);
                    a += w[j][e] * xv;
                }
                y[e] = silu_f(a); ss += y[e] * y[e];
            }
            if (mat < 2) {
                ss += __shfl_xor(ss, 1); ss += __shfl_xor(ss, 2); ss += __shfl_xor(ss, 4); ss += __shfl_xor(ss, 8);
                float inv = rsqrtf(ss + EPS); if (mat == 0) inv *= 0.08838834764831845f;
#pragma unroll
                for (int e = 0; e < 8; ++e) y[e] *= inv;
            }
            uint4 o; o.x = cvt_pk_bf16(y[0], y[1]); o.y = cvt_pk_bf16(y[2], y[3]); o.z = cvt_pk_bf16(y[4], y[5]); o.w = cvt_pk_bf16(y[6], y[7]);
            *(uint4*)(dst + (tl0 + r) * QS + cv * 8) = o;
        }
    }
    __syncthreads();
    {
        const float glast = gcs[63];
        if (tid == 0) *gE = __expf(glast);
#pragma unroll
        for (int i = 0; i < 4; ++i) {
            const int ci = tid + 256 * i, t = ci >> 4, cc = (ci & 15) * 8;
            const uint4 u = *(const uint4*)(qs + t * QS + cc);
            const float e = __expf(gcs[t]);
            uint4 o; o.x = cvt_pk_bf16(bflo(u.x) * e, bfhi(u.x) * e); o.y = cvt_pk_bf16(bflo(u.y) * e, bfhi(u.y) * e);
            o.z = cvt_pk_bf16(bflo(u.z) * e, bfhi(u.z) * e); o.w = cvt_pk_bf16(bflo(u.w) * e, bfhi(u.w) * e);
            *(uint4*)(gQ + (cc >> 5) * 2048 + t * 32 + (cc & 31)) = o;
        }
        const float dk = __expf(glast - gcs[lane]);
#pragma unroll 8
        for (int i = 0; i < 32; ++i) { const int d = wid * 32 + i; gKT[(lane >> 5) * 4096 + d * 32 + (lane & 31)] = f2bf(bf2f(ks[lane * QS + d]) * dk);     }
    }
    f32x4 kk[4], qk[4];
    {
        const int fr = lane & 15, fq = lane >> 4, it = wid;
        bf16x8 kfi[4], qfi[4];
#pragma unroll
        for (int s = 0; s < 4; ++s) { kfi[s] = *(const bf16x8*)(ks + (it * 16 + fr) * QS + s * 32 + fq * 8); qfi[s] = *(const bf16x8*)(qs + (it * 16 + fr) * QS + s * 32 + fq * 8); }
#pragma unroll
        for (int jt = 0; jt < 4; ++jt) {
            kk[jt] = (f32x4){0.f, 0.f, 0.f, 0.f}; qk[jt] = (f32x4){0.f, 0.f, 0.f, 0.f};
#pragma unroll
            for (int s = 0; s < 4; ++s) {
                const bf16x8 kfj = *(const bf16x8*)(ks + (jt * 16 + fr) * QS + s * 32 + fq * 8);
                kk[jt] = __builtin_amdgcn_mfma_f32_16x16x32_bf16(kfi[s], kfj, kk[jt], 0, 0, 0);
                qk[jt] = __builtin_amdgcn_mfma_f32_16x16x32_bf16(kfj, qfi[s], qk[jt], 0, 0, 0);
            }
        }
    }
    __syncthreads();
    {
        const int fr = lane & 15, fq = lane >> 4, it = wid;
#pragma unroll
        for (int jt = 0; jt < 4; ++jt) {
            const int j = jt * 16 + fr; const float gj = gcs[j];
            f32x4 lv;
#pragma unroll
            for (int e = 0; e < 4; ++e) { const int i = it * 16 + fq * 4 + e; lv[e] = (i > j) ? bts[i] * kk[jt][e] * __expf(gcs[i] - gj) : 0.f; }
            *(f32x4*)(lowT + j * 68 + it * 16 + fq * 4) = lv;
            const int i2 = it * 16 + fr; const float gi = gcs[i2];
            f32x4 av;
#pragma unroll
            for (int e = 0; e < 4; ++e) { const int j2 = jt * 16 + fq * 4 + e; av[e] = (i2 >= j2) ? qk[jt][e] * __expf(gi - gcs[j2]) : 0.f; }
            store_bf4(gA + (jt >> 1) * 2048 + i2 * 32 + (jt & 1) * 16 + fq * 4, av);
        }
    }
    __syncthreads();
    {
        const int cc = tid & 127; const bool isw = tid >= 128;
        bf16_t* src = isw ? ks : vs;
#pragma unroll 1
        for (int ib = 0; ib < 4; ++ib) {
            f32x2_t acc[8];
#pragma unroll
            for (int r = 0; r < 16; ++r) { const int j = ib * 16 + r; float f = bts[j]; if (isw) f *= __expf(gcs[j]); acc[r >> 1][r & 1] = f * bf2f(src[j * QS + cc]); }
            const float* lrow = lowT + ib * 16;
#pragma unroll 4
            for (int j = 0; j < ib * 16; ++j) {
                const float xj = -bf2f(src[j * QS + cc]); const f32x2_t nx = {xj, xj};
                const f32x4 l0 = *(const f32x4*)(lrow + j * 68), l1 = *(const f32x4*)(lrow + j * 68 + 4), l2 = *(const f32x4*)(lrow + j * 68 + 8), l3 = *(const f32x4*)(lrow + j * 68 + 12);
                acc[0] += (f32x2_t){l0[0], l0[1]} * nx; acc[1] += (f32x2_t){l0[2], l0[3]} * nx; acc[2] += (f32x2_t){l1[0], l1[1]} * nx; acc[3] += (f32x2_t){l1[2], l1[3]} * nx;
                acc[4] += (f32x2_t){l2[0], l2[1]} * nx; acc[5] += (f32x2_t){l2[2], l2[3]} * nx; acc[6] += (f32x2_t){l3[0], l3[1]} * nx; acc[7] += (f32x2_t){l3[2], l3[3]} * nx;
            }
#pragma unroll
            for (int r2 = 0; r2 < 15; ++r2) {
                asm volatile("" ::: "memory");
                const float xj = -acc[r2 >> 1][r2 & 1]; const f32x2_t nx = {xj, xj};
                const float* lp = lrow + (ib * 16 + r2) * 68;
#pragma unroll
                for (int q = (r2 + 1) >> 2; q < 4; ++q) {
                    const f32x4 l = *(const f32x4*)(lp + q * 4);
                    acc[2 * q] += (f32x2_t){l[0], l[1]} * nx; acc[2 * q + 1] += (f32x2_t){l[2], l[3]} * nx;
                }
            }
#pragma unroll
            for (int r = 0; r < 16; ++r) {
                const int j = ib * 16 + r; const float xv = acc[r >> 1][r & 1]; const bf16_t xb = f2bf(xv);
                src[j * QS + cc] = xb;
                if (isw) gW[(cc >> 5) * 2048 + j * 32 + (cc & 31)] = xb;
                else gU[(((((cc >> 4) * 4 + (j >> 4)) * 4 + (j & 3)) * 4 + ((j >> 2) & 3)) << 4) + (cc & 15)] = xv;
            }
        }
    }
    __syncthreads();
}

#define LDS_BARRIER() do { asm volatile("s_waitcnt lgkmcnt(0)" ::: "memory"); __builtin_amdgcn_s_barrier(); asm volatile("" ::: "memory"); } while (0)
struct ScanEarly { bf16x8 w[4], q[4]; f32x4 u; };
struct ScanLate { bf16x8 a[2], k0[2], k1[2]; };
DEV void gdn_scan_item(const Params& p, int item, unsigned char* lds) {
    int tid = threadIdx.x & 255; asm volatile("" : "+v"(tid)); const int lane = tid & 63, w = tid >> 6, fr = lane & 15, fq = lane >> 4;
    const int s = item & 7, bh = item >> 3;
    const int b = bh >> 3, h = bh & 7;
    bf16_t* ST = (bf16_t*)lds;
    bf16_t* VT = ST + 16 * QS;
    const char* bW = (const char*)((const bf16_t*)(p.ws + WS_GW) + (size_t)bh * 32 * 8192);
    const char* bQ = (const char*)((const bf16_t*)(p.ws + WS_GQ) + (size_t)bh * 32 * 8192);
    const char* bK = (const char*)((const bf16_t*)(p.ws + WS_GKT) + (size_t)bh * 32 * 8192);
    const char* bA = (const char*)((const bf16_t*)(p.ws + WS_GA) + (size_t)bh * 32 * 4096);
    const char* bU = (const char*)((const float*)(p.ws + WS_GU) + (size_t)bh * 32 * 8192);
    const float* gE = (const float*)(p.ws + WS_GE) + bh * 32;
    float* obuf = (float*)(p.ws + WS_O);
    f32x4 S0 = {0.f, 0.f, 0.f, 0.f}, S1 = {0.f, 0.f, 0.f, 0.f};
    for (int i = tid; i < 16 * QS / 2; i += 256) ((unsigned*)ST)[i] = 0u;
    const float egv = gE[lane & 31];
    const unsigned offWQ = (unsigned)(((w * 16 + fr) * 32 + fq * 8) * 2), offA = offWQ;
    const unsigned offK = (unsigned)(((w * 32 + fr) * 32 + fq * 8) * 2), offU = (unsigned)((((s * 4 + w) * 16 + fq) * 16 + fr) * 4);
    ScanEarly E0, E1, E2; ScanLate L0, L1;
#define LOAD_E(F, ch) do { \
        const char* W_ = bW + (size_t)(ch) * 16384; const char* Q_ = bQ + (size_t)(ch) * 16384; \
        _Pragma("unroll") for (int k_ = 0; k_ < 4; ++k_) { F.w[k_] = *(const bf16x8*)(W_ + (offWQ + k_ * 4096)); F.q[k_] = *(const bf16x8*)(Q_ + (offWQ + k_ * 4096)); } \
        const char* U_ = bU + (size_t)(ch) * 32768; F.u[0] = *(const float*)(U_ + offU); F.u[1] = *(const float*)(U_ + (offU + 256)); F.u[2] = *(const float*)(U_ + (offU + 512)); F.u[3] = *(const float*)(U_ + (offU + 768)); \
        } while (0)
#define LOAD_L(F, ch) do { \
        const char* A_ = bA + (size_t)(ch) * 8192; F.a[0] = *(const bf16x8*)(A_ + offA); F.a[1] = *(const bf16x8*)(A_ + (offA + 4096)); \
        const char* K_ = bK + (size_t)(ch) * 16384; F.k0[0] = *(const bf16x8*)(K_ + offK); F.k0[1] = *(const bf16x8*)(K_ + (offK + 8192)); \
        F.k1[0] = *(const bf16x8*)(K_ + (offK + 1024)); F.k1[1] = *(const bf16x8*)(K_ + (offK + 1024 + 8192)); \
        } while (0)
#define SCAN_STEP(X, XL, Y, YL, ch) do { \
        if ((ch) + 2 < 32) LOAD_E(XL, (ch) + 2); \
        if ((ch) + 1 < 32) LOAD_L(YL, (ch) + 1); \
        const float ceg = __builtin_bit_cast(float, __builtin_amdgcn_readlane(__builtin_bit_cast(int, egv), (ch))); \
        f32x4 ws_ = {0.f, 0.f, 0.f, 0.f}, oo = {0.f, 0.f, 0.f, 0.f}; \
        _Pragma("unroll") for (int k = 0; k < 4; ++k) { \
            const bf16x8 sf = *(const bf16x8*)(ST + fr * QS + k * 32 + fq * 8); \
            ws_ = __builtin_amdgcn_mfma_f32_16x16x32_bf16(X.w[k], sf, ws_, 0, 0, 0); \
            oo = __builtin_amdgcn_mfma_f32_16x16x32_bf16(X.q[k], sf, oo, 0, 0, 0); } \
        store_bf4(VT + fr * 72 + w * 16 + fq * 4, X.u - ws_); \
        LDS_BARRIER(); \
        const bf16x8 v0 = *(const bf16x8*)(VT + fr * 72 + fq * 8), v1 = *(const bf16x8*)(VT + fr * 72 + 32 + fq * 8); \
        oo = __builtin_amdgcn_mfma_f32_16x16x32_bf16(Y.a[0], v0, oo, 0, 0, 0); \
        oo = __builtin_amdgcn_mfma_f32_16x16x32_bf16(Y.a[1], v1, oo, 0, 0, 0); \
        S0 = S0 * ceg; S1 = S1 * ceg; \
        S0 = __builtin_amdgcn_mfma_f32_16x16x32_bf16(Y.k0[0], v0, S0, 0, 0, 0); \
        S0 = __builtin_amdgcn_mfma_f32_16x16x32_bf16(Y.k0[1], v1, S0, 0, 0, 0); \
        S1 = __builtin_amdgcn_mfma_f32_16x16x32_bf16(Y.k1[0], v0, S1, 0, 0, 0); \
        S1 = __builtin_amdgcn_mfma_f32_16x16x32_bf16(Y.k1[1], v1, S1, 0, 0, 0); \
        store_bf4(ST + fr * QS + w * 32 + fq * 4, S0); \
        store_bf4(ST + fr * QS + w * 32 + 16 + fq * 4, S1); \
        { float* op = obuf + (size_t)(b * SEQ + (ch) * 64 + w * 16 + fq * 4) * 1024 + h * 128 + s * 16 + fr; \
          op[0] = oo[0]; op[1024] = oo[1]; op[2048] = oo[2]; op[3072] = oo[3]; } \
        LDS_BARRIER(); } while (0)
    LOAD_E(E0, 0); LOAD_L(L0, 0); LOAD_E(E1, 1);
    __syncthreads();
    for (int ch = 0; ch < 30; ch += 6) {
        SCAN_STEP(E0, E2, L0, L1, ch);     SCAN_STEP(E1, E0, L1, L0, ch + 1); SCAN_STEP(E2, E1, L0, L1, ch + 2);
        SCAN_STEP(E0, E2, L1, L0, ch + 3); SCAN_STEP(E1, E0, L0, L1, ch + 4); SCAN_STEP(E2, E1, L1, L0, ch + 5);
    }
    SCAN_STEP(E0, E2, L0, L1, 30); SCAN_STEP(E1, E0, L1, L0, 31);
#undef SCAN_STEP
#undef LOAD_E
#undef LOAD_L
    {
        float* dp = p.out + O_DP + ((size_t)bh * 128 + w * 32 + fq * 4) * 128 + s * 16 + fr;
#pragma unroll
        for (int e = 0; e < 4; ++e) { dp[e * 128] = S0[e]; dp[(16 + e) * 128] = S1[e]; }
    }
    __syncthreads();
}

DEV void gdn_sample_item(const Params& p, int item, unsigned char* lds) {
    int tid = threadIdx.x & 255; asm volatile("" : "+v"(tid)); const int lane = tid & 63, wid = tid >> 6;
    const int sb = item >> 3, h = item & 7, half = tid >> 7, c = tid & 127;
    const int r0 = TP + sb * 4;
    const bf16_t* proj = (const bf16_t*)(p.ws + WS_PROJ);
    const float* ab = (const float*)(p.ws + WS_AB);
    float* ksh = (float*)lds;
    float* qsh = ksh + 512;
    float* red = qsh + 512;
    float* red2 = red + 32;
    float* part = red2 + 32;
    float* opart = part + 1024;
    float qv[4], kv[4], vv[4];
#pragma unroll
    for (int m = 0; m < 3; ++m) {
        const int col = m * 1024 + h * 128 + c;
        float x[7], wj[4];
#pragma unroll
        for (int j = 0; j < 3; ++j) x[j] = p.in[6][((size_t)sb * 3 + j) * 3072 + col];
#pragma unroll
        for (int t = 0; t < 4; ++t) x[3 + t] = bf2f(proj[(size_t)(r0 + t) * NPJ + col]);
#pragma unroll
        for (int j = 0; j < 4; ++j) wj[j] = p.in[10][j * 3072 + col];
#pragma unroll
        for (int t = 0; t < 4; ++t) {
            const float y = silu_f(wj[0] * x[t] + wj[1] * x[t + 1] + wj[2] * x[t + 2] + wj[3] * x[t + 3]);
            if (m == 0) qv[t] = y; else if (m == 1) kv[t] = y; else vv[t] = y;
        }
    }
#pragma unroll
    for (int t = 0; t < 4; ++t) {
        const float a = wave_sum(qv[t] * qv[t]), bq = wave_sum(kv[t] * kv[t]);
        if (lane == 0) { red[wid * 8 + t] = a; red[wid * 8 + 4 + t] = bq; }
    }
    __syncthreads();
    float gt[4], bt[4];
#pragma unroll
    for (int t = 0; t < 4; ++t) {
        const float sq = red[(2 * half) * 8 + t] + red[(2 * half + 1) * 8 + t], sk = red[(2 * half) * 8 + 4 + t] + red[(2 * half + 1) * 8 + 4 + t];
        if (half == 0) {
            qsh[t * 128 + c] = qv[t] * rsqrtf(sq + EPS) * 0.08838834764831845f;
            ksh[t * 128 + c] = kv[t] * rsqrtf(sk + EPS);
        }
        const float a = ab[(size_t)(r0 + t) * 16 + h], bb = ab[(size_t)(r0 + t) * 16 + 8 + h];
        const float xx = a + p.in[12][h];
        const float sp = xx > 20.f ? xx : log1pf(__expf(xx));
        gt[t] = __expf(-__expf(p.in[11][h]) * sp);
        bt[t] = 1.f / (1.f + __expf(-bb));
    }
    float S[64];
    const float* sp0 = p.in[5] + ((size_t)(sb * 8 + h) * 128 + half * 64) * 128 + c;
#pragma unroll
    for (int d = 0; d < 64; ++d) S[d] = __builtin_nontemporal_load(sp0 + (size_t)d * 128);
    __syncthreads();
    float ot[4];
#pragma unroll
    for (int t = 0; t < 4; ++t) {
        const float* kk = ksh + t * 128 + half * 64; const float* qq = qsh + t * 128 + half * 64;
        float kS = 0.f;
#pragma unroll
        for (int d4 = 0; d4 < 16; ++d4) { const f32x4 k4 = *(const f32x4*)(kk + d4 * 4); kS += k4[0] * S[d4 * 4] + k4[1] * S[d4 * 4 + 1] + k4[2] * S[d4 * 4 + 2] + k4[3] * S[d4 * 4 + 3]; }
        part[(t * 2 + half) * 128 + c] = kS;
        __syncthreads();
        kS = part[(t * 2) * 128 + c] + part[(t * 2 + 1) * 128 + c];
        const float eg = gt[t], dl = bt[t] * (vv[t] - eg * kS);
        float o = 0.f;
#pragma unroll
        for (int d4 = 0; d4 < 16; ++d4) {
            const f32x4 k4 = *(const f32x4*)(kk + d4 * 4), q4 = *(const f32x4*)(qq + d4 * 4);
#pragma unroll
            for (int e = 0; e < 4; ++e) { const float sn = eg * S[d4 * 4 + e] + k4[e] * dl; S[d4 * 4 + e] = sn; o += q4[e] * sn; }
        }
        ot[t] = o;
        if (half == 1) opart[t * 128 + c] = o;
    }
    float* dso = p.out + O_DS + ((size_t)(sb * 8 + h) * 128 + half * 64) * 128 + c;
#pragma unroll
    for (int d = 0; d < 64; ++d) __builtin_nontemporal_store(S[d], dso + (size_t)d * 128);
    __syncthreads();
    if (half == 0) {
#pragma unroll
        for (int t = 0; t < 4; ++t) { ot[t] += opart[t * 128 + c]; const float a = wave_sum(ot[t] * ot[t]); if (lane == 0) red2[wid * 4 + t] = a; }
    }
    __syncthreads();
    if (half == 0) {
        bf16_t* mix = (bf16_t*)(p.ws + WS_MIX);
        const float gn = p.in[13][c];
#pragma unroll
        for (int t = 0; t < 4; ++t) {
            const float ms = (red2[t] + red2[4 + t]) * (1.f / 128.f);
            const float z = bf2f(proj[(size_t)(r0 + t) * NPJ + C_ZA + h * 128 + c]);
            mix[(size_t)(r0 + t) * LDB + h * 128 + c] = f2bf(ot[t] * rsqrtf(ms + EPS) * gn * silu_f(z));
        }
    }
    __syncthreads();
}

DEV void attn_sample_item(const Params& p, int item, unsigned char* lds) {
    int tid = threadIdx.x & 255; asm volatile("" : "+v"(tid)); const int lane = tid & 63, wid = tid >> 6;
    const int sb = item >> 2, hd = item & 3;
    float* qs = (float*)lds;
    float* pm = qs + 2048;
    float* red = pm + 1024;
    const bf16_t* qx = (const bf16_t*)(p.ws + WS_QX);
    for (int i = tid; i < 2048; i += 256) { const int t = i >> 9, d = i & 511; qs[i] = bf2f(qx[(size_t)(TP + sb * 4 + t) * LDB + hd * 512 + d]) * 0.04419417382415922f; }
    __syncthreads();
    const float* Kc = p.in[3] + ((size_t)sb * 256) * D + hd * 512;
    const float* Vc = p.in[4] + ((size_t)sb * 256) * D + hd * 512;
    {
        const int sub = lane >> 4, l16 = lane & 15;
        f32x4 kv[8];
        {
            const float* kr = Kc + (size_t)(wid * 64 + sub) * D;
#pragma unroll
            for (int i = 0; i < 8; ++i) kv[i] = __builtin_nontemporal_load((const f32x4*)(kr + (i * 16 + l16) * 4));
        }
        for (int it = 0; it < 16; ++it) {
            const int m = wid * 64 + it * 4 + sub;
            f32x4 cv[8];
#pragma unroll
            for (int i = 0; i < 8; ++i) cv[i] = kv[i];
            if (it + 1 < 16) {
                const float* kr = Kc + (size_t)(m + 4) * D;
#pragma unroll
                for (int i = 0; i < 8; ++i) kv[i] = __builtin_nontemporal_load((const f32x4*)(kr + (i * 16 + l16) * 4));
            }
            float a0 = 0.f, a1 = 0.f, a2 = 0.f, a3 = 0.f;
#pragma unroll
            for (int i = 0; i < 8; ++i) {
                const int d = (i * 16 + l16) * 4;
                const f32x4 q0 = *(const f32x4*)(qs + d), q1 = *(const f32x4*)(qs + 512 + d), q2 = *(const f32x4*)(qs + 1024 + d), q3 = *(const f32x4*)(qs + 1536 + d);
                a0 += cv[i][0] * q0[0] + cv[i][1] * q0[1] + cv[i][2] * q0[2] + cv[i][3] * q0[3];
                a1 += cv[i][0] * q1[0] + cv[i][1] * q1[1] + cv[i][2] * q1[2] + cv[i][3] * q1[3];
                a2 += cv[i][0] * q2[0] + cv[i][1] * q2[1] + cv[i][2] * q2[2] + cv[i][3] * q2[3];
                a3 += cv[i][0] * q3[0] + cv[i][1] * q3[1] + cv[i][2] * q3[2] + cv[i][3] * q3[3];
            }
#pragma unroll
            for (int o = 1; o < 16; o <<= 1) { a0 += __shfl_xor(a0, o); a1 += __shfl_xor(a1, o); a2 += __shfl_xor(a2, o); a3 += __shfl_xor(a3, o); }
            if (l16 == 0) *(f32x4*)(pm + m * 4) = (f32x4){a0, a1, a2, a3};
        }
    }
    __syncthreads();
    {
        const int t = wid;
        float v[4]; float mx = -3.0e38f;
#pragma unroll
        for (int i = 0; i < 4; ++i) { v[i] = pm[(i * 64 + lane) * 4 + t]; mx = fmaxf(mx, v[i]); }
        mx = wave_max(mx);
        float sm = 0.f;
#pragma unroll
        for (int i = 0; i < 4; ++i) { v[i] = __expf(v[i] - mx); sm += v[i]; }
        sm = wave_sum(sm);
        const float inv = 1.f / sm;
#pragma unroll
        for (int i = 0; i < 4; ++i) pm[(i * 64 + lane) * 4 + t] = v[i] * inv;
    }
    __syncthreads();
    {
        f32x4 acc[4][2];
#pragma unroll
        for (int t = 0; t < 4; ++t) { acc[t][0] = (f32x4){0.f, 0.f, 0.f, 0.f}; acc[t][1] = (f32x4){0.f, 0.f, 0.f, 0.f}; }
        f32x4 va[4], vb[4];
#pragma unroll
        for (int i = 0; i < 4; ++i) { const float* vr = Vc + (size_t)(wid * 64 + i) * D; va[i] = __builtin_nontemporal_load((const f32x4*)(vr + lane * 4)); vb[i] = __builtin_nontemporal_load((const f32x4*)(vr + 256 + lane * 4)); }
        for (int m4 = 0; m4 < 16; ++m4) {
            f32x4 ca[4], cb[4];
#pragma unroll
            for (int i = 0; i < 4; ++i) { ca[i] = va[i]; cb[i] = vb[i]; }
            if (m4 + 1 < 16) {
#pragma unroll
                for (int i = 0; i < 4; ++i) { const float* vr = Vc + (size_t)(wid * 64 + (m4 + 1) * 4 + i) * D; va[i] = __builtin_nontemporal_load((const f32x4*)(vr + lane * 4)); vb[i] = __builtin_nontemporal_load((const f32x4*)(vr + 256 + lane * 4)); }
            }
#pragma unroll
            for (int i = 0; i < 4; ++i) {
                const f32x4 pr = *(const f32x4*)(pm + (wid * 64 + m4 * 4 + i) * 4);
#pragma unroll
                for (int t = 0; t < 4; ++t) { acc[t][0] += ca[i] * pr[t]; acc[t][1] += cb[i] * pr[t]; }
            }
        }
#pragma unroll
        for (int t = 0; t < 4; ++t) { *(f32x4*)(red + (wid * 4 + t) * 512 + lane * 4) = acc[t][0]; *(f32x4*)(red + (wid * 4 + t) * 512 + 256 + lane * 4) = acc[t][1]; }
    }
    __syncthreads();
    {
        bf16_t* ctx = (bf16_t*)(p.ws + WS_CTX);
#pragma unroll
        for (int i = 0; i < 2; ++i) {
            const int e = (tid + 256 * i) * 4, t = e >> 9, d = e & 511;
            const f32x4 s = *(const f32x4*)(red + (0 * 4 + t) * 512 + d) + *(const f32x4*)(red + (1 * 4 + t) * 512 + d) + *(const f32x4*)(red + (2 * 4 + t) * 512 + d) + *(const f32x4*)(red + (3 * 4 + t) * 512 + d);
            store_bf4(ctx + (size_t)(TP + sb * 4 + t) * LDB + hd * 512 + d, s);
        }
    }
    __syncthreads();
}

template <int WIN>
DEV void pool_d_prompt(const bf16_t* __restrict__ proj, bf16_t* __restrict__ dpl, int row, int c8) {
    const int tloc = row & 2047;
    uint4 u[WIN];
#pragma unroll
    for (int k = 0; k < WIN; ++k) u[k] = (tloc - k >= 0) ? *(const uint4*)(proj + (size_t)(row - k) * NPJ + C_U + c8) : make_uint4(0u, 0u, 0u, 0u);
    float acc[8] = {0.f, 0.f, 0.f, 0.f, 0.f, 0.f, 0.f, 0.f};
#pragma unroll
    for (int k = 0; k < WIN; ++k) { acc[0] += bflo(u[k].x); acc[1] += bfhi(u[k].x); acc[2] += bflo(u[k].y); acc[3] += bfhi(u[k].y); acc[4] += bflo(u[k].z); acc[5] += bfhi(u[k].z); acc[6] += bflo(u[k].w); acc[7] += bfhi(u[k].w); }
    const float ic = 1.f / (float)min(WIN, tloc + 1);
    uint4 o;
    o.x = cvt_pk_bf16(acc[0] * ic - bflo(u[0].x), acc[1] * ic - bfhi(u[0].x)); o.y = cvt_pk_bf16(acc[2] * ic - bflo(u[0].y), acc[3] * ic - bfhi(u[0].y));
    o.z = cvt_pk_bf16(acc[4] * ic - bflo(u[0].z), acc[5] * ic - bfhi(u[0].z)); o.w = cvt_pk_bf16(acc[6] * ic - bflo(u[0].w), acc[7] * ic - bfhi(u[0].w));
    *(uint4*)(dpl + (size_t)row * LDP + c8) = o;
}

#ifndef REP0
#define REP0 1
#endif
#ifndef REP1
#define REP1 1
#endif
#ifndef REP2
#define REP2 1
#endif
#ifndef REP3
#define REP3 1
#endif
#ifndef REP4
#define REP4 1
#endif
#ifndef REP5
#define REP5 1
#endif
#ifndef REP6
#define REP6 1
#endif
#ifndef REP7
#define REP7 1
#endif
#ifndef REP8
#define REP8 1
#endif
#ifndef REP9
#define REP9 1
#endif
#ifndef REP10
#define REP10 1
#endif
#ifndef REP11
#define REP11 1
#endif
#ifndef REP12
#define REP12 1
#endif
#ifndef NLAUNCH
#define NLAUNCH 1
#endif
#define GRID_BAR() do { if (NLAUNCH == 1) xcd_barrier(bar); } while (0)
#define IN_PH(k) (p.ph_lo <= (k) && (k) < p.ph_hi)
__global__ void __launch_bounds__(512) hymba_fwd(Params p) {
    __shared__ __attribute__((aligned(16))) unsigned char lds[131072];
    __shared__ uint4 xb_words;
    const int G = gridDim.x, bid = blockIdx.x, VG = 2 * G;
    if (threadIdx.x == 0) xb_words = make_uint4(0u, 0u, 0u, 0u);
#define PH_LOCALS int tid = threadIdx.x; asm volatile("" : "+v"(tid)); const int lane = tid & 63, wid = tid >> 6; const int vb = __builtin_amdgcn_readfirstlane(tid >> 8); \
    unsigned char* vlds = lds + vb * 65536; (void)lane; (void)wid; (void)vlds;
    __syncthreads();
    XcdBarrier bar; bar.bar = (unsigned*)(p.ws + WS_BAR); bar.x = 0; bar.st = (volatile LAS unsigned*)&xb_words;
    if (NLAUNCH == 1) bar = xcd_barrier_post((unsigned*)(p.ws + WS_BAR), (volatile LAS unsigned*)&xb_words);
    unsigned char* ws = p.ws;
    bf16_t* Wt_in = (bf16_t*)(ws + WS_WIN); bf16_t* Wt_out = (bf16_t*)(ws + WS_WOUT); bf16_t* Wt_cq = (bf16_t*)(ws + WS_WCQ); bf16_t* Wt_co = (bf16_t*)(ws + WS_WCO);
    bf16_t* Wt_ckv = (bf16_t*)(ws + WS_WCKV); bf16_t* Wt_pool = (bf16_t*)(ws + WS_WPOOL);
    bf16_t* hbuf = (bf16_t*)(ws + WS_H); bf16_t* hm = (bf16_t*)(ws + WS_HM); bf16_t* proj = (bf16_t*)(ws + WS_PROJ); float* ab = (float*)(ws + WS_AB);
    bf16_t* mkb = (bf16_t*)(ws + WS_MKB); bf16_t* mvt = (bf16_t*)(ws + WS_MVT); bf16_t* dpl = (bf16_t*)(ws + WS_DPL); bf16_t* mix = (bf16_t*)(ws + WS_MIX);
    bf16_t* x1 = (bf16_t*)(ws + WS_X1); bf16_t* qx = (bf16_t*)(ws + WS_QX); float* sc = (float*)(ws + WS_SC); bf16_t* pb = (bf16_t*)(ws + WS_PB);
    bf16_t* ctx = (bf16_t*)(ws + WS_CTX); bf16_t* x2 = (bf16_t*)(ws + WS_X2); float* obuf = (float*)(ws + WS_O);
#define VLOOP(t, N) for (int t##0_ = 2 * bid, t = min(t##0_ + vb, (N) - 1); t##0_ < (N); t##0_ += VG, t = min(t##0_ + vb, (N) - 1))

    if (IN_PH(0)) { PH_LOCALS
        const int NT_IN = 98 * 16, NT_SQ = 32 * 16;
        const int total = NT_IN + 5 * NT_SQ + 32;
        VLOOP(t, total) {
            if (t < NT_IN) { const int nt = t >> 4, kt = t & 15; transpose_tile(p.in[9], 6160, nt * 64, true, kt * 128, Wt_in + (size_t)nt * 64 * LDB, LDB, (float*)vlds); }
            else if (t < NT_IN + 5 * NT_SQ) {
                const int u = t - NT_IN, j = u >> 9, v = u & 511, nt = v >> 4, kt = v & 15;
                const float* src = p.in[j == 0 ? 16 : (j == 1 ? 19 : (j == 2 ? 22 : (j == 3 ? 20 : 21)))];
                bf16_t* dst = j == 0 ? Wt_out : (j == 1 ? Wt_cq : (j == 2 ? Wt_co : (j == 3 ? Wt_ckv : Wt_ckv + (size_t)D * LDB)));
                transpose_tile(src, D, nt * 64, false, kt * 128, dst + (size_t)nt * 64 * LDB, LDB, (float*)vlds);
            } else {
                const int u = t - NT_IN - 5 * NT_SQ, g = u >> 3, v = u & 7, nt = v >> 1, kt = v & 1;
                transpose_tile(p.in[14] + (size_t)g * 65536, 256, nt * 64, false, kt * 128, Wt_pool + ((size_t)g * 256 + nt * 64) * LDM, LDM, (float*)vlds);
            }
        }
        for (int r = bid * 8 + wid; r < TT + 1024; r += G * 8) {
            if (r < TP) rmsnorm_row_bf16(p.in[0] + (size_t)r * D, p.in[8], hbuf + (size_t)r * LDB, lane);
            else if (r < TT) rmsnorm_row_bf16(p.in[1] + (size_t)(r - TP) * D, p.in[8], hbuf + (size_t)r * LDB, lane);
            else rmsnorm_row_bf16(p.in[2] + (size_t)(r - TT) * D, p.in[17], hm + (size_t)(r - TT) * LDB, lane);
        }
    }
    GRID_BAR();
    if (IN_PH(1)) { PH_LOCALS
        for (int t = bid; t < 32 * 24; t += G) { int nt, mt; tile_map(t, 32, 24, mt, nt);
            EpiProj e{mt * 256, nt * 256, proj, ab, p.out};
            gemm256_tile(hbuf + (size_t)mt * 256 * LDB, LDB, Wt_in + (size_t)nt * 256 * LDB, LDB, D, lds, e);
        }
        VLOOP(t, 4 * 48 + 256) {
            if (t < 192) { const int mt = t & 3, nt = t >> 2;
                EpiProj e{TP + mt * 128, nt * 128, proj, ab, p.out};
                gemm_tile<64>(hbuf + (size_t)(TP + mt * 128) * LDB, LDB, Wt_in + (size_t)nt * 128 * LDB, LDB, D, vlds, e);
            } else { const int u = t - 192, mt = u & 7, nt = u >> 3;
                EpiMKV e{mt * 128, nt * 128, mkb, mvt, p.out};
                gemm_tile<64>(hm + (size_t)mt * 128 * LDB, LDB, Wt_ckv + (size_t)nt * 128 * LDB, LDB, D, vlds, e);
            }
        }
        for (int rt = bid * 8 + wid; rt < TT / 16; rt += G * 8) ab_rows16(hbuf, Wt_in + (size_t)NPJ * LDB, ab, rt, lane);
    }
    GRID_BAR();
    if (IN_PH(2)) { PH_LOCALS
        VLOOP(t, 1024) gdn_prep_chunk(p, t, vlds);
        for (int i = bid * 512 + tid; i < TP * 128; i += G * 512) {
            const int row = i >> 7, c8 = (i & 127) * 8, g = c8 >> 8;
            if (g == 0) pool_d_prompt<2>(proj, dpl, row, c8); else if (g == 1) pool_d_prompt<4>(proj, dpl, row, c8);
            else if (g == 2) pool_d_prompt<8>(proj, dpl, row, c8); else pool_d_prompt<16>(proj, dpl, row, c8);
        }
        for (int i = TP * 128 + bid * 512 + tid; i < TT * 128; i += G * 512) {
            const int row = i >> 7, c8 = (i & 127) * 8, g = c8 >> 8, win = 2 << g;
            float acc[8] = {0.f, 0.f, 0.f, 0.f, 0.f, 0.f, 0.f, 0.f}, self[8];
            const int tloc = (row - TP) & 3;
            for (int k = 0; k < win; ++k) {
                const int tt = tloc - k;
                if (tt >= 0) {
                    const uint4 u = *(const uint4*)(proj + (size_t)(row - k) * NPJ + C_U + c8);
                    const float f[8] = {bflo(u.x), bfhi(u.x), bflo(u.y), bfhi(u.y), bflo(u.z), bfhi(u.z), bflo(u.w), bfhi(u.w)};
#pragma unroll
                    for (int e = 0; e < 8; ++e) { acc[e] += f[e]; if (k == 0) self[e] = f[e]; }
                } else {
                    const float* sp = p.in[7] + ((size_t)((row - TP) >> 2) * 15 + (15 + tt)) * 1024 + c8;
                    const f32x4 s0 = *(const f32x4*)sp, s1 = *(const f32x4*)(sp + 4);
                    acc[0] += s0[0]; acc[1] += s0[1]; acc[2] += s0[2]; acc[3] += s0[3]; acc[4] += s1[0]; acc[5] += s1[1]; acc[6] += s1[2]; acc[7] += s1[3];
                }
            }
            const float ic = 1.f / (float)win;
            uint4 o; o.x = cvt_pk_bf16(acc[0] * ic - self[0], acc[1] * ic - self[1]); o.y = cvt_pk_bf16(acc[2] * ic - self[2], acc[3] * ic - self[3]);
            o.z = cvt_pk_bf16(acc[4] * ic - self[4], acc[5] * ic - self[5]); o.w = cvt_pk_bf16(acc[6] * ic - self[6], acc[7] * ic - self[7]);
            *(uint4*)(dpl + (size_t)row * LDP + c8) = o;
        }
        for (int i = bid * 512 + tid; i < SB * 11 * 256; i += G * 512) {
            const int c4 = (i & 255) * 4, rr = (i >> 8) % 11, sb = (i >> 8) / 11;
            *(f32x4*)(p.out + O_PS + ((size_t)sb * 15 + rr) * 1024 + c4) = *(const f32x4*)(p.in[7] + ((size_t)sb * 15 + rr + 4) * 1024 + c4);
        }
    }
    GRID_BAR();
    if (IN_PH(3)) { PH_LOCALS
        const int NSC = 256, NSM = 1024, NPL = 68 * 8;
        const int nsb = G >> 1;
        if (bid < nsb) {
            if (G == 256) {
                const int x = bid & 7, j = bid >> 3;
                gdn_scan_item(p, ((x * 4 + (j >> 2)) << 3) | ((j & 3) << 1) | vb, vlds);
            } else
            for (int t0 = 2 * bid; t0 < NSC; t0 += 2 * nsb) gdn_scan_item(p, min(t0 + vb, NSC - 1), vlds);
        } else {
            const int ob = bid - nsb, no = G - nsb;
            for (int t0 = 2 * ob; t0 < NSM; t0 += 2 * no) gdn_sample_item(p, min(t0 + vb, NSM - 1), vlds);
            for (int t0 = 2 * ob; t0 < NPL; t0 += 2 * no) { const int t = min(t0 + vb, NPL - 1); int nt, mt; tile_map(t, 68, 8, mt, nt); const int g = nt >> 1;
                EpiPool e{mt * 128, nt * 128, proj, p.in[15], mix};
                gemm_tile<64>(dpl + (size_t)mt * 128 * LDP + g * 256, LDP, Wt_pool + (size_t)nt * 128 * LDM, LDM, 256, vlds, e);
            }
        }
    }
    GRID_BAR();
    if (IN_PH(4)) { PH_LOCALS
        for (int i = bid * 512 + tid; i < TP * 8 * 16; i += G * 512) {
            const int l16 = i & 15, rh = i >> 4, h = rh & 7, row = rh >> 3;
            const float* op = obuf + (size_t)row * 1024 + h * 128 + l16 * 8;
            const f32x4 a = *(const f32x4*)op, b4 = *(const f32x4*)(op + 4);
            float ss = a[0] * a[0] + a[1] * a[1] + a[2] * a[2] + a[3] * a[3] + b4[0] * b4[0] + b4[1] * b4[1] + b4[2] * b4[2] + b4[3] * b4[3];
            ss += __shfl_xor(ss, 1); ss += __shfl_xor(ss, 2); ss += __shfl_xor(ss, 4); ss += __shfl_xor(ss, 8);
            const float rs = rsqrtf(ss * (1.f / 128.f) + EPS);
            const f32x4 g0 = *(const f32x4*)(p.in[13] + l16 * 8), g1 = *(const f32x4*)(p.in[13] + l16 * 8 + 4);
            const uint4 z = *(const uint4*)(proj + (size_t)row * NPJ + C_ZA + h * 128 + l16 * 8);
            uint4 o;
            o.x = cvt_pk_bf16(a[0] * rs * g0[0] * silu_f(bflo(z.x)), a[1] * rs * g0[1] * silu_f(bfhi(z.x)));
            o.y = cvt_pk_bf16(a[2] * rs * g0[2] * silu_f(bflo(z.y)), a[3] * rs * g0[3] * silu_f(bfhi(z.y)));
            o.z = cvt_pk_bf16(b4[0] * rs * g1[0] * silu_f(bflo(z.z)), b4[1] * rs * g1[1] * silu_f(bfhi(z.z)));
            o.w = cvt_pk_bf16(b4[2] * rs * g1[2] * silu_f(bflo(z.w)), b4[3] * rs * g1[3] * silu_f(bfhi(z.w)));
            *(uint4*)(mix + (size_t)row * LDB + h * 128 + l16 * 8) = o;
        }
    }
    GRID_BAR();
    if (IN_PH(5)) { PH_LOCALS
        for (int t = bid; t < 32 * 8; t += G) { int nt, mt; tile_map(t, 32, 8, mt, nt);
            EpiResid e{p.in[0] + (size_t)mt * 256 * D + nt * 256, x1 + (size_t)mt * 256 * LDB + nt * 256};
            gemm256_tile(mix + (size_t)mt * 256 * LDB, LDB, Wt_out + (size_t)nt * 256 * LDB, LDB, D, lds, e);
        }
        VLOOP(t, 8 * 32) { const int mt = t & 7, nt = t >> 3;
            EpiResid e{p.in[1] + (size_t)mt * 64 * D + nt * 64, x1 + (size_t)(TP + mt * 64) * LDB + nt * 64};
            gemm_tile<32>(mix + (size_t)(TP + mt * 64) * LDB, LDB, Wt_out + (size_t)nt * 64 * LDB, LDB, D, vlds, e);
        }
    }
    GRID_BAR();
    if (IN_PH(6)) { PH_LOCALS
    for (int r = bid * 8 + wid; r < TT; r += G * 8) rmsnorm_row_from_bf16<false>(x1 + (size_t)r * LDB, p.in[18], hbuf + (size_t)r * LDB, lane);
    }
    GRID_BAR();
    if (IN_PH(7)) { PH_LOCALS
        VLOOP(t, 8 * 32) { const int mt = t & 7, nt = t >> 3;
            EpiBf e{qx + (size_t)(TP + mt * 64) * LDB + nt * 64, LDB};
            gemm_tile<32>(hbuf + (size_t)(TP + mt * 64) * LDB, LDB, Wt_cq + (size_t)nt * 64 * LDB, LDB, D, vlds, e);
        }
    }
    GRID_BAR();
    if (IN_PH(7)) { PH_LOCALS
        const int ng = G >> 1;
        if (bid < ng) {
            for (int t = bid; t < 32 * 8; t += ng) { int nt, mt; tile_map(t, 32, 8, mt, nt);
                EpiBf e{qx + (size_t)mt * 256 * LDB + nt * 256, LDB};
                gemm256_tile(hbuf + (size_t)mt * 256 * LDB, LDB, Wt_cq + (size_t)nt * 256 * LDB, LDB, D, lds, e);
            }
        } else {
            const int ob = bid - ng, no = G - ng;
            for (int t0 = 2 * ob; t0 < 512; t0 += 2 * no) attn_sample_item(p, min(t0 + vb, 511), vlds);
        }
    }
    GRID_BAR();
    if (IN_PH(8)) { PH_LOCALS
        const int NS1 = 16 * 16 * 2;
        VLOOP(t, NS1) { const int bhd = t >> 5, v = t & 31, mt = v >> 1, nt = v & 1, b = bhd >> 2, hd = bhd & 3;
            EpiF32s e{sc + (size_t)(b * SEQ + mt * 128) * 1024 + hd * 256 + nt * 128, 1024, 0.04419417382415922f};
            gemm_tile<64>(qx + (size_t)(b * SEQ + mt * 128) * LDB + hd * 512, LDB, mkb + (size_t)(b * 256 + nt * 128) * LDB + hd * 512, LDB, 512, vlds, e);
        }
    }
    GRID_BAR();
    if (IN_PH(9)) { PH_LOCALS
    for (int r = bid * 8 + wid; r < TP * 4; r += G * 8) {
        const f32x4 v = *(const f32x4*)(sc + (size_t)r * 256 + lane * 4);
        const float mx = wave_max(fmaxf(fmaxf(v[0], v[1]), fmaxf(v[2], v[3])));
        f32x4 e; e[0] = __expf(v[0] - mx); e[1] = __expf(v[1] - mx); e[2] = __expf(v[2] - mx); e[3] = __expf(v[3] - mx);
        const float inv = 1.f / wave_sum(e[0] + e[1] + e[2] + e[3]);
        store_bf4(pb + (size_t)(r >> 2) * LDP + (r & 3) * 256 + lane * 4, e * inv);
    }
    }
    GRID_BAR();
    if (IN_PH(10)) { PH_LOCALS
        VLOOP(t, 16 * 16 * 4) { const int bhd = t >> 6, v = t & 63, mt = v >> 2, nt = v & 3, b = bhd >> 2, hd = bhd & 3;
            EpiBf e{ctx + (size_t)(b * SEQ + mt * 128) * LDB + hd * 512 + nt * 128, LDB};
            gemm_tile<64>(pb + (size_t)(b * SEQ + mt * 128) * LDP + hd * 256, LDP, mvt + ((size_t)b * D + hd * 512 + nt * 128) * LDM, LDM, 256, vlds, e);
        }
    }
    GRID_BAR();
    if (IN_PH(11)) { PH_LOCALS
        for (int t = bid; t < 32 * 8; t += G) { int nt, mt; tile_map(t, 32, 8, mt, nt);
            EpiResidB e{x1 + (size_t)mt * 256 * LDB + nt * 256, x2 + (size_t)mt * 256 * LDB + nt * 256};
            gemm256_tile(ctx + (size_t)mt * 256 * LDB, LDB, Wt_co + (size_t)nt * 256 * LDB, LDB, D, lds, e);
        }
        VLOOP(t, 8 * 32) { const int mt = t & 7, nt = t >> 3;
            EpiResidB e{x1 + (size_t)(TP + mt * 64) * LDB + nt * 64, x2 + (size_t)(TP + mt * 64) * LDB + nt * 64};
            gemm_tile<32>(ctx + (size_t)(TP + mt * 64) * LDB, LDB, Wt_co + (size_t)nt * 64 * LDB, LDB, D, vlds, e);
        }
    }
    GRID_BAR();
    if (IN_PH(12)) { PH_LOCALS
    for (int r = bid * 8 + wid; r < TT; r += G * 8) rmsnorm_row_from_bf16<true>(x2 + (size_t)r * LDB, p.in[23], p.out + (r < TP ? O_YP + (size_t)r * D : O_YS + (size_t)(r - TP) * D), lane);
    }
}

extern "C" void kernel_launch(void* const* d_in, const int* in_sizes, int n_in, void* d_out, int out_size, void* d_ws, size_t ws_size, hipStream_t stream) {
    static int grid = 0;
    if (grid == 0) {
        if (n_in != 24 || ws_size < WS_END) { fprintf(stderr, "kernel_launch: need 24 inputs and %zu bytes of workspace (got %d, %zu)\n", (size_t)WS_END, n_in, ws_size); grid = -1; return; }
        int dev = 0, cus = 0, per_cu = 0;
        hipGetDevice(&dev);
        hipDeviceGetAttribute(&cus, hipDeviceAttributeMultiprocessorCount, dev);
        if (hipOccupancyMaxActiveBlocksPerMultiprocessor(&per_cu, (const void*)hymba_fwd, 512, 0) != hipSuccess || per_cu < 1) { fprintf(stderr, "kernel_launch: occupancy query failed\n"); grid = -1; return; }
        if (per_cu > 1) per_cu = 1;
        grid = cus * per_cu;
        fprintf(stderr, "kernel_launch: grid %d (%d per CU)\n", grid, per_cu);
    }
    if (grid < 0) return;
    hipMemsetAsync((char*)d_ws + WS_BAR, 0, 16384, stream);
    Params p{};
    for (int i = 0; i < 24; ++i) p.in[i] = (const float*)d_in[i];
    p.out = (float*)d_out; p.ws = (unsigned char*)d_ws;
    if (NLAUNCH == 1) {
        p.ph_lo = 0; p.ph_hi = 13;
        void* args[] = {&p};
        hipError_t e = hipLaunchCooperativeKernel((const void*)hymba_fwd, dim3(grid), dim3(512), args, 0, stream);
        if (e != hipSuccess) fprintf(stderr, "kernel_launch: cooperative launch failed: %s (grid %d)\n", hipGetErrorString(e), grid);
    } else {
        for (int k = 0; k < 13; ++k) { p.ph_lo = k; p.ph_hi = k + 1; hipLaunchKernelGGL(hymba_fwd, dim3(grid), dim3(512), 0, stream, p); }
    }
}
```

```cpp
#include <hip/hip_runtime.h>
#include <hip/hip_cooperative_groups.h>
#include <cstdio>
#include <cstdint>

typedef unsigned short bf16_t;
typedef short bf16x8 __attribute__((ext_vector_type(8)));
typedef float f32x4 __attribute__((ext_vector_type(4)));
#define DEV __device__ __forceinline__
#define LAS __attribute__((address_space(3)))

constexpr int D = 2048, TP = 8192, TS = 512, TT = 8704, SEQ = 2048, NB = 4, SB = 128;
constexpr int NPJ = 6144;
constexpr int C_ZA = 3072, C_U = 4096, C_ZB = 5120;
constexpr int NWIN = 6272;
constexpr float EPS = 1e-6f;
constexpr int LDB = 2112, LDP = 1088, LDM = 288;

constexpr size_t O_YP = 0, O_YS = 16777216, O_MK = 17825792, O_MV = 19922944, O_DP = 22020096, O_CP = 22544384,
                 O_PP = 22581248, O_DS = 22642688, O_CS = 39419904, O_PS = 40599552;

constexpr size_t al256(size_t x) { return (x + 255) & ~(size_t)255; }
constexpr size_t WS_BAR = 0;
constexpr size_t WS_WIN = 16384;
constexpr size_t WS_WOUT = WS_WIN + (size_t)NWIN * LDB * 2;
constexpr size_t WS_WCQ = WS_WOUT + (size_t)D * LDB * 2;
constexpr size_t WS_WCO = WS_WCQ + (size_t)D * LDB * 2;
constexpr size_t WS_WCKV = WS_WCO + (size_t)D * LDB * 2;
constexpr size_t WS_WPOOL = WS_WCKV + (size_t)2 * D * LDB * 2;
constexpr size_t WS_H = WS_WPOOL + (size_t)1024 * LDM * 2;
constexpr size_t WS_HM = WS_H + (size_t)TT * LDB * 2;
constexpr size_t WS_PROJ = WS_HM + (size_t)1024 * LDB * 2;
constexpr size_t WS_AB = WS_PROJ + (size_t)TT * NPJ * 2;
constexpr size_t WS_MKB = WS_AB + (size_t)TT * 16 * 4;
constexpr size_t WS_MVT = WS_MKB + (size_t)1024 * LDB * 2;
constexpr size_t WS_GW = WS_MVT + (size_t)4 * D * LDM * 2;
constexpr size_t WS_GQ = WS_GW + (size_t)1024 * 8192 * 2;
constexpr size_t WS_GKT = WS_GQ + (size_t)1024 * 8192 * 2;
constexpr size_t WS_GA = WS_GKT + (size_t)1024 * 8192 * 2;
constexpr size_t WS_GU = WS_GA + (size_t)1024 * 4096 * 2;
constexpr size_t WS_GE = WS_GU + (size_t)1024 * 8192 * 4;
constexpr size_t WS_O = WS_GE + 4096;
constexpr size_t WS_DPL = WS_O + (size_t)TP * 1024 * 4;
constexpr size_t WS_MIX = WS_DPL + (size_t)TT * LDP * 2;
constexpr size_t WS_X1 = WS_MIX + (size_t)TT * LDB * 2;
constexpr size_t WS_QX = WS_X1 + (size_t)TT * D * 4;
constexpr size_t WS_SC = WS_QX + (size_t)TT * LDB * 2;
constexpr size_t WS_PB = WS_SC + (size_t)TP * 1024 * 4;
constexpr size_t WS_CTX = WS_PB + (size_t)TP * LDP * 2;
constexpr size_t WS_X2 = WS_CTX + (size_t)TT * LDB * 2;
constexpr size_t WS_END = WS_X2 + (size_t)TT * D * 4;

#ifndef LASTP
#define LASTP 99
#endif
struct Params { const float* in[24]; float* out; unsigned char* ws; int ph_lo, ph_hi; };

typedef __bf16 bf16x2_t __attribute__((ext_vector_type(2)));
typedef float f32x2_t __attribute__((ext_vector_type(2)));
DEV unsigned cvt_pk_bf16(float lo, float hi) { const f32x2_t v = {lo, hi}; const bf16x2_t b = __builtin_convertvector(v, bf16x2_t); return __builtin_bit_cast(unsigned, b); }
DEV bf16_t f2bf(float f) { return (bf16_t)(cvt_pk_bf16(f, 0.f) & 0xffffu); }
DEV float bf2f(unsigned b) { return __uint_as_float(b << 16); }
DEV float bflo(unsigned u) { return __uint_as_float(u << 16); }
DEV float bfhi(unsigned u) { return __uint_as_float(u & 0xffff0000u); }
DEV float silu_f(float x) { return x / (1.f + __expf(-x)); }
DEV float wave_sum(float v) {
#pragma unroll
    for (int o = 32; o >= 1; o >>= 1) v += __shfl_xor(v, o);
    return v;
}
DEV float wave_max(float v) {
#pragma unroll
    for (int o = 32; o >= 1; o >>= 1) v = fmaxf(v, __shfl_xor(v, o));
    return v;
}
DEV void store_bf4(bf16_t* p, f32x4 v) { uint2 w; w.x = cvt_pk_bf16(v[0], v[1]); w.y = cvt_pk_bf16(v[2], v[3]); *(uint2*)p = w; }

#define XB_TMO      128
#define XB_XCNT(j)  (256  + 64 * (j))
#define XB_XSUB(j)  (1280 + 64 * (j))
#define XB_XGEN(j)  (2304 + 64 * (j))
#define XB_TOP      3328
#define XB_TOPGEN   3392
#define XCD_BAR_WORDS 3456
#define XB_SPIN_CAP (1u << 22)
DEV unsigned xb_ld(unsigned* p) { return __hip_atomic_load(p, __ATOMIC_RELAXED, __HIP_MEMORY_SCOPE_AGENT); }
DEV unsigned xb_add(unsigned* p, unsigned v) { return __hip_atomic_fetch_add(p, v, __ATOMIC_RELAXED, __HIP_MEMORY_SCOPE_AGENT); }
DEV unsigned xb_xcc_id() { return (unsigned)__builtin_amdgcn_s_getreg((3 << 11) | 20) & 0xFu; }
#define XB_SPIN(cond, bar) do { unsigned _sp = 0; while (cond) { __builtin_amdgcn_s_sleep(1); \
    if ((++_sp & 255u) == 0u) { if (xb_ld(&(bar)[XB_TMO])) break; if (_sp > XB_SPIN_CAP) { atomicAdd(&(bar)[XB_TMO], 1u); break; } } } } while (0)
struct XcdBarrier { unsigned* bar; unsigned x; volatile LAS unsigned* st; };
DEV XcdBarrier xcd_barrier_post(unsigned* bar, volatile LAS unsigned* st) {
    XcdBarrier b; b.bar = bar; b.x = xb_xcc_id(); b.st = st;
    if (threadIdx.x == 0) (void)xb_add(&bar[XB_XCNT(b.x)], 1u);
    return b;
}
DEV void xcd_barrier_complete(unsigned* bar, unsigned x, unsigned& nloc, unsigned& nx) {
    const unsigned G = gridDim.x;
    unsigned sum, cnt, mine, sp = 0u;
    for (;;) {
        sum = 0u; cnt = 0u; mine = 0u;
#pragma unroll
        for (unsigned j = 0; j < 16; ++j) { const unsigned c = xb_ld(&bar[XB_XCNT(j)]); sum += c; cnt += (c > 0u) ? 1u : 0u; mine = (j == x) ? c : mine; }
        if (sum == G) break;
        __builtin_amdgcn_s_sleep(1);
        if ((++sp & 255u) == 0u) { if (xb_ld(&bar[XB_TMO])) break; if (sp > XB_SPIN_CAP) { atomicAdd(&bar[XB_TMO], 1u); break; } }
    }
    nloc = mine > 0u ? mine : 1u; nx = cnt > 0u ? cnt : 1u;
}
DEV void xcd_barrier(const XcdBarrier& b) {
    asm volatile("s_waitcnt vmcnt(0)" ::: "memory");
    __syncthreads();
    if (threadIdx.x == 0) {
        unsigned* bar = b.bar;
        __builtin_amdgcn_s_waitcnt(0);
        unsigned nloc = b.st[0], nx = b.st[1];
        if (nloc == 0u) { xcd_barrier_complete(bar, b.x, nloc, nx); b.st[0] = nloc; b.st[1] = nx; }
        const unsigned old = xb_add(&bar[XB_XSUB(b.x)], 1u);
        const unsigned gen = old / nloc;
        if (old + 1u == (gen + 1u) * nloc) {
            __builtin_amdgcn_fence(__ATOMIC_RELEASE, "agent");
            asm volatile("s_waitcnt vmcnt(0)" ::: "memory");
            const unsigned og = xb_add(&bar[XB_TOP], 1u);
            const unsigned tg = og / nx;
            if (og + 1u == (tg + 1u) * nx) xb_add(&bar[XB_TOPGEN], 1u);
            else XB_SPIN(xb_ld(&bar[XB_TOPGEN]) == tg, bar);
            __builtin_amdgcn_fence(__ATOMIC_ACQUIRE, "agent");
            xb_add(&bar[XB_XGEN(b.x)], 1u);
            asm volatile("s_waitcnt vmcnt(0)" ::: "memory");
        } else {
            XB_SPIN(xb_ld(&bar[XB_XGEN(b.x)]) == gen, bar);
            __builtin_amdgcn_fence(__ATOMIC_ACQUIRE, "agent");
            asm volatile("s_waitcnt vmcnt(0)" ::: "memory");
        }
    }
    __syncthreads();
}

DEV void glds16(const void* gptr, unsigned lds_addr_lane) {
    const unsigned m = __builtin_amdgcn_readfirstlane(lds_addr_lane);
    unsigned keep;
    asm volatile("s_mov_b32 %0, m0\n\ts_mov_b32 m0, %2\n\ts_nop 0\n\tglobal_load_lds_dwordx4 %1, off\n\ts_mov_b32 m0, %0" : "=&s"(keep) : "v"(gptr), "s"(m) : "memory");
}

template <int WT, class Epi>
DEV void gemm_tile(const bf16_t* __restrict__ A, int lda, const bf16_t* __restrict__ Bt, int ldb, int K, unsigned char* lds, const Epi& epi) {
    constexpr int FI = WT / 16;
    constexpr int OPB = 2 * WT * 128;
    constexpr int STB = 2 * OPB;
    int tid = threadIdx.x & 255; asm volatile("" : "+v"(tid)); const int lane = tid & 63, wid = tid >> 6;
    const int wr = wid >> 1, wc = wid & 1, fr = lane & 15, fq = lane >> 4;
    f32x4 acc[FI][FI];
#pragma unroll
    for (int i = 0; i < FI; ++i)
#pragma unroll
        for (int j = 0; j < FI; ++j) acc[i][j] = (f32x4){0.f, 0.f, 0.f, 0.f};
    const int lrow = tid >> 3, lcs = (tid & 7) ^ (lrow & 7);
    const bf16_t* ap = A + (size_t)lrow * lda + lcs * 8;
    const bf16_t* bp = Bt + (size_t)lrow * ldb + lcs * 8;
    const unsigned l3a = (unsigned)(size_t)(LAS unsigned char*)lds;
    const int nk = K >> 6;
#define GLDS_STAGE(st, kt_) do { \
        _Pragma("unroll") for (int i_ = 0; i_ < FI; ++i_) { \
            glds16(ap + (size_t)(32 * i_) * lda + (kt_) * 64, l3a + (st) + tid * 16 + i_ * 4096); \
            glds16(bp + (size_t)(32 * i_) * ldb + (kt_) * 64, l3a + (st) + OPB + tid * 16 + i_ * 4096); } } while (0)
    constexpr int NSTG = 65536 / STB;
#pragma unroll
    for (int s_ = 0; s_ < NSTG - 1; ++s_) if (s_ < nk) GLDS_STAGE(s_ * STB, s_);
    const int aoff = (wr * WT + fr) * 128, boff = OPB + (wc * WT + fr) * 128, sw = fr & 7;
    int cur = 0, nxt = (NSTG - 1) * STB;
    for (int kt = 0; kt < nk; ++kt) {
        if (NSTG == 4 && kt + 2 < nk) { if (FI == 2) asm volatile("s_waitcnt vmcnt(8)" ::: "memory"); else asm volatile("s_waitcnt vmcnt(0)" ::: "memory"); }
        else asm volatile("s_waitcnt vmcnt(0)" ::: "memory");
        __syncthreads();
        if (kt + NSTG - 1 < nk) GLDS_STAGE(nxt, kt + NSTG - 1);
#pragma unroll
        for (int kh = 0; kh < 2; ++kh) {
            bf16x8 af[FI], bfr[FI];
            const int ch = ((kh * 4 + fq) ^ sw) << 4;
#pragma unroll
            for (int i = 0; i < FI; ++i) { af[i] = *(const bf16x8*)(lds + cur + aoff + i * 2048 + ch); bfr[i] = *(const bf16x8*)(lds + cur + boff + i * 2048 + ch); }
#pragma unroll
            for (int mi = 0; mi < FI; ++mi)
#pragma unroll
                for (int ni = 0; ni < FI; ++ni) acc[mi][ni] = __builtin_amdgcn_mfma_f32_16x16x32_bf16(bfr[ni], af[mi], acc[mi][ni], 0, 0, 0);
        }
        nxt = cur; cur += STB; if (cur == NSTG * STB) cur = 0;
    }
#undef GLDS_STAGE
    __syncthreads();
#pragma unroll
    for (int mi = 0; mi < FI; ++mi)
#pragma unroll
        for (int ni = 0; ni < FI; ++ni) epi(wr * WT + mi * 16 + fr, wc * WT + ni * 16 + fq * 4, acc[mi][ni]);
}

template <class Epi>
DEV void gemm256_tile(const bf16_t* __restrict__ A, int lda, const bf16_t* __restrict__ Bt, int ldb, int K, unsigned char* lds, const Epi& epi) {
    int tid = threadIdx.x; asm volatile("" : "+v"(tid)); const int lane = tid & 63, wid = tid >> 6;
    const int wr = wid >> 2, wc = wid & 3, fr = lane & 15, fq = lane >> 4;
    f32x4 acc[8][4];
#pragma unroll
    for (int i = 0; i < 8; ++i)
#pragma unroll
        for (int j = 0; j < 4; ++j) acc[i][j] = (f32x4){0.f, 0.f, 0.f, 0.f};
    const int lrow = tid >> 3, lcs = (tid & 7) ^ (lrow & 7);
    const bf16_t* ap = A + (size_t)lrow * lda + lcs * 8;
    const bf16_t* bp = Bt + (size_t)lrow * ldb + lcs * 8;
    const unsigned l3a = (unsigned)(size_t)(LAS unsigned char*)lds;
    const int nk = K >> 6;
#define GLDS_STAGE(st, kt_) do { \
        _Pragma("unroll") for (int i_ = 0; i_ < 4; ++i_) { \
            glds16(ap + (size_t)(64 * i_) * lda + (kt_) * 64, l3a + (st) + tid * 16 + i_ * 8192); \
            glds16(bp + (size_t)(64 * i_) * ldb + (kt_) * 64, l3a + (st) + 32768 + tid * 16 + i_ * 8192); } } while (0)
    GLDS_STAGE(0, 0);
    const int aoff = (wr * 128 + fr) * 128, boff = 32768 + (wc * 64 + fr) * 128, sw = fr & 7;
    for (int kt = 0; kt < nk; ++kt) {
        const int cur = (kt & 1) * 65536;
        asm volatile("s_waitcnt vmcnt(0)" ::: "memory");
        __syncthreads();
        if (kt + 1 < nk) GLDS_STAGE(cur ^ 65536, kt + 1);
#pragma unroll
        for (int kh = 0; kh < 2; ++kh) {
            bf16x8 bfr[4];
            const int ch = ((kh * 4 + fq) ^ sw) << 4;
#pragma unroll
            for (int i = 0; i < 4; ++i) bfr[i] = *(const bf16x8*)(lds + cur + boff + i * 2048 + ch);
#pragma unroll
            for (int mh = 0; mh < 2; ++mh) {
                bf16x8 af[4];
#pragma unroll
                for (int i = 0; i < 4; ++i) af[i] = *(const bf16x8*)(lds + cur + aoff + (mh * 4 + i) * 2048 + ch);
#pragma unroll
                for (int mi = 0; mi < 4; ++mi)
#pragma unroll
                    for (int ni = 0; ni < 4; ++ni) acc[mh * 4 + mi][ni] = __builtin_amdgcn_mfma_f32_16x16x32_bf16(bfr[ni], af[mi], acc[mh * 4 + mi][ni], 0, 0, 0);
            }
        }
    }
#undef GLDS_STAGE
    __syncthreads();
#pragma unroll
    for (int mi = 0; mi < 8; ++mi)
#pragma unroll
        for (int ni = 0; ni < 4; ++ni) epi(wr * 128 + mi * 16 + fr, wc * 64 + ni * 16 + fq * 4, acc[mi][ni]);
}

DEV void ab_rows16(const bf16_t* __restrict__ h, const bf16_t* __restrict__ wab, float* __restrict__ ab, int rt, int lane) {
    const int fr = lane & 15, fq = lane >> 4;
    const bf16_t* ap = h + (size_t)(rt * 16 + fr) * LDB + fq * 8;
    const bf16_t* bp = wab + (size_t)fr * LDB + fq * 8;
    f32x4 acc = {0.f, 0.f, 0.f, 0.f};
#pragma unroll 8
    for (int s = 0; s < 64; ++s) {
        const bf16x8 a = *(const bf16x8*)(ap + s * 32), b = *(const bf16x8*)(bp + s * 32);
        acc = __builtin_amdgcn_mfma_f32_16x16x32_bf16(b, a, acc, 0, 0, 0);
    }
    *(f32x4*)(ab + (size_t)(rt * 16 + fr) * 16 + fq * 4) = acc;
}

DEV void tile_map(int L, int nM, int nN, int& pm, int& pn) {
    const int T = nM * nN, q = T >> 3, r = T & 7, xcd = L & 7, off = L >> 3;
    const int w = (xcd < r ? xcd * (q + 1) : r * (q + 1) + (xcd - r) * q) + off;
    const int nig = 8 * nN, gid = w / nig, fm = gid * 8, gsz = (nM - fm) < 8 ? (nM - fm) : 8;
    pm = fm + (w % nig) % gsz; pn = (w % nig) / gsz;
}

struct EpiProj {
    int m0, n0; bf16_t* proj; float* ab; float* out;
    DEV void operator()(int r, int c, f32x4 v) const {
        const int row = m0 + r, col = n0 + c;
        if (col < NPJ) {
            store_bf4(proj + (size_t)row * NPJ + col, v);
            const bool isconv = col < 3072, ispool = (col >= C_U && col < C_ZB);
            if (isconv || ispool) {
                if (row < TP) {
                    const int b = row >> 11, t = row & 2047;
                    if (isconv) { if (t >= 2045) *(f32x4*)(out + O_CP + ((size_t)(b * 3 + (t - 2045))) * 3072 + col) = v; }
                    else { if (t >= 2033) *(f32x4*)(out + O_PP + ((size_t)(b * 15 + (t - 2033))) * 1024 + (col - C_U)) = v; }
                } else {
                    const int sb = (row - TP) >> 2, t = (row - TP) & 3;
                    if (isconv) { if (t >= 1) *(f32x4*)(out + O_CS + ((size_t)(sb * 3 + (t - 1))) * 3072 + col) = v; }
                    else *(f32x4*)(out + O_PS + ((size_t)(sb * 15 + 11 + t)) * 1024 + (col - C_U)) = v;
                }
            }
        } else if (col < NPJ + 16) {
            *(f32x4*)(ab + (size_t)row * 16 + (col - NPJ)) = v;
        }
    }
};
struct EpiMKV {
    int m0, n0; bf16_t* mkb; bf16_t* mvt; float* out;
    DEV void operator()(int r, int c, f32x4 v) const {
        const int row = m0 + r, col = n0 + c;
        if (col < D) {
            *(f32x4*)(out + O_MK + (size_t)row * D + col) = v;
            store_bf4(mkb + (size_t)row * LDB + col, v);
        } else {
            const int cc = col - D, b = row >> 8, m = row & 255;
            *(f32x4*)(out + O_MV + (size_t)row * D + cc) = v;
            bf16_t* p = mvt + ((size_t)b * D + cc) * LDM + m;
            p[0] = f2bf(v[0]); p[LDM] = f2bf(v[1]); p[2 * LDM] = f2bf(v[2]); p[3 * LDM] = f2bf(v[3]);
        }
    }
};
struct EpiPool {
    int m0, n0; const bf16_t* proj; const float* scale; bf16_t* mix;
    DEV void operator()(int r, int c, f32x4 v) const {
        const int row = m0 + r, col = n0 + c;
        const uint2 z = *(const uint2*)(proj + (size_t)row * NPJ + C_ZB + col);
        const f32x4 s = *(const f32x4*)(scale + col);
        f32x4 o;
        o[0] = v[0] * s[0] * silu_f(bflo(z.x)); o[1] = v[1] * s[1] * silu_f(bfhi(z.x));
        o[2] = v[2] * s[2] * silu_f(bflo(z.y)); o[3] = v[3] * s[3] * silu_f(bfhi(z.y));
        store_bf4(mix + (size_t)row * LDB + 1024 + col, o);
    }
};
struct EpiResid {
    const float* res; bf16_t* dst;
    DEV void operator()(int r, int c, f32x4 v) const {
        const f32x4 x = __builtin_nontemporal_load((const f32x4*)(res + (size_t)r * D + c));
        store_bf4(dst + (size_t)r * LDB + c, x + v);
    }
};
struct EpiResidB {
    const bf16_t* res; bf16_t* dst;
    DEV void operator()(int r, int c, f32x4 v) const {
        const uint2 u = *(const uint2*)(res + (size_t)r * LDB + c);
        f32x4 x; x[0] = bflo(u.x); x[1] = bfhi(u.x); x[2] = bflo(u.y); x[3] = bfhi(u.y);
        store_bf4(dst + (size_t)r * LDB + c, x + v);
    }
};
struct EpiBf {
    bf16_t* dst; int ld;
    DEV void operator()(int r, int c, f32x4 v) const { store_bf4(dst + (size_t)r * ld + c, v); }
};
struct EpiF32s {
    float* dst; int ld; float s;
    DEV void operator()(int r, int c, f32x4 v) const { *(f32x4*)(dst + (size_t)r * ld + c) = v * s; }
};

DEV int win_srccol(int n) { return n < 4096 ? n : (n < 6144 ? n + 16 : (n < 6160 ? 4096 + (n - 6144) : -1)); }
DEV void transpose_tile(const float* __restrict__ src, int ld, int srccol0, bool remap, int k0, bf16_t* __restrict__ dstrow0, int ldd, float* tile) {
    int tid = threadIdx.x & 255; asm volatile("" : "+v"(tid));
    const int tx = tid & 63, ty = tid >> 6;
    const int sc = remap ? win_srccol(srccol0 + tx) : (srccol0 + tx);
    float tv[32];
#pragma unroll
    for (int i = 0; i < 32; ++i) tv[i] = sc >= 0 ? __builtin_nontemporal_load(src + (size_t)(k0 + ty + 4 * i) * ld + sc) : 0.f;
#pragma unroll
    for (int i = 0; i < 32; ++i) tile[(ty + 4 * i) * 65 + tx] = tv[i];
    __syncthreads();
#pragma unroll
    for (int i = 0; i < 16; ++i) { const int r = ty + 4 * i; *(unsigned*)(dstrow0 + (size_t)r * ldd + k0 + 2 * tx) = cvt_pk_bf16(tile[(2 * tx) * 65 + r], tile[(2 * tx + 1) * 65 + r]); }
    __syncthreads();
}
DEV void rmsnorm_row_bf16(const float* __restrict__ x, const float* __restrict__ g, bf16_t* __restrict__ y, int lane) {
    f32x4 v[8]; float ss = 0.f;
#pragma unroll
    for (int i = 0; i < 8; ++i) { v[i] = ((const f32x4*)x)[i * 64 + lane]; ss += v[i][0] * v[i][0] + v[i][1] * v[i][1] + v[i][2] * v[i][2] + v[i][3] * v[i][3]; }
    ss = wave_sum(ss);
    const float rs = rsqrtf(ss * (1.f / 2048.f) + EPS);
#pragma unroll
    for (int i = 0; i < 8; ++i) { const f32x4 gg = ((const f32x4*)g)[i * 64 + lane]; store_bf4(y + (size_t)(i * 64 + lane) * 4, v[i] * rs * gg); }
}
template <bool OUT_F32>
DEV void rmsnorm_row_from_bf16(const bf16_t* __restrict__ x, const float* __restrict__ g, void* __restrict__ y, int lane) {
    float v[4][8]; float ss = 0.f;
#pragma unroll
    for (int i = 0; i < 4; ++i) { const uint4 u = ((const uint4*)x)[i * 64 + lane];
        v[i][0] = bflo(u.x); v[i][1] = bfhi(u.x); v[i][2] = bflo(u.y); v[i][3] = bfhi(u.y); v[i][4] = bflo(u.z); v[i][5] = bfhi(u.z); v[i][6] = bflo(u.w); v[i][7] = bfhi(u.w);
#pragma unroll
        for (int e = 0; e < 8; ++e) ss += v[i][e] * v[i][e]; }
    ss = wave_sum(ss);
    const float rs = rsqrtf(ss * (1.f / 2048.f) + EPS);
#pragma unroll
    for (int i = 0; i < 4; ++i) {
        const f32x4 g0 = ((const f32x4*)g)[(i * 64 + lane) * 2], g1 = ((const f32x4*)g)[(i * 64 + lane) * 2 + 1];
        const f32x4 o0 = (f32x4){v[i][0], v[i][1], v[i][2], v[i][3]} * rs * g0, o1 = (f32x4){v[i][4], v[i][5], v[i][6], v[i][7]} * rs * g1;
        if (OUT_F32) { __builtin_nontemporal_store(o0, (f32x4*)y + (i * 64 + lane) * 2); __builtin_nontemporal_store(o1, (f32x4*)y + (i * 64 + lane) * 2 + 1); }
        else { uint4 w; w.x = cvt_pk_bf16(o0[0], o0[1]); w.y = cvt_pk_bf16(o0[2], o0[3]); w.z = cvt_pk_bf16(o1[0], o1[1]); w.w = cvt_pk_bf16(o1[2], o1[3]); ((uint4*)y)[i * 64 + lane] = w; }
    }
}
DEV void rmsnorm_row_f32(const float* __restrict__ x, const float* __restrict__ g, float* __restrict__ y, int lane) {
    f32x4 v[8]; float ss = 0.f;
#pragma unroll
    for (int i = 0; i < 8; ++i) { v[i] = ((const f32x4*)x)[i * 64 + lane]; ss += v[i][0] * v[i][0] + v[i][1] * v[i][1] + v[i][2] * v[i][2] + v[i][3] * v[i][3]; }
    ss = wave_sum(ss);
    const float rs = rsqrtf(ss * (1.f / 2048.f) + EPS);
#pragma unroll
    for (int i = 0; i < 8; ++i) { const f32x4 gg = ((const f32x4*)g)[i * 64 + lane]; __builtin_nontemporal_store(v[i] * rs * gg, (f32x4*)y + i * 64 + lane); }
}

constexpr int QS = 136;
DEV void gdn_prep_chunk(const Params& p, int item, unsigned char* lds) {
    int tid = threadIdx.x & 255; asm volatile("" : "+v"(tid)); const int lane = tid & 63, wid = tid >> 6;
    const int c = item & 31, h = (item >> 5) & 7, b = item >> 8;
    const int row0 = b * SEQ + c * 64;
    const bf16_t* proj = (const bf16_t*)(p.ws + WS_PROJ);
    const float* ab = (const float*)(p.ws + WS_AB);
    bf16_t* qs = (bf16_t*)lds; bf16_t* ks = qs + 64 * QS; bf16_t* vs = ks + 64 * QS;
    float* lowT = (float*)lds;
    float* gcs = (float*)(lds + 3 * 64 * QS * 2);
    float* bts = gcs + 64;
    bf16_t* gW = (bf16_t*)(p.ws + WS_GW) + (size_t)item * 8192;
    bf16_t* gQ = (bf16_t*)(p.ws + WS_GQ) + (size_t)item * 8192;
    bf16_t* gKT = (bf16_t*)(p.ws + WS_GKT) + (size_t)item * 8192;
    bf16_t* gA = (bf16_t*)(p.ws + WS_GA) + (size_t)item * 4096;
    float* gU = (float*)(p.ws + WS_GU) + (size_t)item * 8192;
    float* gE = (float*)(p.ws + WS_GE) + item;

    if (wid == 3) {
        const float a = ab[(size_t)(row0 + lane) * 16 + h], bb = ab[(size_t)(row0 + lane) * 16 + 8 + h];
        const float xx = a + p.in[12][h];
        const float sp = xx > 20.f ? xx : log1pf(__expf(xx));
        float s = -__expf(p.in[11][h]) * sp;
#pragma unroll
        for (int d = 1; d < 64; d <<= 1) { const float t = __shfl_up(s, d); if (lane >= d) s += t; }
        gcs[lane] = s; bts[lane] = 1.f / (1.f + __expf(-bb));
    } else {
        const int mat = wid, rg = lane >> 4, cv = lane & 15;
        const int colg = mat * 1024 + h * 128 + cv * 8;
        const float* cw = p.in[10];
        float w[4][8];
#pragma unroll
        for (int j = 0; j < 4; ++j) { const f32x4 w0 = *(const f32x4*)(cw + j * 3072 + colg), w1 = *(const f32x4*)(cw + j * 3072 + colg + 4);
            w[j][0] = w0[0]; w[j][1] = w0[1]; w[j][2] = w0[2]; w[j][3] = w0[3]; w[j][4] = w1[0]; w[j][5] = w1[1]; w[j][6] = w1[2]; w[j][7] = w1[3]; }
        const int tl0 = rg * 16;
        uint4 raw[19];
#pragma unroll
        for (int i = 0; i < 19; ++i) {
            const int tl = tl0 - 3 + i;
            if (c * 64 + tl >= 0) raw[i] = *(const uint4*)(proj + (size_t)(row0 + tl) * NPJ + colg);
            else raw[i] = make_uint4(0u, 0u, 0u, 0u);
        }
        bf16_t* dst = (mat == 0 ? qs : (mat == 1 ? ks : vs));
#pragma unroll
        for (int r = 0; r < 16; ++r) {
            float y[8]; float ss = 0.f;
#pragma unroll
            for (int e = 0; e < 8; ++e) {
                float a = 0.f;
#pragma unroll
                for (int j = 0; j < 4; ++j) {
                    const uint4 u = raw[r + j];
                    const unsigned wd = (e < 2 ? u.x : (e < 4 ? u.y : (e < 6 ? u.z : u.w)));
                    const float xv = (e & 1) ? bfhi(wd) : bflo(wd);
                    a += w[j][e] * xv;
                }
                y[e] = silu_f(a); ss += y[e] * y[e];
            }
            if (mat < 2) {
                ss += __shfl_xor(ss, 1); ss += __shfl_xor(ss, 2); ss += __shfl_xor(ss, 4); ss += __shfl_xor(ss, 8);
                float inv = rsqrtf(ss + EPS); if (mat == 0) inv *= 0.08838834764831845f;
#pragma unroll
                for (int e = 0; e < 8; ++e) y[e] *= inv;
            }
            uint4 o; o.x = cvt_pk_bf16(y[0], y[1]); o.y = cvt_pk_bf16(y[2], y[3]); o.z = cvt_pk_bf16(y[4], y[5]); o.w = cvt_pk_bf16(y[6], y[7]);
            *(uint4*)(dst + (tl0 + r) * QS + cv * 8) = o;
        }
    }
    __syncthreads();
    {
        const float glast = gcs[63];
        if (tid == 0) *gE = __expf(glast);
#pragma unroll
        for (int i = 0; i < 4; ++i) {
            const int ci = tid + 256 * i, t = ci >> 4, cc = (ci & 15) * 8;
            const uint4 u = *(const uint4*)(qs + t * QS + cc);
            const float e = __expf(gcs[t]);
            uint4 o; o.x = cvt_pk_bf16(bflo(u.x) * e, bfhi(u.x) * e); o.y = cvt_pk_bf16(bflo(u.y) * e, bfhi(u.y) * e);
            o.z = cvt_pk_bf16(bflo(u.z) * e, bfhi(u.z) * e); o.w = cvt_pk_bf16(bflo(u.w) * e, bfhi(u.w) * e);
            *(uint4*)(gQ + (cc >> 5) * 2048 + t * 32 + (cc & 31)) = o;
        }
        const float dk = __expf(glast - gcs[lane]);
#pragma unroll 8
        for (int i = 0; i < 32; ++i) { const int d = wid * 32 + i; gKT[(lane >> 5) * 4096 + d * 32 + (lane & 31)] = f2bf(bf2f(ks[lane * QS + d]) * dk);     }
    }
    f32x4 kk[4], qk[4];
    {
        const int fr = lane & 15, fq = lane >> 4, it = wid;
        bf16x8 kfi[4], qfi[4];
#pragma unroll
        for (int s = 0; s < 4; ++s) { kfi[s] = *(const bf16x8*)(ks + (it * 16 + fr) * QS + s * 32 + fq * 8); qfi[s] = *(const bf16x8*)(qs + (it * 16 + fr) * QS + s * 32 + fq * 8); }
#pragma unroll
        for (int jt = 0; jt < 4; ++jt) {
            kk[jt] = (f32x4){0.f, 0.f, 0.f, 0.f}; qk[jt] = (f32x4){0.f, 0.f, 0.f, 0.f};
#pragma unroll
            for (int s = 0; s < 4; ++s) {
                const bf16x8 kfj = *(const bf16x8*)(ks + (jt * 16 + fr) * QS + s * 32 + fq * 8);
                kk[jt] = __builtin_amdgcn_mfma_f32_16x16x32_bf16(kfi[s], kfj, kk[jt], 0, 0, 0);
                qk[jt] = __builtin_amdgcn_mfma_f32_16x16x32_bf16(kfj, qfi[s], qk[jt], 0, 0, 0);
            }
        }
    }
    __syncthreads();
    {
        const int fr = lane & 15, fq = lane >> 4, it = wid;
#pragma unroll
        for (int jt = 0; jt < 4; ++jt) {
            const int j = jt * 16 + fr; const float gj = gcs[j];
            f32x4 lv;
#pragma unroll
            for (int e = 0; e < 4; ++e) { const int i = it * 16 + fq * 4 + e; lv[e] = (i > j) ? bts[i] * kk[jt][e] * __expf(gcs[i] - gj) : 0.f; }
            *(f32x4*)(lowT + j * 68 + it * 16 + fq * 4) = lv;
            const int i2 = it * 16 + fr; const float gi = gcs[i2];
            f32x4 av;
#pragma unroll
            for (int e = 0; e < 4; ++e) { const int j2 = jt * 16 + fq * 4 + e; av[e] = (i2 >= j2) ? qk[jt][e] * __expf(gi - gcs[j2]) : 0.f; }
            store_bf4(gA + (jt >> 1) * 2048 + i2 * 32 + (jt & 1) * 16 + fq * 4, av);
        }
    }
    __syncthreads();
    {
        const int cc = tid & 127; const bool isw = tid >= 128;
        bf16_t* src = isw ? ks : vs;
#pragma unroll 1
        for (int ib = 0; ib < 4; ++ib) {
            f32x2_t acc[8];
#pragma unroll
            for (int r = 0; r < 16; ++r) { const int j = ib * 16 + r; float f = bts[j]; if (isw) f *= __expf(gcs[j]); acc[r >> 1][r & 1] = f * bf2f(src[j * QS + cc]); }
            const float* lrow = lowT + ib * 16;
#pragma unroll 4
            for (int j = 0; j < ib * 16; ++j) {
                const float xj = -bf2f(src[j * QS + cc]); const f32x2_t nx = {xj, xj};
                const f32x4 l0 = *(const f32x4*)(lrow + j * 68), l1 = *(const f32x4*)(lrow + j * 68 + 4), l2 = *(const f32x4*)(lrow + j * 68 + 8), l3 = *(const f32x4*)(lrow + j * 68 + 12);
                acc[0] += (f32x2_t){l0[0], l0[1]} * nx; acc[1] += (f32x2_t){l0[2], l0[3]} * nx; acc[2] += (f32x2_t){l1[0], l1[1]} * nx; acc[3] += (f32x2_t){l1[2], l1[3]} * nx;
                acc[4] += (f32x2_t){l2[0], l2[1]} * nx; acc[5] += (f32x2_t){l2[2], l2[3]} * nx; acc[6] += (f32x2_t){l3[0], l3[1]} * nx; acc[7] += (f32x2_t){l3[2], l3[3]} * nx;
            }
#pragma unroll
            for (int r2 = 0; r2 < 15; ++r2) {
                asm volatile("" ::: "memory");
                const float xj = -acc[r2 >> 1][r2 & 1]; const f32x2_t nx = {xj, xj};
                const float* lp = lrow + (ib * 16 + r2) * 68;
#pragma unroll
                for (int q = (r2 + 1) >> 2; q < 4; ++q) {
                    const f32x4 l = *(const f32x4*)(lp + q * 4);
                    acc[2 * q] += (f32x2_t){l[0], l[1]} * nx; acc[2 * q + 1] += (f32x2_t){l[2], l[3]} * nx;
                }
            }
#pragma unroll
            for (int r = 0; r < 16; ++r) {
                const int j = ib * 16 + r; const float xv = acc[r >> 1][r & 1]; const bf16_t xb = f2bf(xv);
                src[j * QS + cc] = xb;
                if (isw) gW[(cc >> 5) * 2048 + j * 32 + (cc & 31)] = xb;
                else gU[(((((cc >> 4) * 4 + (j >> 4)) * 4 + (j & 3)) * 4 + ((j >> 2) & 3)) << 4) + (cc & 15)] = xv;
            }
        }
    }
    __syncthreads();
}

#define LDS_BARRIER() do { asm volatile("s_waitcnt lgkmcnt(0)" ::: "memory"); __builtin_amdgcn_s_barrier(); asm volatile("" ::: "memory"); } while (0)
struct ScanEarly { bf16x8 w[4], q[4]; f32x4 u; };
struct ScanLate { bf16x8 a[2], k0[2], k1[2]; };
DEV void gdn_scan_item(const Params& p, int item, unsigned char* lds) {
    int tid = threadIdx.x & 255; asm volatile("" : "+v"(tid)); const int lane = tid & 63, w = tid >> 6, fr = lane & 15, fq = lane >> 4;
    const int s = item & 7, bh = item >> 3;
    const int b = bh >> 3, h = bh & 7;
    bf16_t* ST = (bf16_t*)lds;
    bf16_t* VT = ST + 16 * QS;
    const char* bW = (const char*)((const bf16_t*)(p.ws + WS_GW) + (size_t)bh * 32 * 8192);
    const char* bQ = (const char*)((const bf16_t*)(p.ws + WS_GQ) + (size_t)bh * 32 * 8192);
    const char* bK = (const char*)((const bf16_t*)(p.ws + WS_GKT) + (size_t)bh * 32 * 8192);
    const char* bA = (const char*)((const bf16_t*)(p.ws + WS_GA) + (size_t)bh * 32 * 4096);
    const char* bU = (const char*)((const float*)(p.ws + WS_GU) + (size_t)bh * 32 * 8192);
    const float* gE = (const float*)(p.ws + WS_GE) + bh * 32;
    float* obuf = (float*)(p.ws + WS_O);
    f32x4 S0 = {0.f, 0.f, 0.f, 0.f}, S1 = {0.f, 0.f, 0.f, 0.f};
    for (int i = tid; i < 16 * QS / 2; i += 256) ((unsigned*)ST)[i] = 0u;
    const float egv = gE[lane & 31];
    const unsigned offWQ = (unsigned)(((w * 16 + fr) * 32 + fq * 8) * 2), offA = offWQ;
    const unsigned offK = (unsigned)(((w * 32 + fr) * 32 + fq * 8) * 2), offU = (unsigned)((((s * 4 + w) * 16 + fq) * 16 + fr) * 4);
    ScanEarly E0, E1, E2; ScanLate L0, L1;
#define LOAD_E(F, ch) do { \
        const char* W_ = bW + (size_t)(ch) * 16384; const char* Q_ = bQ + (size_t)(ch) * 16384; \
        _Pragma("unroll") for (int k_ = 0; k_ < 4; ++k_) { F.w[k_] = *(const bf16x8*)(W_ + (offWQ + k_ * 4096)); F.q[k_] = *(const bf16x8*)(Q_ + (offWQ + k_ * 4096)); } \
        const char* U_ = bU + (size_t)(ch) * 32768; F.u[0] = *(const float*)(U_ + offU); F.u[1] = *(const float*)(U_ + (offU + 256)); F.u[2] = *(const float*)(U_ + (offU + 512)); F.u[3] = *(const float*)(U_ + (offU + 768)); \
        } while (0)
#define LOAD_L(F, ch) do { \
        const char* A_ = bA + (size_t)(ch) * 8192; F.a[0] = *(const bf16x8*)(A_ + offA); F.a[1] = *(const bf16x8*)(A_ + (offA + 4096)); \
        const char* K_ = bK + (size_t)(ch) * 16384; F.k0[0] = *(const bf16x8*)(K_ + offK); F.k0[1] = *(const bf16x8*)(K_ + (offK + 8192)); \
        F.k1[0] = *(const bf16x8*)(K_ + (offK + 1024)); F.k1[1] = *(const bf16x8*)(K_ + (offK + 1024 + 8192)); \
        } while (0)
#define SCAN_STEP(X, XL, Y, YL, ch) do { \
        if ((ch) + 2 < 32) LOAD_E(XL, (ch) + 2); \
        if ((ch) + 1 < 32) LOAD_L(YL, (ch) + 1); \
        const float ceg = __builtin_bit_cast(float, __builtin_amdgcn_readlane(__builtin_bit_cast(int, egv), (ch))); \
        f32x4 ws_ = {0.f, 0.f, 0.f, 0.f}, oo = {0.f, 0.f, 0.f, 0.f}; \
        _Pragma("unroll") for (int k = 0; k < 4; ++k) { \
            const bf16x8 sf = *(const bf16x8*)(ST + fr * QS + k * 32 + fq * 8); \
            ws_ = __builtin_amdgcn_mfma_f32_16x16x32_bf16(X.w[k], sf, ws_, 0, 0, 0); \
            oo = __builtin_amdgcn_mfma_f32_16x16x32_bf16(X.q[k], sf, oo, 0, 0, 0); } \
        store_bf4(VT + fr * 72 + w * 16 + fq * 4, X.u - ws_); \
        LDS_BARRIER(); \
        const bf16x8 v0 = *(const bf16x8*)(VT + fr * 72 + fq * 8), v1 = *(const bf16x8*)(VT + fr * 72 + 32 + fq * 8); \
        oo = __builtin_amdgcn_mfma_f32_16x16x32_bf16(Y.a[0], v0, oo, 0, 0, 0); \
        oo = __builtin_amdgcn_mfma_f32_16x16x32_bf16(Y.a[1], v1, oo, 0, 0, 0); \
        S0 = S0 * ceg; S1 = S1 * ceg; \
        S0 = __builtin_amdgcn_mfma_f32_16x16x32_bf16(Y.k0[0], v0, S0, 0, 0, 0); \
        S0 = __builtin_amdgcn_mfma_f32_16x16x32_bf16(Y.k0[1], v1, S0, 0, 0, 0); \
        S1 = __builtin_amdgcn_mfma_f32_16x16x32_bf16(Y.k1[0], v0, S1, 0, 0, 0); \
        S1 = __builtin_amdgcn_mfma_f32_16x16x32_bf16(Y.k1[1], v1, S1, 0, 0, 0); \
        store_bf4(ST + fr * QS + w * 32 + fq * 4, S0); \
        store_bf4(ST + fr * QS + w * 32 + 16 + fq * 4, S1); \
        { float* op = obuf + (size_t)(b * SEQ + (ch) * 64 + w * 16 + fq * 4) * 1024 + h * 128 + s * 16 + fr; \
          op[0] = oo[0]; op[1024] = oo[1]; op[2048] = oo[2]; op[3072] = oo[3]; } \
        LDS_BARRIER(); } while (0)
    LOAD_E(E0, 0); LOAD_L(L0, 0); LOAD_E(E1, 1);
    __syncthreads();
    for (int ch = 0; ch < 30; ch += 6) {
        SCAN_STEP(E0, E2, L0, L1, ch);     SCAN_STEP(E1, E0, L1, L0, ch + 1); SCAN_STEP(E2, E1, L0, L1, ch + 2);
        SCAN_STEP(E0, E2, L1, L0, ch + 3); SCAN_STEP(E1, E0, L0, L1, ch + 4); SCAN_STEP(E2, E1, L1, L0, ch + 5);
    }
    SCAN_STEP(E0, E2, L0, L1, 30); SCAN_STEP(E1, E0, L1, L0, 31);
#undef SCAN_STEP
#undef LOAD_E
#undef LOAD_L
    {
        float* dp = p.out + O_DP + ((size_t)bh * 128 + w * 32 + fq * 4) * 128 + s * 16 + fr;
#pragma unroll
        for (int e = 0; e < 4; ++e) { dp[e * 128] = S0[e]; dp[(16 + e) * 128] = S1[e]; }
    }
    __syncthreads();
}

DEV void gdn_sample_item(const Params& p, int item, unsigned char* lds) {
    int tid = threadIdx.x & 255; asm volatile("" : "+v"(tid)); const int lane = tid & 63, wid = tid >> 6;
    const int sb = item >> 3, h = item & 7, half = tid >> 7, c = tid & 127;
    const int r0 = TP + sb * 4;
    const bf16_t* proj = (const bf16_t*)(p.ws + WS_PROJ);
    const float* ab = (const float*)(p.ws + WS_AB);
    float* ksh = (float*)lds;
    float* qsh = ksh + 512;
    float* red = qsh + 512;
    float* red2 = red + 32;
    float* part = red2 + 32;
    float* opart = part + 1024;
    float qv[4], kv[4], vv[4];
#pragma unroll
    for (int m = 0; m < 3; ++m) {
        const int col = m * 1024 + h * 128 + c;
        float x[7], wj[4];
#pragma unroll
        for (int j = 0; j < 3; ++j) x[j] = p.in[6][((size_t)sb * 3 + j) * 3072 + col];
#pragma unroll
        for (int t = 0; t < 4; ++t) x[3 + t] = bf2f(proj[(size_t)(r0 + t) * NPJ + col]);
#pragma unroll
        for (int j = 0; j < 4; ++j) wj[j] = p.in[10][j * 3072 + col];
#pragma unroll
        for (int t = 0; t < 4; ++t) {
            const float y = silu_f(wj[0] * x[t] + wj[1] * x[t + 1] + wj[2] * x[t + 2] + wj[3] * x[t + 3]);
            if (m == 0) qv[t] = y; else if (m == 1) kv[t] = y; else vv[t] = y;
        }
    }
#pragma unroll
    for (int t = 0; t < 4; ++t) {
        const float a = wave_sum(qv[t] * qv[t]), bq = wave_sum(kv[t] * kv[t]);
        if (lane == 0) { red[wid * 8 + t] = a; red[wid * 8 + 4 + t] = bq; }
    }
    __syncthreads();
    float gt[4], bt[4];
#pragma unroll
    for (int t = 0; t < 4; ++t) {
        const float sq = red[(2 * half) * 8 + t] + red[(2 * half + 1) * 8 + t], sk = red[(2 * half) * 8 + 4 + t] + red[(2 * half + 1) * 8 + 4 + t];
        if (half == 0) {
            qsh[t * 128 + c] = qv[t] * rsqrtf(sq + EPS) * 0.08838834764831845f;
            ksh[t * 128 + c] = kv[t] * rsqrtf(sk + EPS);
        }
        const float a = ab[(size_t)(r0 + t) * 16 + h], bb = ab[(size_t)(r0 + t) * 16 + 8 + h];
        const float xx = a + p.in[12][h];
        const float sp = xx > 20.f ? xx : log1pf(__expf(xx));
        gt[t] = __expf(-__expf(p.in[11][h]) * sp);
        bt[t] = 1.f / (1.f + __expf(-bb));
    }
    f32x2_t S[32];
    const float* sp0 = p.in[5] + ((size_t)(sb * 8 + h) * 128 + half * 64) * 128 + c;
#pragma unroll
    for (int d = 0; d < 64; ++d) S[d >> 1][d & 1] = __builtin_nontemporal_load(sp0 + (size_t)d * 128);
    __syncthreads();
    float ot[4];
#pragma unroll
    for (int t = 0; t < 4; ++t) {
        const float* kk = ksh + t * 128 + half * 64; const float* qq = qsh + t * 128 + half * 64;
        f32x2_t ks2 = {0.f, 0.f};
#pragma unroll
        for (int d4 = 0; d4 < 16; ++d4) { const f32x4 k4 = *(const f32x4*)(kk + d4 * 4); ks2 += (f32x2_t){k4[0], k4[1]} * S[d4 * 2]; ks2 += (f32x2_t){k4[2], k4[3]} * S[d4 * 2 + 1]; }
        part[(t * 2 + half) * 128 + c] = ks2[0] + ks2[1];
        __syncthreads();
        const float kS = part[(t * 2) * 128 + c] + part[(t * 2 + 1) * 128 + c];
        const float eg = gt[t], dl = bt[t] * (vv[t] - eg * kS);
        const f32x2_t eg2 = {eg, eg}, dl2 = {dl, dl};
        f32x2_t o2 = {0.f, 0.f};
#pragma unroll
        for (int d4 = 0; d4 < 16; ++d4) {
            const f32x4 k4 = *(const f32x4*)(kk + d4 * 4), q4 = *(const f32x4*)(qq + d4 * 4);
            const f32x2_t s0 = S[d4 * 2] * eg2 + (f32x2_t){k4[0], k4[1]} * dl2, s1 = S[d4 * 2 + 1] * eg2 + (f32x2_t){k4[2], k4[3]} * dl2;
            S[d4 * 2] = s0; S[d4 * 2 + 1] = s1;
            o2 += (f32x2_t){q4[0], q4[1]} * s0; o2 += (f32x2_t){q4[2], q4[3]} * s1;
        }
        const float o = o2[0] + o2[1];
        ot[t] = o;
        if (half == 1) opart[t * 128 + c] = o;
    }
    float* dso = p.out + O_DS + ((size_t)(sb * 8 + h) * 128 + half * 64) * 128 + c;
#pragma unroll
    for (int d = 0; d < 64; ++d) __builtin_nontemporal_store(S[d >> 1][d & 1], dso + (size_t)d * 128);
    __syncthreads();
    if (half == 0) {
#pragma unroll
        for (int t = 0; t < 4; ++t) { ot[t] += opart[t * 128 + c]; const float a = wave_sum(ot[t] * ot[t]); if (lane == 0) red2[wid * 4 + t] = a; }
    }
    __syncthreads();
    if (half == 0) {
        bf16_t* mix = (bf16_t*)(p.ws + WS_MIX);
        const float gn = p.in[13][c];
#pragma unroll
        for (int t = 0; t < 4; ++t) {
            const float ms = (red2[t] + red2[4 + t]) * (1.f / 128.f);
            const float z = bf2f(proj[(size_t)(r0 + t) * NPJ + C_ZA + h * 128 + c]);
            mix[(size_t)(r0 + t) * LDB + h * 128 + c] = f2bf(ot[t] * rsqrtf(ms + EPS) * gn * silu_f(z));
        }
    }
    __syncthreads();
}

DEV void attn_sample_item(const Params& p, int item, unsigned char* lds) {
    int tid = threadIdx.x & 255; asm volatile("" : "+v"(tid)); const int lane = tid & 63, wid = tid >> 6;
    const int sb = item >> 2, hd = item & 3;
    float* qs = (float*)lds;
    float* pm = qs + 2048;
    float* red = pm + 1024;
    const bf16_t* qx = (const bf16_t*)(p.ws + WS_QX);
    for (int i = tid; i < 2048; i += 256) { const int t = i >> 9, d = i & 511; qs[i] = bf2f(qx[(size_t)(TP + sb * 4 + t) * LDB + hd * 512 + d]) * 0.04419417382415922f; }
    __syncthreads();
    const float* Kc = p.in[3] + ((size_t)sb * 256) * D + hd * 512;
    const float* Vc = p.in[4] + ((size_t)sb * 256) * D + hd * 512;
    {
        const int sub = lane >> 4, l16 = lane & 15;
        f32x4 kv[8];
        {
            const float* kr = Kc + (size_t)(wid * 64 + sub) * D;
#pragma unroll
            for (int i = 0; i < 8; ++i) kv[i] = __builtin_nontemporal_load((const f32x4*)(kr + (i * 16 + l16) * 4));
        }
        for (int it = 0; it < 16; ++it) {
            const int m = wid * 64 + it * 4 + sub;
            f32x4 cv[8];
#pragma unroll
            for (int i = 0; i < 8; ++i) cv[i] = kv[i];
            if (it + 1 < 16) {
                const float* kr = Kc + (size_t)(m + 4) * D;
#pragma unroll
                for (int i = 0; i < 8; ++i) kv[i] = __builtin_nontemporal_load((const f32x4*)(kr + (i * 16 + l16) * 4));
            }
            float a0 = 0.f, a1 = 0.f, a2 = 0.f, a3 = 0.f;
#pragma unroll
            for (int i = 0; i < 8; ++i) {
                const int d = (i * 16 + l16) * 4;
                const f32x4 q0 = *(const f32x4*)(qs + d), q1 = *(const f32x4*)(qs + 512 + d), q2 = *(const f32x4*)(qs + 1024 + d), q3 = *(const f32x4*)(qs + 1536 + d);
                a0 += cv[i][0] * q0[0] + cv[i][1] * q0[1] + cv[i][2] * q0[2] + cv[i][3] * q0[3];
                a1 += cv[i][0] * q1[0] + cv[i][1] * q1[1] + cv[i][2] * q1[2] + cv[i][3] * q1[3];
                a2 += cv[i][0] * q2[0] + cv[i][1] * q2[1] + cv[i][2] * q2[2] + cv[i][3] * q2[3];
                a3 += cv[i][0] * q3[0] + cv[i][1] * q3[1] + cv[i][2] * q3[2] + cv[i][3] * q3[3];
            }
#pragma unroll
            for (int o = 1; o < 16; o <<= 1) { a0 += __shfl_xor(a0, o); a1 += __shfl_xor(a1, o); a2 += __shfl_xor(a2, o); a3 += __shfl_xor(a3, o); }
            if (l16 == 0) *(f32x4*)(pm + m * 4) = (f32x4){a0, a1, a2, a3};
        }
    }
    __syncthreads();
    {
        const int t = wid;
        float v[4]; float mx = -3.0e38f;
#pragma unroll
        for (int i = 0; i < 4; ++i) { v[i] = pm[(i * 64 + lane) * 4 + t]; mx = fmaxf(mx, v[i]); }
        mx = wave_max(mx);
        float sm = 0.f;
#pragma unroll
        for (int i = 0; i < 4; ++i) { v[i] = __expf(v[i] - mx); sm += v[i]; }
        sm = wave_sum(sm);
        const float inv = 1.f / sm;
#pragma unroll
        for (int i = 0; i < 4; ++i) pm[(i * 64 + lane) * 4 + t] = v[i] * inv;
    }
    __syncthreads();
    {
        f32x4 acc[4][2];
#pragma unroll
        for (int t = 0; t < 4; ++t) { acc[t][0] = (f32x4){0.f, 0.f, 0.f, 0.f}; acc[t][1] = (f32x4){0.f, 0.f, 0.f, 0.f}; }
        f32x4 va[4], vb[4];
#pragma unroll
        for (int i = 0; i < 4; ++i) { const float* vr = Vc + (size_t)(wid * 64 + i) * D; va[i] = __builtin_nontemporal_load((const f32x4*)(vr + lane * 4)); vb[i] = __builtin_nontemporal_load((const f32x4*)(vr + 256 + lane * 4)); }
        for (int m4 = 0; m4 < 16; ++m4) {
            f32x4 ca[4], cb[4];
#pragma unroll
            for (int i = 0; i < 4; ++i) { ca[i] = va[i]; cb[i] = vb[i]; }
            if (m4 + 1 < 16) {
#pragma unroll
                for (int i = 0; i < 4; ++i) { const float* vr = Vc + (size_t)(wid * 64 + (m4 + 1) * 4 + i) * D; va[i] = __builtin_nontemporal_load((const f32x4*)(vr + lane * 4)); vb[i] = __builtin_nontemporal_load((const f32x4*)(vr + 256 + lane * 4)); }
            }
#pragma unroll
            for (int i = 0; i < 4; ++i) {
                const f32x4 pr = *(const f32x4*)(pm + (wid * 64 + m4 * 4 + i) * 4);
#pragma unroll
                for (int t = 0; t < 4; ++t) { acc[t][0] += ca[i] * pr[t]; acc[t][1] += cb[i] * pr[t]; }
            }
        }
#pragma unroll
        for (int t = 0; t < 4; ++t) { *(f32x4*)(red + (wid * 4 + t) * 512 + lane * 4) = acc[t][0]; *(f32x4*)(red + (wid * 4 + t) * 512 + 256 + lane * 4) = acc[t][1]; }
    }
    __syncthreads();
    {
        bf16_t* ctx = (bf16_t*)(p.ws + WS_CTX);
#pragma unroll
        for (int i = 0; i < 2; ++i) {
            const int e = (tid + 256 * i) * 4, t = e >> 9, d = e & 511;
            const f32x4 s = *(const f32x4*)(red + (0 * 4 + t) * 512 + d) + *(const f32x4*)(red + (1 * 4 + t) * 512 + d) + *(const f32x4*)(red + (2 * 4 + t) * 512 + d) + *(const f32x4*)(red + (3 * 4 + t) * 512 + d);
            store_bf4(ctx + (size_t)(TP + sb * 4 + t) * LDB + hd * 512 + d, s);
        }
    }
    __syncthreads();
}

template <int WIN>
DEV void pool_d_prompt(const bf16_t* __restrict__ proj, bf16_t* __restrict__ dpl, int row, int c8) {
    const int tloc = row & 2047;
    uint4 u[WIN];
#pragma unroll
    for (int k = 0; k < WIN; ++k) u[k] = (tloc - k >= 0) ? *(const uint4*)(proj + (size_t)(row - k) * NPJ + C_U + c8) : make_uint4(0u, 0u, 0u, 0u);
    float acc[8] = {0.f, 0.f, 0.f, 0.f, 0.f, 0.f, 0.f, 0.f};
#pragma unroll
    for (int k = 0; k < WIN; ++k) { acc[0] += bflo(u[k].x); acc[1] += bfhi(u[k].x); acc[2] += bflo(u[k].y); acc[3] += bfhi(u[k].y); acc[4] += bflo(u[k].z); acc[5] += bfhi(u[k].z); acc[6] += bflo(u[k].w); acc[7] += bfhi(u[k].w); }
    const float ic = 1.f / (float)min(WIN, tloc + 1);
    uint4 o;
    o.x = cvt_pk_bf16(acc[0] * ic - bflo(u[0].x), acc[1] * ic - bfhi(u[0].x)); o.y = cvt_pk_bf16(acc[2] * ic - bflo(u[0].y), acc[3] * ic - bfhi(u[0].y));
    o.z = cvt_pk_bf16(acc[4] * ic - bflo(u[0].z), acc[5] * ic - bfhi(u[0].z)); o.w = cvt_pk_bf16(acc[6] * ic - bflo(u[0].w), acc[7] * ic - bfhi(u[0].w));
    *(uint4*)(dpl + (size_t)row * LDP + c8) = o;
}

#ifndef REP0
#define REP0 1
#endif
#ifndef REP1
#define REP1 1
#endif
#ifndef REP2
#define REP2 1
#endif
#ifndef REP3
#define REP3 1
#endif
#ifndef REP4
#define REP4 1
#endif
#ifndef REP5
#define REP5 1
#endif
#ifndef REP6
#define REP6 1
#endif
#ifndef REP7
#define REP7 1
#endif
#ifndef REP8
#define REP8 1
#endif
#ifndef REP9
#define REP9 1
#endif
#ifndef REP10
#define REP10 1
#endif
#ifndef REP11
#define REP11 1
#endif
#ifndef REP12
#define REP12 1
#endif
#ifndef NLAUNCH
#define NLAUNCH 1
#endif
#define GRID_BAR() do { if (NLAUNCH == 1) xcd_barrier(bar); } while (0)
#define IN_PH(k) (p.ph_lo <= (k) && (k) < p.ph_hi)
__global__ void __launch_bounds__(512) hymba_fwd(Params p) {
    __shared__ __attribute__((aligned(16))) unsigned char lds[131072];
    __shared__ uint4 xb_words;
    const int G = gridDim.x, bid = blockIdx.x, VG = 2 * G;
    if (threadIdx.x == 0) xb_words = make_uint4(0u, 0u, 0u, 0u);
#define PH_LOCALS int tid = threadIdx.x; asm volatile("" : "+v"(tid)); const int lane = tid & 63, wid = tid >> 6; const int vb = __builtin_amdgcn_readfirstlane(tid >> 8); \
    unsigned char* vlds = lds + vb * 65536; (void)lane; (void)wid; (void)vlds;
    __syncthreads();
    XcdBarrier bar; bar.bar = (unsigned*)(p.ws + WS_BAR); bar.x = 0; bar.st = (volatile LAS unsigned*)&xb_words;
    if (NLAUNCH == 1) bar = xcd_barrier_post((unsigned*)(p.ws + WS_BAR), (volatile LAS unsigned*)&xb_words);
    unsigned char* ws = p.ws;
    bf16_t* Wt_in = (bf16_t*)(ws + WS_WIN); bf16_t* Wt_out = (bf16_t*)(ws + WS_WOUT); bf16_t* Wt_cq = (bf16_t*)(ws + WS_WCQ); bf16_t* Wt_co = (bf16_t*)(ws + WS_WCO);
    bf16_t* Wt_ckv = (bf16_t*)(ws + WS_WCKV); bf16_t* Wt_pool = (bf16_t*)(ws + WS_WPOOL);
    bf16_t* hbuf = (bf16_t*)(ws + WS_H); bf16_t* hm = (bf16_t*)(ws + WS_HM); bf16_t* proj = (bf16_t*)(ws + WS_PROJ); float* ab = (float*)(ws + WS_AB);
    bf16_t* mkb = (bf16_t*)(ws + WS_MKB); bf16_t* mvt = (bf16_t*)(ws + WS_MVT); bf16_t* dpl = (bf16_t*)(ws + WS_DPL); bf16_t* mix = (bf16_t*)(ws + WS_MIX);
    bf16_t* x1 = (bf16_t*)(ws + WS_X1); bf16_t* qx = (bf16_t*)(ws + WS_QX); float* sc = (float*)(ws + WS_SC); bf16_t* pb = (bf16_t*)(ws + WS_PB);
    bf16_t* ctx = (bf16_t*)(ws + WS_CTX); bf16_t* x2 = (bf16_t*)(ws + WS_X2); float* obuf = (float*)(ws + WS_O);
#define VLOOP(t, N) for (int t##0_ = 2 * bid, t = min(t##0_ + vb, (N) - 1); t##0_ < (N); t##0_ += VG, t = min(t##0_ + vb, (N) - 1))

    if (IN_PH(0)) { PH_LOCALS
        const int NT_IN = 98 * 16, NT_SQ = 32 * 16;
        const int total = NT_IN + 5 * NT_SQ + 32;
        VLOOP(t, total) {
            if (t < NT_IN) { const int nt = t >> 4, kt = t & 15; transpose_tile(p.in[9], 6160, nt * 64, true, kt * 128, Wt_in + (size_t)nt * 64 * LDB, LDB, (float*)vlds); }
            else if (t < NT_IN + 5 * NT_SQ) {
                const int u = t - NT_IN, j = u >> 9, v = u & 511, nt = v >> 4, kt = v & 15;
                const float* src = p.in[j == 0 ? 16 : (j == 1 ? 19 : (j == 2 ? 22 : (j == 3 ? 20 : 21)))];
                bf16_t* dst = j == 0 ? Wt_out : (j == 1 ? Wt_cq : (j == 2 ? Wt_co : (j == 3 ? Wt_ckv : Wt_ckv + (size_t)D * LDB)));
                transpose_tile(src, D, nt * 64, false, kt * 128, dst + (size_t)nt * 64 * LDB, LDB, (float*)vlds);
            } else {
                const int u = t - NT_IN - 5 * NT_SQ, g = u >> 3, v = u & 7, nt = v >> 1, kt = v & 1;
                transpose_tile(p.in[14] + (size_t)g * 65536, 256, nt * 64, false, kt * 128, Wt_pool + ((size_t)g * 256 + nt * 64) * LDM, LDM, (float*)vlds);
            }
        }
        for (int r = bid * 8 + wid; r < TT + 1024; r += G * 8) {
            if (r < TP) rmsnorm_row_bf16(p.in[0] + (size_t)r * D, p.in[8], hbuf + (size_t)r * LDB, lane);
            else if (r < TT) rmsnorm_row_bf16(p.in[1] + (size_t)(r - TP) * D, p.in[8], hbuf + (size_t)r * LDB, lane);
            else rmsnorm_row_bf16(p.in[2] + (size_t)(r - TT) * D, p.in[17], hm + (size_t)(r - TT) * LDB, lane);
        }
    }
    GRID_BAR();
    if (IN_PH(1)) { PH_LOCALS
        for (int t = bid; t < 32 * 24; t += G) { int nt, mt; tile_map(t, 32, 24, mt, nt);
            EpiProj e{mt * 256, nt * 256, proj, ab, p.out};
            gemm256_tile(hbuf + (size_t)mt * 256 * LDB, LDB, Wt_in + (size_t)nt * 256 * LDB, LDB, D, lds, e);
        }
        VLOOP(t, 4 * 48 + 256) {
            if (t < 192) { const int mt = t & 3, nt = t >> 2;
                EpiProj e{TP + mt * 128, nt * 128, proj, ab, p.out};
                gemm_tile<64>(hbuf + (size_t)(TP + mt * 128) * LDB, LDB, Wt_in + (size_t)nt * 128 * LDB, LDB, D, vlds, e);
            } else { const int u = t - 192, mt = u & 7, nt = u >> 3;
                EpiMKV e{mt * 128, nt * 128, mkb, mvt, p.out};
                gemm_tile<64>(hm + (size_t)mt * 128 * LDB, LDB, Wt_ckv + (size_t)nt * 128 * LDB, LDB, D, vlds, e);
            }
        }
        for (int rt = bid * 8 + wid; rt < TT / 16; rt += G * 8) ab_rows16(hbuf, Wt_in + (size_t)NPJ * LDB, ab, rt, lane);
    }
    GRID_BAR();
    if (IN_PH(2)) { PH_LOCALS
        VLOOP(t, 1024) gdn_prep_chunk(p, t, vlds);
        for (int i = bid * 512 + tid; i < TP * 128; i += G * 512) {
            const int row = i >> 7, c8 = (i & 127) * 8, g = c8 >> 8;
            if (g == 0) pool_d_prompt<2>(proj, dpl, row, c8); else if (g == 1) pool_d_prompt<4>(proj, dpl, row, c8);
            else if (g == 2) pool_d_prompt<8>(proj, dpl, row, c8); else pool_d_prompt<16>(proj, dpl, row, c8);
        }
        for (int i = TP * 128 + bid * 512 + tid; i < TT * 128; i += G * 512) {
            const int row = i >> 7, c8 = (i & 127) * 8, g = c8 >> 8, win = 2 << g;
            float acc[8] = {0.f, 0.f, 0.f, 0.f, 0.f, 0.f, 0.f, 0.f}, self[8];
            const int tloc = (row - TP) & 3;
            for (int k = 0; k < win; ++k) {
                const int tt = tloc - k;
                if (tt >= 0) {
                    const uint4 u = *(const uint4*)(proj + (size_t)(row - k) * NPJ + C_U + c8);
                    const float f[8] = {bflo(u.x), bfhi(u.x), bflo(u.y), bfhi(u.y), bflo(u.z), bfhi(u.z), bflo(u.w), bfhi(u.w)};
#pragma unroll
                    for (int e = 0; e < 8; ++e) { acc[e] += f[e]; if (k == 0) self[e] = f[e]; }
                } else {
                    const float* sp = p.in[7] + ((size_t)((row - TP) >> 2) * 15 + (15 + tt)) * 1024 + c8;
                    const f32x4 s0 = *(const f32x4*)sp, s1 = *(const f32x4*)(sp + 4);
                    acc[0] += s0[0]; acc[1] += s0[1]; acc[2] += s0[2]; acc[3] += s0[3]; acc[4] += s1[0]; acc[5] += s1[1]; acc[6] += s1[2]; acc[7] += s1[3];
                }
            }
            const float ic = 1.f / (float)win;
            uint4 o; o.x = cvt_pk_bf16(acc[0] * ic - self[0], acc[1] * ic - self[1]); o.y = cvt_pk_bf16(acc[2] * ic - self[2], acc[3] * ic - self[3]);
            o.z = cvt_pk_bf16(acc[4] * ic - self[4], acc[5] * ic - self[5]); o.w = cvt_pk_bf16(acc[6] * ic - self[6], acc[7] * ic - self[7]);
            *(uint4*)(dpl + (size_t)row * LDP + c8) = o;
        }
        for (int i = bid * 512 + tid; i < SB * 11 * 256; i += G * 512) {
            const int c4 = (i & 255) * 4, rr = (i >> 8) % 11, sb = (i >> 8) / 11;
            *(f32x4*)(p.out + O_PS + ((size_t)sb * 15 + rr) * 1024 + c4) = *(const f32x4*)(p.in[7] + ((size_t)sb * 15 + rr + 4) * 1024 + c4);
        }
    }
    GRID_BAR();
    if (IN_PH(3)) { PH_LOCALS
        const int NSC = 256, NSM = 1024, NPL = 68 * 8;
        const int nsb = G >> 1;
        if (bid < nsb) {
            if (G == 256) {
                const int x = bid & 7, j = bid >> 3;
                gdn_scan_item(p, ((x * 4 + (j >> 2)) << 3) | ((j & 3) << 1) | vb, vlds);
            } else
            for (int t0 = 2 * bid; t0 < NSC; t0 += 2 * nsb) gdn_scan_item(p, min(t0 + vb, NSC - 1), vlds);
        } else {
            const int ob = bid - nsb, no = G - nsb;
            for (int t0 = 2 * ob; t0 < NSM; t0 += 2 * no) gdn_sample_item(p, min(t0 + vb, NSM - 1), vlds);
            for (int t0 = 2 * ob; t0 < NPL; t0 += 2 * no) { const int t = min(t0 + vb, NPL - 1); int nt, mt; tile_map(t, 68, 8, mt, nt); const int g = nt >> 1;
                EpiPool e{mt * 128, nt * 128, proj, p.in[15], mix};
                gemm_tile<64>(dpl + (size_t)mt * 128 * LDP + g * 256, LDP, Wt_pool + (size_t)nt * 128 * LDM, LDM, 256, vlds, e);
            }
        }
    }
    GRID_BAR();
    if (IN_PH(4)) { PH_LOCALS
        for (int i = bid * 512 + tid; i < TP * 8 * 16; i += G * 512) {
            const int l16 = i & 15, rh = i >> 4, h = rh & 7, row = rh >> 3;
            const float* op = obuf + (size_t)row * 1024 + h * 128 + l16 * 8;
            const f32x4 a = *(const f32x4*)op, b4 = *(const f32x4*)(op + 4);
            float ss = a[0] * a[0] + a[1] * a[1] + a[2] * a[2] + a[3] * a[3] + b4[0] * b4[0] + b4[1] * b4[1] + b4[2] * b4[2] + b4[3] * b4[3];
            ss += __shfl_xor(ss, 1); ss += __shfl_xor(ss, 2); ss += __shfl_xor(ss, 4); ss += __shfl_xor(ss, 8);
            const float rs = rsqrtf(ss * (1.f / 128.f) + EPS);
            const f32x4 g0 = *(const f32x4*)(p.in[13] + l16 * 8), g1 = *(const f32x4*)(p.in[13] + l16 * 8 + 4);
            const uint4 z = *(const uint4*)(proj + (size_t)row * NPJ + C_ZA + h * 128 + l16 * 8);
            uint4 o;
            o.x = cvt_pk_bf16(a[0] * rs * g0[0] * silu_f(bflo(z.x)), a[1] * rs * g0[1] * silu_f(bfhi(z.x)));
            o.y = cvt_pk_bf16(a[2] * rs * g0[2] * silu_f(bflo(z.y)), a[3] * rs * g0[3] * silu_f(bfhi(z.y)));
            o.z = cvt_pk_bf16(b4[0] * rs * g1[0] * silu_f(bflo(z.z)), b4[1] * rs * g1[1] * silu_f(bfhi(z.z)));
            o.w = cvt_pk_bf16(b4[2] * rs * g1[2] * silu_f(bflo(z.w)), b4[3] * rs * g1[3] * silu_f(bfhi(z.w)));
            *(uint4*)(mix + (size_t)row * LDB + h * 128 + l16 * 8) = o;
        }
    }
    GRID_BAR();
    if (IN_PH(5)) { PH_LOCALS
        for (int t = bid; t < 32 * 8; t += G) { int nt, mt; tile_map(t, 32, 8, mt, nt);
            EpiResid e{p.in[0] + (size_t)mt * 256 * D + nt * 256, x1 + (size_t)mt * 256 * LDB + nt * 256};
            gemm256_tile(mix + (size_t)mt * 256 * LDB, LDB, Wt_out + (size_t)nt * 256 * LDB, LDB, D, lds, e);
        }
        VLOOP(t, 8 * 32) { const int mt = t & 7, nt = t >> 3;
            EpiResid e{p.in[1] + (size_t)mt * 64 * D + nt * 64, x1 + (size_t)(TP + mt * 64) * LDB + nt * 64};
            gemm_tile<32>(mix + (size_t)(TP + mt * 64) * LDB, LDB, Wt_out + (size_t)nt * 64 * LDB, LDB, D, vlds, e);
        }
    }
    GRID_BAR();
    if (IN_PH(6)) { PH_LOCALS
    for (int r = bid * 8 + wid; r < TT; r += G * 8) rmsnorm_row_from_bf16<false>(x1 + (size_t)r * LDB, p.in[18], hbuf + (size_t)r * LDB, lane);
    }
    GRID_BAR();
    if (IN_PH(7)) { PH_LOCALS
        VLOOP(t, 8 * 32) { const int mt = t & 7, nt = t >> 3;
            EpiBf e{qx + (size_t)(TP + mt * 64) * LDB + nt * 64, LDB};
            gemm_tile<32>(hbuf + (size_t)(TP + mt * 64) * LDB, LDB, Wt_cq + (size_t)nt * 64 * LDB, LDB, D, vlds, e);
        }
    }
    GRID_BAR();
    if (IN_PH(7)) { PH_LOCALS
        const int ng = G >> 1;
        if (bid < ng) {
            for (int t = bid; t < 32 * 8; t += ng) { int nt, mt; tile_map(t, 32, 8, mt, nt);
                EpiBf e{qx + (size_t)mt * 256 * LDB + nt * 256, LDB};
                gemm256_tile(hbuf + (size_t)mt * 256 * LDB, LDB, Wt_cq + (size_t)nt * 256 * LDB, LDB, D, lds, e);
            }
        } else {
            const int ob = bid - ng, no = G - ng;
            for (int t0 = 2 * ob; t0 < 512; t0 += 2 * no) attn_sample_item(p, min(t0 + vb, 511), vlds);
        }
    }
    GRID_BAR();
    if (IN_PH(8)) { PH_LOCALS
        const int NS1 = 16 * 16 * 2;
        VLOOP(t, NS1) { const int bhd = t >> 5, v = t & 31, mt = v >> 1, nt = v & 1, b = bhd >> 2, hd = bhd & 3;
            EpiF32s e{sc + (size_t)(b * SEQ + mt * 128) * 1024 + hd * 256 + nt * 128, 1024, 0.04419417382415922f};
            gemm_tile<64>(qx + (size_t)(b * SEQ + mt * 128) * LDB + hd * 512, LDB, mkb + (size_t)(b * 256 + nt * 128) * LDB + hd * 512, LDB, 512, vlds, e);
        }
    }
    GRID_BAR();
    if (IN_PH(9)) { PH_LOCALS
    for (int r = bid * 8 + wid; r < TP * 4; r += G * 8) {
        const f32x4 v = *(const f32x4*)(sc + (size_t)r * 256 + lane * 4);
        const float mx = wave_max(fmaxf(fmaxf(v[0], v[1]), fmaxf(v[2], v[3])));
        f32x4 e; e[0] = __expf(v[0] - mx); e[1] = __expf(v[1] - mx); e[2] = __expf(v[2] - mx); e[3] = __expf(v[3] - mx);
        const float inv = 1.f / wave_sum(e[0] + e[1] + e[2] + e[3]);
        store_bf4(pb + (size_t)(r >> 2) * LDP + (r & 3) * 256 + lane * 4, e * inv);
    }
    }
    GRID_BAR();
    if (IN_PH(10)) { PH_LOCALS
        VLOOP(t, 16 * 16 * 4) { const int bhd = t >> 6, v = t & 63, mt = v >> 2, nt = v & 3, b = bhd >> 2, hd = bhd & 3;
            EpiBf e{ctx + (size_t)(b * SEQ + mt * 128) * LDB + hd * 512 + nt * 128, LDB};
            gemm_tile<64>(pb + (size_t)(b * SEQ + mt * 128) * LDP + hd * 256, LDP, mvt + ((size_t)b * D + hd * 512 + nt * 128) * LDM, LDM, 256, vlds, e);
        }
    }
    GRID_BAR();
    if (IN_PH(11)) { PH_LOCALS
        for (int t = bid; t < 32 * 8; t += G) { int nt, mt; tile_map(t, 32, 8, mt, nt);
            EpiResidB e{x1 + (size_t)mt * 256 * LDB + nt * 256, x2 + (size_t)mt * 256 * LDB + nt * 256};
            gemm256_tile(ctx + (size_t)mt * 256 * LDB, LDB, Wt_co + (size_t)nt * 256 * LDB, LDB, D, lds, e);
        }
        VLOOP(t, 8 * 32) { const int mt = t & 7, nt = t >> 3;
            EpiResidB e{x1 + (size_t)(TP + mt * 64) * LDB + nt * 64, x2 + (size_t)(TP + mt * 64) * LDB + nt * 64};
            gemm_tile<32>(ctx + (size_t)(TP + mt * 64) * LDB, LDB, Wt_co + (size_t)nt * 64 * LDB, LDB, D, vlds, e);
        }
    }
    GRID_BAR();
    if (IN_PH(12)) { PH_LOCALS
    for (int r = bid * 8 + wid; r < TT; r += G * 8) rmsnorm_row_from_bf16<true>(x2 + (size_t)r * LDB, p.in[23], p.out + (r < TP ? O_YP + (size_t)r * D : O_YS + (size_t)(r - TP) * D), lane);
    }
}

extern "C" void kernel_launch(void* const* d_in, const int* in_sizes, int n_in, void* d_out, int out_size, void* d_ws, size_t ws_size, hipStream_t stream) {
    static int grid = 0;
    if (grid == 0) {
        if (n_in != 24 || ws_size < WS_END) { fprintf(stderr, "kernel_launch: need 24 inputs and %zu bytes of workspace (got %d, %zu)\n", (size_t)WS_END, n_in, ws_size); grid = -1; return; }
        int dev = 0, cus = 0, per_cu = 0;
        hipGetDevice(&dev);
        hipDeviceGetAttribute(&cus, hipDeviceAttributeMultiprocessorCount, dev);
        if (hipOccupancyMaxActiveBlocksPerMultiprocessor(&per_cu, (const void*)hymba_fwd, 512, 0) != hipSuccess || per_cu < 1) { fprintf(stderr, "kernel_launch: occupancy query failed\n"); grid = -1; return; }
        if (per_cu > 1) per_cu = 1;
        grid = cus * per_cu;
        fprintf(stderr, "kernel_launch: grid %d (%d per CU)\n", grid, per_cu);
    }
    if (grid < 0) return;
    hipMemsetAsync((char*)d_ws + WS_BAR, 0, 16384, stream);
    Params p{};
    for (int i = 0; i < 24; ++i) p.in[i] = (const float*)d_in[i];
    p.out = (float*)d_out; p.ws = (unsigned char*)d_ws;
    if (NLAUNCH == 1) {
        p.ph_lo = 0; p.ph_hi = 13;
        void* args[] = {&p};
        hipError_t e = hipLaunchCooperativeKernel((const void*)hymba_fwd, dim3(grid), dim3(512), args, 0, stream);
        if (e != hipSuccess) fprintf(stderr, "kernel_launch: cooperative launch failed: %s (grid %d)\n", hipGetErrorString(e), grid);
    } else {
        for (int k = 0; k < 13; ++k) { p.ph_lo = k; p.ph_hi = k + 1; hipLaunchKernelGGL(hymba_fwd, dim3(grid), dim3(512), 0, stream, p); }
    }
}
```

```cpp
#include <hip/hip_runtime.h>
#include <hip/hip_cooperative_groups.h>
#include <cstdio>
#include <cstdint>

typedef unsigned short bf16_t;
typedef short bf16x8 __attribute__((ext_vector_type(8)));
typedef float f32x4 __attribute__((ext_vector_type(4)));
#define DEV __device__ __forceinline__
#define LAS __attribute__((address_space(3)))

constexpr int D = 2048, TP = 8192, TS = 512, TT = 8704, SEQ = 2048, NB = 4, SB = 128;
constexpr int NPJ = 6144;
constexpr int C_ZA = 3072, C_U = 4096, C_ZB = 5120;
constexpr int NWIN = 6272;
constexpr float EPS = 1e-6f;
constexpr int LDB = 2112, LDP = 1088, LDM = 288;

constexpr size_t O_YP = 0, O_YS = 16777216, O_MK = 17825792, O_MV = 19922944, O_DP = 22020096, O_CP = 22544384,
                 O_PP = 22581248, O_DS = 22642688, O_CS = 39419904, O_PS = 40599552;

constexpr size_t al256(size_t x) { return (x + 255) & ~(size_t)255; }
constexpr size_t WS_BAR = 0;
constexpr size_t WS_WIN = 16384;
constexpr size_t WS_WOUT = WS_WIN + (size_t)NWIN * LDB * 2;
constexpr size_t WS_WCQ = WS_WOUT + (size_t)D * LDB * 2;
constexpr size_t WS_WCO = WS_WCQ + (size_t)D * LDB * 2;
constexpr size_t WS_WCKV = WS_WCO + (size_t)D * LDB * 2;
constexpr size_t WS_WPOOL = WS_WCKV + (size_t)2 * D * LDB * 2;
constexpr size_t WS_H = WS_WPOOL + (size_t)1024 * LDM * 2;
constexpr size_t WS_HM = WS_H + (size_t)TT * LDB * 2;
constexpr size_t WS_PROJ = WS_HM + (size_t)1024 * LDB * 2;
constexpr size_t WS_AB = WS_PROJ + (size_t)TT * NPJ * 2;
constexpr size_t WS_MKB = WS_AB + (size_t)4 * TT * 16 * 4;
constexpr size_t WS_MVT = WS_MKB + (size_t)1024 * LDB * 2;
constexpr size_t WS_GW = WS_MVT + (size_t)4 * D * LDM * 2;
constexpr size_t WS_GQ = WS_GW + (size_t)1024 * 8192 * 2;
constexpr size_t WS_GKT = WS_GQ + (size_t)1024 * 8192 * 2;
constexpr size_t WS_GA = WS_GKT + (size_t)1024 * 8192 * 2;
constexpr size_t WS_GU = WS_GA + (size_t)1024 * 4096 * 2;
constexpr size_t WS_GE = WS_GU + (size_t)1024 * 8192 * 4;
constexpr size_t WS_O = WS_GE + 4096;
constexpr size_t WS_DPL = WS_O + (size_t)TP * 1024 * 4;
constexpr size_t WS_MIX = WS_DPL + (size_t)TT * LDP * 2;
constexpr size_t WS_X1 = WS_MIX + (size_t)TT * LDB * 2;
constexpr size_t WS_QX = WS_X1 + (size_t)TT * D * 4;
constexpr size_t WS_SC = WS_QX + (size_t)TT * LDB * 2;
constexpr size_t WS_PB = WS_SC + (size_t)TP * 1024 * 4;
constexpr size_t WS_CTX = WS_PB + (size_t)TP * LDP * 2;
constexpr size_t WS_X2 = WS_CTX + (size_t)TT * LDB * 2;
constexpr size_t WS_END = WS_X2 + (size_t)TT * D * 4;

#ifndef LASTP
#define LASTP 99
#endif
struct Params { const float* in[24]; float* out; unsigned char* ws; int ph_lo, ph_hi; };

typedef __bf16 bf16x2_t __attribute__((ext_vector_type(2)));
typedef float f32x2_t __attribute__((ext_vector_type(2)));
DEV unsigned cvt_pk_bf16(float lo, float hi) { const f32x2_t v = {lo, hi}; const bf16x2_t b = __builtin_convertvector(v, bf16x2_t); return __builtin_bit_cast(unsigned, b); }
DEV bf16_t f2bf(float f) { return (bf16_t)(cvt_pk_bf16(f, 0.f) & 0xffffu); }
DEV float bf2f(unsigned b) { return __uint_as_float(b << 16); }
DEV float bflo(unsigned u) { return __uint_as_float(u << 16); }
DEV float bfhi(unsigned u) { return __uint_as_float(u & 0xffff0000u); }
DEV float silu_f(float x) { return x / (1.f + __expf(-x)); }
DEV float wave_sum(float v) {
#pragma unroll
    for (int o = 32; o >= 1; o >>= 1) v += __shfl_xor(v, o);
    return v;
}
DEV float wave_max(float v) {
#pragma unroll
    for (int o = 32; o >= 1; o >>= 1) v = fmaxf(v, __shfl_xor(v, o));
    return v;
}
DEV void store_bf4(bf16_t* p, f32x4 v) { uint2 w; w.x = cvt_pk_bf16(v[0], v[1]); w.y = cvt_pk_bf16(v[2], v[3]); *(uint2*)p = w; }

#define XB_TMO      128
#define XB_XCNT(j)  (256  + 64 * (j))
#define XB_XSUB(j)  (1280 + 64 * (j))
#define XB_XGEN(j)  (2304 + 64 * (j))
#define XB_TOP      3328
#define XB_TOPGEN   3392
#define XCD_BAR_WORDS 3456
#define XB_SPIN_CAP (1u << 22)
DEV unsigned xb_ld(unsigned* p) { return __hip_atomic_load(p, __ATOMIC_RELAXED, __HIP_MEMORY_SCOPE_AGENT); }
DEV unsigned xb_add(unsigned* p, unsigned v) { return __hip_atomic_fetch_add(p, v, __ATOMIC_RELAXED, __HIP_MEMORY_SCOPE_AGENT); }
DEV unsigned xb_xcc_id() { return (unsigned)__builtin_amdgcn_s_getreg((3 << 11) | 20) & 0xFu; }
#define XB_SPIN(cond, bar) do { unsigned _sp = 0; while (cond) { __builtin_amdgcn_s_sleep(1); \
    if ((++_sp & 255u) == 0u) { if (xb_ld(&(bar)[XB_TMO])) break; if (_sp > XB_SPIN_CAP) { atomicAdd(&(bar)[XB_TMO], 1u); break; } } } } while (0)
struct XcdBarrier { unsigned* bar; unsigned x; volatile LAS unsigned* st; };
DEV XcdBarrier xcd_barrier_post(unsigned* bar, volatile LAS unsigned* st) {
    XcdBarrier b; b.bar = bar; b.x = xb_xcc_id(); b.st = st;
    if (threadIdx.x == 0) (void)xb_add(&bar[XB_XCNT(b.x)], 1u);
    return b;
}
DEV void xcd_barrier_complete(unsigned* bar, unsigned x, unsigned& nloc, unsigned& nx) {
    const unsigned G = gridDim.x;
    unsigned sum, cnt, mine, sp = 0u;
    for (;;) {
        sum = 0u; cnt = 0u; mine = 0u;
#pragma unroll
        for (unsigned j = 0; j < 16; ++j) { const unsigned c = xb_ld(&bar[XB_XCNT(j)]); sum += c; cnt += (c > 0u) ? 1u : 0u; mine = (j == x) ? c : mine; }
        if (sum == G) break;
        __builtin_amdgcn_s_sleep(1);
        if ((++sp & 255u) == 0u) { if (xb_ld(&bar[XB_TMO])) break; if (sp > XB_SPIN_CAP) { atomicAdd(&bar[XB_TMO], 1u); break; } }
    }
    nloc = mine > 0u ? mine : 1u; nx = cnt > 0u ? cnt : 1u;
}
DEV void xcd_barrier(const XcdBarrier& b) {
    asm volatile("s_waitcnt vmcnt(0)" ::: "memory");
    __syncthreads();
    if (threadIdx.x == 0) {
        unsigned* bar = b.bar;
        __builtin_amdgcn_s_waitcnt(0);
        unsigned nloc = b.st[0], nx = b.st[1];
        if (nloc == 0u) { xcd_barrier_complete(bar, b.x, nloc, nx); b.st[0] = nloc; b.st[1] = nx; }
        const unsigned old = xb_add(&bar[XB_XSUB(b.x)], 1u);
        const unsigned gen = old / nloc;
        if (old + 1u == (gen + 1u) * nloc) {
            __builtin_amdgcn_fence(__ATOMIC_RELEASE, "agent");
            asm volatile("s_waitcnt vmcnt(0)" ::: "memory");
            const unsigned og = xb_add(&bar[XB_TOP], 1u);
            const unsigned tg = og / nx;
            if (og + 1u == (tg + 1u) * nx) xb_add(&bar[XB_TOPGEN], 1u);
            else XB_SPIN(xb_ld(&bar[XB_TOPGEN]) == tg, bar);
            __builtin_amdgcn_fence(__ATOMIC_ACQUIRE, "agent");
            xb_add(&bar[XB_XGEN(b.x)], 1u);
            asm volatile("s_waitcnt vmcnt(0)" ::: "memory");
        } else {
            XB_SPIN(xb_ld(&bar[XB_XGEN(b.x)]) == gen, bar);
            __builtin_amdgcn_fence(__ATOMIC_ACQUIRE, "agent");
            asm volatile("s_waitcnt vmcnt(0)" ::: "memory");
        }
    }
    __syncthreads();
}

DEV void glds16(const void* gptr, unsigned lds_addr_lane) {
    const unsigned m = __builtin_amdgcn_readfirstlane(lds_addr_lane);
    unsigned keep;
    asm volatile("s_mov_b32 %0, m0\n\ts_mov_b32 m0, %2\n\ts_nop 0\n\tglobal_load_lds_dwordx4 %1, off\n\ts_mov_b32 m0, %0" : "=&s"(keep) : "v"(gptr), "s"(m) : "memory");
}

template <int WT, class Epi>
DEV void gemm_tile(const bf16_t* __restrict__ A, int lda, const bf16_t* __restrict__ Bt, int ldb, int K, unsigned char* lds, const Epi& epi) {
    constexpr int FI = WT / 16;
    constexpr int OPB = 2 * WT * 128;
    constexpr int STB = 2 * OPB;
    int tid = threadIdx.x & 255; asm volatile("" : "+v"(tid)); const int lane = tid & 63, wid = tid >> 6;
    const int wr = wid >> 1, wc = wid & 1, fr = lane & 15, fq = lane >> 4;
    f32x4 acc[FI][FI];
#pragma unroll
    for (int i = 0; i < FI; ++i)
#pragma unroll
        for (int j = 0; j < FI; ++j) acc[i][j] = (f32x4){0.f, 0.f, 0.f, 0.f};
    const int lrow = tid >> 3, lcs = (tid & 7) ^ (lrow & 7);
    const bf16_t* ap = A + (size_t)lrow * lda + lcs * 8;
    const bf16_t* bp = Bt + (size_t)lrow * ldb + lcs * 8;
    const unsigned l3a = (unsigned)(size_t)(LAS unsigned char*)lds;
    const int nk = K >> 6;
#define GLDS_STAGE(st, kt_) do { \
        _Pragma("unroll") for (int i_ = 0; i_ < FI; ++i_) { \
            glds16(ap + (size_t)(32 * i_) * lda + (kt_) * 64, l3a + (st) + tid * 16 + i_ * 4096); \
            glds16(bp + (size_t)(32 * i_) * ldb + (kt_) * 64, l3a + (st) + OPB + tid * 16 + i_ * 4096); } } while (0)
    constexpr int NSTG = 65536 / STB;
#pragma unroll
    for (int s_ = 0; s_ < NSTG - 1; ++s_) if (s_ < nk) GLDS_STAGE(s_ * STB, s_);
    const int aoff = (wr * WT + fr) * 128, boff = OPB + (wc * WT + fr) * 128, sw = fr & 7;
    int cur = 0, nxt = (NSTG - 1) * STB;
    for (int kt = 0; kt < nk; ++kt) {
        if (NSTG == 4 && kt + 2 < nk) { if (FI == 2) asm volatile("s_waitcnt vmcnt(8)" ::: "memory"); else asm volatile("s_waitcnt vmcnt(0)" ::: "memory"); }
        else asm volatile("s_waitcnt vmcnt(0)" ::: "memory");
        __syncthreads();
        if (kt + NSTG - 1 < nk) GLDS_STAGE(nxt, kt + NSTG - 1);
#pragma unroll
        for (int kh = 0; kh < 2; ++kh) {
            bf16x8 af[FI], bfr[FI];
            const int ch = ((kh * 4 + fq) ^ sw) << 4;
#pragma unroll
            for (int i = 0; i < FI; ++i) { af[i] = *(const bf16x8*)(lds + cur + aoff + i * 2048 + ch); bfr[i] = *(const bf16x8*)(lds + cur + boff + i * 2048 + ch); }
#pragma unroll
            for (int mi = 0; mi < FI; ++mi)
#pragma unroll
                for (int ni = 0; ni < FI; ++ni) acc[mi][ni] = __builtin_amdgcn_mfma_f32_16x16x32_bf16(bfr[ni], af[mi], acc[mi][ni], 0, 0, 0);
        }
        nxt = cur; cur += STB; if (cur == NSTG * STB) cur = 0;
    }
#undef GLDS_STAGE
    __syncthreads();
#pragma unroll
    for (int mi = 0; mi < FI; ++mi)
#pragma unroll
        for (int ni = 0; ni < FI; ++ni) epi(wr * WT + mi * 16 + fr, wc * WT + ni * 16 + fq * 4, acc[mi][ni]);
}

template <class Epi>
DEV void gemm256_tile(const bf16_t* __restrict__ A, int lda, const bf16_t* __restrict__ Bt, int ldb, int K, unsigned char* lds, const Epi& epi) {
    int tid = threadIdx.x; asm volatile("" : "+v"(tid)); const int lane = tid & 63, wid = tid >> 6;
    const int wr = wid >> 2, wc = wid & 3, fr = lane & 15, fq = lane >> 4;
    f32x4 acc[8][4];
#pragma unroll
    for (int i = 0; i < 8; ++i)
#pragma unroll
        for (int j = 0; j < 4; ++j) acc[i][j] = (f32x4){0.f, 0.f, 0.f, 0.f};
    const int lrow = tid >> 3, lcs = (tid & 7) ^ (lrow & 7);
    const bf16_t* ap = A + (size_t)lrow * lda + lcs * 8;
    const bf16_t* bp = Bt + (size_t)lrow * ldb + lcs * 8;
    const unsigned l3a = (unsigned)(size_t)(LAS unsigned char*)lds;
    const int nk = K >> 6;
#define GLDS_STAGE(st, kt_) do { \
        _Pragma("unroll") for (int i_ = 0; i_ < 4; ++i_) { \
            glds16(ap + (size_t)(64 * i_) * lda + (kt_) * 64, l3a + (st) + tid * 16 + i_ * 8192); \
            glds16(bp + (size_t)(64 * i_) * ldb + (kt_) * 64, l3a + (st) + 32768 + tid * 16 + i_ * 8192); } } while (0)
    GLDS_STAGE(0, 0);
    const int aoff = (wr * 128 + fr) * 128, boff = 32768 + (wc * 64 + fr) * 128, sw = fr & 7;
    for (int kt = 0; kt < nk; ++kt) {
        const int cur = (kt & 1) * 65536;
        asm volatile("s_waitcnt vmcnt(0)" ::: "memory");
        __syncthreads();
        if (kt + 1 < nk) GLDS_STAGE(cur ^ 65536, kt + 1);
#pragma unroll
        for (int kh = 0; kh < 2; ++kh) {
            bf16x8 bfr[4];
            const int ch = ((kh * 4 + fq) ^ sw) << 4;
#pragma unroll
            for (int i = 0; i < 4; ++i) bfr[i] = *(const bf16x8*)(lds + cur + boff + i * 2048 + ch);
#pragma unroll
            for (int mh = 0; mh < 2; ++mh) {
                bf16x8 af[4];
#pragma unroll
                for (int i = 0; i < 4; ++i) af[i] = *(const bf16x8*)(lds + cur + aoff + (mh * 4 + i) * 2048 + ch);
#pragma unroll
                for (int mi = 0; mi < 4; ++mi)
#pragma unroll
                    for (int ni = 0; ni < 4; ++ni) acc[mh * 4 + mi][ni] = __builtin_amdgcn_mfma_f32_16x16x32_bf16(bfr[ni], af[mi], acc[mh * 4 + mi][ni], 0, 0, 0);
            }
        }
    }
#undef GLDS_STAGE
    __syncthreads();
#pragma unroll
    for (int mi = 0; mi < 8; ++mi)
#pragma unroll
        for (int ni = 0; ni < 4; ++ni) epi(wr * 128 + mi * 16 + fr, wc * 64 + ni * 16 + fq * 4, acc[mi][ni]);
}

DEV void ab_rows16(const bf16_t* __restrict__ h, const bf16_t* __restrict__ wab, float* __restrict__ ab4, int rt, int kq, int lane) {
    const int fr = lane & 15, fq = lane >> 4;
    const bf16_t* ap = h + (size_t)(rt * 16 + fr) * LDB + kq * 512 + fq * 8;
    const bf16_t* bp = wab + (size_t)fr * LDB + kq * 512 + fq * 8;
    bf16x8 a[16], b[16];
#pragma unroll
    for (int s = 0; s < 16; ++s) { a[s] = *(const bf16x8*)(ap + s * 32); b[s] = *(const bf16x8*)(bp + s * 32); }
    f32x4 acc = {0.f, 0.f, 0.f, 0.f};
#pragma unroll
    for (int s = 0; s < 16; ++s) acc = __builtin_amdgcn_mfma_f32_16x16x32_bf16(b[s], a[s], acc, 0, 0, 0);
    *(f32x4*)(ab4 + (size_t)kq * TT * 16 + (size_t)(rt * 16 + fr) * 16 + fq * 4) = acc;
}

DEV void tile_map(int L, int nM, int nN, int& pm, int& pn) {
    const int T = nM * nN, q = T >> 3, r = T & 7, xcd = L & 7, off = L >> 3;
    const int w = (xcd < r ? xcd * (q + 1) : r * (q + 1) + (xcd - r) * q) + off;
    const int nig = 8 * nN, gid = w / nig, fm = gid * 8, gsz = (nM - fm) < 8 ? (nM - fm) : 8;
    pm = fm + (w % nig) % gsz; pn = (w % nig) / gsz;
}

struct EpiProj {
    int m0, n0; bf16_t* proj; float* ab; float* out;
    DEV void operator()(int r, int c, f32x4 v) const {
        const int row = m0 + r, col = n0 + c;
        if (col < NPJ) {
            store_bf4(proj + (size_t)row * NPJ + col, v);
            const bool isconv = col < 3072, ispool = (col >= C_U && col < C_ZB);
            if (isconv || ispool) {
                if (row < TP) {
                    const int b = row >> 11, t = row & 2047;
                    if (isconv) { if (t >= 2045) *(f32x4*)(out + O_CP + ((size_t)(b * 3 + (t - 2045))) * 3072 + col) = v; }
                    else { if (t >= 2033) *(f32x4*)(out + O_PP + ((size_t)(b * 15 + (t - 2033))) * 1024 + (col - C_U)) = v; }
                } else {
                    const int sb = (row - TP) >> 2, t = (row - TP) & 3;
                    if (isconv) { if (t >= 1) *(f32x4*)(out + O_CS + ((size_t)(sb * 3 + (t - 1))) * 3072 + col) = v; }
                    else *(f32x4*)(out + O_PS + ((size_t)(sb * 15 + 11 + t)) * 1024 + (col - C_U)) = v;
                }
            }
        } else if (col < NPJ + 16) {
            *(f32x4*)(ab + (size_t)row * 16 + (col - NPJ)) = v;
        }
    }
};
struct EpiMKV {
    int m0, n0; bf16_t* mkb; bf16_t* mvt; float* out;
    DEV void operator()(int r, int c, f32x4 v) const {
        const int row = m0 + r, col = n0 + c;
        if (col < D) {
            *(f32x4*)(out + O_MK + (size_t)row * D + col) = v;
            store_bf4(mkb + (size_t)row * LDB + col, v);
        } else {
            const int cc = col - D, b = row >> 8, m = row & 255;
            *(f32x4*)(out + O_MV + (size_t)row * D + cc) = v;
            bf16_t* p = mvt + ((size_t)b * D + cc) * LDM + m;
            p[0] = f2bf(v[0]); p[LDM] = f2bf(v[1]); p[2 * LDM] = f2bf(v[2]); p[3 * LDM] = f2bf(v[3]);
        }
    }
};
struct EpiPool {
    int m0, n0; const bf16_t* proj; const float* scale; bf16_t* mix;
    DEV void operator()(int r, int c, f32x4 v) const {
        const int row = m0 + r, col = n0 + c;
        const uint2 z = *(const uint2*)(proj + (size_t)row * NPJ + C_ZB + col);
        const f32x4 s = *(const f32x4*)(scale + col);
        f32x4 o;
        o[0] = v[0] * s[0] * silu_f(bflo(z.x)); o[1] = v[1] * s[1] * silu_f(bfhi(z.x));
        o[2] = v[2] * s[2] * silu_f(bflo(z.y)); o[3] = v[3] * s[3] * silu_f(bfhi(z.y));
        store_bf4(mix + (size_t)row * LDB + 1024 + col, o);
    }
};
struct EpiResid {
    const float* res; bf16_t* dst;
    DEV void operator()(int r, int c, f32x4 v) const {
        const f32x4 x = __builtin_nontemporal_load((const f32x4*)(res + (size_t)r * D + c));
        store_bf4(dst + (size_t)r * LDB + c, x + v);
    }
};
struct EpiResidB {
    const bf16_t* res; bf16_t* dst;
    DEV void operator()(int r, int c, f32x4 v) const {
        const uint2 u = *(const uint2*)(res + (size_t)r * LDB + c);
        f32x4 x; x[0] = bflo(u.x); x[1] = bfhi(u.x); x[2] = bflo(u.y); x[3] = bfhi(u.y);
        store_bf4(dst + (size_t)r * LDB + c, x + v);
    }
};
struct EpiBf {
    bf16_t* dst; int ld;
    DEV void operator()(int r, int c, f32x4 v) const { store_bf4(dst + (size_t)r * ld + c, v); }
};
struct EpiF32s {
    float* dst; int ld; float s;
    DEV void operator()(int r, int c, f32x4 v) const { *(f32x4*)(dst + (size_t)r * ld + c) = v * s; }
};

DEV int win_srccol(int n) { return n < 4096 ? n : (n < 6144 ? n + 16 : (n < 6160 ? 4096 + (n - 6144) : -1)); }
DEV void transpose_tile(const float* __restrict__ src, int ld, int srccol0, bool remap, int k0, bf16_t* __restrict__ dstrow0, int ldd, float* tile) {
    int tid = threadIdx.x & 255; asm volatile("" : "+v"(tid));
    const int tx = tid & 63, ty = tid >> 6;
    const int sc = remap ? win_srccol(srccol0 + tx) : (srccol0 + tx);
    float tv[32];
#pragma unroll
    for (int i = 0; i < 32; ++i) tv[i] = sc >= 0 ? __builtin_nontemporal_load(src + (size_t)(k0 + ty + 4 * i) * ld + sc) : 0.f;
#pragma unroll
    for (int i = 0; i < 32; ++i) tile[(ty + 4 * i) * 65 + tx] = tv[i];
    __syncthreads();
#pragma unroll
    for (int i = 0; i < 16; ++i) { const int r = ty + 4 * i; *(unsigned*)(dstrow0 + (size_t)r * ldd + k0 + 2 * tx) = cvt_pk_bf16(tile[(2 * tx) * 65 + r], tile[(2 * tx + 1) * 65 + r]); }
    __syncthreads();
}
DEV void rmsnorm_row_bf16(const float* __restrict__ x, const float* __restrict__ g, bf16_t* __restrict__ y, int lane) {
    f32x4 v[8]; float ss = 0.f;
#pragma unroll
    for (int i = 0; i < 8; ++i) { v[i] = ((const f32x4*)x)[i * 64 + lane]; ss += v[i][0] * v[i][0] + v[i][1] * v[i][1] + v[i][2] * v[i][2] + v[i][3] * v[i][3]; }
    ss = wave_sum(ss);
    const float rs = rsqrtf(ss * (1.f / 2048.f) + EPS);
#pragma unroll
    for (int i = 0; i < 8; ++i) { const f32x4 gg = ((const f32x4*)g)[i * 64 + lane]; store_bf4(y + (size_t)(i * 64 + lane) * 4, v[i] * rs * gg); }
}
template <bool OUT_F32>
DEV void rmsnorm_row_from_bf16(const bf16_t* __restrict__ x, const float* __restrict__ g, void* __restrict__ y, int lane) {
    float v[4][8]; float ss = 0.f;
#pragma unroll
    for (int i = 0; i < 4; ++i) { const uint4 u = ((const uint4*)x)[i * 64 + lane];
        v[i][0] = bflo(u.x); v[i][1] = bfhi(u.x); v[i][2] = bflo(u.y); v[i][3] = bfhi(u.y); v[i][4] = bflo(u.z); v[i][5] = bfhi(u.z); v[i][6] = bflo(u.w); v[i][7] = bfhi(u.w);
#pragma unroll
        for (int e = 0; e < 8; ++e) ss += v[i][e] * v[i][e]; }
    ss = wave_sum(ss);
    const float rs = rsqrtf(ss * (1.f / 2048.f) + EPS);
#pragma unroll
    for (int i = 0; i < 4; ++i) {
        const f32x4 g0 = ((const f32x4*)g)[(i * 64 + lane) * 2], g1 = ((const f32x4*)g)[(i * 64 + lane) * 2 + 1];
        const f32x4 o0 = (f32x4){v[i][0], v[i][1], v[i][2], v[i][3]} * rs * g0, o1 = (f32x4){v[i][4], v[i][5], v[i][6], v[i][7]} * rs * g1;
        if (OUT_F32) { __builtin_nontemporal_store(o0, (f32x4*)y + (i * 64 + lane) * 2); __builtin_nontemporal_store(o1, (f32x4*)y + (i * 64 + lane) * 2 + 1); }
        else { uint4 w; w.x = cvt_pk_bf16(o0[0], o0[1]); w.y = cvt_pk_bf16(o0[2], o0[3]); w.z = cvt_pk_bf16(o1[0], o1[1]); w.w = cvt_pk_bf16(o1[2], o1[3]); ((uint4*)y)[i * 64 + lane] = w; }
    }
}
DEV void rmsnorm_row_f32(const float* __restrict__ x, const float* __restrict__ g, float* __restrict__ y, int lane) {
    f32x4 v[8]; float ss = 0.f;
#pragma unroll
    for (int i = 0; i < 8; ++i) { v[i] = ((const f32x4*)x)[i * 64 + lane]; ss += v[i][0] * v[i][0] + v[i][1] * v[i][1] + v[i][2] * v[i][2] + v[i][3] * v[i][3]; }
    ss = wave_sum(ss);
    const float rs = rsqrtf(ss * (1.f / 2048.f) + EPS);
#pragma unroll
    for (int i = 0; i < 8; ++i) { const f32x4 gg = ((const f32x4*)g)[i * 64 + lane]; __builtin_nontemporal_store(v[i] * rs * gg, (f32x4*)y + i * 64 + lane); }
}

constexpr int QS = 136;
DEV void gdn_prep_chunk(const Params& p, int item, unsigned char* lds) {
    int tid = threadIdx.x & 255; asm volatile("" : "+v"(tid)); const int lane = tid & 63, wid = tid >> 6;
    const int c = item & 31, h = (item >> 5) & 7, b = item >> 8;
    const int row0 = b * SEQ + c * 64;
    const bf16_t* proj = (const bf16_t*)(p.ws + WS_PROJ);
    const float* ab = (const float*)(p.ws + WS_AB);
    bf16_t* qs = (bf16_t*)lds; bf16_t* ks = qs + 64 * QS; bf16_t* vs = ks + 64 * QS;
    float* lowT = (float*)lds;
    float* gcs = (float*)(lds + 3 * 64 * QS * 2);
    float* bts = gcs + 64;
    bf16_t* gW = (bf16_t*)(p.ws + WS_GW) + (size_t)item * 8192;
    bf16_t* gQ = (bf16_t*)(p.ws + WS_GQ) + (size_t)item * 8192;
    bf16_t* gKT = (bf16_t*)(p.ws + WS_GKT) + (size_t)item * 8192;
    bf16_t* gA = (bf16_t*)(p.ws + WS_GA) + (size_t)item * 4096;
    float* gU = (float*)(p.ws + WS_GU) + (size_t)item * 8192;
    float* gE = (float*)(p.ws + WS_GE) + item;

    if (wid == 3) {
        float a = 0.f, bb = 0.f;
#pragma unroll
        for (int kq = 0; kq < 4; ++kq) { a += ab[(size_t)kq * TT * 16 + (size_t)(row0 + lane) * 16 + h]; bb += ab[(size_t)kq * TT * 16 + (size_t)(row0 + lane) * 16 + 8 + h]; }
        const float xx = a + p.in[12][h];
        const float sp = xx > 20.f ? xx : log1pf(__expf(xx));
        float s = -__expf(p.in[11][h]) * sp;
#pragma unroll
        for (int d = 1; d < 64; d <<= 1) { const float t = __shfl_up(s, d); if (lane >= d) s += t; }
        gcs[lane] = s; bts[lane] = 1.f / (1.f + __expf(-bb));
    } else {
        const int mat = wid, rg = lane >> 4, cv = lane & 15;
        const int colg = mat * 1024 + h * 128 + cv * 8;
        const float* cw = p.in[10];
        float w[4][8];
#pragma unroll
        for (int j = 0; j < 4; ++j) { const f32x4 w0 = *(const f32x4*)(cw + j * 3072 + colg), w1 = *(const f32x4*)(cw + j * 3072 + colg + 4);
            w[j][0] = w0[0]; w[j][1] = w0[1]; w[j][2] = w0[2]; w[j][3] = w0[3]; w[j][4] = w1[0]; w[j][5] = w1[1]; w[j][6] = w1[2]; w[j][7] = w1[3]; }
        const int tl0 = rg * 16;
        uint4 raw[19];
#pragma unroll
        for (int i = 0; i < 19; ++i) {
            const int tl = tl0 - 3 + i;
            if (c * 64 + tl >= 0) raw[i] = *(const uint4*)(proj + (size_t)(row0 + tl) * NPJ + colg);
            else raw[i] = make_uint4(0u, 0u, 0u, 0u);
        }
        bf16_t* dst = (mat == 0 ? qs : (mat == 1 ? ks : vs));
#pragma unroll
        for (int r = 0; r < 16; ++r) {
            float y[8]; float ss = 0.f;
#pragma unroll
            for (int e = 0; e < 8; ++e) {
                float a = 0.f;
#pragma unroll
                for (int j = 0; j < 4; ++j) {
                    const uint4 u = raw[r + j];
                    const unsigned wd = (e < 2 ? u.x : (e < 4 ? u.y : (e < 6 ? u.z : u.w)));
                    const float xv = (e & 1) ? bfhi(wd) : bflo(wd);
                    a += w[j][e] * xv;
                }
                y[e] = silu_f(a); ss += y[e] * y[e];
            }
            if (mat < 2) {
                ss += __shfl_xor(ss, 1); ss += __shfl_xor(ss, 2); ss += __shfl_xor(ss, 4); ss += __shfl_xor(ss, 8);
                float inv = rsqrtf(ss + EPS); if (mat == 0) inv *= 0.08838834764831845f;
#pragma unroll
                for (int e = 0; e < 8; ++e) y[e] *= inv;
            }
            uint4 o; o.x = cvt_pk_bf16(y[0], y[1]); o.y = cvt_pk_bf16(y[2], y[3]); o.z = cvt_pk_bf16(y[4], y[5]); o.w = cvt_pk_bf16(y[6], y[7]);
            *(uint4*)(dst + (tl0 + r) * QS + cv * 8) = o;
        }
    }
    __syncthreads();
    {
        const float glast = gcs[63];
        if (tid == 0) *gE = __expf(glast);
#pragma unroll
        for (int i = 0; i < 4; ++i) {
            const int ci = tid + 256 * i, t = ci >> 4, cc = (ci & 15) * 8;
            const uint4 u = *(const uint4*)(qs + t * QS + cc);
            const float e = __expf(gcs[t]);
            uint4 o; o.x = cvt_pk_bf16(bflo(u.x) * e, bfhi(u.x) * e); o.y = cvt_pk_bf16(bflo(u.y) * e, bfhi(u.y) * e);
            o.z = cvt_pk_bf16(bflo(u.z) * e, bfhi(u.z) * e); o.w = cvt_pk_bf16(bflo(u.w) * e, bfhi(u.w) * e);
            *(uint4*)(gQ + (cc >> 5) * 2048 + t * 32 + (cc & 31)) = o;
        }
        const float dk = __expf(glast - gcs[lane]);
#pragma unroll 8
        for (int i = 0; i < 32; ++i) { const int d = wid * 32 + i; gKT[(lane >> 5) * 4096 + d * 32 + (lane & 31)] = f2bf(bf2f(ks[lane * QS + d]) * dk);     }
    }
    f32x4 kk[4], qk[4];
    {
        const int fr = lane & 15, fq = lane >> 4, it = wid;
        bf16x8 kfi[4], qfi[4];
#pragma unroll
        for (int s = 0; s < 4; ++s) { kfi[s] = *(const bf16x8*)(ks + (it * 16 + fr) * QS + s * 32 + fq * 8); qfi[s] = *(const bf16x8*)(qs + (it * 16 + fr) * QS + s * 32 + fq * 8); }
#pragma unroll
        for (int jt = 0; jt < 4; ++jt) {
            kk[jt] = (f32x4){0.f, 0.f, 0.f, 0.f}; qk[jt] = (f32x4){0.f, 0.f, 0.f, 0.f};
#pragma unroll
            for (int s = 0; s < 4; ++s) {
                const bf16x8 kfj = *(const bf16x8*)(ks + (jt * 16 + fr) * QS + s * 32 + fq * 8);
                kk[jt] = __builtin_amdgcn_mfma_f32_16x16x32_bf16(kfi[s], kfj, kk[jt], 0, 0, 0);
                qk[jt] = __builtin_amdgcn_mfma_f32_16x16x32_bf16(kfj, qfi[s], qk[jt], 0, 0, 0);
            }
        }
    }
    __syncthreads();
    {
        const int fr = lane & 15, fq = lane >> 4, it = wid;
#pragma unroll
        for (int jt = 0; jt < 4; ++jt) {
            const int j = jt * 16 + fr; const float gj = gcs[j];
            f32x4 lv;
#pragma unroll
            for (int e = 0; e < 4; ++e) { const int i = it * 16 + fq * 4 + e; lv[e] = (i > j) ? bts[i] * kk[jt][e] * __expf(gcs[i] - gj) : 0.f; }
            *(f32x4*)(lowT + j * 68 + it * 16 + fq * 4) = lv;
            const int i2 = it * 16 + fr; const float gi = gcs[i2];
            f32x4 av;
#pragma unroll
            for (int e = 0; e < 4; ++e) { const int j2 = jt * 16 + fq * 4 + e; av[e] = (i2 >= j2) ? qk[jt][e] * __expf(gi - gcs[j2]) : 0.f; }
            store_bf4(gA + (jt >> 1) * 2048 + i2 * 32 + (jt & 1) * 16 + fq * 4, av);
        }
    }
    __syncthreads();
    {
        const int cc = tid & 127; const bool isw = tid >= 128;
        bf16_t* src = isw ? ks : vs;
#pragma unroll 1
        for (int ib = 0; ib < 4; ++ib) {
            f32x2_t acc[8];
#pragma unroll
            for (int r = 0; r < 16; ++r) { const int j = ib * 16 + r; float f = bts[j]; if (isw) f *= __expf(gcs[j]); acc[r >> 1][r & 1] = f * bf2f(src[j * QS + cc]); }
            const float* lrow = lowT + ib * 16;
#pragma unroll 4
            for (int j = 0; j < ib * 16; ++j) {
                const float xj = -bf2f(src[j * QS + cc]); const f32x2_t nx = {xj, xj};
                const f32x4 l0 = *(const f32x4*)(lrow + j * 68), l1 = *(const f32x4*)(lrow + j * 68 + 4), l2 = *(const f32x4*)(lrow + j * 68 + 8), l3 = *(const f32x4*)(lrow + j * 68 + 12);
                acc[0] += (f32x2_t){l0[0], l0[1]} * nx; acc[1] += (f32x2_t){l0[2], l0[3]} * nx; acc[2] += (f32x2_t){l1[0], l1[1]} * nx; acc[3] += (f32x2_t){l1[2], l1[3]} * nx;
                acc[4] += (f32x2_t){l2[0], l2[1]} * nx; acc[5] += (f32x2_t){l2[2], l2[3]} * nx; acc[6] += (f32x2_t){l3[0], l3[1]} * nx; acc[7] += (f32x2_t){l3[2], l3[3]} * nx;
            }
#pragma unroll
            for (int r2 = 0; r2 < 15; ++r2) {
                asm volatile("" ::: "memory");
                const float xj = -acc[r2 >> 1][r2 & 1]; const f32x2_t nx = {xj, xj};
                const float* lp = lrow + (ib * 16 + r2) * 68;
#pragma unroll
                for (int q = (r2 + 1) >> 2; q < 4; ++q) {
                    const f32x4 l = *(const f32x4*)(lp + q * 4);
                    acc[2 * q] += (f32x2_t){l[0], l[1]} * nx; acc[2 * q + 1] += (f32x2_t){l[2], l[3]} * nx;
                }
            }
#pragma unroll
            for (int r = 0; r < 16; ++r) {
                const int j = ib * 16 + r; const float xv = acc[r >> 1][r & 1]; const bf16_t xb = f2bf(xv);
                src[j * QS + cc] = xb;
                if (isw) gW[(cc >> 5) * 2048 + j * 32 + (cc & 31)] = xb;
                else gU[(((((cc >> 4) * 4 + (j >> 4)) * 4 + (j & 3)) * 4 + ((j >> 2) & 3)) << 4) + (cc & 15)] = xv;
            }
        }
    }
    __syncthreads();
}

#define LDS_BARRIER() do { asm volatile("s_waitcnt lgkmcnt(0)" ::: "memory"); __builtin_amdgcn_s_barrier(); asm volatile("" ::: "memory"); } while (0)
struct ScanEarly { bf16x8 w[4], q[4]; f32x4 u; };
struct ScanLate { bf16x8 a[2], k0[2], k1[2]; };
DEV void gdn_scan_item(const Params& p, int item, unsigned char* lds) {
    int tid = threadIdx.x & 255; asm volatile("" : "+v"(tid)); const int lane = tid & 63, w = tid >> 6, fr = lane & 15, fq = lane >> 4;
    const int s = item & 7, bh = item >> 3;
    const int b = bh >> 3, h = bh & 7;
    bf16_t* ST = (bf16_t*)lds;
    bf16_t* VT = ST + 16 * QS;
    const char* bW = (const char*)((const bf16_t*)(p.ws + WS_GW) + (size_t)bh * 32 * 8192);
    const char* bQ = (const char*)((const bf16_t*)(p.ws + WS_GQ) + (size_t)bh * 32 * 8192);
    const char* bK = (const char*)((const bf16_t*)(p.ws + WS_GKT) + (size_t)bh * 32 * 8192);
    const char* bA = (const char*)((const bf16_t*)(p.ws + WS_GA) + (size_t)bh * 32 * 4096);
    const char* bU = (const char*)((const float*)(p.ws + WS_GU) + (size_t)bh * 32 * 8192);
    const float* gE = (const float*)(p.ws + WS_GE) + bh * 32;
    float* obuf = (float*)(p.ws + WS_O);
    f32x4 S0 = {0.f, 0.f, 0.f, 0.f}, S1 = {0.f, 0.f, 0.f, 0.f};
    for (int i = tid; i < 16 * QS / 2; i += 256) ((unsigned*)ST)[i] = 0u;
    const float egv = gE[lane & 31];
    const unsigned offWQ = (unsigned)(((w * 16 + fr) * 32 + fq * 8) * 2), offA = offWQ;
    const unsigned offK = (unsigned)(((w * 32 + fr) * 32 + fq * 8) * 2), offU = (unsigned)((((s * 4 + w) * 16 + fq) * 16 + fr) * 4);
    ScanEarly E0, E1, E2; ScanLate L0, L1;
#define LOAD_E(F, ch) do { \
        const char* W_ = bW + (size_t)(ch) * 16384; const char* Q_ = bQ + (size_t)(ch) * 16384; \
        _Pragma("unroll") for (int k_ = 0; k_ < 4; ++k_) { F.w[k_] = *(const bf16x8*)(W_ + (offWQ + k_ * 4096)); F.q[k_] = *(const bf16x8*)(Q_ + (offWQ + k_ * 4096)); } \
        const char* U_ = bU + (size_t)(ch) * 32768; F.u[0] = *(const float*)(U_ + offU); F.u[1] = *(const float*)(U_ + (offU + 256)); F.u[2] = *(const float*)(U_ + (offU + 512)); F.u[3] = *(const float*)(U_ + (offU + 768)); \
        } while (0)
#define LOAD_L(F, ch) do { \
        const char* A_ = bA + (size_t)(ch) * 8192; F.a[0] = *(const bf16x8*)(A_ + offA); F.a[1] = *(const bf16x8*)(A_ + (offA + 4096)); \
        const char* K_ = bK + (size_t)(ch) * 16384; F.k0[0] = *(const bf16x8*)(K_ + offK); F.k0[1] = *(const bf16x8*)(K_ + (offK + 8192)); \
        F.k1[0] = *(const bf16x8*)(K_ + (offK + 1024)); F.k1[1] = *(const bf16x8*)(K_ + (offK + 1024 + 8192)); \
        } while (0)
#define SCAN_STEP(X, XL, Y, YL, ch) do { \
        if ((ch) + 2 < 32) LOAD_E(XL, (ch) + 2); \
        if ((ch) + 1 < 32) LOAD_L(YL, (ch) + 1); \
        const float ceg = __builtin_bit_cast(float, __builtin_amdgcn_readlane(__builtin_bit_cast(int, egv), (ch))); \
        f32x4 ws_ = {0.f, 0.f, 0.f, 0.f}, oo = {0.f, 0.f, 0.f, 0.f}; \
        _Pragma("unroll") for (int k = 0; k < 4; ++k) { \
            const bf16x8 sf = *(const bf16x8*)(ST + fr * QS + k * 32 + fq * 8); \
            ws_ = __builtin_amdgcn_mfma_f32_16x16x32_bf16(X.w[k], sf, ws_, 0, 0, 0); \
            oo = __builtin_amdgcn_mfma_f32_16x16x32_bf16(X.q[k], sf, oo, 0, 0, 0); } \
        store_bf4(VT + fr * 72 + w * 16 + fq * 4, X.u - ws_); \
        LDS_BARRIER(); \
        const bf16x8 v0 = *(const bf16x8*)(VT + fr * 72 + fq * 8), v1 = *(const bf16x8*)(VT + fr * 72 + 32 + fq * 8); \
        oo = __builtin_amdgcn_mfma_f32_16x16x32_bf16(Y.a[0], v0, oo, 0, 0, 0); \
        oo = __builtin_amdgcn_mfma_f32_16x16x32_bf16(Y.a[1], v1, oo, 0, 0, 0); \
        S0 = S0 * ceg; S1 = S1 * ceg; \
        S0 = __builtin_amdgcn_mfma_f32_16x16x32_bf16(Y.k0[0], v0, S0, 0, 0, 0); \
        S0 = __builtin_amdgcn_mfma_f32_16x16x32_bf16(Y.k0[1], v1, S0, 0, 0, 0); \
        S1 = __builtin_amdgcn_mfma_f32_16x16x32_bf16(Y.k1[0], v0, S1, 0, 0, 0); \
        S1 = __builtin_amdgcn_mfma_f32_16x16x32_bf16(Y.k1[1], v1, S1, 0, 0, 0); \
        store_bf4(ST + fr * QS + w * 32 + fq * 4, S0); \
        store_bf4(ST + fr * QS + w * 32 + 16 + fq * 4, S1); \
        { float* op = obuf + (size_t)(b * SEQ + (ch) * 64 + w * 16 + fq * 4) * 1024 + h * 128 + s * 16 + fr; \
          op[0] = oo[0]; op[1024] = oo[1]; op[2048] = oo[2]; op[3072] = oo[3]; } \
        LDS_BARRIER(); } while (0)
    LOAD_E(E0, 0); LOAD_L(L0, 0); LOAD_E(E1, 1);
    __syncthreads();
    for (int ch = 0; ch < 30; ch += 6) {
        SCAN_STEP(E0, E2, L0, L1, ch);     SCAN_STEP(E1, E0, L1, L0, ch + 1); SCAN_STEP(E2, E1, L0, L1, ch + 2);
        SCAN_STEP(E0, E2, L1, L0, ch + 3); SCAN_STEP(E1, E0, L0, L1, ch + 4); SCAN_STEP(E2, E1, L1, L0, ch + 5);
    }
    SCAN_STEP(E0, E2, L0, L1, 30); SCAN_STEP(E1, E0, L1, L0, 31);
#undef SCAN_STEP
#undef LOAD_E
#undef LOAD_L
    {
        float* dp = p.out + O_DP + ((size_t)bh * 128 + w * 32 + fq * 4) * 128 + s * 16 + fr;
#pragma unroll
        for (int e = 0; e < 4; ++e) { dp[e * 128] = S0[e]; dp[(16 + e) * 128] = S1[e]; }
    }
    __syncthreads();
}

DEV void gdn_sample_item(const Params& p, int item, unsigned char* lds) {
    int tid = threadIdx.x & 255; asm volatile("" : "+v"(tid)); const int lane = tid & 63, wid = tid >> 6;
    const int sb = item >> 3, h = item & 7, half = tid >> 7, c = tid & 127;
    const int r0 = TP + sb * 4;
    const bf16_t* proj = (const bf16_t*)(p.ws + WS_PROJ);
    const float* ab = (const float*)(p.ws + WS_AB);
    float* ksh = (float*)lds;
    float* qsh = ksh + 512;
    float* red = qsh + 512;
    float* red2 = red + 32;
    float* part = red2 + 32;
    float* opart = part + 1024;
    float qv[4], kv[4], vv[4];
#pragma unroll
    for (int m = 0; m < 3; ++m) {
        const int col = m * 1024 + h * 128 + c;
        float x[7], wj[4];
#pragma unroll
        for (int j = 0; j < 3; ++j) x[j] = p.in[6][((size_t)sb * 3 + j) * 3072 + col];
#pragma unroll
        for (int t = 0; t < 4; ++t) x[3 + t] = bf2f(proj[(size_t)(r0 + t) * NPJ + col]);
#pragma unroll
        for (int j = 0; j < 4; ++j) wj[j] = p.in[10][j * 3072 + col];
#pragma unroll
        for (int t = 0; t < 4; ++t) {
            const float y = silu_f(wj[0] * x[t] + wj[1] * x[t + 1] + wj[2] * x[t + 2] + wj[3] * x[t + 3]);
            if (m == 0) qv[t] = y; else if (m == 1) kv[t] = y; else vv[t] = y;
        }
    }
#pragma unroll
    for (int t = 0; t < 4; ++t) {
        const float a = wave_sum(qv[t] * qv[t]), bq = wave_sum(kv[t] * kv[t]);
        if (lane == 0) { red[wid * 8 + t] = a; red[wid * 8 + 4 + t] = bq; }
    }
    __syncthreads();
    float gt[4], bt[4];
#pragma unroll
    for (int t = 0; t < 4; ++t) {
        const float sq = red[(2 * half) * 8 + t] + red[(2 * half + 1) * 8 + t], sk = red[(2 * half) * 8 + 4 + t] + red[(2 * half + 1) * 8 + 4 + t];
        if (half == 0) {
            qsh[t * 128 + c] = qv[t] * rsqrtf(sq + EPS) * 0.08838834764831845f;
            ksh[t * 128 + c] = kv[t] * rsqrtf(sk + EPS);
        }
        float a = 0.f, bb = 0.f;
#pragma unroll
        for (int kq = 0; kq < 4; ++kq) { a += ab[(size_t)kq * TT * 16 + (size_t)(r0 + t) * 16 + h]; bb += ab[(size_t)kq * TT * 16 + (size_t)(r0 + t) * 16 + 8 + h]; }
        const float xx = a + p.in[12][h];
        const float sp = xx > 20.f ? xx : log1pf(__expf(xx));
        gt[t] = __expf(-__expf(p.in[11][h]) * sp);
        bt[t] = 1.f / (1.f + __expf(-bb));
    }
    f32x2_t S[32];
    const float* sp0 = p.in[5] + ((size_t)(sb * 8 + h) * 128 + half * 64) * 128 + c;
#pragma unroll
    for (int d = 0; d < 64; ++d) S[d >> 1][d & 1] = __builtin_nontemporal_load(sp0 + (size_t)d * 128);
    __syncthreads();
    float ot[4];
#pragma unroll
    for (int t = 0; t < 4; ++t) {
        const float* kk = ksh + t * 128 + half * 64; const float* qq = qsh + t * 128 + half * 64;
        f32x2_t ks2 = {0.f, 0.f};
#pragma unroll
        for (int d4 = 0; d4 < 16; ++d4) { const f32x4 k4 = *(const f32x4*)(kk + d4 * 4); ks2 += (f32x2_t){k4[0], k4[1]} * S[d4 * 2]; ks2 += (f32x2_t){k4[2], k4[3]} * S[d4 * 2 + 1]; }
        part[(t * 2 + half) * 128 + c] = ks2[0] + ks2[1];
        __syncthreads();
        const float kS = part[(t * 2) * 128 + c] + part[(t * 2 + 1) * 128 + c];
        const float eg = gt[t], dl = bt[t] * (vv[t] - eg * kS);
        const f32x2_t eg2 = {eg, eg}, dl2 = {dl, dl};
        f32x2_t o2 = {0.f, 0.f};
#pragma unroll
        for (int d4 = 0; d4 < 16; ++d4) {
            const f32x4 k4 = *(const f32x4*)(kk + d4 * 4), q4 = *(const f32x4*)(qq + d4 * 4);
            const f32x2_t s0 = S[d4 * 2] * eg2 + (f32x2_t){k4[0], k4[1]} * dl2, s1 = S[d4 * 2 + 1] * eg2 + (f32x2_t){k4[2], k4[3]} * dl2;
            S[d4 * 2] = s0; S[d4 * 2 + 1] = s1;
            o2 += (f32x2_t){q4[0], q4[1]} * s0; o2 += (f32x2_t){q4[2], q4[3]} * s1;
        }
        const float o = o2[0] + o2[1];
        ot[t] = o;
        if (half == 1) opart[t * 128 + c] = o;
    }
    float* dso = p.out + O_DS + ((size_t)(sb * 8 + h) * 128 + half * 64) * 128 + c;
#pragma unroll
    for (int d = 0; d < 64; ++d) __builtin_nontemporal_store(S[d >> 1][d & 1], dso + (size_t)d * 128);
    __syncthreads();
    if (half == 0) {
#pragma unroll
        for (int t = 0; t < 4; ++t) { ot[t] += opart[t * 128 + c]; const float a = wave_sum(ot[t] * ot[t]); if (lane == 0) red2[wid * 4 + t] = a; }
    }
    __syncthreads();
    if (half == 0) {
        bf16_t* mix = (bf16_t*)(p.ws + WS_MIX);
        const float gn = p.in[13][c];
#pragma unroll
        for (int t = 0; t < 4; ++t) {
            const float ms = (red2[t] + red2[4 + t]) * (1.f / 128.f);
            const float z = bf2f(proj[(size_t)(r0 + t) * NPJ + C_ZA + h * 128 + c]);
            mix[(size_t)(r0 + t) * LDB + h * 128 + c] = f2bf(ot[t] * rsqrtf(ms + EPS) * gn * silu_f(z));
        }
    }
    __syncthreads();
}

DEV void attn_sample_item(const Params& p, int item, unsigned char* lds) {
    int tid = threadIdx.x & 255; asm volatile("" : "+v"(tid)); const int lane = tid & 63, wid = tid >> 6;
    const int sb = item >> 2, hd = item & 3;
    float* qs = (float*)lds;
    float* pm = qs + 2048;
    float* red = pm + 1024;
    const bf16_t* qx = (const bf16_t*)(p.ws + WS_QX);
    for (int i = tid; i < 2048; i += 256) { const int t = i >> 9, d = i & 511; qs[i] = bf2f(qx[(size_t)(TP + sb * 4 + t) * LDB + hd * 512 + d]) * 0.04419417382415922f; }
    __syncthreads();
    const float* Kc = p.in[3] + ((size_t)sb * 256) * D + hd * 512;
    const float* Vc = p.in[4] + ((size_t)sb * 256) * D + hd * 512;
    {
        const int sub = lane >> 4, l16 = lane & 15;
        f32x4 kv[8];
        {
            const float* kr = Kc + (size_t)(wid * 64 + sub) * D;
#pragma unroll
            for (int i = 0; i < 8; ++i) kv[i] = __builtin_nontemporal_load((const f32x4*)(kr + (i * 16 + l16) * 4));
        }
        for (int it = 0; it < 16; ++it) {
            const int m = wid * 64 + it * 4 + sub;
            f32x4 cv[8];
#pragma unroll
            for (int i = 0; i < 8; ++i) cv[i] = kv[i];
            if (it + 1 < 16) {
                const float* kr = Kc + (size_t)(m + 4) * D;
#pragma unroll
                for (int i = 0; i < 8; ++i) kv[i] = __builtin_nontemporal_load((const f32x4*)(kr + (i * 16 + l16) * 4));
            }
            float a0 = 0.f, a1 = 0.f, a2 = 0.f, a3 = 0.f;
#pragma unroll
            for (int i = 0; i < 8; ++i) {
                const int d = (i * 16 + l16) * 4;
                const f32x4 q0 = *(const f32x4*)(qs + d), q1 = *(const f32x4*)(qs + 512 + d), q2 = *(const f32x4*)(qs + 1024 + d), q3 = *(const f32x4*)(qs + 1536 + d);
                a0 += cv[i][0] * q0[0] + cv[i][1] * q0[1] + cv[i][2] * q0[2] + cv[i][3] * q0[3];
                a1 += cv[i][0] * q1[0] + cv[i][1] * q1[1] + cv[i][2] * q1[2] + cv[i][3] * q1[3];
                a2 += cv[i][0] * q2[0] + cv[i][1] * q2[1] + cv[i][2] * q2[2] + cv[i][3] * q2[3];
                a3 += cv[i][0] * q3[0] + cv[i][1] * q3[1] + cv[i][2] * q3[2] + cv[i][3] * q3[3];
            }
#pragma unroll
            for (int o = 1; o < 16; o <<= 1) { a0 += __shfl_xor(a0, o); a1 += __shfl_xor(a1, o); a2 += __shfl_xor(a2, o); a3 += __shfl_xor(a3, o); }
            if (l16 == 0) *(f32x4*)(pm + m * 4) = (f32x4){a0, a1, a2, a3};
        }
    }
    __syncthreads();
    {
        const int t = wid;
        float v[4]; float mx = -3.0e38f;
#pragma unroll
        for (int i = 0; i < 4; ++i) { v[i] = pm[(i * 64 + lane) * 4 + t]; mx = fmaxf(mx, v[i]); }
        mx = wave_max(mx);
        float sm = 0.f;
#pragma unroll
        for (int i = 0; i < 4; ++i) { v[i] = __expf(v[i] - mx); sm += v[i]; }
        sm = wave_sum(sm);
        const float inv = 1.f / sm;
#pragma unroll
        for (int i = 0; i < 4; ++i) pm[(i * 64 + lane) * 4 + t] = v[i] * inv;
    }
    __syncthreads();
    {
        f32x4 acc[4][2];
#pragma unroll
        for (int t = 0; t < 4; ++t) { acc[t][0] = (f32x4){0.f, 0.f, 0.f, 0.f}; acc[t][1] = (f32x4){0.f, 0.f, 0.f, 0.f}; }
        f32x4 va[4], vb[4];
#pragma unroll
        for (int i = 0; i < 4; ++i) { const float* vr = Vc + (size_t)(wid * 64 + i) * D; va[i] = __builtin_nontemporal_load((const f32x4*)(vr + lane * 4)); vb[i] = __builtin_nontemporal_load((const f32x4*)(vr + 256 + lane * 4)); }
        for (int m4 = 0; m4 < 16; ++m4) {
            f32x4 ca[4], cb[4];
#pragma unroll
            for (int i = 0; i < 4; ++i) { ca[i] = va[i]; cb[i] = vb[i]; }
            if (m4 + 1 < 16) {
#pragma unroll
                for (int i = 0; i < 4; ++i) { const float* vr = Vc + (size_t)(wid * 64 + (m4 + 1) * 4 + i) * D; va[i] = __builtin_nontemporal_load((const f32x4*)(vr + lane * 4)); vb[i] = __builtin_nontemporal_load((const f32x4*)(vr + 256 + lane * 4)); }
            }
#pragma unroll
            for (int i = 0; i < 4; ++i) {
                const f32x4 pr = *(const f32x4*)(pm + (wid * 64 + m4 * 4 + i) * 4);
#pragma unroll
                for (int t = 0; t < 4; ++t) { acc[t][0] += ca[i] * pr[t]; acc[t][1] += cb[i] * pr[t]; }
            }
        }
#pragma unroll
        for (int t = 0; t < 4; ++t) { *(f32x4*)(red + (wid * 4 + t) * 512 + lane * 4) = acc[t][0]; *(f32x4*)(red + (wid * 4 + t) * 512 + 256 + lane * 4) = acc[t][1]; }
    }
    __syncthreads();
    {
        bf16_t* ctx = (bf16_t*)(p.ws + WS_CTX);
#pragma unroll
        for (int i = 0; i < 2; ++i) {
            const int e = (tid + 256 * i) * 4, t = e >> 9, d = e & 511;
            const f32x4 s = *(const f32x4*)(red + (0 * 4 + t) * 512 + d) + *(const f32x4*)(red + (1 * 4 + t) * 512 + d) + *(const f32x4*)(red + (2 * 4 + t) * 512 + d) + *(const f32x4*)(red + (3 * 4 + t) * 512 + d);
            store_bf4(ctx + (size_t)(TP + sb * 4 + t) * LDB + hd * 512 + d, s);
        }
    }
    __syncthreads();
}

template <int WIN>
DEV void pool_d_prompt(const bf16_t* __restrict__ proj, bf16_t* __restrict__ dpl, int row, int c8) {
    const int tloc = row & 2047;
    uint4 u[WIN];
#pragma unroll
    for (int k = 0; k < WIN; ++k) u[k] = (tloc - k >= 0) ? *(const uint4*)(proj + (size_t)(row - k) * NPJ + C_U + c8) : make_uint4(0u, 0u, 0u, 0u);
    float acc[8] = {0.f, 0.f, 0.f, 0.f, 0.f, 0.f, 0.f, 0.f};
#pragma unroll
    for (int k = 0; k < WIN; ++k) { acc[0] += bflo(u[k].x); acc[1] += bfhi(u[k].x); acc[2] += bflo(u[k].y); acc[3] += bfhi(u[k].y); acc[4] += bflo(u[k].z); acc[5] += bfhi(u[k].z); acc[6] += bflo(u[k].w); acc[7] += bfhi(u[k].w); }
    const float ic = 1.f / (float)min(WIN, tloc + 1);
    uint4 o;
    o.x = cvt_pk_bf16(acc[0] * ic - bflo(u[0].x), acc[1] * ic - bfhi(u[0].x)); o.y = cvt_pk_bf16(acc[2] * ic - bflo(u[0].y), acc[3] * ic - bfhi(u[0].y));
    o.z = cvt_pk_bf16(acc[4] * ic - bflo(u[0].z), acc[5] * ic - bfhi(u[0].z)); o.w = cvt_pk_bf16(acc[6] * ic - bflo(u[0].w), acc[7] * ic - bfhi(u[0].w));
    *(uint4*)(dpl + (size_t)row * LDP + c8) = o;
}

#ifndef REP0
#define REP0 1
#endif
#ifndef REP1
#define REP1 1
#endif
#ifndef REP2
#define REP2 1
#endif
#ifndef REP3
#define REP3 1
#endif
#ifndef REP4
#define REP4 1
#endif
#ifndef REP5
#define REP5 1
#endif
#ifndef REP6
#define REP6 1
#endif
#ifndef REP7
#define REP7 1
#endif
#ifndef REP8
#define REP8 1
#endif
#ifndef REP9
#define REP9 1
#endif
#ifndef REP10
#define REP10 1
#endif
#ifndef REP11
#define REP11 1
#endif
#ifndef REP12
#define REP12 1
#endif
#ifndef NLAUNCH
#define NLAUNCH 1
#endif
#define GRID_BAR() do { if (NLAUNCH == 1) xcd_barrier(bar); } while (0)
#define IN_PH(k) (p.ph_lo <= (k) && (k) < p.ph_hi)
__global__ void __launch_bounds__(512) hymba_fwd(Params p) {
    __shared__ __attribute__((aligned(16))) unsigned char lds[131072];
    __shared__ uint4 xb_words;
    const int G = gridDim.x, bid = blockIdx.x, VG = 2 * G;
    if (threadIdx.x == 0) xb_words = make_uint4(0u, 0u, 0u, 0u);
#define PH_LOCALS int tid = threadIdx.x; asm volatile("" : "+v"(tid)); const int lane = tid & 63, wid = tid >> 6; const int vb = __builtin_amdgcn_readfirstlane(tid >> 8); \
    unsigned char* vlds = lds + vb * 65536; (void)lane; (void)wid; (void)vlds;
    __syncthreads();
    XcdBarrier bar; bar.bar = (unsigned*)(p.ws + WS_BAR); bar.x = 0; bar.st = (volatile LAS unsigned*)&xb_words;
    if (NLAUNCH == 1) bar = xcd_barrier_post((unsigned*)(p.ws + WS_BAR), (volatile LAS unsigned*)&xb_words);
    unsigned char* ws = p.ws;
    bf16_t* Wt_in = (bf16_t*)(ws + WS_WIN); bf16_t* Wt_out = (bf16_t*)(ws + WS_WOUT); bf16_t* Wt_cq = (bf16_t*)(ws + WS_WCQ); bf16_t* Wt_co = (bf16_t*)(ws + WS_WCO);
    bf16_t* Wt_ckv = (bf16_t*)(ws + WS_WCKV); bf16_t* Wt_pool = (bf16_t*)(ws + WS_WPOOL);
    bf16_t* hbuf = (bf16_t*)(ws + WS_H); bf16_t* hm = (bf16_t*)(ws + WS_HM); bf16_t* proj = (bf16_t*)(ws + WS_PROJ); float* ab = (float*)(ws + WS_AB);
    bf16_t* mkb = (bf16_t*)(ws + WS_MKB); bf16_t* mvt = (bf16_t*)(ws + WS_MVT); bf16_t* dpl = (bf16_t*)(ws + WS_DPL); bf16_t* mix = (bf16_t*)(ws + WS_MIX);
    bf16_t* x1 = (bf16_t*)(ws + WS_X1); bf16_t* qx = (bf16_t*)(ws + WS_QX); float* sc = (float*)(ws + WS_SC); bf16_t* pb = (bf16_t*)(ws + WS_PB);
    bf16_t* ctx = (bf16_t*)(ws + WS_CTX); bf16_t* x2 = (bf16_t*)(ws + WS_X2); float* obuf = (float*)(ws + WS_O);
#define VLOOP(t, N) for (int t##0_ = 2 * bid, t = min(t##0_ + vb, (N) - 1); t##0_ < (N); t##0_ += VG, t = min(t##0_ + vb, (N) - 1))

    if (IN_PH(0)) { PH_LOCALS
        const int NT_IN = 98 * 16, NT_SQ = 32 * 16;
        const int total = NT_IN + 5 * NT_SQ + 32;
        VLOOP(t, total) {
            if (t < NT_IN) { const int nt = t >> 4, kt = t & 15; transpose_tile(p.in[9], 6160, nt * 64, true, kt * 128, Wt_in + (size_t)nt * 64 * LDB, LDB, (float*)vlds); }
            else if (t < NT_IN + 5 * NT_SQ) {
                const int u = t - NT_IN, j = u >> 9, v = u & 511, nt = v >> 4, kt = v & 15;
                const float* src = p.in[j == 0 ? 16 : (j == 1 ? 19 : (j == 2 ? 22 : (j == 3 ? 20 : 21)))];
                bf16_t* dst = j == 0 ? Wt_out : (j == 1 ? Wt_cq : (j == 2 ? Wt_co : (j == 3 ? Wt_ckv : Wt_ckv + (size_t)D * LDB)));
                transpose_tile(src, D, nt * 64, false, kt * 128, dst + (size_t)nt * 64 * LDB, LDB, (float*)vlds);
            } else {
                const int u = t - NT_IN - 5 * NT_SQ, g = u >> 3, v = u & 7, nt = v >> 1, kt = v & 1;
                transpose_tile(p.in[14] + (size_t)g * 65536, 256, nt * 64, false, kt * 128, Wt_pool + ((size_t)g * 256 + nt * 64) * LDM, LDM, (float*)vlds);
            }
        }
        for (int r = bid * 8 + wid; r < TT + 1024; r += G * 8) {
            if (r < TP) rmsnorm_row_bf16(p.in[0] + (size_t)r * D, p.in[8], hbuf + (size_t)r * LDB, lane);
            else if (r < TT) rmsnorm_row_bf16(p.in[1] + (size_t)(r - TP) * D, p.in[8], hbuf + (size_t)r * LDB, lane);
            else rmsnorm_row_bf16(p.in[2] + (size_t)(r - TT) * D, p.in[17], hm + (size_t)(r - TT) * LDB, lane);
        }
    }
    GRID_BAR();
    if (IN_PH(1)) { PH_LOCALS
        for (int t = bid; t < 32 * 24; t += G) { int nt, mt; tile_map(t, 32, 24, mt, nt);
            EpiProj e{mt * 256, nt * 256, proj, ab, p.out};
            gemm256_tile(hbuf + (size_t)mt * 256 * LDB, LDB, Wt_in + (size_t)nt * 256 * LDB, LDB, D, lds, e);
        }
        VLOOP(t, 4 * 48 + 256) {
            if (t < 192) { const int mt = t & 3, nt = t >> 2;
                EpiProj e{TP + mt * 128, nt * 128, proj, ab, p.out};
                gemm_tile<64>(hbuf + (size_t)(TP + mt * 128) * LDB, LDB, Wt_in + (size_t)nt * 128 * LDB, LDB, D, vlds, e);
            } else { const int u = t - 192, mt = u & 7, nt = u >> 3;
                EpiMKV e{mt * 128, nt * 128, mkb, mvt, p.out};
                gemm_tile<64>(hm + (size_t)mt * 128 * LDB, LDB, Wt_ckv + (size_t)nt * 128 * LDB, LDB, D, vlds, e);
            }
        }
        for (int tk = bid * 8 + wid; tk < (TT / 16) * 4; tk += G * 8) ab_rows16(hbuf, Wt_in + (size_t)NPJ * LDB, ab, tk >> 2, tk & 3, lane);
    }
    GRID_BAR();
    if (IN_PH(2)) { PH_LOCALS
        VLOOP(t, 1024) gdn_prep_chunk(p, t, vlds);
        for (int i = bid * 512 + tid; i < TP * 128; i += G * 512) {
            const int row = i >> 7, c8 = (i & 127) * 8, g = c8 >> 8;
            if (g == 0) pool_d_prompt<2>(proj, dpl, row, c8); else if (g == 1) pool_d_prompt<4>(proj, dpl, row, c8);
            else if (g == 2) pool_d_prompt<8>(proj, dpl, row, c8); else pool_d_prompt<16>(proj, dpl, row, c8);
        }
        for (int i = TP * 128 + bid * 512 + tid; i < TT * 128; i += G * 512) {
            const int row = i >> 7, c8 = (i & 127) * 8, g = c8 >> 8, win = 2 << g;
            float acc[8] = {0.f, 0.f, 0.f, 0.f, 0.f, 0.f, 0.f, 0.f}, self[8];
            const int tloc = (row - TP) & 3;
            for (int k = 0; k < win; ++k) {
                const int tt = tloc - k;
                if (tt >= 0) {
                    const uint4 u = *(const uint4*)(proj + (size_t)(row - k) * NPJ + C_U + c8);
                    const float f[8] = {bflo(u.x), bfhi(u.x), bflo(u.y), bfhi(u.y), bflo(u.z), bfhi(u.z), bflo(u.w), bfhi(u.w)};
#pragma unroll
                    for (int e = 0; e < 8; ++e) { acc[e] += f[e]; if (k == 0) self[e] = f[e]; }
                } else {
                    const float* sp = p.in[7] + ((size_t)((row - TP) >> 2) * 15 + (15 + tt)) * 1024 + c8;
                    const f32x4 s0 = *(const f32x4*)sp, s1 = *(const f32x4*)(sp + 4);
                    acc[0] += s0[0]; acc[1] += s0[1]; acc[2] += s0[2]; acc[3] += s0[3]; acc[4] += s1[0]; acc[5] += s1[1]; acc[6] += s1[2]; acc[7] += s1[3];
                }
            }
            const float ic = 1.f / (float)win;
            uint4 o; o.x = cvt_pk_bf16(acc[0] * ic - self[0], acc[1] * ic - self[1]); o.y = cvt_pk_bf16(acc[2] * ic - self[2], acc[3] * ic - self[3]);
            o.z = cvt_pk_bf16(acc[4] * ic - self[4], acc[5] * ic - self[5]); o.w = cvt_pk_bf16(acc[6] * ic - self[6], acc[7] * ic - self[7]);
            *(uint4*)(dpl + (size_t)row * LDP + c8) = o;
        }
        for (int i = bid * 512 + tid; i < SB * 11 * 256; i += G * 512) {
            const int c4 = (i & 255) * 4, rr = (i >> 8) % 11, sb = (i >> 8) / 11;
            *(f32x4*)(p.out + O_PS + ((size_t)sb * 15 + rr) * 1024 + c4) = *(const f32x4*)(p.in[7] + ((size_t)sb * 15 + rr + 4) * 1024 + c4);
        }
    }
    GRID_BAR();
    if (IN_PH(3)) { PH_LOCALS
        const int NSC = 256, NSM = 1024, NPL = 68 * 8;
        const int nsb = G >> 1;
        if (bid < nsb) {
            if (G == 256) {
                const int x = bid & 7, j = bid >> 3;
                gdn_scan_item(p, ((x * 4 + (j >> 2)) << 3) | ((j & 3) << 1) | vb, vlds);
            } else
            for (int t0 = 2 * bid; t0 < NSC; t0 += 2 * nsb) gdn_scan_item(p, min(t0 + vb, NSC - 1), vlds);
        } else {
            const int ob = bid - nsb, no = G - nsb;
            for (int t0 = 2 * ob; t0 < NSM; t0 += 2 * no) gdn_sample_item(p, min(t0 + vb, NSM - 1), vlds);
            for (int t0 = 2 * ob; t0 < NPL; t0 += 2 * no) { const int t = min(t0 + vb, NPL - 1); int nt, mt; tile_map(t, 68, 8, mt, nt); const int g = nt >> 1;
                EpiPool e{mt * 128, nt * 128, proj, p.in[15], mix};
                gemm_tile<64>(dpl + (size_t)mt * 128 * LDP + g * 256, LDP, Wt_pool + (size_t)nt * 128 * LDM, LDM, 256, vlds, e);
            }
        }
    }
    GRID_BAR();
    if (IN_PH(4)) { PH_LOCALS
        for (int i = bid * 512 + tid; i < TP * 8 * 16; i += G * 512) {
            const int l16 = i & 15, rh = i >> 4, h = rh & 7, row = rh >> 3;
            const float* op = obuf + (size_t)row * 1024 + h * 128 + l16 * 8;
            const f32x4 a = *(const f32x4*)op, b4 = *(const f32x4*)(op + 4);
            float ss = a[0] * a[0] + a[1] * a[1] + a[2] * a[2] + a[3] * a[3] + b4[0] * b4[0] + b4[1] * b4[1] + b4[2] * b4[2] + b4[3] * b4[3];
            ss += __shfl_xor(ss, 1); ss += __shfl_xor(ss, 2); ss += __shfl_xor(ss, 4); ss += __shfl_xor(ss, 8);
            const float rs = rsqrtf(ss * (1.f / 128.f) + EPS);
            const f32x4 g0 = *(const f32x4*)(p.in[13] + l16 * 8), g1 = *(const f32x4*)(p.in[13] + l16 * 8 + 4);
            const uint4 z = *(const uint4*)(proj + (size_t)row * NPJ + C_ZA + h * 128 + l16 * 8);
            uint4 o;
            o.x = cvt_pk_bf16(a[0] * rs * g0[0] * silu_f(bflo(z.x)), a[1] * rs * g0[1] * silu_f(bfhi(z.x)));
            o.y = cvt_pk_bf16(a[2] * rs * g0[2] * silu_f(bflo(z.y)), a[3] * rs * g0[3] * silu_f(bfhi(z.y)));
            o.z = cvt_pk_bf16(b4[0] * rs * g1[0] * silu_f(bflo(z.z)), b4[1] * rs * g1[1] * silu_f(bfhi(z.z)));
            o.w = cvt_pk_bf16(b4[2] * rs * g1[2] * silu_f(bflo(z.w)), b4[3] * rs * g1[3] * silu_f(bfhi(z.w)));
            *(uint4*)(mix + (size_t)row * LDB + h * 128 + l16 * 8) = o;
        }
    }
    GRID_BAR();
    if (IN_PH(5)) { PH_LOCALS
        for (int t = bid; t < 32 * 8; t += G) { int nt, mt; tile_map(t, 32, 8, mt, nt);
            EpiResid e{p.in[0] + (size_t)mt * 256 * D + nt * 256, x1 + (size_t)mt * 256 * LDB + nt * 256};
            gemm256_tile(mix + (size_t)mt * 256 * LDB, LDB, Wt_out + (size_t)nt * 256 * LDB, LDB, D, lds, e);
        }
        VLOOP(t, 8 * 32) { const int mt = t & 7, nt = t >> 3;
            EpiResid e{p.in[1] + (size_t)mt * 64 * D + nt * 64, x1 + (size_t)(TP + mt * 64) * LDB + nt * 64};
            gemm_tile<32>(mix + (size_t)(TP + mt * 64) * LDB, LDB, Wt_out + (size_t)nt * 64 * LDB, LDB, D, vlds, e);
        }
    }
    GRID_BAR();
    if (IN_PH(6)) { PH_LOCALS
    for (int r = bid * 8 + wid; r < TT; r += G * 8) rmsnorm_row_from_bf16<false>(x1 + (size_t)r * LDB, p.in[18], hbuf + (size_t)r * LDB, lane);
    }
    GRID_BAR();
    if (IN_PH(7)) { PH_LOCALS
        VLOOP(t, 8 * 32) { const int mt = t & 7, nt = t >> 3;
            EpiBf e{qx + (size_t)(TP + mt * 64) * LDB + nt * 64, LDB};
            gemm_tile<32>(hbuf + (size_t)(TP + mt * 64) * LDB, LDB, Wt_cq + (size_t)nt * 64 * LDB, LDB, D, vlds, e);
        }
    }
    GRID_BAR();
    if (IN_PH(7)) { PH_LOCALS
        const int ng = G >> 1;
        if (bid < ng) {
            for (int t = bid; t < 32 * 8; t += ng) { int nt, mt; tile_map(t, 32, 8, mt, nt);
                EpiBf e{qx + (size_t)mt * 256 * LDB + nt * 256, LDB};
                gemm256_tile(hbuf + (size_t)mt * 256 * LDB, LDB, Wt_cq + (size_t)nt * 256 * LDB, LDB, D, lds, e);
            }
        } else {
            const int ob = bid - ng, no = G - ng;
            for (int t0 = 2 * ob; t0 < 512; t0 += 2 * no) attn_sample_item(p, min(t0 + vb, 511), vlds);
        }
    }
    GRID_BAR();
    if (IN_PH(8)) { PH_LOCALS
        const int NS1 = 16 * 16 * 2;
        VLOOP(t, NS1) { const int bhd = t >> 5, v = t & 31, mt = v >> 1, nt = v & 1, b = bhd >> 2, hd = bhd & 3;
            EpiF32s e{sc + (size_t)(b * SEQ + mt * 128) * 1024 + hd * 256 + nt * 128, 1024, 0.04419417382415922f};
            gemm_tile<64>(qx + (size_t)(b * SEQ + mt * 128) * LDB + hd * 512, LDB, mkb + (size_t)(b * 256 + nt * 128) * LDB + hd * 512, LDB, 512, vlds, e);
        }
    }
    GRID_BAR();
    if (IN_PH(9)) { PH_LOCALS
    for (int r = bid * 8 + wid; r < TP * 4; r += G * 8) {
        const f32x4 v = *(const f32x4*)(sc + (size_t)r * 256 + lane * 4);
        const float mx = wave_max(fmaxf(fmaxf(v[0], v[1]), fmaxf(v[2], v[3])));
        f32x4 e; e[0] = __expf(v[0] - mx); e[1] = __expf(v[1] - mx); e[2] = __expf(v[2] - mx); e[3] = __expf(v[3] - mx);
        const float inv = 1.f / wave_sum(e[0] + e[1] + e[2] + e[3]);
        store_bf4(pb + (size_t)(r >> 2) * LDP + (r & 3) * 256 + lane * 4, e * inv);
    }
    }
    GRID_BAR();
    if (IN_PH(10)) { PH_LOCALS
        VLOOP(t, 16 * 16 * 4) { const int bhd = t >> 6, v = t & 63, mt = v >> 2, nt = v & 3, b = bhd >> 2, hd = bhd & 3;
            EpiBf e{ctx + (size_t)(b * SEQ + mt * 128) * LDB + hd * 512 + nt * 128, LDB};
            gemm_tile<64>(pb + (size_t)(b * SEQ + mt * 128) * LDP + hd * 256, LDP, mvt + ((size_t)b * D + hd * 512 + nt * 128) * LDM, LDM, 256, vlds, e);
        }
    }
    GRID_BAR();
    if (IN_PH(11)) { PH_LOCALS
        for (int t = bid; t < 32 * 8; t += G) { int nt, mt; tile_map(t, 32, 8, mt, nt);
            EpiResidB e{x1 + (size_t)mt * 256 * LDB + nt * 256, x2 + (size_t)mt * 256 * LDB + nt * 256};
            gemm256_tile(ctx + (size_t)mt * 256 * LDB, LDB, Wt_co + (size_t)nt * 256 * LDB, LDB, D, lds, e);
        }
        VLOOP(t, 8 * 32) { const int mt = t & 7, nt = t >> 3;
            EpiResidB e{x1 + (size_t)(TP + mt * 64) * LDB + nt * 64, x2 + (size_t)(TP + mt * 64) * LDB + nt * 64};
            gemm_tile<32>(ctx + (size_t)(TP + mt * 64) * LDB, LDB, Wt_co + (size_t)nt * 64 * LDB, LDB, D, vlds, e);
        }
    }
    GRID_BAR();
    if (IN_PH(12)) { PH_LOCALS
    for (int r = bid * 8 + wid; r < TT; r += G * 8) rmsnorm_row_from_bf16<true>(x2 + (size_t)r * LDB, p.in[23], p.out + (r < TP ? O_YP + (size_t)r * D : O_YS + (size_t)(r - TP) * D), lane);
    }
}

extern "C" void kernel_launch(void* const* d_in, const int* in_sizes, int n_in, void* d_out, int out_size, void* d_ws, size_t ws_size, hipStream_t stream) {
    static int grid = 0;
    if (grid == 0) {
        if (n_in != 24 || ws_size < WS_END) { fprintf(stderr, "kernel_launch: need 24 inputs and %zu bytes of workspace (got %d, %zu)\n", (size_t)WS_END, n_in, ws_size); grid = -1; return; }
        int dev = 0, cus = 0, per_cu = 0;
        hipGetDevice(&dev);
        hipDeviceGetAttribute(&cus, hipDeviceAttributeMultiprocessorCount, dev);
        if (hipOccupancyMaxActiveBlocksPerMultiprocessor(&per_cu, (const void*)hymba_fwd, 512, 0) != hipSuccess || per_cu < 1) { fprintf(stderr, "kernel_launch: occupancy query failed\n"); grid = -1; return; }
        if (per_cu > 1) per_cu = 1;
        grid = cus * per_cu;
        fprintf(stderr, "kernel_launch: grid %d (%d per CU)\n", grid, per_cu);
    }
    if (grid < 0) return;
    hipMemsetAsync((char*)d_ws + WS_BAR, 0, 16384, stream);
    Params p{};
    for (int i = 0; i < 24; ++i) p.in[i] = (const float*)d_in[i];
    p.out = (float*)d_out; p.ws = (unsigned char*)d_ws;
    if (NLAUNCH == 1) {
        p.ph_lo = 0; p.ph_hi = 13;
        void* args[] = {&p};
        hipError_t e = hipLaunchCooperativeKernel((const void*)hymba_fwd, dim3(grid), dim3(512), args, 0, stream);
        if (e != hipSuccess) fprintf(stderr, "kernel_launch: cooperative launch failed: %s (grid %d)\n", hipGetErrorString(e), grid);
    } else {
        for (int k = 0; k < 13; ++k) { p.ph_lo = k; p.ph_hi = k + 1; hipLaunchKernelGGL(hymba_fwd, dim3(grid), dim3(512), 0, stream, p); }
    }
}
```

```cpp
#include <hip/hip_runtime.h>
#include <hip/hip_cooperative_groups.h>
#include <cstdio>
#include <cstdint>

typedef unsigned short bf16_t;
typedef short bf16x8 __attribute__((ext_vector_type(8)));
typedef float f32x4 __attribute__((ext_vector_type(4)));
#define DEV __device__ __forceinline__
#define LAS __attribute__((address_space(3)))

constexpr int D = 2048, TP = 8192, TS = 512, TT = 8704, SEQ = 2048, NB = 4, SB = 128;
constexpr int NPJ = 6144;
constexpr int C_ZA = 3072, C_U = 4096, C_ZB = 5120;
constexpr int NWIN = 6272;
constexpr float EPS = 1e-6f;
constexpr int LDB = 2112, LDP = 1088, LDM = 288;

constexpr size_t O_YP = 0, O_YS = 16777216, O_MK = 17825792, O_MV = 19922944, O_DP = 22020096, O_CP = 22544384,
                 O_PP = 22581248, O_DS = 22642688, O_CS = 39419904, O_PS = 40599552;

constexpr size_t al256(size_t x) { return (x + 255) & ~(size_t)255; }
constexpr size_t WS_BAR = 0;
constexpr size_t WS_WIN = 16384;
constexpr size_t WS_WOUT = WS_WIN + (size_t)NWIN * LDB * 2;
constexpr size_t WS_WCQ = WS_WOUT + (size_t)D * LDB * 2;
constexpr size_t WS_WCO = WS_WCQ + (size_t)D * LDB * 2;
constexpr size_t WS_WCKV = WS_WCO + (size_t)D * LDB * 2;
constexpr size_t WS_WPOOL = WS_WCKV + (size_t)2 * D * LDB * 2;
constexpr size_t WS_H = WS_WPOOL + (size_t)1024 * LDM * 2;
constexpr size_t WS_HM = WS_H + (size_t)TT * LDB * 2;
constexpr size_t WS_PROJ = WS_HM + (size_t)1024 * LDB * 2;
constexpr size_t WS_AB = WS_PROJ + (size_t)TT * NPJ * 2;
constexpr size_t WS_MKB = WS_AB + (size_t)4 * TT * 16 * 4;
constexpr size_t WS_MVT = WS_MKB + (size_t)1024 * LDB * 2;
constexpr size_t WS_GW = WS_MVT + (size_t)4 * D * LDM * 2;
constexpr size_t WS_GQ = WS_GW + (size_t)1024 * 8192 * 2;
constexpr size_t WS_GKT = WS_GQ + (size_t)1024 * 8192 * 2;
constexpr size_t WS_GA = WS_GKT + (size_t)1024 * 8192 * 2;
constexpr size_t WS_GU = WS_GA + (size_t)1024 * 4096 * 2;
constexpr size_t WS_GE = WS_GU + (size_t)1024 * 8192 * 4;
constexpr size_t WS_O = WS_GE + 4096;
constexpr size_t WS_DPL = WS_O + (size_t)TP * 1024 * 4;
constexpr size_t WS_MIX = WS_DPL + (size_t)TT * LDP * 2;
constexpr size_t WS_X1 = WS_MIX + (size_t)TT * LDB * 2;
constexpr size_t WS_QX = WS_X1 + (size_t)TT * D * 4;
constexpr size_t WS_SC = WS_QX + (size_t)TT * LDB * 2;
constexpr size_t WS_PB = WS_SC + (size_t)TP * 1024 * 4;
constexpr size_t WS_CTX = WS_PB + (size_t)TP * LDP * 2;
constexpr size_t WS_X2 = WS_CTX + (size_t)TT * LDB * 2;
constexpr size_t WS_END = WS_X2 + (size_t)TT * D * 4;

#ifndef LASTP
#define LASTP 99
#endif
struct Params { const float* in[24]; float* out; unsigned char* ws; int ph_lo, ph_hi; };

typedef __bf16 bf16x2_t __attribute__((ext_vector_type(2)));
typedef float f32x2_t __attribute__((ext_vector_type(2)));
DEV unsigned cvt_pk_bf16(float lo, float hi) { const f32x2_t v = {lo, hi}; const bf16x2_t b = __builtin_convertvector(v, bf16x2_t); return __builtin_bit_cast(unsigned, b); }
DEV bf16_t f2bf(float f) { return (bf16_t)(cvt_pk_bf16(f, 0.f) & 0xffffu); }
DEV float bf2f(unsigned b) { return __uint_as_float(b << 16); }
DEV float bflo(unsigned u) { return __uint_as_float(u << 16); }
DEV float bfhi(unsigned u) { return __uint_as_float(u & 0xffff0000u); }
DEV float silu_f(float x) { return x / (1.f + __expf(-x)); }
DEV float wave_sum(float v) {
#pragma unroll
    for (int o = 32; o >= 1; o >>= 1) v += __shfl_xor(v, o);
    return v;
}
DEV float wave_max(float v) {
#pragma unroll
    for (int o = 32; o >= 1; o >>= 1) v = fmaxf(v, __shfl_xor(v, o));
    return v;
}
DEV void store_bf4(bf16_t* p, f32x4 v) { uint2 w; w.x = cvt_pk_bf16(v[0], v[1]); w.y = cvt_pk_bf16(v[2], v[3]); *(uint2*)p = w; }

#define XB_TMO      128
#define XB_XCNT(j)  (256  + 64 * (j))
#define XB_XSUB(j)  (1280 + 64 * (j))
#define XB_XGEN(j)  (2304 + 64 * (j))
#define XB_TOP      3328
#define XB_TOPGEN   3392
#define XCD_BAR_WORDS 3456
#define XB_SPIN_CAP (1u << 22)
DEV unsigned xb_ld(unsigned* p) { return __hip_atomic_load(p, __ATOMIC_RELAXED, __HIP_MEMORY_SCOPE_AGENT); }
DEV unsigned xb_add(unsigned* p, unsigned v) { return __hip_atomic_fetch_add(p, v, __ATOMIC_RELAXED, __HIP_MEMORY_SCOPE_AGENT); }
DEV unsigned xb_xcc_id() { return (unsigned)__builtin_amdgcn_s_getreg((3 << 11) | 20) & 0xFu; }
#define XB_SPIN(cond, bar) do { unsigned _sp = 0; while (cond) { __builtin_amdgcn_s_sleep(1); \
    if ((++_sp & 255u) == 0u) { if (xb_ld(&(bar)[XB_TMO])) break; if (_sp > XB_SPIN_CAP) { atomicAdd(&(bar)[XB_TMO], 1u); break; } } } } while (0)
struct XcdBarrier { unsigned* bar; unsigned x; volatile LAS unsigned* st; };
DEV XcdBarrier xcd_barrier_post(unsigned* bar, volatile LAS unsigned* st) {
    XcdBarrier b; b.bar = bar; b.x = xb_xcc_id(); b.st = st;
    if (threadIdx.x == 0) (void)xb_add(&bar[XB_XCNT(b.x)], 1u);
    return b;
}
DEV void xcd_barrier_complete(unsigned* bar, unsigned x, unsigned& nloc, unsigned& nx) {
    const unsigned G = gridDim.x;
    unsigned sum, cnt, mine, sp = 0u;
    for (;;) {
        sum = 0u; cnt = 0u; mine = 0u;
#pragma unroll
        for (unsigned j = 0; j < 16; ++j) { const unsigned c = xb_ld(&bar[XB_XCNT(j)]); sum += c; cnt += (c > 0u) ? 1u : 0u; mine = (j == x) ? c : mine; }
        if (sum == G) break;
        __builtin_amdgcn_s_sleep(1);
        if ((++sp & 255u) == 0u) { if (xb_ld(&bar[XB_TMO])) break; if (sp > XB_SPIN_CAP) { atomicAdd(&bar[XB_TMO], 1u); break; } }
    }
    nloc = mine > 0u ? mine : 1u; nx = cnt > 0u ? cnt : 1u;
}
DEV void xcd_barrier(const XcdBarrier& b) {
    asm volatile("s_waitcnt vmcnt(0)" ::: "memory");
    __syncthreads();
    if (threadIdx.x == 0) {
        unsigned* bar = b.bar;
        __builtin_amdgcn_s_waitcnt(0);
        unsigned nloc = b.st[0], nx = b.st[1];
        if (nloc == 0u) { xcd_barrier_complete(bar, b.x, nloc, nx); b.st[0] = nloc; b.st[1] = nx; }
        const unsigned old = xb_add(&bar[XB_XSUB(b.x)], 1u);
        const unsigned gen = old / nloc;
        if (old + 1u == (gen + 1u) * nloc) {
            __builtin_amdgcn_fence(__ATOMIC_RELEASE, "agent");
            asm volatile("s_waitcnt vmcnt(0)" ::: "memory");
            const unsigned og = xb_add(&bar[XB_TOP], 1u);
            const unsigned tg = og / nx;
            if (og + 1u == (tg + 1u) * nx) xb_add(&bar[XB_TOPGEN], 1u);
            else XB_SPIN(xb_ld(&bar[XB_TOPGEN]) == tg, bar);
            __builtin_amdgcn_fence(__ATOMIC_ACQUIRE, "agent");
            xb_add(&bar[XB_XGEN(b.x)], 1u);
            asm volatile("s_waitcnt vmcnt(0)" ::: "memory");
        } else {
            XB_SPIN(xb_ld(&bar[XB_XGEN(b.x)]) == gen, bar);
            __builtin_amdgcn_fence(__ATOMIC_ACQUIRE, "agent");
            asm volatile("s_waitcnt vmcnt(0)" ::: "memory");
        }
    }
    __syncthreads();
}

DEV void glds16(const void* gptr, unsigned lds_addr_lane) {
    const unsigned m = __builtin_amdgcn_readfirstlane(lds_addr_lane);
    unsigned keep;
    asm volatile("s_mov_b32 %0, m0\n\ts_mov_b32 m0, %2\n\ts_nop 0\n\tglobal_load_lds_dwordx4 %1, off\n\ts_mov_b32 m0, %0" : "=&s"(keep) : "v"(gptr), "s"(m) : "memory");
}

template <int WT, class Epi>
DEV void gemm_tile(const bf16_t* __restrict__ A, int lda, const bf16_t* __restrict__ Bt, int ldb, int K, unsigned char* lds, const Epi& epi) {
    constexpr int FI = WT / 16;
    constexpr int OPB = 2 * WT * 128;
    constexpr int STB = 2 * OPB;
    int tid = threadIdx.x & 255; asm volatile("" : "+v"(tid)); const int lane = tid & 63, wid = tid >> 6;
    const int wr = wid >> 1, wc = wid & 1, fr = lane & 15, fq = lane >> 4;
    f32x4 acc[FI][FI];
#pragma unroll
    for (int i = 0; i < FI; ++i)
#pragma unroll
        for (int j = 0; j < FI; ++j) acc[i][j] = (f32x4){0.f, 0.f, 0.f, 0.f};
    const int lrow = tid >> 3, lcs = (tid & 7) ^ (lrow & 7);
    const bf16_t* ap = A + (size_t)lrow * lda + lcs * 8;
    const bf16_t* bp = Bt + (size_t)lrow * ldb + lcs * 8;
    const unsigned l3a = (unsigned)(size_t)(LAS unsigned char*)lds;
    const int nk = K >> 6;
#define GLDS_STAGE(st, kt_) do { \
        _Pragma("unroll") for (int i_ = 0; i_ < FI; ++i_) { \
            glds16(ap + (size_t)(32 * i_) * lda + (kt_) * 64, l3a + (st) + tid * 16 + i_ * 4096); \
            glds16(bp + (size_t)(32 * i_) * ldb + (kt_) * 64, l3a + (st) + OPB + tid * 16 + i_ * 4096); } } while (0)
    constexpr int NSTG = 65536 / STB;
#pragma unroll
    for (int s_ = 0; s_ < NSTG - 1; ++s_) if (s_ < nk) GLDS_STAGE(s_ * STB, s_);
    const int aoff = (wr * WT + fr) * 128, boff = OPB + (wc * WT + fr) * 128, sw = fr & 7;
    int cur = 0, nxt = (NSTG - 1) * STB;
    for (int kt = 0; kt < nk; ++kt) {
        if (NSTG == 4 && kt + 2 < nk) { if (FI == 2) asm volatile("s_waitcnt vmcnt(8)" ::: "memory"); else asm volatile("s_waitcnt vmcnt(0)" ::: "memory"); }
        else asm volatile("s_waitcnt vmcnt(0)" ::: "memory");
        __syncthreads();
        if (kt + NSTG - 1 < nk) GLDS_STAGE(nxt, kt + NSTG - 1);
#pragma unroll
        for (int kh = 0; kh < 2; ++kh) {
            bf16x8 af[FI], bfr[FI];
            const int ch = ((kh * 4 + fq) ^ sw) << 4;
#pragma unroll
            for (int i = 0; i < FI; ++i) { af[i] = *(const bf16x8*)(lds + cur + aoff + i * 2048 + ch); bfr[i] = *(const bf16x8*)(lds + cur + boff + i * 2048 + ch); }
#pragma unroll
            for (int mi = 0; mi < FI; ++mi)
#pragma unroll
                for (int ni = 0; ni < FI; ++ni) acc[mi][ni] = __builtin_amdgcn_mfma_f32_16x16x32_bf16(bfr[ni], af[mi], acc[mi][ni], 0, 0, 0);
        }
        nxt = cur; cur += STB; if (cur == NSTG * STB) cur = 0;
    }
#undef GLDS_STAGE
    __syncthreads();
#pragma unroll
    for (int mi = 0; mi < FI; ++mi)
#pragma unroll
        for (int ni = 0; ni < FI; ++ni) epi(wr * WT + mi * 16 + fr, wc * WT + ni * 16 + fq * 4, acc[mi][ni]);
}

template <class Epi>
DEV void gemm256_tile(const bf16_t* __restrict__ A, int lda, const bf16_t* __restrict__ Bt, int ldb, int K, unsigned char* lds, const Epi& epi) {
    int tid = threadIdx.x; asm volatile("" : "+v"(tid)); const int lane = tid & 63, wid = tid >> 6;
    const int wr = wid >> 2, wc = wid & 3, fr = lane & 15, fq = lane >> 4;
    f32x4 acc[8][4];
#pragma unroll
    for (int i = 0; i < 8; ++i)
#pragma unroll
        for (int j = 0; j < 4; ++j) acc[i][j] = (f32x4){0.f, 0.f, 0.f, 0.f};
    const int lrow = tid >> 3, lcs = (tid & 7) ^ (lrow & 7);
    const bf16_t* ap = A + (size_t)lrow * lda + lcs * 8;
    const bf16_t* bp = Bt + (size_t)lrow * ldb + lcs * 8;
    const unsigned l3a = (unsigned)(size_t)(LAS unsigned char*)lds;
    const int nk = K >> 6;
#define GLDS_STAGE(st, kt_) do { \
        _Pragma("unroll") for (int i_ = 0; i_ < 4; ++i_) { \
            glds16(ap + (size_t)(64 * i_) * lda + (kt_) * 64, l3a + (st) + tid * 16 + i_ * 8192); \
            glds16(bp + (size_t)(64 * i_) * ldb + (kt_) * 64, l3a + (st) + 32768 + tid * 16 + i_ * 8192); } } while (0)
    GLDS_STAGE(0, 0);
    const int aoff = (wr * 128 + fr) * 128, boff = 32768 + (wc * 64 + fr) * 128, sw = fr & 7;
    for (int kt = 0; kt < nk; ++kt) {
        const int cur = (kt & 1) * 65536;
        asm volatile("s_waitcnt vmcnt(0)" ::: "memory");
        __syncthreads();
        if (kt + 1 < nk) GLDS_STAGE(cur ^ 65536, kt + 1);
#pragma unroll
        for (int kh = 0; kh < 2; ++kh) {
            bf16x8 bfr[4];
            const int ch = ((kh * 4 + fq) ^ sw) << 4;
#pragma unroll
            for (int i = 0; i < 4; ++i) bfr[i] = *(const bf16x8*)(lds + cur + boff + i * 2048 + ch);
#pragma unroll
            for (int mh = 0; mh < 2; ++mh) {
                bf16x8 af[4];
#pragma unroll
                for (int i = 0; i < 4; ++i) af[i] = *(const bf16x8*)(lds + cur + aoff + (mh * 4 + i) * 2048 + ch);
#pragma unroll
                for (int mi = 0; mi < 4; ++mi)
#pragma unroll
                    for (int ni = 0; ni < 4; ++ni) acc[mh * 4 + mi][ni] = __builtin_amdgcn_mfma_f32_16x16x32_bf16(bfr[ni], af[mi], acc[mh * 4 + mi][ni], 0, 0, 0);
            }
        }
    }
#undef GLDS_STAGE
    __syncthreads();
#pragma unroll
    for (int mi = 0; mi < 8; ++mi)
#pragma unroll
        for (int ni = 0; ni < 4; ++ni) epi(wr * 128 + mi * 16 + fr, wc * 64 + ni * 16 + fq * 4, acc[mi][ni]);
}

DEV void ab_rows16(const bf16_t* __restrict__ h, const bf16_t* __restrict__ wab, float* __restrict__ ab4, int rt, int kq, int lane) {
    const int fr = lane & 15, fq = lane >> 4;
    const bf16_t* ap = h + (size_t)(rt * 16 + fr) * LDB + kq * 512 + fq * 8;
    const bf16_t* bp = wab + (size_t)fr * LDB + kq * 512 + fq * 8;
    bf16x8 a[16], b[16];
#pragma unroll
    for (int s = 0; s < 16; ++s) { a[s] = *(const bf16x8*)(ap + s * 32); b[s] = *(const bf16x8*)(bp + s * 32); }
    f32x4 acc = {0.f, 0.f, 0.f, 0.f};
#pragma unroll
    for (int s = 0; s < 16; ++s) acc = __builtin_amdgcn_mfma_f32_16x16x32_bf16(b[s], a[s], acc, 0, 0, 0);
    *(f32x4*)(ab4 + (size_t)kq * TT * 16 + (size_t)(rt * 16 + fr) * 16 + fq * 4) = acc;
}

DEV void tile_map(int L, int nM, int nN, int& pm, int& pn) {
    const int T = nM * nN, q = T >> 3, r = T & 7, xcd = L & 7, off = L >> 3;
    const int w = (xcd < r ? xcd * (q + 1) : r * (q + 1) + (xcd - r) * q) + off;
    const int nig = 8 * nN, gid = w / nig, fm = gid * 8, gsz = (nM - fm) < 8 ? (nM - fm) : 8;
    pm = fm + (w % nig) % gsz; pn = (w % nig) / gsz;
}

struct EpiProj {
    int m0, n0; bf16_t* proj; float* ab; float* out;
    DEV void operator()(int r, int c, f32x4 v) const {
        const int row = m0 + r, col = n0 + c;
        if (col < NPJ) {
            store_bf4(proj + (size_t)row * NPJ + col, v);
            const bool isconv = col < 3072, ispool = (col >= C_U && col < C_ZB);
            if (isconv || ispool) {
                if (row < TP) {
                    const int b = row >> 11, t = row & 2047;
                    if (isconv) { if (t >= 2045) *(f32x4*)(out + O_CP + ((size_t)(b * 3 + (t - 2045))) * 3072 + col) = v; }
                    else { if (t >= 2033) *(f32x4*)(out + O_PP + ((size_t)(b * 15 + (t - 2033))) * 1024 + (col - C_U)) = v; }
                } else {
                    const int sb = (row - TP) >> 2, t = (row - TP) & 3;
                    if (isconv) { if (t >= 1) *(f32x4*)(out + O_CS + ((size_t)(sb * 3 + (t - 1))) * 3072 + col) = v; }
                    else *(f32x4*)(out + O_PS + ((size_t)(sb * 15 + 11 + t)) * 1024 + (col - C_U)) = v;
                }
            }
        } else if (col < NPJ + 16) {
            *(f32x4*)(ab + (size_t)row * 16 + (col - NPJ)) = v;
        }
    }
};
struct EpiMKV {
    int m0, n0; bf16_t* mkb; bf16_t* mvt; float* out;
    DEV void operator()(int r, int c, f32x4 v) const {
        const int row = m0 + r, col = n0 + c;
        if (col < D) {
            *(f32x4*)(out + O_MK + (size_t)row * D + col) = v;
            store_bf4(mkb + (size_t)row * LDB + col, v);
        } else {
            const int cc = col - D, b = row >> 8, m = row & 255;
            *(f32x4*)(out + O_MV + (size_t)row * D + cc) = v;
            bf16_t* p = mvt + ((size_t)b * D + cc) * LDM + m;
            p[0] = f2bf(v[0]); p[LDM] = f2bf(v[1]); p[2 * LDM] = f2bf(v[2]); p[3 * LDM] = f2bf(v[3]);
        }
    }
};
struct EpiPool {
    int m0, n0; const bf16_t* proj; const float* scale; bf16_t* mix;
    DEV void operator()(int r, int c, f32x4 v) const {
        const int row = m0 + r, col = n0 + c;
        const uint2 z = *(const uint2*)(proj + (size_t)row * NPJ + C_ZB + col);
        const f32x4 s = *(const f32x4*)(scale + col);
        f32x4 o;
        o[0] = v[0] * s[0] * silu_f(bflo(z.x)); o[1] = v[1] * s[1] * silu_f(bfhi(z.x));
        o[2] = v[2] * s[2] * silu_f(bflo(z.y)); o[3] = v[3] * s[3] * silu_f(bfhi(z.y));
        store_bf4(mix + (size_t)row * LDB + 1024 + col, o);
    }
};
struct EpiResid {
    const float* res; bf16_t* dst;
    DEV void operator()(int r, int c, f32x4 v) const {
        const f32x4 x = __builtin_nontemporal_load((const f32x4*)(res + (size_t)r * D + c));
        store_bf4(dst + (size_t)r * LDB + c, x + v);
    }
};
struct EpiResidB {
    const bf16_t* res; bf16_t* dst;
    DEV void operator()(int r, int c, f32x4 v) const {
        const uint2 u = *(const uint2*)(res + (size_t)r * LDB + c);
        f32x4 x; x[0] = bflo(u.x); x[1] = bfhi(u.x); x[2] = bflo(u.y); x[3] = bfhi(u.y);
        store_bf4(dst + (size_t)r * LDB + c, x + v);
    }
};
struct EpiBf {
    bf16_t* dst; int ld;
    DEV void operator()(int r, int c, f32x4 v) const { store_bf4(dst + (size_t)r * ld + c, v); }
};
struct EpiF32s {
    float* dst; int ld; float s;
    DEV void operator()(int r, int c, f32x4 v) const { *(f32x4*)(dst + (size_t)r * ld + c) = v * s; }
};

DEV int win_srccol(int n) { return n < 4096 ? n : (n < 6144 ? n + 16 : (n < 6160 ? 4096 + (n - 6144) : -1)); }
DEV void transpose_tile(const float* __restrict__ src, int ld, int srccol0, bool remap, int k0, bf16_t* __restrict__ dstrow0, int ldd, float* tile) {
    int tid = threadIdx.x & 255; asm volatile("" : "+v"(tid));
    const int tx = tid & 63, ty = tid >> 6;
    const int sc = remap ? win_srccol(srccol0 + tx) : (srccol0 + tx);
    float tv[32];
#pragma unroll
    for (int i = 0; i < 32; ++i) tv[i] = sc >= 0 ? __builtin_nontemporal_load(src + (size_t)(k0 + ty + 4 * i) * ld + sc) : 0.f;
#pragma unroll
    for (int i = 0; i < 32; ++i) tile[(ty + 4 * i) * 65 + tx] = tv[i];
    __syncthreads();
#pragma unroll
    for (int i = 0; i < 16; ++i) { const int r = ty + 4 * i; *(unsigned*)(dstrow0 + (size_t)r * ldd + k0 + 2 * tx) = cvt_pk_bf16(tile[(2 * tx) * 65 + r], tile[(2 * tx + 1) * 65 + r]); }
    __syncthreads();
}
DEV void rmsnorm_row_bf16(const float* __restrict__ x, const float* __restrict__ g, bf16_t* __restrict__ y, int lane) {
    f32x4 v[8]; float ss = 0.f;
#pragma unroll
    for (int i = 0; i < 8; ++i) { v[i] = ((const f32x4*)x)[i * 64 + lane]; ss += v[i][0] * v[i][0] + v[i][1] * v[i][1] + v[i][2] * v[i][2] + v[i][3] * v[i][3]; }
    ss = wave_sum(ss);
    const float rs = rsqrtf(ss * (1.f / 2048.f) + EPS);
#pragma unroll
    for (int i = 0; i < 8; ++i) { const f32x4 gg = ((const f32x4*)g)[i * 64 + lane]; store_bf4(y + (size_t)(i * 64 + lane) * 4, v[i] * rs * gg); }
}
template <bool OUT_F32>
DEV void rmsnorm_row_from_bf16(const bf16_t* __restrict__ x, const float* __restrict__ g, void* __restrict__ y, int lane) {
    float v[4][8]; float ss = 0.f;
#pragma unroll
    for (int i = 0; i < 4; ++i) { const uint4 u = ((const uint4*)x)[i * 64 + lane];
        v[i][0] = bflo(u.x); v[i][1] = bfhi(u.x); v[i][2] = bflo(u.y); v[i][3] = bfhi(u.y); v[i][4] = bflo(u.z); v[i][5] = bfhi(u.z); v[i][6] = bflo(u.w); v[i][7] = bfhi(u.w);
#pragma unroll
        for (int e = 0; e < 8; ++e) ss += v[i][e] * v[i][e]; }
    ss = wave_sum(ss);
    const float rs = rsqrtf(ss * (1.f / 2048.f) + EPS);
#pragma unroll
    for (int i = 0; i < 4; ++i) {
        const f32x4 g0 = ((const f32x4*)g)[(i * 64 + lane) * 2], g1 = ((const f32x4*)g)[(i * 64 + lane) * 2 + 1];
        const f32x4 o0 = (f32x4){v[i][0], v[i][1], v[i][2], v[i][3]} * rs * g0, o1 = (f32x4){v[i][4], v[i][5], v[i][6], v[i][7]} * rs * g1;
        if (OUT_F32) { __builtin_nontemporal_store(o0, (f32x4*)y + (i * 64 + lane) * 2); __builtin_nontemporal_store(o1, (f32x4*)y + (i * 64 + lane) * 2 + 1); }
        else { uint4 w; w.x = cvt_pk_bf16(o0[0], o0[1]); w.y = cvt_pk_bf16(o0[2], o0[3]); w.z = cvt_pk_bf16(o1[0], o1[1]); w.w = cvt_pk_bf16(o1[2], o1[3]); ((uint4*)y)[i * 64 + lane] = w; }
    }
}
DEV void rmsnorm_row_f32(const float* __restrict__ x, const float* __restrict__ g, float* __restrict__ y, int lane) {
    f32x4 v[8]; float ss = 0.f;
#pragma unroll
    for (int i = 0; i < 8; ++i) { v[i] = ((const f32x4*)x)[i * 64 + lane]; ss += v[i][0] * v[i][0] + v[i][1] * v[i][1] + v[i][2] * v[i][2] + v[i][3] * v[i][3]; }
    ss = wave_sum(ss);
    const float rs = rsqrtf(ss * (1.f / 2048.f) + EPS);
#pragma unroll
    for (int i = 0; i < 8; ++i) { const f32x4 gg = ((const f32x4*)g)[i * 64 + lane]; __builtin_nontemporal_store(v[i] * rs * gg, (f32x4*)y + i * 64 + lane); }
}

constexpr int QS = 136;
DEV void gdn_prep_chunk(const Params& p, int item, unsigned char* lds) {
    int tid = threadIdx.x & 255; asm volatile("" : "+v"(tid)); const int lane = tid & 63, wid = tid >> 6;
    const int c = item & 31, h = (item >> 5) & 7, b = item >> 8;
    const int row0 = b * SEQ + c * 64;
    const bf16_t* proj = (const bf16_t*)(p.ws + WS_PROJ);
    const float* ab = (const float*)(p.ws + WS_AB);
    bf16_t* qs = (bf16_t*)lds; bf16_t* ks = qs + 64 * QS; bf16_t* vs = ks + 64 * QS;
    float* lowT = (float*)lds;
    float* gcs = (float*)(lds + 3 * 64 * QS * 2);
    float* bts = gcs + 64;
    bf16_t* gW = (bf16_t*)(p.ws + WS_GW) + (size_t)item * 8192;
    bf16_t* gQ = (bf16_t*)(p.ws + WS_GQ) + (size_t)item * 8192;
    bf16_t* gKT = (bf16_t*)(p.ws + WS_GKT) + (size_t)item * 8192;
    bf16_t* gA = (bf16_t*)(p.ws + WS_GA) + (size_t)item * 4096;
    float* gU = (float*)(p.ws + WS_GU) + (size_t)item * 8192;
    float* gE = (float*)(p.ws + WS_GE) + item;

    if (wid == 3) {
        float a = 0.f, bb = 0.f;
#pragma unroll
        for (int kq = 0; kq < 4; ++kq) { a += ab[(size_t)kq * TT * 16 + (size_t)(row0 + lane) * 16 + h]; bb += ab[(size_t)kq * TT * 16 + (size_t)(row0 + lane) * 16 + 8 + h]; }
        const float xx = a + p.in[12][h];
        const float sp = xx > 20.f ? xx : log1pf(__expf(xx));
        float s = -__expf(p.in[11][h]) * sp;
#pragma unroll
        for (int d = 1; d < 64; d <<= 1) { const float t = __shfl_up(s, d); if (lane >= d) s += t; }
        gcs[lane] = s; bts[lane] = 1.f / (1.f + __expf(-bb));
    } else {
        const int mat = wid, rg = lane >> 4, cv = lane & 15;
        const int colg = mat * 1024 + h * 128 + cv * 8;
        const float* cw = p.in[10];
        float w[4][8];
#pragma unroll
        for (int j = 0; j < 4; ++j) { const f32x4 w0 = *(const f32x4*)(cw + j * 3072 + colg), w1 = *(const f32x4*)(cw + j * 3072 + colg + 4);
            w[j][0] = w0[0]; w[j][1] = w0[1]; w[j][2] = w0[2]; w[j][3] = w0[3]; w[j][4] = w1[0]; w[j][5] = w1[1]; w[j][6] = w1[2]; w[j][7] = w1[3]; }
        const int tl0 = rg * 16;
        uint4 raw[19];
#pragma unroll
        for (int i = 0; i < 19; ++i) {
            const int tl = tl0 - 3 + i;
            if (c * 64 + tl >= 0) raw[i] = *(const uint4*)(proj + (size_t)(row0 + tl) * NPJ + colg);
            else raw[i] = make_uint4(0u, 0u, 0u, 0u);
        }
        bf16_t* dst = (mat == 0 ? qs : (mat == 1 ? ks : vs));
#pragma unroll
        for (int r = 0; r < 16; ++r) {
            float y[8]; float ss = 0.f;
#pragma unroll
            for (int e = 0; e < 8; ++e) {
                float a = 0.f;
#pragma unroll
                for (int j = 0; j < 4; ++j) {
                    const uint4 u = raw[r + j];
                    const unsigned wd = (e < 2 ? u.x : (e < 4 ? u.y : (e < 6 ? u.z : u.w)));
                    const float xv = (e & 1) ? bfhi(wd) : bflo(wd);
                    a += w[j][e] * xv;
                }
                y[e] = silu_f(a); ss += y[e] * y[e];
            }
            if (mat < 2) {
                ss += __shfl_xor(ss, 1); ss += __shfl_xor(ss, 2); ss += __shfl_xor(ss, 4); ss += __shfl_xor(ss, 8);
                float inv = rsqrtf(ss + EPS); if (mat == 0) inv *= 0.08838834764831845f;
#pragma unroll
                for (int e = 0; e < 8; ++e) y[e] *= inv;
            }
            uint4 o; o.x = cvt_pk_bf16(y[0], y[1]); o.y = cvt_pk_bf16(y[2], y[3]); o.z = cvt_pk_bf16(y[4], y[5]); o.w = cvt_pk_bf16(y[6], y[7]);
            *(uint4*)(dst + (tl0 + r) * QS + cv * 8) = o;
        }
    }
    __syncthreads();
    {
        const float glast = gcs[63];
        if (tid == 0) *gE = __expf(glast);
#pragma unroll
        for (int i = 0; i < 4; ++i) {
            const int ci = tid + 256 * i, t = ci >> 4, cc = (ci & 15) * 8;
            const uint4 u = *(const uint4*)(qs + t * QS + cc);
            const float e = __expf(gcs[t]);
            uint4 o; o.x = cvt_pk_bf16(bflo(u.x) * e, bfhi(u.x) * e); o.y = cvt_pk_bf16(bflo(u.y) * e, bfhi(u.y) * e);
            o.z = cvt_pk_bf16(bflo(u.z) * e, bfhi(u.z) * e); o.w = cvt_pk_bf16(bflo(u.w) * e, bfhi(u.w) * e);
            *(uint4*)(gQ + (cc >> 5) * 2048 + t * 32 + (cc & 31)) = o;
        }
        const float dk = __expf(glast - gcs[lane]);
#pragma unroll 8
        for (int i = 0; i < 32; ++i) { const int d = wid * 32 + i; gKT[(lane >> 5) * 4096 + d * 32 + (lane & 31)] = f2bf(bf2f(ks[lane * QS + d]) * dk);     }
    }
    f32x4 kk[4], qk[4];
    {
        const int fr = lane & 15, fq = lane >> 4, it = wid;
        bf16x8 kfi[4], qfi[4];
#pragma unroll
        for (int s = 0; s < 4; ++s) { kfi[s] = *(const bf16x8*)(ks + (it * 16 + fr) * QS + s * 32 + fq * 8); qfi[s] = *(const bf16x8*)(qs + (it * 16 + fr) * QS + s * 32 + fq * 8); }
#pragma unroll
        for (int jt = 0; jt < 4; ++jt) {
            kk[jt] = (f32x4){0.f, 0.f, 0.f, 0.f}; qk[jt] = (f32x4){0.f, 0.f, 0.f, 0.f};
#pragma unroll
            for (int s = 0; s < 4; ++s) {
                const bf16x8 kfj = *(const bf16x8*)(ks + (jt * 16 + fr) * QS + s * 32 + fq * 8);
                kk[jt] = __builtin_amdgcn_mfma_f32_16x16x32_bf16(kfi[s], kfj, kk[jt], 0, 0, 0);
                qk[jt] = __builtin_amdgcn_mfma_f32_16x16x32_bf16(kfj, qfi[s], qk[jt], 0, 0, 0);
            }
        }
    }
    __syncthreads();
    {
        const int fr = lane & 15, fq = lane >> 4, it = wid;
#pragma unroll
        for (int jt = 0; jt < 4; ++jt) {
            const int j = jt * 16 + fr; const float gj = gcs[j];
            f32x4 lv;
#pragma unroll
            for (int e = 0; e < 4; ++e) { const int i = it * 16 + fq * 4 + e; lv[e] = (i > j) ? bts[i] * kk[jt][e] * __expf(gcs[i] - gj) : 0.f; }
            *(f32x4*)(lowT + j * 68 + it * 16 + fq * 4) = lv;
            const int i2 = it * 16 + fr; const float gi = gcs[i2];
            f32x4 av;
#pragma unroll
            for (int e = 0; e < 4; ++e) { const int j2 = jt * 16 + fq * 4 + e; av[e] = (i2 >= j2) ? qk[jt][e] * __expf(gi - gcs[j2]) : 0.f; }
            store_bf4(gA + (jt >> 1) * 2048 + i2 * 32 + (jt & 1) * 16 + fq * 4, av);
        }
    }
    __syncthreads();
    {
        const int cc = tid & 127; const bool isw = tid >= 128;
        bf16_t* src = isw ? ks : vs;
#pragma unroll 1
        for (int ib = 0; ib < 4; ++ib) {
            f32x2_t acc[8];
#pragma unroll
            for (int r = 0; r < 16; ++r) { const int j = ib * 16 + r; float f = bts[j]; if (isw) f *= __expf(gcs[j]); acc[r >> 1][r & 1] = f * bf2f(src[j * QS + cc]); }
            const float* lrow = lowT + ib * 16;
#pragma unroll 4
            for (int j = 0; j < ib * 16; ++j) {
                const float xj = -bf2f(src[j * QS + cc]); const f32x2_t nx = {xj, xj};
                const f32x4 l0 = *(const f32x4*)(lrow + j * 68), l1 = *(const f32x4*)(lrow + j * 68 + 4), l2 = *(const f32x4*)(lrow + j * 68 + 8), l3 = *(const f32x4*)(lrow + j * 68 + 12);
                acc[0] += (f32x2_t){l0[0], l0[1]} * nx; acc[1] += (f32x2_t){l0[2], l0[3]} * nx; acc[2] += (f32x2_t){l1[0], l1[1]} * nx; acc[3] += (f32x2_t){l1[2], l1[3]} * nx;
                acc[4] += (f32x2_t){l2[0], l2[1]} * nx; acc[5] += (f32x2_t){l2[2], l2[3]} * nx; acc[6] += (f32x2_t){l3[0], l3[1]} * nx; acc[7] += (f32x2_t){l3[2], l3[3]} * nx;
            }
#pragma unroll
            for (int r2 = 0; r2 < 15; ++r2) {
                asm volatile("" ::: "memory");
                const float xj = -acc[r2 >> 1][r2 & 1]; const f32x2_t nx = {xj, xj};
                const float* lp = lrow + (ib * 16 + r2) * 68;
#pragma unroll
                for (int q = (r2 + 1) >> 2; q < 4; ++q) {
                    const f32x4 l = *(const f32x4*)(lp + q * 4);
                    acc[2 * q] += (f32x2_t){l[0], l[1]} * nx; acc[2 * q + 1] += (f32x2_t){l[2], l[3]} * nx;
                }
            }
#pragma unroll
            for (int r = 0; r < 16; ++r) {
                const int j = ib * 16 + r; const float xv = acc[r >> 1][r & 1]; const bf16_t xb = f2bf(xv);
                src[j * QS + cc] = xb;
                if (isw) gW[(cc >> 5) * 2048 + j * 32 + (cc & 31)] = xb;
                else gU[(((((cc >> 4) * 4 + (j >> 4)) * 4 + (j & 3)) * 4 + ((j >> 2) & 3)) << 4) + (cc & 15)] = xv;
            }
        }
    }
    __syncthreads();
}

#define LDS_BARRIER() do { asm volatile("s_waitcnt lgkmcnt(0)" ::: "memory"); __builtin_amdgcn_s_barrier(); asm volatile("" ::: "memory"); } while (0)
struct ScanEarly { bf16x8 w[4], q[4]; f32x4 u; };
struct ScanLate { bf16x8 a[2], k0[2], k1[2]; };
DEV void gdn_scan_item(const Params& p, int item, unsigned char* lds) {
    int tid = threadIdx.x & 255; asm volatile("" : "+v"(tid)); const int lane = tid & 63, w = tid >> 6, fr = lane & 15, fq = lane >> 4;
    const int s = item & 7, bh = item >> 3;
    const int b = bh >> 3, h = bh & 7;
    bf16_t* ST = (bf16_t*)lds;
    bf16_t* VT = ST + 16 * QS;
    const char* bW = (const char*)((const bf16_t*)(p.ws + WS_GW) + (size_t)bh * 32 * 8192);
    const char* bQ = (const char*)((const bf16_t*)(p.ws + WS_GQ) + (size_t)bh * 32 * 8192);
    const char* bK = (const char*)((const bf16_t*)(p.ws + WS_GKT) + (size_t)bh * 32 * 8192);
    const char* bA = (const char*)((const bf16_t*)(p.ws + WS_GA) + (size_t)bh * 32 * 4096);
    const char* bU = (const char*)((const float*)(p.ws + WS_GU) + (size_t)bh * 32 * 8192);
    const float* gE = (const float*)(p.ws + WS_GE) + bh * 32;
    float* obuf = (float*)(p.ws + WS_O);
    f32x4 S0 = {0.f, 0.f, 0.f, 0.f}, S1 = {0.f, 0.f, 0.f, 0.f};
    for (int i = tid; i < 16 * QS / 2; i += 256) ((unsigned*)ST)[i] = 0u;
    const float egv = gE[lane & 31];
    const unsigned offWQ = (unsigned)(((w * 16 + fr) * 32 + fq * 8) * 2), offA = offWQ;
    const unsigned offK = (unsigned)(((w * 32 + fr) * 32 + fq * 8) * 2), offU = (unsigned)((((s * 4 + w) * 16 + fq) * 16 + fr) * 4);
    ScanEarly E0, E1, E2; ScanLate L0, L1;
#define LOAD_E(F, ch) do { \
        const char* W_ = bW + (size_t)(ch) * 16384; const char* Q_ = bQ + (size_t)(ch) * 16384; \
        _Pragma("unroll") for (int k_ = 0; k_ < 4; ++k_) { F.w[k_] = *(const bf16x8*)(W_ + (offWQ + k_ * 4096)); F.q[k_] = *(const bf16x8*)(Q_ + (offWQ + k_ * 4096)); } \
        const char* U_ = bU + (size_t)(ch) * 32768; F.u[0] = *(const float*)(U_ + offU); F.u[1] = *(const float*)(U_ + (offU + 256)); F.u[2] = *(const float*)(U_ + (offU + 512)); F.u[3] = *(const float*)(U_ + (offU + 768)); \
        } while (0)
#define LOAD_L(F, ch) do { \
        const char* A_ = bA + (size_t)(ch) * 8192; F.a[0] = *(const bf16x8*)(A_ + offA); F.a[1] = *(const bf16x8*)(A_ + (offA + 4096)); \
        const char* K_ = bK + (size_t)(ch) * 16384; F.k0[0] = *(const bf16x8*)(K_ + offK); F.k0[1] = *(const bf16x8*)(K_ + (offK + 8192)); \
        F.k1[0] = *(const bf16x8*)(K_ + (offK + 1024)); F.k1[1] = *(const bf16x8*)(K_ + (offK + 1024 + 8192)); \
        } while (0)
#define SCAN_STEP(X, XL, Y, YL, ch) do { \
        if ((ch) + 2 < 32) LOAD_E(XL, (ch) + 2); \
        if ((ch) + 1 < 32) LOAD_L(YL, (ch) + 1); \
        const float ceg = __builtin_bit_cast(float, __builtin_amdgcn_readlane(__builtin_bit_cast(int, egv), (ch))); \
        f32x4 ws_ = {0.f, 0.f, 0.f, 0.f}, oo = {0.f, 0.f, 0.f, 0.f}; \
        _Pragma("unroll") for (int k = 0; k < 4; ++k) { \
            const bf16x8 sf = *(const bf16x8*)(ST + fr * QS + k * 32 + fq * 8); \
            ws_ = __builtin_amdgcn_mfma_f32_16x16x32_bf16(X.w[k], sf, ws_, 0, 0, 0); \
            oo = __builtin_amdgcn_mfma_f32_16x16x32_bf16(X.q[k], sf, oo, 0, 0, 0); } \
        store_bf4(VT + fr * 72 + w * 16 + fq * 4, X.u - ws_); \
        LDS_BARRIER(); \
        const bf16x8 v0 = *(const bf16x8*)(VT + fr * 72 + fq * 8), v1 = *(const bf16x8*)(VT + fr * 72 + 32 + fq * 8); \
        oo = __builtin_amdgcn_mfma_f32_16x16x32_bf16(Y.a[0], v0, oo, 0, 0, 0); \
        oo = __builtin_amdgcn_mfma_f32_16x16x32_bf16(Y.a[1], v1, oo, 0, 0, 0); \
        S0 = S0 * ceg; S1 = S1 * ceg; \
        S0 = __builtin_amdgcn_mfma_f32_16x16x32_bf16(Y.k0[0], v0, S0, 0, 0, 0); \
        S0 = __builtin_amdgcn_mfma_f32_16x16x32_bf16(Y.k0[1], v1, S0, 0, 0, 0); \
        S1 = __builtin_amdgcn_mfma_f32_16x16x32_bf16(Y.k1[0], v0, S1, 0, 0, 0); \
        S1 = __builtin_amdgcn_mfma_f32_16x16x32_bf16(Y.k1[1], v1, S1, 0, 0, 0); \
        store_bf4(ST + fr * QS + w * 32 + fq * 4, S0); \
        store_bf4(ST + fr * QS + w * 32 + 16 + fq * 4, S1); \
        { float* op = obuf + (size_t)(b * SEQ + (ch) * 64 + w * 16 + fq * 4) * 1024 + h * 128 + s * 16 + fr; \
          op[0] = oo[0]; op[1024] = oo[1]; op[2048] = oo[2]; op[3072] = oo[3]; } \
        LDS_BARRIER(); } while (0)
    LOAD_E(E0, 0); LOAD_L(L0, 0); LOAD_E(E1, 1);
    __syncthreads();
    for (int ch = 0; ch < 30; ch += 6) {
        SCAN_STEP(E0, E2, L0, L1, ch);     SCAN_STEP(E1, E0, L1, L0, ch + 1); SCAN_STEP(E2, E1, L0, L1, ch + 2);
        SCAN_STEP(E0, E2, L1, L0, ch + 3); SCAN_STEP(E1, E0, L0, L1, ch + 4); SCAN_STEP(E2, E1, L1, L0, ch + 5);
    }
    SCAN_STEP(E0, E2, L0, L1, 30); SCAN_STEP(E1, E0, L1, L0, 31);
#undef SCAN_STEP
#undef LOAD_E
#undef LOAD_L
    {
        float* dp = p.out + O_DP + ((size_t)bh * 128 + w * 32 + fq * 4) * 128 + s * 16 + fr;
#pragma unroll
        for (int e = 0; e < 4; ++e) { dp[e * 128] = S0[e]; dp[(16 + e) * 128] = S1[e]; }
    }
    __syncthreads();
}

DEV void gdn_sample_item(const Params& p, int item, unsigned char* lds) {
    int tid = threadIdx.x & 255; asm volatile("" : "+v"(tid)); const int lane = tid & 63, wid = tid >> 6;
    const int sb = item >> 3, h = item & 7, half = tid >> 7, c = tid & 127;
    const int r0 = TP + sb * 4;
    const bf16_t* proj = (const bf16_t*)(p.ws + WS_PROJ);
    const float* ab = (const float*)(p.ws + WS_AB);
    float* ksh = (float*)lds;
    float* qsh = ksh + 512;
    float* red = qsh + 512;
    float* red2 = red + 32;
    float* part = red2 + 32;
    float* opart = part + 1024;
    float qv[4], kv[4], vv[4];
#pragma unroll
    for (int m = 0; m < 3; ++m) {
        const int col = m * 1024 + h * 128 + c;
        float x[7], wj[4];
#pragma unroll
        for (int j = 0; j < 3; ++j) x[j] = p.in[6][((size_t)sb * 3 + j) * 3072 + col];
#pragma unroll
        for (int t = 0; t < 4; ++t) x[3 + t] = bf2f(proj[(size_t)(r0 + t) * NPJ + col]);
#pragma unroll
        for (int j = 0; j < 4; ++j) wj[j] = p.in[10][j * 3072 + col];
#pragma unroll
        for (int t = 0; t < 4; ++t) {
            const float y = silu_f(wj[0] * x[t] + wj[1] * x[t + 1] + wj[2] * x[t + 2] + wj[3] * x[t + 3]);
            if (m == 0) qv[t] = y; else if (m == 1) kv[t] = y; else vv[t] = y;
        }
    }
#pragma unroll
    for (int t = 0; t < 4; ++t) {
        const float a = wave_sum(qv[t] * qv[t]), bq = wave_sum(kv[t] * kv[t]);
        if (lane == 0) { red[wid * 8 + t] = a; red[wid * 8 + 4 + t] = bq; }
    }
    __syncthreads();
    float gt[4], bt[4];
#pragma unroll
    for (int t = 0; t < 4; ++t) {
        const float sq = red[(2 * half) * 8 + t] + red[(2 * half + 1) * 8 + t], sk = red[(2 * half) * 8 + 4 + t] + red[(2 * half + 1) * 8 + 4 + t];
        if (half == 0) {
            qsh[t * 128 + c] = qv[t] * rsqrtf(sq + EPS) * 0.08838834764831845f;
            ksh[t * 128 + c] = kv[t] * rsqrtf(sk + EPS);
        }
        float a = 0.f, bb = 0.f;
#pragma unroll
        for (int kq = 0; kq < 4; ++kq) { a += ab[(size_t)kq * TT * 16 + (size_t)(r0 + t) * 16 + h]; bb += ab[(size_t)kq * TT * 16 + (size_t)(r0 + t) * 16 + 8 + h]; }
        const float xx = a + p.in[12][h];
        const float sp = xx > 20.f ? xx : log1pf(__expf(xx));
        gt[t] = __expf(-__expf(p.in[11][h]) * sp);
        bt[t] = 1.f / (1.f + __expf(-bb));
    }
    f32x2_t S[32];
    const float* sp0 = p.in[5] + ((size_t)(sb * 8 + h) * 128 + half * 64) * 128 + c;
#pragma unroll
    for (int d = 0; d < 64; ++d) S[d >> 1][d & 1] = __builtin_nontemporal_load(sp0 + (size_t)d * 128);
    __syncthreads();
    float ot[4];
#pragma unroll
    for (int t = 0; t < 4; ++t) {
        const float* kk = ksh + t * 128 + half * 64; const float* qq = qsh + t * 128 + half * 64;
        f32x2_t ks2 = {0.f, 0.f};
#pragma unroll
        for (int d4 = 0; d4 < 16; ++d4) { const f32x4 k4 = *(const f32x4*)(kk + d4 * 4); ks2 += (f32x2_t){k4[0], k4[1]} * S[d4 * 2]; ks2 += (f32x2_t){k4[2], k4[3]} * S[d4 * 2 + 1]; }
        part[(t * 2 + half) * 128 + c] = ks2[0] + ks2[1];
        __syncthreads();
        const float kS = part[(t * 2) * 128 + c] + part[(t * 2 + 1) * 128 + c];
        const float eg = gt[t], dl = bt[t] * (vv[t] - eg * kS);
        const f32x2_t eg2 = {eg, eg}, dl2 = {dl, dl};
        f32x2_t o2 = {0.f, 0.f};
#pragma unroll
        for (int d4 = 0; d4 < 16; ++d4) {
            const f32x4 k4 = *(const f32x4*)(kk + d4 * 4), q4 = *(const f32x4*)(qq + d4 * 4);
            const f32x2_t s0 = S[d4 * 2] * eg2 + (f32x2_t){k4[0], k4[1]} * dl2, s1 = S[d4 * 2 + 1] * eg2 + (f32x2_t){k4[2], k4[3]} * dl2;
            S[d4 * 2] = s0; S[d4 * 2 + 1] = s1;
            o2 += (f32x2_t){q4[0], q4[1]} * s0; o2 += (f32x2_t){q4[2], q4[3]} * s1;
        }
        const float o = o2[0] + o2[1];
        ot[t] = o;
        if (half == 1) opart[t * 128 + c] = o;
    }
    float* dso = p.out + O_DS + ((size_t)(sb * 8 + h) * 128 + half * 64) * 128 + c;
#pragma unroll
    for (int d = 0; d < 64; ++d) __builtin_nontemporal_store(S[d >> 1][d & 1], dso + (size_t)d * 128);
    __syncthreads();
    if (half == 0) {
#pragma unroll
        for (int t = 0; t < 4; ++t) { ot[t] += opart[t * 128 + c]; const float a = wave_sum(ot[t] * ot[t]); if (lane == 0) red2[wid * 4 + t] = a; }
    }
    __syncthreads();
    if (half == 0) {
        bf16_t* mix = (bf16_t*)(p.ws + WS_MIX);
        const float gn = p.in[13][c];
#pragma unroll
        for (int t = 0; t < 4; ++t) {
            const float ms = (red2[t] + red2[4 + t]) * (1.f / 128.f);
            const float z = bf2f(proj[(size_t)(r0 + t) * NPJ + C_ZA + h * 128 + c]);
            mix[(size_t)(r0 + t) * LDB + h * 128 + c] = f2bf(ot[t] * rsqrtf(ms + EPS) * gn * silu_f(z));
        }
    }
    __syncthreads();
}

DEV void attn_sample_item(const Params& p, int item, unsigned char* lds) {
    int tid = threadIdx.x & 255; asm volatile("" : "+v"(tid)); const int lane = tid & 63, wid = tid >> 6;
    const int sb = item >> 2, hd = item & 3;
    float* qs = (float*)lds;
    float* pm = qs + 2048;
    float* red = pm + 1024;
    const bf16_t* qx = (const bf16_t*)(p.ws + WS_QX);
    for (int i = tid; i < 2048; i += 256) { const int t = i >> 9, d = i & 511; qs[i] = bf2f(qx[(size_t)(TP + sb * 4 + t) * LDB + hd * 512 + d]) * 0.04419417382415922f; }
    __syncthreads();
    const float* Kc = p.in[3] + ((size_t)sb * 256) * D + hd * 512;
    const float* Vc = p.in[4] + ((size_t)sb * 256) * D + hd * 512;
    {
        const int sub = lane >> 4, l16 = lane & 15;
        f32x4 kv[8];
        {
            const float* kr = Kc + (size_t)(wid * 64 + sub) * D;
#pragma unroll
            for (int i = 0; i < 8; ++i) kv[i] = __builtin_nontemporal_load((const f32x4*)(kr + (i * 16 + l16) * 4));
        }
        for (int it = 0; it < 16; ++it) {
            const int m = wid * 64 + it * 4 + sub;
            f32x4 cv[8];
#pragma unroll
            for (int i = 0; i < 8; ++i) cv[i] = kv[i];
            if (it + 1 < 16) {
                const float* kr = Kc + (size_t)(m + 4) * D;
#pragma unroll
                for (int i = 0; i < 8; ++i) kv[i] = __builtin_nontemporal_load((const f32x4*)(kr + (i * 16 + l16) * 4));
            }
            float a0 = 0.f, a1 = 0.f, a2 = 0.f, a3 = 0.f;
#pragma unroll
            for (int i = 0; i < 8; ++i) {
                const int d = (i * 16 + l16) * 4;
                const f32x4 q0 = *(const f32x4*)(qs + d), q1 = *(const f32x4*)(qs + 512 + d), q2 = *(const f32x4*)(qs + 1024 + d), q3 = *(const f32x4*)(qs + 1536 + d);
                a0 += cv[i][0] * q0[0] + cv[i][1] * q0[1] + cv[i][2] * q0[2] + cv[i][3] * q0[3];
                a1 += cv[i][0] * q1[0] + cv[i][1] * q1[1] + cv[i][2] * q1[2] + cv[i][3] * q1[3];
                a2 += cv[i][0] * q2[0] + cv[i][1] * q2[1] + cv[i][2] * q2[2] + cv[i][3] * q2[3];
                a3 += cv[i][0] * q3[0] + cv[i][1] * q3[1] + cv[i][2] * q3[2] + cv[i][3] * q3[3];
            }
#pragma unroll
            for (int o = 1; o < 16; o <<= 1) { a0 += __shfl_xor(a0, o); a1 += __shfl_xor(a1, o); a2 += __shfl_xor(a2, o); a3 += __shfl_xor(a3, o); }
            if (l16 == 0) *(f32x4*)(pm + m * 4) = (f32x4){a0, a1, a2, a3};
        }
    }
    __syncthreads();
    {
        const int t = wid;
        float v[4]; float mx = -3.0e38f;
#pragma unroll
        for (int i = 0; i < 4; ++i) { v[i] = pm[(i * 64 + lane) * 4 + t]; mx = fmaxf(mx, v[i]); }
        mx = wave_max(mx);
        float sm = 0.f;
#pragma unroll
        for (int i = 0; i < 4; ++i) { v[i] = __expf(v[i] - mx); sm += v[i]; }
        sm = wave_sum(sm);
        const float inv = 1.f / sm;
#pragma unroll
        for (int i = 0; i < 4; ++i) pm[(i * 64 + lane) * 4 + t] = v[i] * inv;
    }
    __syncthreads();
    {
        f32x4 acc[4][2];
#pragma unroll
        for (int t = 0; t < 4; ++t) { acc[t][0] = (f32x4){0.f, 0.f, 0.f, 0.f}; acc[t][1] = (f32x4){0.f, 0.f, 0.f, 0.f}; }
        f32x4 va[4], vb[4];
#pragma unroll
        for (int i = 0; i < 4; ++i) { const float* vr = Vc + (size_t)(wid * 64 + i) * D; va[i] = __builtin_nontemporal_load((const f32x4*)(vr + lane * 4)); vb[i] = __builtin_nontemporal_load((const f32x4*)(vr + 256 + lane * 4)); }
        for (int m4 = 0; m4 < 16; ++m4) {
            f32x4 ca[4], cb[4];
#pragma unroll
            for (int i = 0; i < 4; ++i) { ca[i] = va[i]; cb[i] = vb[i]; }
            if (m4 + 1 < 16) {
#pragma unroll
                for (int i = 0; i < 4; ++i) { const float* vr = Vc + (size_t)(wid * 64 + (m4 + 1) * 4 + i) * D; va[i] = __builtin_nontemporal_load((const f32x4*)(vr + lane * 4)); vb[i] = __builtin_nontemporal_load((const f32x4*)(vr + 256 + lane * 4)); }
            }
#pragma unroll
            for (int i = 0; i < 4; ++i) {
                const f32x4 pr = *(const f32x4*)(pm + (wid * 64 + m4 * 4 + i) * 4);
#pragma unroll
                for (int t = 0; t < 4; ++t) { acc[t][0] += ca[i] * pr[t]; acc[t][1] += cb[i] * pr[t]; }
            }
        }
#pragma unroll
        for (int t = 0; t < 4; ++t) { *(f32x4*)(red + (wid * 4 + t) * 512 + lane * 4) = acc[t][0]; *(f32x4*)(red + (wid * 4 + t) * 512 + 256 + lane * 4) = acc[t][1]; }
    }
    __syncthreads();
    {
        bf16_t* ctx = (bf16_t*)(p.ws + WS_CTX);
#pragma unroll
        for (int i = 0; i < 2; ++i) {
            const int e = (tid + 256 * i) * 4, t = e >> 9, d = e & 511;
            const f32x4 s = *(const f32x4*)(red + (0 * 4 + t) * 512 + d) + *(const f32x4*)(red + (1 * 4 + t) * 512 + d) + *(const f32x4*)(red + (2 * 4 + t) * 512 + d) + *(const f32x4*)(red + (3 * 4 + t) * 512 + d);
            store_bf4(ctx + (size_t)(TP + sb * 4 + t) * LDB + hd * 512 + d, s);
        }
    }
    __syncthreads();
}

template <int WIN>
DEV void pool_d_prompt8(const bf16_t* __restrict__ proj, bf16_t* __restrict__ dpl, int row0, int c8) {
    const int t0 = row0 & 2047;
    uint4 u[WIN + 7];
#pragma unroll
    for (int i = 0; i < WIN + 7; ++i) { const int tt = t0 - (WIN - 1) + i; u[i] = (tt >= 0) ? *(const uint4*)(proj + (size_t)(row0 - (WIN - 1) + i) * NPJ + C_U + c8) : make_uint4(0u, 0u, 0u, 0u); }
    float acc[8] = {0.f, 0.f, 0.f, 0.f, 0.f, 0.f, 0.f, 0.f};
#pragma unroll
    for (int i = 0; i < WIN - 1; ++i) { acc[0] += bflo(u[i].x); acc[1] += bfhi(u[i].x); acc[2] += bflo(u[i].y); acc[3] += bfhi(u[i].y); acc[4] += bflo(u[i].z); acc[5] += bfhi(u[i].z); acc[6] += bflo(u[i].w); acc[7] += bfhi(u[i].w); }
#pragma unroll
    for (int j = 0; j < 8; ++j) {
        const uint4 x = u[j + WIN - 1];
        const float xs[8] = {bflo(x.x), bfhi(x.x), bflo(x.y), bfhi(x.y), bflo(x.z), bfhi(x.z), bflo(x.w), bfhi(x.w)};
#pragma unroll
        for (int e_ = 0; e_ < 8; ++e_) acc[e_] += xs[e_];
        const float ic = 1.f / (float)min(WIN, t0 + j + 1);
        uint4 o;
        o.x = cvt_pk_bf16(acc[0] * ic - xs[0], acc[1] * ic - xs[1]); o.y = cvt_pk_bf16(acc[2] * ic - xs[2], acc[3] * ic - xs[3]);
        o.z = cvt_pk_bf16(acc[4] * ic - xs[4], acc[5] * ic - xs[5]); o.w = cvt_pk_bf16(acc[6] * ic - xs[6], acc[7] * ic - xs[7]);
        *(uint4*)(dpl + (size_t)(row0 + j) * LDP + c8) = o;
        const uint4 y = u[j];
        acc[0] -= bflo(y.x); acc[1] -= bfhi(y.x); acc[2] -= bflo(y.y); acc[3] -= bfhi(y.y); acc[4] -= bflo(y.z); acc[5] -= bfhi(y.z); acc[6] -= bflo(y.w); acc[7] -= bfhi(y.w);
    }
}

#ifndef REP0
#define REP0 1
#endif
#ifndef REP1
#define REP1 1
#endif
#ifndef REP2
#define REP2 1
#endif
#ifndef REP3
#define REP3 1
#endif
#ifndef REP4
#define REP4 1
#endif
#ifndef REP5
#define REP5 1
#endif
#ifndef REP6
#define REP6 1
#endif
#ifndef REP7
#define REP7 1
#endif
#ifndef REP8
#define REP8 1
#endif
#ifndef REP9
#define REP9 1
#endif
#ifndef REP10
#define REP10 1
#endif
#ifndef REP11
#define REP11 1
#endif
#ifndef REP12
#define REP12 1
#endif
#ifndef NLAUNCH
#define NLAUNCH 1
#endif
#define GRID_BAR() do { if (NLAUNCH == 1) xcd_barrier(bar); } while (0)
#define IN_PH(k) (p.ph_lo <= (k) && (k) < p.ph_hi)
__global__ void __launch_bounds__(512) hymba_fwd(Params p) {
    __shared__ __attribute__((aligned(16))) unsigned char lds[131072];
    __shared__ uint4 xb_words;
    const int G = gridDim.x, bid = blockIdx.x, VG = 2 * G;
    if (threadIdx.x == 0) xb_words = make_uint4(0u, 0u, 0u, 0u);
#define PH_LOCALS int tid = threadIdx.x; asm volatile("" : "+v"(tid)); const int lane = tid & 63, wid = tid >> 6; const int vb = __builtin_amdgcn_readfirstlane(tid >> 8); \
    unsigned char* vlds = lds + vb * 65536; (void)lane; (void)wid; (void)vlds;
    __syncthreads();
    XcdBarrier bar; bar.bar = (unsigned*)(p.ws + WS_BAR); bar.x = 0; bar.st = (volatile LAS unsigned*)&xb_words;
    if (NLAUNCH == 1) bar = xcd_barrier_post((unsigned*)(p.ws + WS_BAR), (volatile LAS unsigned*)&xb_words);
    unsigned char* ws = p.ws;
    bf16_t* Wt_in = (bf16_t*)(ws + WS_WIN); bf16_t* Wt_out = (bf16_t*)(ws + WS_WOUT); bf16_t* Wt_cq = (bf16_t*)(ws + WS_WCQ); bf16_t* Wt_co = (bf16_t*)(ws + WS_WCO);
    bf16_t* Wt_ckv = (bf16_t*)(ws + WS_WCKV); bf16_t* Wt_pool = (bf16_t*)(ws + WS_WPOOL);
    bf16_t* hbuf = (bf16_t*)(ws + WS_H); bf16_t* hm = (bf16_t*)(ws + WS_HM); bf16_t* proj = (bf16_t*)(ws + WS_PROJ); float* ab = (float*)(ws + WS_AB);
    bf16_t* mkb = (bf16_t*)(ws + WS_MKB); bf16_t* mvt = (bf16_t*)(ws + WS_MVT); bf16_t* dpl = (bf16_t*)(ws + WS_DPL); bf16_t* mix = (bf16_t*)(ws + WS_MIX);
    bf16_t* x1 = (bf16_t*)(ws + WS_X1); bf16_t* qx = (bf16_t*)(ws + WS_QX); float* sc = (float*)(ws + WS_SC); bf16_t* pb = (bf16_t*)(ws + WS_PB);
    bf16_t* ctx = (bf16_t*)(ws + WS_CTX); bf16_t* x2 = (bf16_t*)(ws + WS_X2); float* obuf = (float*)(ws + WS_O);
#define VLOOP(t, N) for (int t##0_ = 2 * bid, t = min(t##0_ + vb, (N) - 1); t##0_ < (N); t##0_ += VG, t = min(t##0_ + vb, (N) - 1))

    if (IN_PH(0)) { PH_LOCALS
        const int NT_IN = 98 * 16, NT_SQ = 32 * 16;
        const int total = NT_IN + 5 * NT_SQ + 32;
        VLOOP(t, total) {
            if (t < NT_IN) { const int nt = t >> 4, kt = t & 15; transpose_tile(p.in[9], 6160, nt * 64, true, kt * 128, Wt_in + (size_t)nt * 64 * LDB, LDB, (float*)vlds); }
            else if (t < NT_IN + 5 * NT_SQ) {
                const int u = t - NT_IN, j = u >> 9, v = u & 511, nt = v >> 4, kt = v & 15;
                const float* src = p.in[j == 0 ? 16 : (j == 1 ? 19 : (j == 2 ? 22 : (j == 3 ? 20 : 21)))];
                bf16_t* dst = j == 0 ? Wt_out : (j == 1 ? Wt_cq : (j == 2 ? Wt_co : (j == 3 ? Wt_ckv : Wt_ckv + (size_t)D * LDB)));
                transpose_tile(src, D, nt * 64, false, kt * 128, dst + (size_t)nt * 64 * LDB, LDB, (float*)vlds);
            } else {
                const int u = t - NT_IN - 5 * NT_SQ, g = u >> 3, v = u & 7, nt = v >> 1, kt = v & 1;
                transpose_tile(p.in[14] + (size_t)g * 65536, 256, nt * 64, false, kt * 128, Wt_pool + ((size_t)g * 256 + nt * 64) * LDM, LDM, (float*)vlds);
            }
        }
        for (int r = bid * 8 + wid; r < TT + 1024; r += G * 8) {
            if (r < TP) rmsnorm_row_bf16(p.in[0] + (size_t)r * D, p.in[8], hbuf + (size_t)r * LDB, lane);
            else if (r < TT) rmsnorm_row_bf16(p.in[1] + (size_t)(r - TP) * D, p.in[8], hbuf + (size_t)r * LDB, lane);
            else rmsnorm_row_bf16(p.in[2] + (size_t)(r - TT) * D, p.in[17], hm + (size_t)(r - TT) * LDB, lane);
        }
    }
    GRID_BAR();
    if (IN_PH(1)) { PH_LOCALS
        for (int t = bid; t < 32 * 24; t += G) { int nt, mt; tile_map(t, 32, 24, mt, nt);
            EpiProj e{mt * 256, nt * 256, proj, ab, p.out};
            gemm256_tile(hbuf + (size_t)mt * 256 * LDB, LDB, Wt_in + (size_t)nt * 256 * LDB, LDB, D, lds, e);
        }
        VLOOP(t, 4 * 48 + 256) {
            if (t < 192) { const int mt = t & 3, nt = t >> 2;
                EpiProj e{TP + mt * 128, nt * 128, proj, ab, p.out};
                gemm_tile<64>(hbuf + (size_t)(TP + mt * 128) * LDB, LDB, Wt_in + (size_t)nt * 128 * LDB, LDB, D, vlds, e);
            } else { const int u = t - 192, mt = u & 7, nt = u >> 3;
                EpiMKV e{mt * 128, nt * 128, mkb, mvt, p.out};
                gemm_tile<64>(hm + (size_t)mt * 128 * LDB, LDB, Wt_ckv + (size_t)nt * 128 * LDB, LDB, D, vlds, e);
            }
        }
        for (int tk = bid * 8 + wid; tk < (TT / 16) * 4; tk += G * 8) ab_rows16(hbuf, Wt_in + (size_t)NPJ * LDB, ab, tk >> 2, tk & 3, lane);
    }
    GRID_BAR();
    if (IN_PH(2)) { PH_LOCALS
        VLOOP(t, 1024) gdn_prep_chunk(p, t, vlds);
        for (int i = bid * 512 + tid; i < (TP / 8) * 128; i += G * 512) {
            const int row0 = (i >> 7) * 8, c8 = (i & 127) * 8, g = c8 >> 8;
            if (g == 0) pool_d_prompt8<2>(proj, dpl, row0, c8); else if (g == 1) pool_d_prompt8<4>(proj, dpl, row0, c8);
            else if (g == 2) pool_d_prompt8<8>(proj, dpl, row0, c8); else pool_d_prompt8<16>(proj, dpl, row0, c8);
        }
        for (int i = TP * 128 + bid * 512 + tid; i < TT * 128; i += G * 512) {
            const int row = i >> 7, c8 = (i & 127) * 8, g = c8 >> 8, win = 2 << g;
            float acc[8] = {0.f, 0.f, 0.f, 0.f, 0.f, 0.f, 0.f, 0.f}, self[8];
            const int tloc = (row - TP) & 3;
            for (int k = 0; k < win; ++k) {
                const int tt = tloc - k;
                if (tt >= 0) {
                    const uint4 u = *(const uint4*)(proj + (size_t)(row - k) * NPJ + C_U + c8);
                    const float f[8] = {bflo(u.x), bfhi(u.x), bflo(u.y), bfhi(u.y), bflo(u.z), bfhi(u.z), bflo(u.w), bfhi(u.w)};
#pragma unroll
                    for (int e = 0; e < 8; ++e) { acc[e] += f[e]; if (k == 0) self[e] = f[e]; }
                } else {
                    const float* sp = p.in[7] + ((size_t)((row - TP) >> 2) * 15 + (15 + tt)) * 1024 + c8;
                    const f32x4 s0 = *(const f32x4*)sp, s1 = *(const f32x4*)(sp + 4);
                    acc[0] += s0[0]; acc[1] += s0[1]; acc[2] += s0[2]; acc[3] += s0[3]; acc[4] += s1[0]; acc[5] += s1[1]; acc[6] += s1[2]; acc[7] += s1[3];
                }
            }
            const float ic = 1.f / (float)win;
            uint4 o; o.x = cvt_pk_bf16(acc[0] * ic - self[0], acc[1] * ic - self[1]); o.y = cvt_pk_bf16(acc[2] * ic - self[2], acc[3] * ic - self[3]);
            o.z = cvt_pk_bf16(acc[4] * ic - self[4], acc[5] * ic - self[5]); o.w = cvt_pk_bf16(acc[6] * ic - self[6], acc[7] * ic - self[7]);
            *(uint4*)(dpl + (size_t)row * LDP + c8) = o;
        }
        for (int i = bid * 512 + tid; i < SB * 11 * 256; i += G * 512) {
            const int c4 = (i & 255) * 4, rr = (i >> 8) % 11, sb = (i >> 8) / 11;
            *(f32x4*)(p.out + O_PS + ((size_t)sb * 15 + rr) * 1024 + c4) = *(const f32x4*)(p.in[7] + ((size_t)sb * 15 + rr + 4) * 1024 + c4);
        }
    }
    GRID_BAR();
    if (IN_PH(3)) { PH_LOCALS
        const int NSC = 256, NSM = 1024, NPL = 68 * 8;
        const int nsb = G >> 1;
        if (bid < nsb) {
            if (G == 256) {
                const int x = bid & 7, j = bid >> 3;
                gdn_scan_item(p, ((x * 4 + (j >> 2)) << 3) | ((j & 3) << 1) | vb, vlds);
            } else
            for (int t0 = 2 * bid; t0 < NSC; t0 += 2 * nsb) gdn_scan_item(p, min(t0 + vb, NSC - 1), vlds);
        } else {
            const int ob = bid - nsb, no = G - nsb;
            for (int t0 = 2 * ob; t0 < NSM; t0 += 2 * no) gdn_sample_item(p, min(t0 + vb, NSM - 1), vlds);
            for (int t0 = 2 * ob; t0 < NPL; t0 += 2 * no) { const int t = min(t0 + vb, NPL - 1); int nt, mt; tile_map(t, 68, 8, mt, nt); const int g = nt >> 1;
                EpiPool e{mt * 128, nt * 128, proj, p.in[15], mix};
                gemm_tile<64>(dpl + (size_t)mt * 128 * LDP + g * 256, LDP, Wt_pool + (size_t)nt * 128 * LDM, LDM, 256, vlds, e);
            }
        }
    }
    GRID_BAR();
    if (IN_PH(4)) { PH_LOCALS
        for (int i = bid * 512 + tid; i < TP * 8 * 16; i += G * 512) {
            const int l16 = i & 15, rh = i >> 4, h = rh & 7, row = rh >> 3;
            const float* op = obuf + (size_t)row * 1024 + h * 128 + l16 * 8;
            const f32x4 a = *(const f32x4*)op, b4 = *(const f32x4*)(op + 4);
            float ss = a[0] * a[0] + a[1] * a[1] + a[2] * a[2] + a[3] * a[3] + b4[0] * b4[0] + b4[1] * b4[1] + b4[2] * b4[2] + b4[3] * b4[3];
            ss += __shfl_xor(ss, 1); ss += __shfl_xor(ss, 2); ss += __shfl_xor(ss, 4); ss += __shfl_xor(ss, 8);
            const float rs = rsqrtf(ss * (1.f / 128.f) + EPS);
            const f32x4 g0 = *(const f32x4*)(p.in[13] + l16 * 8), g1 = *(const f32x4*)(p.in[13] + l16 * 8 + 4);
            const uint4 z = *(const uint4*)(proj + (size_t)row * NPJ + C_ZA + h * 128 + l16 * 8);
            uint4 o;
            o.x = cvt_pk_bf16(a[0] * rs * g0[0] * silu_f(bflo(z.x)), a[1] * rs * g0[1] * silu_f(bfhi(z.x)));
            o.y = cvt_pk_bf16(a[2] * rs * g0[2] * silu_f(bflo(z.y)), a[3] * rs * g0[3] * silu_f(bfhi(z.y)));
            o.z = cvt_pk_bf16(b4[0] * rs * g1[0] * silu_f(bflo(z.z)), b4[1] * rs * g1[1] * silu_f(bfhi(z.z)));
            o.w = cvt_pk_bf16(b4[2] * rs * g1[2] * silu_f(bflo(z.w)), b4[3] * rs * g1[3] * silu_f(bfhi(z.w)));
            *(uint4*)(mix + (size_t)row * LDB + h * 128 + l16 * 8) = o;
        }
    }
    GRID_BAR();
    if (IN_PH(5)) { PH_LOCALS
        for (int t = bid; t < 32 * 8; t += G) { int nt, mt; tile_map(t, 32, 8, mt, nt);
            EpiResid e{p.in[0] + (size_t)mt * 256 * D + nt * 256, x1 + (size_t)mt * 256 * LDB + nt * 256};
            gemm256_tile(mix + (size_t)mt * 256 * LDB, LDB, Wt_out + (size_t)nt * 256 * LDB, LDB, D, lds, e);
        }
        VLOOP(t, 8 * 32) { const int mt = t & 7, nt = t >> 3;
            EpiResid e{p.in[1] + (size_t)mt * 64 * D + nt * 64, x1 + (size_t)(TP + mt * 64) * LDB + nt * 64};
            gemm_tile<32>(mix + (size_t)(TP + mt * 64) * LDB, LDB, Wt_out + (size_t)nt * 64 * LDB, LDB, D, vlds, e);
        }
    }
    GRID_BAR();
    if (IN_PH(6)) { PH_LOCALS
    for (int r = bid * 8 + wid; r < TT; r += G * 8) rmsnorm_row_from_bf16<false>(x1 + (size_t)r * LDB, p.in[18], hbuf + (size_t)r * LDB, lane);
    }
    GRID_BAR();
    if (IN_PH(7)) { PH_LOCALS
        VLOOP(t, 8 * 32) { const int mt = t & 7, nt = t >> 3;
            EpiBf e{qx + (size_t)(TP + mt * 64) * LDB + nt * 64, LDB};
            gemm_tile<32>(hbuf + (size_t)(TP + mt * 64) * LDB, LDB, Wt_cq + (size_t)nt * 64 * LDB, LDB, D, vlds, e);
        }
    }
    GRID_BAR();
    if (IN_PH(7)) { PH_LOCALS
        const int ng = G >> 1;
        if (bid < ng) {
            for (int t = bid; t < 32 * 8; t += ng) { int nt, mt; tile_map(t, 32, 8, mt, nt);
                EpiBf e{qx + (size_t)mt * 256 * LDB + nt * 256, LDB};
                gemm256_tile(hbuf + (size_t)mt * 256 * LDB, LDB, Wt_cq + (size_t)nt * 256 * LDB, LDB, D, lds, e);
            }
        } else {
            const int ob = bid - ng, no = G - ng;
            for (int t0 = 2 * ob; t0 < 512; t0 += 2 * no) attn_sample_item(p, min(t0 + vb, 511), vlds);
        }
    }
    GRID_BAR();
    if (IN_PH(8)) { PH_LOCALS
        const int NS1 = 16 * 16 * 2;
        VLOOP(t, NS1) { const int bhd = t >> 5, v = t & 31, mt = v >> 1, nt = v & 1, b = bhd >> 2, hd = bhd & 3;
            EpiF32s e{sc + (size_t)(b * SEQ + mt * 128) * 1024 + hd * 256 + nt * 128, 1024, 0.04419417382415922f};
            gemm_tile<64>(qx + (size_t)(b * SEQ + mt * 128) * LDB + hd * 512, LDB, mkb + (size_t)(b * 256 + nt * 128) * LDB + hd * 512, LDB, 512, vlds, e);
        }
    }
    GRID_BAR();
    if (IN_PH(9)) { PH_LOCALS
    for (int r = bid * 8 + wid; r < TP * 4; r += G * 8) {
        const f32x4 v = *(const f32x4*)(sc + (size_t)r * 256 + lane * 4);
        const float mx = wave_max(fmaxf(fmaxf(v[0], v[1]), fmaxf(v[2], v[3])));
        f32x4 e; e[0] = __expf(v[0] - mx); e[1] = __expf(v[1] - mx); e[2] = __expf(v[2] - mx); e[3] = __expf(v[3] - mx);
        const float inv = 1.f / wave_sum(e[0] + e[1] + e[2] + e[3]);
        store_bf4(pb + (size_t)(r >> 2) * LDP + (r & 3) * 256 + lane * 4, e * inv);
    }
    }
    GRID_BAR();
    if (IN_PH(10)) { PH_LOCALS
        VLOOP(t, 16 * 16 * 4) { const int bhd = t >> 6, v = t & 63, mt = v >> 2, nt = v & 3, b = bhd >> 2, hd = bhd & 3;
            EpiBf e{ctx + (size_t)(b * SEQ + mt * 128) * LDB + hd * 512 + nt * 128, LDB};
            gemm_tile<64>(pb + (size_t)(b * SEQ + mt * 128) * LDP + hd * 256, LDP, mvt + ((size_t)b * D + hd * 512 + nt * 128) * LDM, LDM, 256, vlds, e);
        }
    }
    GRID_BAR();
    if (IN_PH(11)) { PH_LOCALS
        for (int t = bid; t < 32 * 8; t += G) { int nt, mt; tile_map(t, 32, 8, mt, nt);
            EpiResidB e{x1 + (size_t)mt * 256 * LDB + nt * 256, x2 + (size_t)mt * 256 * LDB + nt * 256};
            gemm256_tile(ctx + (size_t)mt * 256 * LDB, LDB, Wt_co + (size_t)nt * 256 * LDB, LDB, D, lds, e);
        }
        VLOOP(t, 8 * 32) { const int mt = t & 7, nt = t >> 3;
            EpiResidB e{x1 + (size_t)(TP + mt * 64) * LDB + nt * 64, x2 + (size_t)(TP + mt * 64) * LDB + nt * 64};
            gemm_tile<32>(ctx + (size_t)(TP + mt * 64) * LDB, LDB, Wt_co + (size_t)nt * 64 * LDB, LDB, D, vlds, e);
        }
    }
    GRID_BAR();
    if (IN_PH(12)) { PH_LOCALS
    for (int r = bid * 8 + wid; r < TT; r += G * 8) rmsnorm_row_from_bf16<true>(x2 + (size_t)r * LDB, p.in[23], p.out + (r < TP ? O_YP + (size_t)r * D : O_YS + (size_t)(r - TP) * D), lane);
    }
}

extern "C" void kernel_launch(void* const* d_in, const int* in_sizes, int n_in, void* d_out, int out_size, void* d_ws, size_t ws_size, hipStream_t stream) {
    static int grid = 0;
    if (grid == 0) {
        if (n_in != 24 || ws_size < WS_END) { fprintf(stderr, "kernel_launch: need 24 inputs and %zu bytes of workspace (got %d, %zu)\n", (size_t)WS_END, n_in, ws_size); grid = -1; return; }
        int dev = 0, cus = 0, per_cu = 0;
        hipGetDevice(&dev);
        hipDeviceGetAttribute(&cus, hipDeviceAttributeMultiprocessorCount, dev);
        if (hipOccupancyMaxActiveBlocksPerMultiprocessor(&per_cu, (const void*)hymba_fwd, 512, 0) != hipSuccess || per_cu < 1) { fprintf(stderr, "kernel_launch: occupancy query failed\n"); grid = -1; return; }
        if (per_cu > 1) per_cu = 1;
        grid = cus * per_cu;
        fprintf(stderr, "kernel_launch: grid %d (%d per CU)\n", grid, per_cu);
    }
    if (grid < 0) return;
    hipMemsetAsync((char*)d_ws + WS_BAR, 0, 16384, stream);
    Params p{};
    for (int i = 0; i < 24; ++i) p.in[i] = (const float*)d_in[i];
    p.out = (float*)d_out; p.ws = (unsigned char*)d_ws;
    if (NLAUNCH == 1) {
        p.ph_lo = 0; p.ph_hi = 13;
        void* args[] = {&p};
        hipError_t e = hipLaunchCooperativeKernel((const void*)hymba_fwd, dim3(grid), dim3(512), args, 0, stream);
        if (e != hipSuccess) fprintf(stderr, "kernel_launch: cooperative launch failed: %s (grid %d)\n", hipGetErrorString(e), grid);
    } else {
        for (int k = 0; k < 13; ++k) { p.ph_lo = k; p.ph_hi = k + 1; hipLaunchKernelGGL(hymba_fwd, dim3(grid), dim3(512), 0, stream, p); }
    }
}
```

```cpp
#include <hip/hip_runtime.h>
#include <hip/hip_cooperative_groups.h>
#include <cstdio>
#include <cstdint>

typedef unsigned short bf16_t;
typedef short bf16x8 __attribute__((ext_vector_type(8)));
typedef float f32x4 __attribute__((ext_vector_type(4)));
typedef unsigned u32x4 __attribute__((ext_vector_type(4)));
#define DEV __device__ __forceinline__
#define LAS __attribute__((address_space(3)))

constexpr int D = 2048, TP = 8192, TS = 512, TT = 8704, SEQ = 2048, NB = 4, SB = 128;
constexpr int NPJ = 6144;
constexpr int C_ZA = 3072, C_U = 4096, C_ZB = 5120;
constexpr int NWIN = 6272;
constexpr float EPS = 1e-6f;
constexpr int LDB = 2112, LDP = 1088, LDM = 288;

constexpr size_t O_YP = 0, O_YS = 16777216, O_MK = 17825792, O_MV = 19922944, O_DP = 22020096, O_CP = 22544384,
                 O_PP = 22581248, O_DS = 22642688, O_CS = 39419904, O_PS = 40599552;

constexpr size_t al256(size_t x) { return (x + 255) & ~(size_t)255; }
constexpr size_t WS_BAR = 0;
constexpr size_t WS_WIN = 16384;
constexpr size_t WS_WOUT = WS_WIN + (size_t)NWIN * LDB * 2;
constexpr size_t WS_WCQ = WS_WOUT + (size_t)D * LDB * 2;
constexpr size_t WS_WCO = WS_WCQ + (size_t)D * LDB * 2;
constexpr size_t WS_WCKV = WS_WCO + (size_t)D * LDB * 2;
constexpr size_t WS_WPOOL = WS_WCKV + (size_t)2 * D * LDB * 2;
constexpr size_t WS_H = WS_WPOOL + (size_t)1024 * LDM * 2;
constexpr size_t WS_HM = WS_H + (size_t)TT * LDB * 2;
constexpr size_t WS_PROJ = WS_HM + (size_t)1024 * LDB * 2;
constexpr size_t WS_AB = WS_PROJ + (size_t)TT * NPJ * 2;
constexpr size_t WS_MKB = WS_AB + (size_t)4 * TT * 16 * 4;
constexpr size_t WS_MVT = WS_MKB + (size_t)1024 * LDB * 2;
constexpr size_t WS_GW = WS_MVT + (size_t)4 * D * LDM * 2;
constexpr size_t WS_GQ = WS_GW + (size_t)1024 * 8192 * 2;
constexpr size_t WS_GKT = WS_GQ + (size_t)1024 * 8192 * 2;
constexpr size_t WS_GA = WS_GKT + (size_t)1024 * 8192 * 2;
constexpr size_t WS_GU = WS_GA + (size_t)1024 * 4096 * 2;
constexpr size_t WS_GE = WS_GU + (size_t)1024 * 8192 * 4;
constexpr size_t WS_O = WS_GE + 4096;
constexpr size_t WS_DPL = WS_O + (size_t)TP * 1024 * 4;
constexpr size_t WS_MIX = WS_DPL + (size_t)TT * LDP * 2;
constexpr size_t WS_X1 = WS_MIX + (size_t)TT * LDB * 2;
constexpr size_t WS_QX = WS_X1 + (size_t)TT * D * 4;
constexpr size_t WS_SC = WS_QX + (size_t)TT * LDB * 2;
constexpr size_t WS_PB = WS_SC + (size_t)TP * 1024 * 4;
constexpr size_t WS_CTX = WS_PB + (size_t)TP * LDP * 2;
constexpr size_t WS_X2 = WS_CTX + (size_t)TT * LDB * 2;
constexpr size_t WS_END = WS_X2 + (size_t)TT * D * 4;

#ifndef LASTP
#define LASTP 99
#endif
struct Params { const float* in[24]; float* out; unsigned char* ws; int ph_lo, ph_hi; };

typedef __bf16 bf16x2_t __attribute__((ext_vector_type(2)));
typedef float f32x2_t __attribute__((ext_vector_type(2)));
DEV unsigned cvt_pk_bf16(float lo, float hi) { const f32x2_t v = {lo, hi}; const bf16x2_t b = __builtin_convertvector(v, bf16x2_t); return __builtin_bit_cast(unsigned, b); }
DEV bf16_t f2bf(float f) { return (bf16_t)(cvt_pk_bf16(f, 0.f) & 0xffffu); }
DEV float bf2f(unsigned b) { return __uint_as_float(b << 16); }
DEV float bflo(unsigned u) { return __uint_as_float(u << 16); }
DEV float bfhi(unsigned u) { return __uint_as_float(u & 0xffff0000u); }
DEV float silu_f(float x) { return x / (1.f + __expf(-x)); }
DEV float wave_sum(float v) {
#pragma unroll
    for (int o = 32; o >= 1; o >>= 1) v += __shfl_xor(v, o);
    return v;
}
DEV float wave_max(float v) {
#pragma unroll
    for (int o = 32; o >= 1; o >>= 1) v = fmaxf(v, __shfl_xor(v, o));
    return v;
}
DEV void store_bf4(bf16_t* p, f32x4 v) { uint2 w; w.x = cvt_pk_bf16(v[0], v[1]); w.y = cvt_pk_bf16(v[2], v[3]); *(uint2*)p = w; }

#define XB_TMO      128
#define XB_XCNT(j)  (256  + 64 * (j))
#define XB_XSUB(j)  (1280 + 64 * (j))
#define XB_XGEN(j)  (2304 + 64 * (j))
#define XB_TOP      3328
#define XB_TOPGEN   3392
#define XCD_BAR_WORDS 3456
#define XB_SPIN_CAP (1u << 22)
DEV unsigned xb_ld(unsigned* p) { return __hip_atomic_load(p, __ATOMIC_RELAXED, __HIP_MEMORY_SCOPE_AGENT); }
DEV unsigned xb_add(unsigned* p, unsigned v) { return __hip_atomic_fetch_add(p, v, __ATOMIC_RELAXED, __HIP_MEMORY_SCOPE_AGENT); }
DEV unsigned xb_xcc_id() { return (unsigned)__builtin_amdgcn_s_getreg((3 << 11) | 20) & 0xFu; }
#define XB_SPIN(cond, bar) do { unsigned _sp = 0; while (cond) { __builtin_amdgcn_s_sleep(1); \
    if ((++_sp & 255u) == 0u) { if (xb_ld(&(bar)[XB_TMO])) break; if (_sp > XB_SPIN_CAP) { atomicAdd(&(bar)[XB_TMO], 1u); break; } } } } while (0)
struct XcdBarrier { unsigned* bar; unsigned x; volatile LAS unsigned* st; };
DEV XcdBarrier xcd_barrier_post(unsigned* bar, volatile LAS unsigned* st) {
    XcdBarrier b; b.bar = bar; b.x = xb_xcc_id(); b.st = st;
    if (threadIdx.x == 0) (void)xb_add(&bar[XB_XCNT(b.x)], 1u);
    return b;
}
DEV void xcd_barrier_complete(unsigned* bar, unsigned x, unsigned& nloc, unsigned& nx) {
    const unsigned G = gridDim.x;
    unsigned sum, cnt, mine, sp = 0u;
    for (;;) {
        sum = 0u; cnt = 0u; mine = 0u;
#pragma unroll
        for (unsigned j = 0; j < 16; ++j) { const unsigned c = xb_ld(&bar[XB_XCNT(j)]); sum += c; cnt += (c > 0u) ? 1u : 0u; mine = (j == x) ? c : mine; }
        if (sum == G) break;
        __builtin_amdgcn_s_sleep(1);
        if ((++sp & 255u) == 0u) { if (xb_ld(&bar[XB_TMO])) break; if (sp > XB_SPIN_CAP) { atomicAdd(&bar[XB_TMO], 1u); break; } }
    }
    nloc = mine > 0u ? mine : 1u; nx = cnt > 0u ? cnt : 1u;
}
DEV void xcd_barrier(const XcdBarrier& b) {
    asm volatile("s_waitcnt vmcnt(0)" ::: "memory");
    __syncthreads();
    if (threadIdx.x == 0) {
        unsigned* bar = b.bar;
        __builtin_amdgcn_s_waitcnt(0);
        unsigned nloc = b.st[0], nx = b.st[1];
        if (nloc == 0u) { xcd_barrier_complete(bar, b.x, nloc, nx); b.st[0] = nloc; b.st[1] = nx; }
        const unsigned old = xb_add(&bar[XB_XSUB(b.x)], 1u);
        const unsigned gen = old / nloc;
        if (old + 1u == (gen + 1u) * nloc) {
            __builtin_amdgcn_fence(__ATOMIC_RELEASE, "agent");
            asm volatile("s_waitcnt vmcnt(0)" ::: "memory");
            const unsigned og = xb_add(&bar[XB_TOP], 1u);
            const unsigned tg = og / nx;
            if (og + 1u == (tg + 1u) * nx) xb_add(&bar[XB_TOPGEN], 1u);
            else XB_SPIN(xb_ld(&bar[XB_TOPGEN]) == tg, bar);
            __builtin_amdgcn_fence(__ATOMIC_ACQUIRE, "agent");
            xb_add(&bar[XB_XGEN(b.x)], 1u);
            asm volatile("s_waitcnt vmcnt(0)" ::: "memory");
        } else {
            XB_SPIN(xb_ld(&bar[XB_XGEN(b.x)]) == gen, bar);
            __builtin_amdgcn_fence(__ATOMIC_ACQUIRE, "agent");
            asm volatile("s_waitcnt vmcnt(0)" ::: "memory");
        }
    }
    __syncthreads();
}

DEV void glds16(const void* gptr, unsigned lds_addr_lane) {
    const unsigned m = __builtin_amdgcn_readfirstlane(lds_addr_lane);
    unsigned keep;
    asm volatile("s_mov_b32 %0, m0\n\ts_mov_b32 m0, %2\n\ts_nop 0\n\tglobal_load_lds_dwordx4 %1, off\n\ts_mov_b32 m0, %0" : "=&s"(keep) : "v"(gptr), "s"(m) : "memory");
}

template <int WT, class Epi>
DEV void gemm_tile(const bf16_t* __restrict__ A, int lda, const bf16_t* __restrict__ Bt, int ldb, int K, unsigned char* lds, const Epi& epi) {
    constexpr int FI = WT / 16;
    constexpr int OPB = 2 * WT * 128;
    constexpr int STB = 2 * OPB;
    int tid = threadIdx.x & 255; asm volatile("" : "+v"(tid)); const int lane = tid & 63, wid = tid >> 6;
    const int wr = wid >> 1, wc = wid & 1, fr = lane & 15, fq = lane >> 4;
    f32x4 acc[FI][FI];
#pragma unroll
    for (int i = 0; i < FI; ++i)
#pragma unroll
        for (int j = 0; j < FI; ++j) acc[i][j] = (f32x4){0.f, 0.f, 0.f, 0.f};
    const int lrow = tid >> 3, lcs = (tid & 7) ^ (lrow & 7);
    const bf16_t* ap = A + (size_t)lrow * lda + lcs * 8;
    const bf16_t* bp = Bt + (size_t)lrow * ldb + lcs * 8;
    const unsigned l3a = (unsigned)(size_t)(LAS unsigned char*)lds;
    const int nk = K >> 6;
#define GLDS_STAGE(st, kt_) do { \
        _Pragma("unroll") for (int i_ = 0; i_ < FI; ++i_) { \
            glds16(ap + (size_t)(32 * i_) * lda + (kt_) * 64, l3a + (st) + tid * 16 + i_ * 4096); \
            glds16(bp + (size_t)(32 * i_) * ldb + (kt_) * 64, l3a + (st) + OPB + tid * 16 + i_ * 4096); } } while (0)
    constexpr int NSTG = 65536 / STB;
#pragma unroll
    for (int s_ = 0; s_ < NSTG - 1; ++s_) if (s_ < nk) GLDS_STAGE(s_ * STB, s_);
    const int aoff = (wr * WT + fr) * 128, boff = OPB + (wc * WT + fr) * 128, sw = fr & 7;
    int cur = 0, nxt = (NSTG - 1) * STB;
    for (int kt = 0; kt < nk; ++kt) {
        if (NSTG == 4 && kt + 2 < nk) { if (FI == 2) asm volatile("s_waitcnt vmcnt(8)" ::: "memory"); else asm volatile("s_waitcnt vmcnt(0)" ::: "memory"); }
        else asm volatile("s_waitcnt vmcnt(0)" ::: "memory");
        __syncthreads();
        if (kt + NSTG - 1 < nk) GLDS_STAGE(nxt, kt + NSTG - 1);
#pragma unroll
        for (int kh = 0; kh < 2; ++kh) {
            bf16x8 af[FI], bfr[FI];
            const int ch = ((kh * 4 + fq) ^ sw) << 4;
#pragma unroll
            for (int i = 0; i < FI; ++i) { af[i] = *(const bf16x8*)(lds + cur + aoff + i * 2048 + ch); bfr[i] = *(const bf16x8*)(lds + cur + boff + i * 2048 + ch); }
#pragma unroll
            for (int mi = 0; mi < FI; ++mi)
#pragma unroll
                for (int ni = 0; ni < FI; ++ni) acc[mi][ni] = __builtin_amdgcn_mfma_f32_16x16x32_bf16(bfr[ni], af[mi], acc[mi][ni], 0, 0, 0);
        }
        nxt = cur; cur += STB; if (cur == NSTG * STB) cur = 0;
    }
#undef GLDS_STAGE
    __syncthreads();
#pragma unroll
    for (int mi = 0; mi < FI; ++mi)
#pragma unroll
        for (int ni = 0; ni < FI; ++ni) epi(wr * WT + mi * 16 + fr, wc * WT + ni * 16 + fq * 4, acc[mi][ni]);
}

template <class Epi>
DEV void gemm256_tile(const bf16_t* __restrict__ A, int lda, const bf16_t* __restrict__ Bt, int ldb, int K, unsigned char* lds, const Epi& epi) {
    int tid = threadIdx.x; asm volatile("" : "+v"(tid)); const int lane = tid & 63, wid = tid >> 6;
    const int wr = wid >> 2, wc = wid & 3, fr = lane & 15, fq = lane >> 4;
    f32x4 acc[8][4];
#pragma unroll
    for (int i = 0; i < 8; ++i)
#pragma unroll
        for (int j = 0; j < 4; ++j) acc[i][j] = (f32x4){0.f, 0.f, 0.f, 0.f};
    const int lrow = tid >> 3, lcs = (tid & 7) ^ (lrow & 7);
    const bf16_t* ap = A + (size_t)lrow * lda + lcs * 8;
    const bf16_t* bp = Bt + (size_t)lrow * ldb + lcs * 8;
    const unsigned l3a = (unsigned)(size_t)(LAS unsigned char*)lds;
    const int nk = K >> 6;
#define GLDS_STAGE(st, kt_) do { \
        _Pragma("unroll") for (int i_ = 0; i_ < 4; ++i_) { \
            glds16(ap + (size_t)(64 * i_) * lda + (kt_) * 64, l3a + (st) + tid * 16 + i_ * 8192); \
            glds16(bp + (size_t)(64 * i_) * ldb + (kt_) * 64, l3a + (st) + 32768 + tid * 16 + i_ * 8192); } } while (0)
    GLDS_STAGE(0, 0);
    const int aoff = (wr * 128 + fr) * 128, boff = 32768 + (wc * 64 + fr) * 128, sw = fr & 7;
    for (int kt = 0; kt < nk; ++kt) {
        const int cur = (kt & 1) * 65536;
        asm volatile("s_waitcnt vmcnt(0)" ::: "memory");
        __syncthreads();
        if (kt + 1 < nk) GLDS_STAGE(cur ^ 65536, kt + 1);
#pragma unroll
        for (int kh = 0; kh < 2; ++kh) {
            bf16x8 bfr[4];
            const int ch = ((kh * 4 + fq) ^ sw) << 4;
#pragma unroll
            for (int i = 0; i < 4; ++i) bfr[i] = *(const bf16x8*)(lds + cur + boff + i * 2048 + ch);
#pragma unroll
            for (int mh = 0; mh < 2; ++mh) {
                bf16x8 af[4];
#pragma unroll
                for (int i = 0; i < 4; ++i) af[i] = *(const bf16x8*)(lds + cur + aoff + (mh * 4 + i) * 2048 + ch);
#pragma unroll
                for (int mi = 0; mi < 4; ++mi)
#pragma unroll
                    for (int ni = 0; ni < 4; ++ni) acc[mh * 4 + mi][ni] = __builtin_amdgcn_mfma_f32_16x16x32_bf16(bfr[ni], af[mi], acc[mh * 4 + mi][ni], 0, 0, 0);
            }
        }
    }
#undef GLDS_STAGE
    __syncthreads();
#pragma unroll
    for (int mi = 0; mi < 8; ++mi)
#pragma unroll
        for (int ni = 0; ni < 4; ++ni) epi(wr * 128 + mi * 16 + fr, wc * 64 + ni * 16 + fq * 4, acc[mi][ni]);
}

DEV void ab_rows16(const bf16_t* __restrict__ h, const bf16_t* __restrict__ wab, float* __restrict__ ab4, int rt, int kq, int lane) {
    const int fr = lane & 15, fq = lane >> 4;
    const bf16_t* ap = h + (size_t)(rt * 16 + fr) * LDB + kq * 512 + fq * 8;
    const bf16_t* bp = wab + (size_t)fr * LDB + kq * 512 + fq * 8;
    bf16x8 a[16], b[16];
#pragma unroll
    for (int s = 0; s < 16; ++s) { a[s] = *(const bf16x8*)(ap + s * 32); b[s] = *(const bf16x8*)(bp + s * 32); }
    f32x4 acc = {0.f, 0.f, 0.f, 0.f};
#pragma unroll
    for (int s = 0; s < 16; ++s) acc = __builtin_amdgcn_mfma_f32_16x16x32_bf16(b[s], a[s], acc, 0, 0, 0);
    *(f32x4*)(ab4 + (size_t)kq * TT * 16 + (size_t)(rt * 16 + fr) * 16 + fq * 4) = acc;
}

DEV void tile_map(int L, int nM, int nN, int& pm, int& pn) {
    const int T = nM * nN, q = T >> 3, r = T & 7, xcd = L & 7, off = L >> 3;
    const int w = (xcd < r ? xcd * (q + 1) : r * (q + 1) + (xcd - r) * q) + off;
    const int nig = 8 * nN, gid = w / nig, fm = gid * 8, gsz = (nM - fm) < 8 ? (nM - fm) : 8;
    pm = fm + (w % nig) % gsz; pn = (w % nig) / gsz;
}

struct EpiProj {
    int m0, n0; bf16_t* proj; float* ab; float* out;
    DEV void operator()(int r, int c, f32x4 v) const {
        const int row = m0 + r, col = n0 + c;
        if (col < NPJ) {
            store_bf4(proj + (size_t)row * NPJ + col, v);
            const bool isconv = col < 3072, ispool = (col >= C_U && col < C_ZB);
            if (isconv || ispool) {
                if (row < TP) {
                    const int b = row >> 11, t = row & 2047;
                    if (isconv) { if (t >= 2045) *(f32x4*)(out + O_CP + ((size_t)(b * 3 + (t - 2045))) * 3072 + col) = v; }
                    else { if (t >= 2033) *(f32x4*)(out + O_PP + ((size_t)(b * 15 + (t - 2033))) * 1024 + (col - C_U)) = v; }
                } else {
                    const int sb = (row - TP) >> 2, t = (row - TP) & 3;
                    if (isconv) { if (t >= 1) *(f32x4*)(out + O_CS + ((size_t)(sb * 3 + (t - 1))) * 3072 + col) = v; }
                    else *(f32x4*)(out + O_PS + ((size_t)(sb * 15 + 11 + t)) * 1024 + (col - C_U)) = v;
                }
            }
        } else if (col < NPJ + 16) {
            *(f32x4*)(ab + (size_t)row * 16 + (col - NPJ)) = v;
        }
    }
};
struct EpiMKV {
    int m0, n0; bf16_t* mkb; bf16_t* mvt; float* out;
    DEV void operator()(int r, int c, f32x4 v) const {
        const int row = m0 + r, col = n0 + c;
        if (col < D) {
            __builtin_nontemporal_store(v, (f32x4*)(out + O_MK + (size_t)row * D + col));
            store_bf4(mkb + (size_t)row * LDB + col, v);
        } else {
            const int cc = col - D, b = row >> 8, m = row & 255;
            __builtin_nontemporal_store(v, (f32x4*)(out + O_MV + (size_t)row * D + cc));
            bf16_t* p = mvt + ((size_t)b * D + cc) * LDM + m;
            p[0] = f2bf(v[0]); p[LDM] = f2bf(v[1]); p[2 * LDM] = f2bf(v[2]); p[3 * LDM] = f2bf(v[3]);
        }
    }
};
struct EpiPool {
    int m0, n0; const bf16_t* proj; const float* scale; bf16_t* mix;
    DEV void operator()(int r, int c, f32x4 v) const {
        const int row = m0 + r, col = n0 + c;
        const uint2 z = *(const uint2*)(proj + (size_t)row * NPJ + C_ZB + col);
        const f32x4 s = *(const f32x4*)(scale + col);
        f32x4 o;
        o[0] = v[0] * s[0] * silu_f(bflo(z.x)); o[1] = v[1] * s[1] * silu_f(bfhi(z.x));
        o[2] = v[2] * s[2] * silu_f(bflo(z.y)); o[3] = v[3] * s[3] * silu_f(bfhi(z.y));
        store_bf4(mix + (size_t)row * LDB + 1024 + col, o);
    }
};
struct EpiResid {
    const float* res; bf16_t* dst;
    DEV void operator()(int r, int c, f32x4 v) const {
        const f32x4 x = __builtin_nontemporal_load((const f32x4*)(res + (size_t)r * D + c));
        store_bf4(dst + (size_t)r * LDB + c, x + v);
    }
};
struct EpiResidB {
    const bf16_t* res; bf16_t* dst;
    DEV void operator()(int r, int c, f32x4 v) const {
        const uint2 u = *(const uint2*)(res + (size_t)r * LDB + c);
        f32x4 x; x[0] = bflo(u.x); x[1] = bfhi(u.x); x[2] = bflo(u.y); x[3] = bfhi(u.y);
        store_bf4(dst + (size_t)r * LDB + c, x + v);
    }
};
struct EpiBf {
    bf16_t* dst; int ld;
    DEV void operator()(int r, int c, f32x4 v) const { store_bf4(dst + (size_t)r * ld + c, v); }
};
struct EpiF32s {
    float* dst; int ld; float s;
    DEV void operator()(int r, int c, f32x4 v) const { *(f32x4*)(dst + (size_t)r * ld + c) = v * s; }
};

DEV int win_srccol(int n) { return n < 4096 ? n : (n < 6144 ? n + 16 : (n < 6160 ? 4096 + (n - 6144) : -1)); }
DEV void transpose_tile(const float* __restrict__ src, int ld, int srccol0, bool remap, int k0, bf16_t* __restrict__ dstrow0, int ldd, float* tile) {
    int tid = threadIdx.x & 255; asm volatile("" : "+v"(tid));
    const int tx = tid & 63, ty = tid >> 6;
    const int sc = remap ? win_srccol(srccol0 + tx) : (srccol0 + tx);
    float tv[32];
#pragma unroll
    for (int i = 0; i < 32; ++i) tv[i] = sc >= 0 ? __builtin_nontemporal_load(src + (size_t)(k0 + ty + 4 * i) * ld + sc) : 0.f;
#pragma unroll
    for (int i = 0; i < 32; ++i) tile[(ty + 4 * i) * 65 + tx] = tv[i];
    __syncthreads();
#pragma unroll
    for (int i = 0; i < 16; ++i) { const int r = ty + 4 * i; *(unsigned*)(dstrow0 + (size_t)r * ldd + k0 + 2 * tx) = cvt_pk_bf16(tile[(2 * tx) * 65 + r], tile[(2 * tx + 1) * 65 + r]); }
    __syncthreads();
}
DEV void rmsnorm_row_bf16(const float* __restrict__ x, const float* __restrict__ g, bf16_t* __restrict__ y, int lane) {
    f32x4 v[8]; float ss = 0.f;
#pragma unroll
    for (int i = 0; i < 8; ++i) { v[i] = __builtin_nontemporal_load((const f32x4*)x + i * 64 + lane); ss += v[i][0] * v[i][0] + v[i][1] * v[i][1] + v[i][2] * v[i][2] + v[i][3] * v[i][3]; }
    ss = wave_sum(ss);
    const float rs = rsqrtf(ss * (1.f / 2048.f) + EPS);
#pragma unroll
    for (int i = 0; i < 8; ++i) { const f32x4 gg = ((const f32x4*)g)[i * 64 + lane]; store_bf4(y + (size_t)(i * 64 + lane) * 4, v[i] * rs * gg); }
}
template <bool OUT_F32>
DEV void rmsnorm_row_from_bf16(const bf16_t* __restrict__ x, const float* __restrict__ g, void* __restrict__ y, int lane) {
    float v[4][8]; float ss = 0.f;
#pragma unroll
    for (int i = 0; i < 4; ++i) { uint4 u; if (OUT_F32) { const u32x4 t_ = __builtin_nontemporal_load((const u32x4*)x + i * 64 + lane); u = make_uint4(t_[0], t_[1], t_[2], t_[3]); } else u = ((const uint4*)x)[i * 64 + lane];
        v[i][0] = bflo(u.x); v[i][1] = bfhi(u.x); v[i][2] = bflo(u.y); v[i][3] = bfhi(u.y); v[i][4] = bflo(u.z); v[i][5] = bfhi(u.z); v[i][6] = bflo(u.w); v[i][7] = bfhi(u.w);
#pragma unroll
        for (int e = 0; e < 8; ++e) ss += v[i][e] * v[i][e]; }
    ss = wave_sum(ss);
    const float rs = rsqrtf(ss * (1.f / 2048.f) + EPS);
#pragma unroll
    for (int i = 0; i < 4; ++i) {
        const f32x4 g0 = ((const f32x4*)g)[(i * 64 + lane) * 2], g1 = ((const f32x4*)g)[(i * 64 + lane) * 2 + 1];
        const f32x4 o0 = (f32x4){v[i][0], v[i][1], v[i][2], v[i][3]} * rs * g0, o1 = (f32x4){v[i][4], v[i][5], v[i][6], v[i][7]} * rs * g1;
        if (OUT_F32) { __builtin_nontemporal_store(o0, (f32x4*)y + (i * 64 + lane) * 2); __builtin_nontemporal_store(o1, (f32x4*)y + (i * 64 + lane) * 2 + 1); }
        else { uint4 w; w.x = cvt_pk_bf16(o0[0], o0[1]); w.y = cvt_pk_bf16(o0[2], o0[3]); w.z = cvt_pk_bf16(o1[0], o1[1]); w.w = cvt_pk_bf16(o1[2], o1[3]); ((uint4*)y)[i * 64 + lane] = w; }
    }
}
DEV void rmsnorm_row_f32(const float* __restrict__ x, const float* __restrict__ g, float* __restrict__ y, int lane) {
    f32x4 v[8]; float ss = 0.f;
#pragma unroll
    for (int i = 0; i < 8; ++i) { v[i] = ((const f32x4*)x)[i * 64 + lane]; ss += v[i][0] * v[i][0] + v[i][1] * v[i][1] + v[i][2] * v[i][2] + v[i][3] * v[i][3]; }
    ss = wave_sum(ss);
    const float rs = rsqrtf(ss * (1.f / 2048.f) + EPS);
#pragma unroll
    for (int i = 0; i < 8; ++i) { const f32x4 gg = ((const f32x4*)g)[i * 64 + lane]; __builtin_nontemporal_store(v[i] * rs * gg, (f32x4*)y + i * 64 + lane); }
}

constexpr int QS = 136;
DEV void gdn_prep_chunk(const Params& p, int item, unsigned char* lds) {
    int tid = threadIdx.x & 255; asm volatile("" : "+v"(tid)); const int lane = tid & 63, wid = tid >> 6;
    const int c = item & 31, h = (item >> 5) & 7, b = item >> 8;
    const int row0 = b * SEQ + c * 64;
    const bf16_t* proj = (const bf16_t*)(p.ws + WS_PROJ);
    const float* ab = (const float*)(p.ws + WS_AB);
    bf16_t* qs = (bf16_t*)lds; bf16_t* ks = qs + 64 * QS; bf16_t* vs = ks + 64 * QS;
    float* lowT = (float*)lds;
    float* gcs = (float*)(lds + 3 * 64 * QS * 2);
    float* bts = gcs + 64;
    bf16_t* gW = (bf16_t*)(p.ws + WS_GW) + (size_t)item * 8192;
    bf16_t* gQ = (bf16_t*)(p.ws + WS_GQ) + (size_t)item * 8192;
    bf16_t* gKT = (bf16_t*)(p.ws + WS_GKT) + (size_t)item * 8192;
    bf16_t* gA = (bf16_t*)(p.ws + WS_GA) + (size_t)item * 4096;
    float* gU = (float*)(p.ws + WS_GU) + (size_t)item * 8192;
    float* gE = (float*)(p.ws + WS_GE) + item;

    if (wid == 3) {
        float a = 0.f, bb = 0.f;
#pragma unroll
        for (int kq = 0; kq < 4; ++kq) { a += ab[(size_t)kq * TT * 16 + (size_t)(row0 + lane) * 16 + h]; bb += ab[(size_t)kq * TT * 16 + (size_t)(row0 + lane) * 16 + 8 + h]; }
        const float xx = a + p.in[12][h];
        const float sp = xx > 20.f ? xx : log1pf(__expf(xx));
        float s = -__expf(p.in[11][h]) * sp;
#pragma unroll
        for (int d = 1; d < 64; d <<= 1) { const float t = __shfl_up(s, d); if (lane >= d) s += t; }
        gcs[lane] = s; bts[lane] = 1.f / (1.f + __expf(-bb));
    } else {
        const int mat = wid, rg = lane >> 4, cv = lane & 15;
        const int colg = mat * 1024 + h * 128 + cv * 8;
        const float* cw = p.in[10];
        float w[4][8];
#pragma unroll
        for (int j = 0; j < 4; ++j) { const f32x4 w0 = *(const f32x4*)(cw + j * 3072 + colg), w1 = *(const f32x4*)(cw + j * 3072 + colg + 4);
            w[j][0] = w0[0]; w[j][1] = w0[1]; w[j][2] = w0[2]; w[j][3] = w0[3]; w[j][4] = w1[0]; w[j][5] = w1[1]; w[j][6] = w1[2]; w[j][7] = w1[3]; }
        const int tl0 = rg * 16;
        uint4 raw[19];
#pragma unroll
        for (int i = 0; i < 19; ++i) {
            const int tl = tl0 - 3 + i;
            if (c * 64 + tl >= 0) raw[i] = *(const uint4*)(proj + (size_t)(row0 + tl) * NPJ + colg);
            else raw[i] = make_uint4(0u, 0u, 0u, 0u);
        }
        bf16_t* dst = (mat == 0 ? qs : (mat == 1 ? ks : vs));
#pragma unroll
        for (int r = 0; r < 16; ++r) {
            float y[8]; float ss = 0.f;
#pragma unroll
            for (int e = 0; e < 8; ++e) {
                float a = 0.f;
#pragma unroll
                for (int j = 0; j < 4; ++j) {
                    const uint4 u = raw[r + j];
                    const unsigned wd = (e < 2 ? u.x : (e < 4 ? u.y : (e < 6 ? u.z : u.w)));
                    const float xv = (e & 1) ? bfhi(wd) : bflo(wd);
                    a += w[j][e] * xv;
                }
                y[e] = silu_f(a); ss += y[e] * y[e];
            }
            if (mat < 2) {
                ss += __shfl_xor(ss, 1); ss += __shfl_xor(ss, 2); ss += __shfl_xor(ss, 4); ss += __shfl_xor(ss, 8);
                float inv = rsqrtf(ss + EPS); if (mat == 0) inv *= 0.08838834764831845f;
#pragma unroll
                for (int e = 0; e < 8; ++e) y[e] *= inv;
            }
            uint4 o; o.x = cvt_pk_bf16(y[0], y[1]); o.y = cvt_pk_bf16(y[2], y[3]); o.z = cvt_pk_bf16(y[4], y[5]); o.w = cvt_pk_bf16(y[6], y[7]);
            *(uint4*)(dst + (tl0 + r) * QS + cv * 8) = o;
        }
    }
    __syncthreads();
    {
        const float glast = gcs[63];
        if (tid == 0) *gE = __expf(glast);
#pragma unroll
        for (int i = 0; i < 4; ++i) {
            const int ci = tid + 256 * i, t = ci >> 4, cc = (ci & 15) * 8;
            const uint4 u = *(const uint4*)(qs + t * QS + cc);
            const float e = __expf(gcs[t]);
            uint4 o; o.x = cvt_pk_bf16(bflo(u.x) * e, bfhi(u.x) * e); o.y = cvt_pk_bf16(bflo(u.y) * e, bfhi(u.y) * e);
            o.z = cvt_pk_bf16(bflo(u.z) * e, bfhi(u.z) * e); o.w = cvt_pk_bf16(bflo(u.w) * e, bfhi(u.w) * e);
            *(uint4*)(gQ + (cc >> 5) * 2048 + t * 32 + (cc & 31)) = o;
        }
        const float dk = __expf(glast - gcs[lane]);
#pragma unroll 8
        for (int i = 0; i < 32; ++i) { const int d = wid * 32 + i; gKT[(lane >> 5) * 4096 + d * 32 + (lane & 31)] = f2bf(bf2f(ks[lane * QS + d]) * dk);     }
    }
    f32x4 kk[4], qk[4];
    {
        const int fr = lane & 15, fq = lane >> 4, it = wid;
        bf16x8 kfi[4], qfi[4];
#pragma unroll
        for (int s = 0; s < 4; ++s) { kfi[s] = *(const bf16x8*)(ks + (it * 16 + fr) * QS + s * 32 + fq * 8); qfi[s] = *(const bf16x8*)(qs + (it * 16 + fr) * QS + s * 32 + fq * 8); }
#pragma unroll
        for (int jt = 0; jt < 4; ++jt) {
            kk[jt] = (f32x4){0.f, 0.f, 0.f, 0.f}; qk[jt] = (f32x4){0.f, 0.f, 0.f, 0.f};
#pragma unroll
            for (int s = 0; s < 4; ++s) {
                const bf16x8 kfj = *(const bf16x8*)(ks + (jt * 16 + fr) * QS + s * 32 + fq * 8);
                kk[jt] = __builtin_amdgcn_mfma_f32_16x16x32_bf16(kfi[s], kfj, kk[jt], 0, 0, 0);
                qk[jt] = __builtin_amdgcn_mfma_f32_16x16x32_bf16(kfj, qfi[s], qk[jt], 0, 0, 0);
            }
        }
    }
    __syncthreads();
    {
        const int fr = lane & 15, fq = lane >> 4, it = wid;
#pragma unroll
        for (int jt = 0; jt < 4; ++jt) {
            const int j = jt * 16 + fr; const float gj = gcs[j];
            f32x4 lv;
#pragma unroll
            for (int e = 0; e < 4; ++e) { const int i = it * 16 + fq * 4 + e; lv[e] = (i > j) ? bts[i] * kk[jt][e] * __expf(gcs[i] - gj) : 0.f; }
            *(f32x4*)(lowT + j * 68 + it * 16 + fq * 4) = lv;
            const int i2 = it * 16 + fr; const float gi = gcs[i2];
            f32x4 av;
#pragma unroll
            for (int e = 0; e < 4; ++e) { const int j2 = jt * 16 + fq * 4 + e; av[e] = (i2 >= j2) ? qk[jt][e] * __expf(gi - gcs[j2]) : 0.f; }
            store_bf4(gA + (jt >> 1) * 2048 + i2 * 32 + (jt & 1) * 16 + fq * 4, av);
        }
    }
    __syncthreads();
    {
        const int cc = tid & 127; const bool isw = tid >= 128;
        bf16_t* src = isw ? ks : vs;
#pragma unroll 1
        for (int ib = 0; ib < 4; ++ib) {
            f32x2_t acc[8];
#pragma unroll
            for (int r = 0; r < 16; ++r) { const int j = ib * 16 + r; float f = bts[j]; if (isw) f *= __expf(gcs[j]); acc[r >> 1][r & 1] = f * bf2f(src[j * QS + cc]); }
            const float* lrow = lowT + ib * 16;
#pragma unroll 4
            for (int j = 0; j < ib * 16; ++j) {
                const float xj = -bf2f(src[j * QS + cc]); const f32x2_t nx = {xj, xj};
                const f32x4 l0 = *(const f32x4*)(lrow + j * 68), l1 = *(const f32x4*)(lrow + j * 68 + 4), l2 = *(const f32x4*)(lrow + j * 68 + 8), l3 = *(const f32x4*)(lrow + j * 68 + 12);
                acc[0] += (f32x2_t){l0[0], l0[1]} * nx; acc[1] += (f32x2_t){l0[2], l0[3]} * nx; acc[2] += (f32x2_t){l1[0], l1[1]} * nx; acc[3] += (f32x2_t){l1[2], l1[3]} * nx;
                acc[4] += (f32x2_t){l2[0], l2[1]} * nx; acc[5] += (f32x2_t){l2[2], l2[3]} * nx; acc[6] += (f32x2_t){l3[0], l3[1]} * nx; acc[7] += (f32x2_t){l3[2], l3[3]} * nx;
            }
#pragma unroll
            for (int r2 = 0; r2 < 15; ++r2) {
                asm volatile("" ::: "memory");
                const float xj = -acc[r2 >> 1][r2 & 1]; const f32x2_t nx = {xj, xj};
                const float* lp = lrow + (ib * 16 + r2) * 68;
#pragma unroll
                for (int q = (r2 + 1) >> 2; q < 4; ++q) {
                    const f32x4 l = *(const f32x4*)(lp + q * 4);
                    acc[2 * q] += (f32x2_t){l[0], l[1]} * nx; acc[2 * q + 1] += (f32x2_t){l[2], l[3]} * nx;
                }
            }
#pragma unroll
            for (int r = 0; r < 16; ++r) {
                const int j = ib * 16 + r; const float xv = acc[r >> 1][r & 1]; const bf16_t xb = f2bf(xv);
                src[j * QS + cc] = xb;
                if (isw) gW[(cc >> 5) * 2048 + j * 32 + (cc & 31)] = xb;
                else gU[(((((cc >> 4) * 4 + (j >> 4)) * 4 + (j & 3)) * 4 + ((j >> 2) & 3)) << 4) + (cc & 15)] = xv;
            }
        }
    }
    __syncthreads();
}

#define LDS_BARRIER() do { asm volatile("s_waitcnt lgkmcnt(0)" ::: "memory"); __builtin_amdgcn_s_barrier(); asm volatile("" ::: "memory"); } while (0)
struct ScanEarly { bf16x8 w[4], q[4]; f32x4 u; };
struct ScanLate { bf16x8 a[2], k0[2], k1[2]; };
DEV void gdn_scan_item(const Params& p, int item, unsigned char* lds) {
    int tid = threadIdx.x & 255; asm volatile("" : "+v"(tid)); const int lane = tid & 63, w = tid >> 6, fr = lane & 15, fq = lane >> 4;
    const int s = item & 7, bh = item >> 3;
    const int b = bh >> 3, h = bh & 7;
    bf16_t* ST = (bf16_t*)lds;
    bf16_t* VT = ST + 16 * QS;
    const char* bW = (const char*)((const bf16_t*)(p.ws + WS_GW) + (size_t)bh * 32 * 8192);
    const char* bQ = (const char*)((const bf16_t*)(p.ws + WS_GQ) + (size_t)bh * 32 * 8192);
    const char* bK = (const char*)((const bf16_t*)(p.ws + WS_GKT) + (size_t)bh * 32 * 8192);
    const char* bA = (const char*)((const bf16_t*)(p.ws + WS_GA) + (size_t)bh * 32 * 4096);
    const char* bU = (const char*)((const float*)(p.ws + WS_GU) + (size_t)bh * 32 * 8192);
    const float* gE = (const float*)(p.ws + WS_GE) + bh * 32;
    float* obuf = (float*)(p.ws + WS_O);
    f32x4 S0 = {0.f, 0.f, 0.f, 0.f}, S1 = {0.f, 0.f, 0.f, 0.f};
    for (int i = tid; i < 16 * QS / 2; i += 256) ((unsigned*)ST)[i] = 0u;
    const float egv = gE[lane & 31];
    const unsigned offWQ = (unsigned)(((w * 16 + fr) * 32 + fq * 8) * 2), offA = offWQ;
    const unsigned offK = (unsigned)(((w * 32 + fr) * 32 + fq * 8) * 2), offU = (unsigned)((((s * 4 + w) * 16 + fq) * 16 + fr) * 4);
    ScanEarly E0, E1, E2; ScanLate L0, L1;
#define LOAD_E(F, ch) do { \
        const char* W_ = bW + (size_t)(ch) * 16384; const char* Q_ = bQ + (size_t)(ch) * 16384; \
        _Pragma("unroll") for (int k_ = 0; k_ < 4; ++k_) { F.w[k_] = *(const bf16x8*)(W_ + (offWQ + k_ * 4096)); F.q[k_] = *(const bf16x8*)(Q_ + (offWQ + k_ * 4096)); } \
        const char* U_ = bU + (size_t)(ch) * 32768; F.u[0] = *(const float*)(U_ + offU); F.u[1] = *(const float*)(U_ + (offU + 256)); F.u[2] = *(const float*)(U_ + (offU + 512)); F.u[3] = *(const float*)(U_ + (offU + 768)); \
        } while (0)
#define LOAD_L(F, ch) do { \
        const char* A_ = bA + (size_t)(ch) * 8192; F.a[0] = *(const bf16x8*)(A_ + offA); F.a[1] = *(const bf16x8*)(A_ + (offA + 4096)); \
        const char* K_ = bK + (size_t)(ch) * 16384; F.k0[0] = *(const bf16x8*)(K_ + offK); F.k0[1] = *(const bf16x8*)(K_ + (offK + 8192)); \
        F.k1[0] = *(const bf16x8*)(K_ + (offK + 1024)); F.k1[1] = *(const bf16x8*)(K_ + (offK + 1024 + 8192)); \
        } while (0)
#define SCAN_STEP(X, XL, Y, YL, ch) do { \
        if ((ch) + 2 < 32) LOAD_E(XL, (ch) + 2); \
        if ((ch) + 1 < 32) LOAD_L(YL, (ch) + 1); \
        const float ceg = __builtin_bit_cast(float, __builtin_amdgcn_readlane(__builtin_bit_cast(int, egv), (ch))); \
        f32x4 ws_ = {0.f, 0.f, 0.f, 0.f}, oo = {0.f, 0.f, 0.f, 0.f}; \
        _Pragma("unroll") for (int k = 0; k < 4; ++k) { \
            const bf16x8 sf = *(const bf16x8*)(ST + fr * QS + k * 32 + fq * 8); \
            ws_ = __builtin_amdgcn_mfma_f32_16x16x32_bf16(X.w[k], sf, ws_, 0, 0, 0); \
            oo = __builtin_amdgcn_mfma_f32_16x16x32_bf16(X.q[k], sf, oo, 0, 0, 0); } \
        store_bf4(VT + fr * 72 + w * 16 + fq * 4, X.u - ws_); \
        LDS_BARRIER(); \
        const bf16x8 v0 = *(const bf16x8*)(VT + fr * 72 + fq * 8), v1 = *(const bf16x8*)(VT + fr * 72 + 32 + fq * 8); \
        oo = __builtin_amdgcn_mfma_f32_16x16x32_bf16(Y.a[0], v0, oo, 0, 0, 0); \
        oo = __builtin_amdgcn_mfma_f32_16x16x32_bf16(Y.a[1], v1, oo, 0, 0, 0); \
        S0 = S0 * ceg; S1 = S1 * ceg; \
        S0 = __builtin_amdgcn_mfma_f32_16x16x32_bf16(Y.k0[0], v0, S0, 0, 0, 0); \
        S0 = __builtin_amdgcn_mfma_f32_16x16x32_bf16(Y.k0[1], v1, S0, 0, 0, 0); \
        S1 = __builtin_amdgcn_mfma_f32_16x16x32_bf16(Y.k1[0], v0, S1, 0, 0, 0); \
        S1 = __builtin_amdgcn_mfma_f32_16x16x32_bf16(Y.k1[1], v1, S1, 0, 0, 0); \
        store_bf4(ST + fr * QS + w * 32 + fq * 4, S0); \
        store_bf4(ST + fr * QS + w * 32 + 16 + fq * 4, S1); \
        { float* op = obuf + (size_t)(b * SEQ + (ch) * 64 + w * 16 + fq * 4) * 1024 + h * 128 + s * 16 + fr; \
          op[0] = oo[0]; op[1024] = oo[1]; op[2048] = oo[2]; op[3072] = oo[3]; } \
        LDS_BARRIER(); } while (0)
    LOAD_E(E0, 0); LOAD_L(L0, 0); LOAD_E(E1, 1);
    __syncthreads();
    for (int ch = 0; ch < 30; ch += 6) {
        SCAN_STEP(E0, E2, L0, L1, ch);     SCAN_STEP(E1, E0, L1, L0, ch + 1); SCAN_STEP(E2, E1, L0, L1, ch + 2);
        SCAN_STEP(E0, E2, L1, L0, ch + 3); SCAN_STEP(E1, E0, L0, L1, ch + 4); SCAN_STEP(E2, E1, L1, L0, ch + 5);
    }
    SCAN_STEP(E0, E2, L0, L1, 30); SCAN_STEP(E1, E0, L1, L0, 31);
#undef SCAN_STEP
#undef LOAD_E
#undef LOAD_L
    {
        float* dp = p.out + O_DP + ((size_t)bh * 128 + w * 32 + fq * 4) * 128 + s * 16 + fr;
#pragma unroll
        for (int e = 0; e < 4; ++e) { dp[e * 128] = S0[e]; dp[(16 + e) * 128] = S1[e]; }
    }
    __syncthreads();
}

DEV void gdn_sample_item(const Params& p, int item, unsigned char* lds) {
    int tid = threadIdx.x & 255; asm volatile("" : "+v"(tid)); const int lane = tid & 63, wid = tid >> 6;
    const int sb = item >> 3, h = item & 7, half = tid >> 7, c = tid & 127;
    const int r0 = TP + sb * 4;
    const bf16_t* proj = (const bf16_t*)(p.ws + WS_PROJ);
    const float* ab = (const float*)(p.ws + WS_AB);
    float* ksh = (float*)lds;
    float* qsh = ksh + 512;
    float* red = qsh + 512;
    float* red2 = red + 32;
    float* part = red2 + 32;
    float* opart = part + 1024;
    float qv[4], kv[4], vv[4];
#pragma unroll
    for (int m = 0; m < 3; ++m) {
        const int col = m * 1024 + h * 128 + c;
        float x[7], wj[4];
#pragma unroll
        for (int j = 0; j < 3; ++j) x[j] = p.in[6][((size_t)sb * 3 + j) * 3072 + col];
#pragma unroll
        for (int t = 0; t < 4; ++t) x[3 + t] = bf2f(proj[(size_t)(r0 + t) * NPJ + col]);
#pragma unroll
        for (int j = 0; j < 4; ++j) wj[j] = p.in[10][j * 3072 + col];
#pragma unroll
        for (int t = 0; t < 4; ++t) {
            const float y = silu_f(wj[0] * x[t] + wj[1] * x[t + 1] + wj[2] * x[t + 2] + wj[3] * x[t + 3]);
            if (m == 0) qv[t] = y; else if (m == 1) kv[t] = y; else vv[t] = y;
        }
    }
#pragma unroll
    for (int t = 0; t < 4; ++t) {
        const float a = wave_sum(qv[t] * qv[t]), bq = wave_sum(kv[t] * kv[t]);
        if (lane == 0) { red[wid * 8 + t] = a; red[wid * 8 + 4 + t] = bq; }
    }
    __syncthreads();
    float gt[4], bt[4];
#pragma unroll
    for (int t = 0; t < 4; ++t) {
        const float sq = red[(2 * half) * 8 + t] + red[(2 * half + 1) * 8 + t], sk = red[(2 * half) * 8 + 4 + t] + red[(2 * half + 1) * 8 + 4 + t];
        if (half == 0) {
            qsh[t * 128 + c] = qv[t] * rsqrtf(sq + EPS) * 0.08838834764831845f;
            ksh[t * 128 + c] = kv[t] * rsqrtf(sk + EPS);
        }
        float a = 0.f, bb = 0.f;
#pragma unroll
        for (int kq = 0; kq < 4; ++kq) { a += ab[(size_t)kq * TT * 16 + (size_t)(r0 + t) * 16 + h]; bb += ab[(size_t)kq * TT * 16 + (size_t)(r0 + t) * 16 + 8 + h]; }
        const float xx = a + p.in[12][h];
        const float sp = xx > 20.f ? xx : log1pf(__expf(xx));
        gt[t] = __expf(-__expf(p.in[11][h]) * sp);
        bt[t] = 1.f / (1.f + __expf(-bb));
    }
    f32x2_t S[32];
    const float* sp0 = p.in[5] + ((size_t)(sb * 8 + h) * 128 + half * 64) * 128 + c;
#pragma unroll
    for (int d = 0; d < 64; ++d) S[d >> 1][d & 1] = __builtin_nontemporal_load(sp0 + (size_t)d * 128);
    __syncthreads();
    float ot[4];
#pragma unroll
    for (int t = 0; t < 4; ++t) {
        const float* kk = ksh + t * 128 + half * 64; const float* qq = qsh + t * 128 + half * 64;
        f32x2_t ks2 = {0.f, 0.f};
#pragma unroll
        for (int d4 = 0; d4 < 16; ++d4) { const f32x4 k4 = *(const f32x4*)(kk + d4 * 4); ks2 += (f32x2_t){k4[0], k4[1]} * S[d4 * 2]; ks2 += (f32x2_t){k4[2], k4[3]} * S[d4 * 2 + 1]; }
        part[(t * 2 + half) * 128 + c] = ks2[0] + ks2[1];
        __syncthreads();
        const float kS = part[(t * 2) * 128 + c] + part[(t * 2 + 1) * 128 + c];
        const float eg = gt[t], dl = bt[t] * (vv[t] - eg * kS);
        const f32x2_t eg2 = {eg, eg}, dl2 = {dl, dl};
        f32x2_t o2 = {0.f, 0.f};
#pragma unroll
        for (int d4 = 0; d4 < 16; ++d4) {
            const f32x4 k4 = *(const f32x4*)(kk + d4 * 4), q4 = *(const f32x4*)(qq + d4 * 4);
            const f32x2_t s0 = S[d4 * 2] * eg2 + (f32x2_t){k4[0], k4[1]} * dl2, s1 = S[d4 * 2 + 1] * eg2 + (f32x2_t){k4[2], k4[3]} * dl2;
            S[d4 * 2] = s0; S[d4 * 2 + 1] = s1;
            o2 += (f32x2_t){q4[0], q4[1]} * s0; o2 += (f32x2_t){q4[2], q4[3]} * s1;
        }
        const float o = o2[0] + o2[1];
        ot[t] = o;
        if (half == 1) opart[t * 128 + c] = o;
    }
    float* dso = p.out + O_DS + ((size_t)(sb * 8 + h) * 128 + half * 64) * 128 + c;
#pragma unroll
    for (int d = 0; d < 64; ++d) __builtin_nontemporal_store(S[d >> 1][d & 1], dso + (size_t)d * 128);
    __syncthreads();
    if (half == 0) {
#pragma unroll
        for (int t = 0; t < 4; ++t) { ot[t] += opart[t * 128 + c]; const float a = wave_sum(ot[t] * ot[t]); if (lane == 0) red2[wid * 4 + t] = a; }
    }
    __syncthreads();
    if (half == 0) {
        bf16_t* mix = (bf16_t*)(p.ws + WS_MIX);
        const float gn = p.in[13][c];
#pragma unroll
        for (int t = 0; t < 4; ++t) {
            const float ms = (red2[t] + red2[4 + t]) * (1.f / 128.f);
            const float z = bf2f(proj[(size_t)(r0 + t) * NPJ + C_ZA + h * 128 + c]);
            mix[(size_t)(r0 + t) * LDB + h * 128 + c] = f2bf(ot[t] * rsqrtf(ms + EPS) * gn * silu_f(z));
        }
    }
    __syncthreads();
}

DEV void attn_sample_item(const Params& p, int item, unsigned char* lds) {
    int tid = threadIdx.x & 255; asm volatile("" : "+v"(tid)); const int lane = tid & 63, wid = tid >> 6;
    const int sb = item >> 2, hd = item & 3;
    float* qs = (float*)lds;
    float* pm = qs + 2048;
    float* red = pm + 1024;
    const bf16_t* qx = (const bf16_t*)(p.ws + WS_QX);
    for (int i = tid; i < 2048; i += 256) { const int t = i >> 9, d = i & 511; qs[i] = bf2f(qx[(size_t)(TP + sb * 4 + t) * LDB + hd * 512 + d]) * 0.04419417382415922f; }
    __syncthreads();
    const float* Kc = p.in[3] + ((size_t)sb * 256) * D + hd * 512;
    const float* Vc = p.in[4] + ((size_t)sb * 256) * D + hd * 512;
    {
        const int sub = lane >> 4, l16 = lane & 15;
        f32x4 kv[8];
        {
            const float* kr = Kc + (size_t)(wid * 64 + sub) * D;
#pragma unroll
            for (int i = 0; i < 8; ++i) kv[i] = __builtin_nontemporal_load((const f32x4*)(kr + (i * 16 + l16) * 4));
        }
        for (int it = 0; it < 16; ++it) {
            const int m = wid * 64 + it * 4 + sub;
            f32x4 cv[8];
#pragma unroll
            for (int i = 0; i < 8; ++i) cv[i] = kv[i];
            if (it + 1 < 16) {
                const float* kr = Kc + (size_t)(m + 4) * D;
#pragma unroll
                for (int i = 0; i < 8; ++i) kv[i] = __builtin_nontemporal_load((const f32x4*)(kr + (i * 16 + l16) * 4));
            }
            float a0 = 0.f, a1 = 0.f, a2 = 0.f, a3 = 0.f;
#pragma unroll
            for (int i = 0; i < 8; ++i) {
                const int d = (i * 16 + l16) * 4;
                const f32x4 q0 = *(const f32x4*)(qs + d), q1 = *(const f32x4*)(qs + 512 + d), q2 = *(const f32x4*)(qs + 1024 + d), q3 = *(const f32x4*)(qs + 1536 + d);
                a0 += cv[i][0] * q0[0] + cv[i][1] * q0[1] + cv[i][2] * q0[2] + cv[i][3] * q0[3];
                a1 += cv[i][0] * q1[0] + cv[i][1] * q1[1] + cv[i][2] * q1[2] + cv[i][3] * q1[3];
                a2 += cv[i][0] * q2[0] + cv[i][1] * q2[1] + cv[i][2] * q2[2] + cv[i][3] * q2[3];
                a3 += cv[i][0] * q3[0] + cv[i][1] * q3[1] + cv[i][2] * q3[2] + cv[i][3] * q3[3];
            }
#pragma unroll
            for (int o = 1; o < 16; o <<= 1) { a0 += __shfl_xor(a0, o); a1 += __shfl_xor(a1, o); a2 += __shfl_xor(a2, o); a3 += __shfl_xor(a3, o); }
            if (l16 == 0) *(f32x4*)(pm + m * 4) = (f32x4){a0, a1, a2, a3};
        }
    }
    __syncthreads();
    {
        const int t = wid;
        float v[4]; float mx = -3.0e38f;
#pragma unroll
        for (int i = 0; i < 4; ++i) { v[i] = pm[(i * 64 + lane) * 4 + t]; mx = fmaxf(mx, v[i]); }
        mx = wave_max(mx);
        float sm = 0.f;
#pragma unroll
        for (int i = 0; i < 4; ++i) { v[i] = __expf(v[i] - mx); sm += v[i]; }
        sm = wave_sum(sm);
        const float inv = 1.f / sm;
#pragma unroll
        for (int i = 0; i < 4; ++i) pm[(i * 64 + lane) * 4 + t] = v[i] * inv;
    }
    __syncthreads();
    {
        f32x4 acc[4][2];
#pragma unroll
        for (int t = 0; t < 4; ++t) { acc[t][0] = (f32x4){0.f, 0.f, 0.f, 0.f}; acc[t][1] = (f32x4){0.f, 0.f, 0.f, 0.f}; }
        f32x4 va[4], vb[4];
#pragma unroll
        for (int i = 0; i < 4; ++i) { const float* vr = Vc + (size_t)(wid * 64 + i) * D; va[i] = __builtin_nontemporal_load((const f32x4*)(vr + lane * 4)); vb[i] = __builtin_nontemporal_load((const f32x4*)(vr + 256 + lane * 4)); }
        for (int m4 = 0; m4 < 16; ++m4) {
            f32x4 ca[4], cb[4];
#pragma unroll
            for (int i = 0; i < 4; ++i) { ca[i] = va[i]; cb[i] = vb[i]; }
            if (m4 + 1 < 16) {
#pragma unroll
                for (int i = 0; i < 4; ++i) { const float* vr = Vc + (size_t)(wid * 64 + (m4 + 1) * 4 + i) * D; va[i] = __builtin_nontemporal_load((const f32x4*)(vr + lane * 4)); vb[i] = __builtin_nontemporal_load((const f32x4*)(vr + 256 + lane * 4)); }
            }
#pragma unroll
            for (int i = 0; i < 4; ++i) {
                const f32x4 pr = *(const f32x4*)(pm + (wid * 64 + m4 * 4 + i) * 4);
#pragma unroll
                for (int t = 0; t < 4; ++t) { acc[t][0] += ca[i] * pr[t]; acc[t][1] += cb[i] * pr[t]; }
            }
        }
#pragma unroll
        for (int t = 0; t < 4; ++t) { *(f32x4*)(red + (wid * 4 + t) * 512 + lane * 4) = acc[t][0]; *(f32x4*)(red + (wid * 4 + t) * 512 + 256 + lane * 4) = acc[t][1]; }
    }
    __syncthreads();
    {
        bf16_t* ctx = (bf16_t*)(p.ws + WS_CTX);
#pragma unroll
        for (int i = 0; i < 2; ++i) {
            const int e = (tid + 256 * i) * 4, t = e >> 9, d = e & 511;
            const f32x4 s = *(const f32x4*)(red + (0 * 4 + t) * 512 + d) + *(const f32x4*)(red + (1 * 4 + t) * 512 + d) + *(const f32x4*)(red + (2 * 4 + t) * 512 + d) + *(const f32x4*)(red + (3 * 4 + t) * 512 + d);
            store_bf4(ctx + (size_t)(TP + sb * 4 + t) * LDB + hd * 512 + d, s);
        }
    }
    __syncthreads();
}

template <int WIN>
DEV void pool_d_prompt8(const bf16_t* __restrict__ proj, bf16_t* __restrict__ dpl, int row0, int c8) {
    const int t0 = row0 & 2047;
    uint4 u[WIN + 7];
#pragma unroll
    for (int i = 0; i < WIN + 7; ++i) { const int tt = t0 - (WIN - 1) + i; u[i] = (tt >= 0) ? *(const uint4*)(proj + (size_t)(row0 - (WIN - 1) + i) * NPJ + C_U + c8) : make_uint4(0u, 0u, 0u, 0u); }
    float acc[8] = {0.f, 0.f, 0.f, 0.f, 0.f, 0.f, 0.f, 0.f};
#pragma unroll
    for (int i = 0; i < WIN - 1; ++i) { acc[0] += bflo(u[i].x); acc[1] += bfhi(u[i].x); acc[2] += bflo(u[i].y); acc[3] += bfhi(u[i].y); acc[4] += bflo(u[i].z); acc[5] += bfhi(u[i].z); acc[6] += bflo(u[i].w); acc[7] += bfhi(u[i].w); }
#pragma unroll
    for (int j = 0; j < 8; ++j) {
        const uint4 x = u[j + WIN - 1];
        const float xs[8] = {bflo(x.x), bfhi(x.x), bflo(x.y), bfhi(x.y), bflo(x.z), bfhi(x.z), bflo(x.w), bfhi(x.w)};
#pragma unroll
        for (int e_ = 0; e_ < 8; ++e_) acc[e_] += xs[e_];
        const float ic = 1.f / (float)min(WIN, t0 + j + 1);
        uint4 o;
        o.x = cvt_pk_bf16(acc[0] * ic - xs[0], acc[1] * ic - xs[1]); o.y = cvt_pk_bf16(acc[2] * ic - xs[2], acc[3] * ic - xs[3]);
        o.z = cvt_pk_bf16(acc[4] * ic - xs[4], acc[5] * ic - xs[5]); o.w = cvt_pk_bf16(acc[6] * ic - xs[6], acc[7] * ic - xs[7]);
        *(uint4*)(dpl + (size_t)(row0 + j) * LDP + c8) = o;
        const uint4 y = u[j];
        acc[0] -= bflo(y.x); acc[1] -= bfhi(y.x); acc[2] -= bflo(y.y); acc[3] -= bfhi(y.y); acc[4] -= bflo(y.z); acc[5] -= bfhi(y.z); acc[6] -= bflo(y.w); acc[7] -= bfhi(y.w);
    }
}

#ifndef REP0
#define REP0 1
#endif
#ifndef REP1
#define REP1 1
#endif
#ifndef REP2
#define REP2 1
#endif
#ifndef REP3
#define REP3 1
#endif
#ifndef REP4
#define REP4 1
#endif
#ifndef REP5
#define REP5 1
#endif
#ifndef REP6
#define REP6 1
#endif
#ifndef REP7
#define REP7 1
#endif
#ifndef REP8
#define REP8 1
#endif
#ifndef REP9
#define REP9 1
#endif
#ifndef REP10
#define REP10 1
#endif
#ifndef REP11
#define REP11 1
#endif
#ifndef REP12
#define REP12 1
#endif
#ifndef NLAUNCH
#define NLAUNCH 1
#endif
#define GRID_BAR() do { if (NLAUNCH == 1) xcd_barrier(bar); } while (0)
#define IN_PH(k) (p.ph_lo <= (k) && (k) < p.ph_hi)
__global__ void __launch_bounds__(512) hymba_fwd(Params p) {
    __shared__ __attribute__((aligned(16))) unsigned char lds[131072];
    __shared__ uint4 xb_words;
    const int G = gridDim.x, bid = blockIdx.x, VG = 2 * G;
    if (threadIdx.x == 0) xb_words = make_uint4(0u, 0u, 0u, 0u);
#define PH_LOCALS int tid = threadIdx.x; asm volatile("" : "+v"(tid)); const int lane = tid & 63, wid = tid >> 6; const int vb = __builtin_amdgcn_readfirstlane(tid >> 8); \
    unsigned char* vlds = lds + vb * 65536; (void)lane; (void)wid; (void)vlds;
    __syncthreads();
    XcdBarrier bar; bar.bar = (unsigned*)(p.ws + WS_BAR); bar.x = 0; bar.st = (volatile LAS unsigned*)&xb_words;
    if (NLAUNCH == 1) bar = xcd_barrier_post((unsigned*)(p.ws + WS_BAR), (volatile LAS unsigned*)&xb_words);
    unsigned char* ws = p.ws;
    bf16_t* Wt_in = (bf16_t*)(ws + WS_WIN); bf16_t* Wt_out = (bf16_t*)(ws + WS_WOUT); bf16_t* Wt_cq = (bf16_t*)(ws + WS_WCQ); bf16_t* Wt_co = (bf16_t*)(ws + WS_WCO);
    bf16_t* Wt_ckv = (bf16_t*)(ws + WS_WCKV); bf16_t* Wt_pool = (bf16_t*)(ws + WS_WPOOL);
    bf16_t* hbuf = (bf16_t*)(ws + WS_H); bf16_t* hm = (bf16_t*)(ws + WS_HM); bf16_t* proj = (bf16_t*)(ws + WS_PROJ); float* ab = (float*)(ws + WS_AB);
    bf16_t* mkb = (bf16_t*)(ws + WS_MKB); bf16_t* mvt = (bf16_t*)(ws + WS_MVT); bf16_t* dpl = (bf16_t*)(ws + WS_DPL); bf16_t* mix = (bf16_t*)(ws + WS_MIX);
    bf16_t* x1 = (bf16_t*)(ws + WS_X1); bf16_t* qx = (bf16_t*)(ws + WS_QX); float* sc = (float*)(ws + WS_SC); bf16_t* pb = (bf16_t*)(ws + WS_PB);
    bf16_t* ctx = (bf16_t*)(ws + WS_CTX); bf16_t* x2 = (bf16_t*)(ws + WS_X2); float* obuf = (float*)(ws + WS_O);
#define VLOOP(t, N) for (int t##0_ = 2 * bid, t = min(t##0_ + vb, (N) - 1); t##0_ < (N); t##0_ += VG, t = min(t##0_ + vb, (N) - 1))

    if (IN_PH(0)) { PH_LOCALS
        const int NT_IN = 98 * 16, NT_SQ = 32 * 16;
        const int total = NT_IN + 5 * NT_SQ + 32;
        VLOOP(t, total) {
            if (t < NT_IN) { const int nt = t >> 4, kt = t & 15; transpose_tile(p.in[9], 6160, nt * 64, true, kt * 128, Wt_in + (size_t)nt * 64 * LDB, LDB, (float*)vlds); }
            else if (t < NT_IN + 5 * NT_SQ) {
                const int u = t - NT_IN, j = u >> 9, v = u & 511, nt = v >> 4, kt = v & 15;
                const float* src = p.in[j == 0 ? 16 : (j == 1 ? 19 : (j == 2 ? 22 : (j == 3 ? 20 : 21)))];
                bf16_t* dst = j == 0 ? Wt_out : (j == 1 ? Wt_cq : (j == 2 ? Wt_co : (j == 3 ? Wt_ckv : Wt_ckv + (size_t)D * LDB)));
                transpose_tile(src, D, nt * 64, false, kt * 128, dst + (size_t)nt * 64 * LDB, LDB, (float*)vlds);
            } else {
                const int u = t - NT_IN - 5 * NT_SQ, g = u >> 3, v = u & 7, nt = v >> 1, kt = v & 1;
                transpose_tile(p.in[14] + (size_t)g * 65536, 256, nt * 64, false, kt * 128, Wt_pool + ((size_t)g * 256 + nt * 64) * LDM, LDM, (float*)vlds);
            }
        }
        for (int r = bid * 8 + wid; r < TT + 1024; r += G * 8) {
            if (r < TP) rmsnorm_row_bf16(p.in[0] + (size_t)r * D, p.in[8], hbuf + (size_t)r * LDB, lane);
            else if (r < TT) rmsnorm_row_bf16(p.in[1] + (size_t)(r - TP) * D, p.in[8], hbuf + (size_t)r * LDB, lane);
            else rmsnorm_row_bf16(p.in[2] + (size_t)(r - TT) * D, p.in[17], hm + (size_t)(r - TT) * LDB, lane);
        }
    }
    GRID_BAR();
    if (IN_PH(1)) { PH_LOCALS
        for (int t = bid; t < 32 * 24; t += G) { int nt, mt; tile_map(t, 32, 24, mt, nt);
            EpiProj e{mt * 256, nt * 256, proj, ab, p.out};
            gemm256_tile(hbuf + (size_t)mt * 256 * LDB, LDB, Wt_in + (size_t)nt * 256 * LDB, LDB, D, lds, e);
        }
        VLOOP(t, 4 * 48 + 256) {
            if (t < 192) { const int mt = t & 3, nt = t >> 2;
                EpiProj e{TP + mt * 128, nt * 128, proj, ab, p.out};
                gemm_tile<64>(hbuf + (size_t)(TP + mt * 128) * LDB, LDB, Wt_in + (size_t)nt * 128 * LDB, LDB, D, vlds, e);
            } else { const int u = t - 192, mt = u & 7, nt = u >> 3;
                EpiMKV e{mt * 128, nt * 128, mkb, mvt, p.out};
                gemm_tile<64>(hm + (size_t)mt * 128 * LDB, LDB, Wt_ckv + (size_t)nt * 128 * LDB, LDB, D, vlds, e);
            }
        }
        for (int tk = bid * 8 + wid; tk < (TT / 16) * 4; tk += G * 8) ab_rows16(hbuf, Wt_in + (size_t)NPJ * LDB, ab, tk >> 2, tk & 3, lane);
    }
    GRID_BAR();
    if (IN_PH(2)) { PH_LOCALS
        VLOOP(t, 1024) gdn_prep_chunk(p, t, vlds);
        for (int i = bid * 512 + tid; i < (TP / 8) * 128; i += G * 512) {
            const int row0 = (i >> 7) * 8, c8 = (i & 127) * 8, g = c8 >> 8;
            if (g == 0) pool_d_prompt8<2>(proj, dpl, row0, c8); else if (g == 1) pool_d_prompt8<4>(proj, dpl, row0, c8);
            else if (g == 2) pool_d_prompt8<8>(proj, dpl, row0, c8); else pool_d_prompt8<16>(proj, dpl, row0, c8);
        }
        for (int i = TP * 128 + bid * 512 + tid; i < TT * 128; i += G * 512) {
            const int row = i >> 7, c8 = (i & 127) * 8, g = c8 >> 8, win = 2 << g;
            float acc[8] = {0.f, 0.f, 0.f, 0.f, 0.f, 0.f, 0.f, 0.f}, self[8];
            const int tloc = (row - TP) & 3;
            for (int k = 0; k < win; ++k) {
                const int tt = tloc - k;
                if (tt >= 0) {
                    const uint4 u = *(const uint4*)(proj + (size_t)(row - k) * NPJ + C_U + c8);
                    const float f[8] = {bflo(u.x), bfhi(u.x), bflo(u.y), bfhi(u.y), bflo(u.z), bfhi(u.z), bflo(u.w), bfhi(u.w)};
#pragma unroll
                    for (int e = 0; e < 8; ++e) { acc[e] += f[e]; if (k == 0) self[e] = f[e]; }
                } else {
                    const float* sp = p.in[7] + ((size_t)((row - TP) >> 2) * 15 + (15 + tt)) * 1024 + c8;
                    const f32x4 s0 = *(const f32x4*)sp, s1 = *(const f32x4*)(sp + 4);
                    acc[0] += s0[0]; acc[1] += s0[1]; acc[2] += s0[2]; acc[3] += s0[3]; acc[4] += s1[0]; acc[5] += s1[1]; acc[6] += s1[2]; acc[7] += s1[3];
                }
            }
            const float ic = 1.f / (float)win;
            uint4 o; o.x = cvt_pk_bf16(acc[0] * ic - self[0], acc[1] * ic - self[1]); o.y = cvt_pk_bf16(acc[2] * ic - self[2], acc[3] * ic - self[3]);
            o.z = cvt_pk_bf16(acc[4] * ic - self[4], acc[5] * ic - self[5]); o.w = cvt_pk_bf16(acc[6] * ic - self[6], acc[7] * ic - self[7]);
            *(uint4*)(dpl + (size_t)row * LDP + c8) = o;
        }
        for (int i = bid * 512 + tid; i < SB * 11 * 256; i += G * 512) {
            const int c4 = (i & 255) * 4, rr = (i >> 8) % 11, sb = (i >> 8) / 11;
            *(f32x4*)(p.out + O_PS + ((size_t)sb * 15 + rr) * 1024 + c4) = *(const f32x4*)(p.in[7] + ((size_t)sb * 15 + rr + 4) * 1024 + c4);
        }
    }
    GRID_BAR();
    if (IN_PH(3)) { PH_LOCALS
        const int NSC = 256, NSM = 1024, NPL = 68 * 8;
        const int nsb = G >> 1;
        if (bid < nsb) {
            if (G == 256) {
                const int x = bid & 7, j = bid >> 3;
                gdn_scan_item(p, ((x * 4 + (j >> 2)) << 3) | ((j & 3) << 1) | vb, vlds);
            } else
            for (int t0 = 2 * bid; t0 < NSC; t0 += 2 * nsb) gdn_scan_item(p, min(t0 + vb, NSC - 1), vlds);
        } else {
            const int ob = bid - nsb, no = G - nsb;
            for (int t0 = 2 * ob; t0 < NSM; t0 += 2 * no) gdn_sample_item(p, min(t0 + vb, NSM - 1), vlds);
            for (int t0 = 2 * ob; t0 < NPL; t0 += 2 * no) { const int t = min(t0 + vb, NPL - 1); int nt, mt; tile_map(t, 68, 8, mt, nt); const int g = nt >> 1;
                EpiPool e{mt * 128, nt * 128, proj, p.in[15], mix};
                gemm_tile<64>(dpl + (size_t)mt * 128 * LDP + g * 256, LDP, Wt_pool + (size_t)nt * 128 * LDM, LDM, 256, vlds, e);
            }
        }
    }
    GRID_BAR();
    if (IN_PH(4)) { PH_LOCALS
        for (int i = bid * 512 + tid; i < TP * 8 * 16; i += G * 512) {
            const int l16 = i & 15, rh = i >> 4, h = rh & 7, row = rh >> 3;
            const float* op = obuf + (size_t)row * 1024 + h * 128 + l16 * 8;
            const f32x4 a = __builtin_nontemporal_load((const f32x4*)op), b4 = __builtin_nontemporal_load((const f32x4*)(op + 4));
            float ss = a[0] * a[0] + a[1] * a[1] + a[2] * a[2] + a[3] * a[3] + b4[0] * b4[0] + b4[1] * b4[1] + b4[2] * b4[2] + b4[3] * b4[3];
            ss += __shfl_xor(ss, 1); ss += __shfl_xor(ss, 2); ss += __shfl_xor(ss, 4); ss += __shfl_xor(ss, 8);
            const float rs = rsqrtf(ss * (1.f / 128.f) + EPS);
            const f32x4 g0 = *(const f32x4*)(p.in[13] + l16 * 8), g1 = *(const f32x4*)(p.in[13] + l16 * 8 + 4);
            const uint4 z = *(const uint4*)(proj + (size_t)row * NPJ + C_ZA + h * 128 + l16 * 8);
            uint4 o;
            o.x = cvt_pk_bf16(a[0] * rs * g0[0] * silu_f(bflo(z.x)), a[1] * rs * g0[1] * silu_f(bfhi(z.x)));
            o.y = cvt_pk_bf16(a[2] * rs * g0[2] * silu_f(bflo(z.y)), a[3] * rs * g0[3] * silu_f(bfhi(z.y)));
            o.z = cvt_pk_bf16(b4[0] * rs * g1[0] * silu_f(bflo(z.z)), b4[1] * rs * g1[1] * silu_f(bfhi(z.z)));
            o.w = cvt_pk_bf16(b4[2] * rs * g1[2] * silu_f(bflo(z.w)), b4[3] * rs * g1[3] * silu_f(bfhi(z.w)));
            *(uint4*)(mix + (size_t)row * LDB + h * 128 + l16 * 8) = o;
        }
    }
    GRID_BAR();
    if (IN_PH(5)) { PH_LOCALS
        for (int t = bid; t < 32 * 8; t += G) { int nt, mt; tile_map(t, 32, 8, mt, nt);
            EpiResid e{p.in[0] + (size_t)mt * 256 * D + nt * 256, x1 + (size_t)mt * 256 * LDB + nt * 256};
            gemm256_tile(mix + (size_t)mt * 256 * LDB, LDB, Wt_out + (size_t)nt * 256 * LDB, LDB, D, lds, e);
        }
        VLOOP(t, 8 * 32) { const int mt = t & 7, nt = t >> 3;
            EpiResid e{p.in[1] + (size_t)mt * 64 * D + nt * 64, x1 + (size_t)(TP + mt * 64) * LDB + nt * 64};
            gemm_tile<32>(mix + (size_t)(TP + mt * 64) * LDB, LDB, Wt_out + (size_t)nt * 64 * LDB, LDB, D, vlds, e);
        }
    }
    GRID_BAR();
    if (IN_PH(6)) { PH_LOCALS
    for (int r = bid * 8 + wid; r < TT; r += G * 8) rmsnorm_row_from_bf16<false>(x1 + (size_t)r * LDB, p.in[18], hbuf + (size_t)r * LDB, lane);
    }
    GRID_BAR();
    if (IN_PH(7)) { PH_LOCALS
        VLOOP(t, 8 * 32) { const int mt = t & 7, nt = t >> 3;
            EpiBf e{qx + (size_t)(TP + mt * 64) * LDB + nt * 64, LDB};
            gemm_tile<32>(hbuf + (size_t)(TP + mt * 64) * LDB, LDB, Wt_cq + (size_t)nt * 64 * LDB, LDB, D, vlds, e);
        }
    }
    GRID_BAR();
    if (IN_PH(7)) { PH_LOCALS
        const int ng = G >> 1;
        if (bid < ng) {
            for (int t = bid; t < 32 * 8; t += ng) { int nt, mt; tile_map(t, 32, 8, mt, nt);
                EpiBf e{qx + (size_t)mt * 256 * LDB + nt * 256, LDB};
                gemm256_tile(hbuf + (size_t)mt * 256 * LDB, LDB, Wt_cq + (size_t)nt * 256 * LDB, LDB, D, lds, e);
            }
        } else {
            const int ob = bid - ng, no = G - ng;
            for (int t0 = 2 * ob; t0 < 512; t0 += 2 * no) attn_sample_item(p, min(t0 + vb, 511), vlds);
        }
    }
    GRID_BAR();
    if (IN_PH(8)) { PH_LOCALS
        const int NS1 = 16 * 16 * 2;
        VLOOP(t, NS1) { const int bhd = t >> 5, v = t & 31, mt = v >> 1, nt = v & 1, b = bhd >> 2, hd = bhd & 3;
            EpiF32s e{sc + (size_t)(b * SEQ + mt * 128) * 1024 + hd * 256 + nt * 128, 1024, 0.04419417382415922f};
            gemm_tile<64>(qx + (size_t)(b * SEQ + mt * 128) * LDB + hd * 512, LDB, mkb + (size_t)(b * 256 + nt * 128) * LDB + hd * 512, LDB, 512, vlds, e);
        }
    }
    GRID_BAR();
    if (IN_PH(9)) { PH_LOCALS
    for (int r = bid * 8 + wid; r < TP * 4; r += G * 8) {
        const f32x4 v = __builtin_nontemporal_load((const f32x4*)(sc + (size_t)r * 256 + lane * 4));
        const float mx = wave_max(fmaxf(fmaxf(v[0], v[1]), fmaxf(v[2], v[3])));
        f32x4 e; e[0] = __expf(v[0] - mx); e[1] = __expf(v[1] - mx); e[2] = __expf(v[2] - mx); e[3] = __expf(v[3] - mx);
        const float inv = 1.f / wave_sum(e[0] + e[1] + e[2] + e[3]);
        store_bf4(pb + (size_t)(r >> 2) * LDP + (r & 3) * 256 + lane * 4, e * inv);
    }
    }
    GRID_BAR();
    if (IN_PH(10)) { PH_LOCALS
        VLOOP(t, 16 * 16 * 4) { const int bhd = t >> 6, v = t & 63, mt = v >> 2, nt = v & 3, b = bhd >> 2, hd = bhd & 3;
            EpiBf e{ctx + (size_t)(b * SEQ + mt * 128) * LDB + hd * 512 + nt * 128, LDB};
            gemm_tile<64>(pb + (size_t)(b * SEQ + mt * 128) * LDP + hd * 256, LDP, mvt + ((size_t)b * D + hd * 512 + nt * 128) * LDM, LDM, 256, vlds, e);
        }
    }
    GRID_BAR();
    if (IN_PH(11)) { PH_LOCALS
        for (int t = bid; t < 32 * 8; t += G) { int nt, mt; tile_map(t, 32, 8, mt, nt);
            EpiResidB e{x1 + (size_t)mt * 256 * LDB + nt * 256, x2 + (size_t)mt * 256 * LDB + nt * 256};
            gemm256_tile(ctx + (size_t)mt * 256 * LDB, LDB, Wt_co + (size_t)nt * 256 * LDB, LDB, D, lds, e);
        }
        VLOOP(t, 8 * 32) { const int mt = t & 7, nt = t >> 3;
            EpiResidB e{x1 + (size_t)(TP + mt * 64) * LDB + nt * 64, x2 + (size_t)(TP + mt * 64) * LDB + nt * 64};
            gemm_tile<32>(ctx + (size_t)(TP + mt * 64) * LDB, LDB, Wt_co + (size_t)nt * 64 * LDB, LDB, D, vlds, e);
        }
    }
    GRID_BAR();
    if (IN_PH(12)) { PH_LOCALS
    for (int r = bid * 8 + wid; r < TT; r += G * 8) rmsnorm_row_from_bf16<true>(x2 + (size_t)r * LDB, p.in[23], p.out + (r < TP ? O_YP + (size_t)r * D : O_YS + (size_t)(r - TP) * D), lane);
    }
}

extern "C" void kernel_launch(void* const* d_in, const int* in_sizes, int n_in, void* d_out, int out_size, void* d_ws, size_t ws_size, hipStream_t stream) {
    static int grid = 0;
    if (grid == 0) {
        if (n_in != 24 || ws_size < WS_END) { fprintf(stderr, "kernel_launch: need 24 inputs and %zu bytes of workspace (got %d, %zu)\n", (size_t)WS_END, n_in, ws_size); grid = -1; return; }
        int dev = 0, cus = 0, per_cu = 0;
        hipGetDevice(&dev);
        hipDeviceGetAttribute(&cus, hipDeviceAttributeMultiprocessorCount, dev);
        if (hipOccupancyMaxActiveBlocksPerMultiprocessor(&per_cu, (const void*)hymba_fwd, 512, 0) != hipSuccess || per_cu < 1) { fprintf(stderr, "kernel_launch: occupancy query failed\n"); grid = -1; return; }
        if (per_cu > 1) per_cu = 1;
        grid = cus * per_cu;
        fprintf(stderr, "kernel_launch: grid %d (%d per CU)\n", grid, per_cu);
    }
    if (grid < 0) return;
    hipMemsetAsync((char*)d_ws + WS_BAR, 0, 16384, stream);
    Params p{};
    for (int i = 0; i < 24; ++i) p.in[i] = (const float*)d_in[i];
    p.out = (float*)d_out; p.ws = (unsigned char*)d_ws;
    if (NLAUNCH == 1) {
        p.ph_lo = 0; p.ph_hi = 13;
        void* args[] = {&p};
        hipError_t e = hipLaunchCooperativeKernel((const void*)hymba_fwd, dim3(grid), dim3(512), args, 0, stream);
        if (e != hipSuccess) fprintf(stderr, "kernel_launch: cooperative launch failed: %s (grid %d)\n", hipGetErrorString(e), grid);
    } else {
        for (int k = 0; k < 13; ++k) { p.ph_lo = k; p.ph_hi = k + 1; hipLaunchKernelGGL(hymba_fwd, dim3(grid), dim3(512), 0, stream, p); }
    }
}
```

```cpp
#include <hip/hip_runtime.h>
#include <hip/hip_cooperative_groups.h>
#include <cstdio>
#include <cstdint>

typedef unsigned short bf16_t;
typedef short bf16x8 __attribute__((ext_vector_type(8)));
typedef float f32x4 __attribute__((ext_vector_type(4)));
typedef unsigned u32x4 __attribute__((ext_vector_type(4)));
#define DEV __device__ __forceinline__
#define LAS __attribute__((address_space(3)))

constexpr int D = 2048, TP = 8192, TS = 512, TT = 8704, SEQ = 2048, NB = 4, SB = 128;
constexpr int NPJ = 6144;
constexpr int C_ZA = 3072, C_U = 4096, C_ZB = 5120;
constexpr int NWIN = 6272;
constexpr float EPS = 1e-6f;
constexpr int LDB = 2112, LDP = 1088, LDM = 288;

constexpr size_t O_YP = 0, O_YS = 16777216, O_MK = 17825792, O_MV = 19922944, O_DP = 22020096, O_CP = 22544384,
                 O_PP = 22581248, O_DS = 22642688, O_CS = 39419904, O_PS = 40599552;

constexpr size_t al256(size_t x) { return (x + 255) & ~(size_t)255; }
constexpr size_t WS_BAR = 0;
constexpr size_t WS_WIN = 16384;
constexpr size_t WS_WOUT = WS_WIN + (size_t)NWIN * LDB * 2;
constexpr size_t WS_WCQ = WS_WOUT + (size_t)D * LDB * 2;
constexpr size_t WS_WCO = WS_WCQ + (size_t)D * LDB * 2;
constexpr size_t WS_WCKV = WS_WCO + (size_t)D * LDB * 2;
constexpr size_t WS_WPOOL = WS_WCKV + (size_t)2 * D * LDB * 2;
constexpr size_t WS_H = WS_WPOOL + (size_t)1024 * LDM * 2;
constexpr size_t WS_HM = WS_H + (size_t)TT * LDB * 2;
constexpr size_t WS_PROJ = WS_HM + (size_t)1024 * LDB * 2;
constexpr size_t WS_AB = WS_PROJ + (size_t)TT * NPJ * 2;
constexpr size_t WS_MKB = WS_AB + (size_t)4 * TT * 16 * 4;
constexpr size_t WS_MVT = WS_MKB + (size_t)1024 * LDB * 2;
constexpr size_t WS_GW = WS_MVT + (size_t)4 * D * LDM * 2;
constexpr size_t WS_GQ = WS_GW + (size_t)1024 * 8192 * 2;
constexpr size_t WS_GKT = WS_GQ + (size_t)1024 * 8192 * 2;
constexpr size_t WS_GA = WS_GKT + (size_t)1024 * 8192 * 2;
constexpr size_t WS_GU = WS_GA + (size_t)1024 * 4096 * 2;
constexpr size_t WS_GE = WS_GU + (size_t)1024 * 8192 * 4;
constexpr size_t WS_O = WS_GE + 4096;
constexpr size_t WS_DPL = WS_O + (size_t)TP * 1024 * 4;
constexpr size_t WS_MIX = WS_DPL + (size_t)TT * LDP * 2;
constexpr size_t WS_X1 = WS_MIX + (size_t)TT * LDB * 2;
constexpr size_t WS_QX = WS_X1 + (size_t)TT * D * 4;
constexpr size_t WS_SC = WS_QX + (size_t)TT * LDB * 2;
constexpr size_t WS_PB = WS_SC + (size_t)TP * 1024 * 4;
constexpr size_t WS_CTX = WS_PB + (size_t)TP * LDP * 2;
constexpr size_t WS_X2 = WS_CTX + (size_t)TT * LDB * 2;
constexpr size_t WS_END = WS_X2 + (size_t)TT * D * 4;

#ifndef LASTP
#define LASTP 99
#endif
struct Params { const float* in[24]; float* out; unsigned char* ws; int ph_lo, ph_hi; };

typedef __bf16 bf16x2_t __attribute__((ext_vector_type(2)));
typedef float f32x2_t __attribute__((ext_vector_type(2)));
DEV unsigned cvt_pk_bf16(float lo, float hi) { const f32x2_t v = {lo, hi}; const bf16x2_t b = __builtin_convertvector(v, bf16x2_t); return __builtin_bit_cast(unsigned, b); }
DEV bf16_t f2bf(float f) { return (bf16_t)(cvt_pk_bf16(f, 0.f) & 0xffffu); }
DEV float bf2f(unsigned b) { return __uint_as_float(b << 16); }
DEV float bflo(unsigned u) { return __uint_as_float(u << 16); }
DEV float bfhi(unsigned u) { return __uint_as_float(u & 0xffff0000u); }
DEV float silu_f(float x) { return x / (1.f + __expf(-x)); }
DEV float wave_sum(float v) {
#pragma unroll
    for (int o = 32; o >= 1; o >>= 1) v += __shfl_xor(v, o);
    return v;
}
DEV float wave_max(float v) {
#pragma unroll
    for (int o = 32; o >= 1; o >>= 1) v = fmaxf(v, __shfl_xor(v, o));
    return v;
}
DEV void store_bf4(bf16_t* p, f32x4 v) { uint2 w; w.x = cvt_pk_bf16(v[0], v[1]); w.y = cvt_pk_bf16(v[2], v[3]); *(uint2*)p = w; }

#define XB_TMO      128
#define XB_XCNT(j)  (256  + 64 * (j))
#define XB_XSUB(j)  (1280 + 64 * (j))
#define XB_XGEN(j)  (2304 + 64 * (j))
#define XB_TOP      3328
#define XB_TOPGEN   3392
#define XCD_BAR_WORDS 3456
#define XB_SPIN_CAP (1u << 22)
DEV unsigned xb_ld(unsigned* p) { return __hip_atomic_load(p, __ATOMIC_RELAXED, __HIP_MEMORY_SCOPE_AGENT); }
DEV unsigned xb_add(unsigned* p, unsigned v) { return __hip_atomic_fetch_add(p, v, __ATOMIC_RELAXED, __HIP_MEMORY_SCOPE_AGENT); }
DEV unsigned xb_xcc_id() { return (unsigned)__builtin_amdgcn_s_getreg((3 << 11) | 20) & 0xFu; }
#define XB_SPIN(cond, bar) do { unsigned _sp = 0; while (cond) { __builtin_amdgcn_s_sleep(1); \
    if ((++_sp & 255u) == 0u) { if (xb_ld(&(bar)[XB_TMO])) break; if (_sp > XB_SPIN_CAP) { atomicAdd(&(bar)[XB_TMO], 1u); break; } } } } while (0)
struct XcdBarrier { unsigned* bar; unsigned x; volatile LAS unsigned* st; };
DEV XcdBarrier xcd_barrier_post(unsigned* bar, volatile LAS unsigned* st) {
    XcdBarrier b; b.bar = bar; b.x = xb_xcc_id(); b.st = st;
    if (threadIdx.x == 0) (void)xb_add(&bar[XB_XCNT(b.x)], 1u);
    return b;
}
DEV void xcd_barrier_complete(unsigned* bar, unsigned x, unsigned& nloc, unsigned& nx) {
    const unsigned G = gridDim.x;
    unsigned sum, cnt, mine, sp = 0u;
    for (;;) {
        sum = 0u; cnt = 0u; mine = 0u;
#pragma unroll
        for (unsigned j = 0; j < 16; ++j) { const unsigned c = xb_ld(&bar[XB_XCNT(j)]); sum += c; cnt += (c > 0u) ? 1u : 0u; mine = (j == x) ? c : mine; }
        if (sum == G) break;
        __builtin_amdgcn_s_sleep(1);
        if ((++sp & 255u) == 0u) { if (xb_ld(&bar[XB_TMO])) break; if (sp > XB_SPIN_CAP) { atomicAdd(&bar[XB_TMO], 1u); break; } }
    }
    nloc = mine > 0u ? mine : 1u; nx = cnt > 0u ? cnt : 1u;
}
DEV void xcd_barrier(const XcdBarrier& b) {
    asm volatile("s_waitcnt vmcnt(0)" ::: "memory");
    __syncthreads();
    if (threadIdx.x == 0) {
        unsigned* bar = b.bar;
        __builtin_amdgcn_s_waitcnt(0);
        unsigned nloc = b.st[0], nx = b.st[1];
        if (nloc == 0u) { xcd_barrier_complete(bar, b.x, nloc, nx); b.st[0] = nloc; b.st[1] = nx; }
        const unsigned old = xb_add(&bar[XB_XSUB(b.x)], 1u);
        const unsigned gen = old / nloc;
        if (old + 1u == (gen + 1u) * nloc) {
            __builtin_amdgcn_fence(__ATOMIC_RELEASE, "agent");
            asm volatile("s_waitcnt vmcnt(0)" ::: "memory");
            const unsigned og = xb_add(&bar[XB_TOP], 1u);
            const unsigned tg = og / nx;
            if (og + 1u == (tg + 1u) * nx) xb_add(&bar[XB_TOPGEN], 1u);
            else XB_SPIN(xb_ld(&bar[XB_TOPGEN]) == tg, bar);
            __builtin_amdgcn_fence(__ATOMIC_ACQUIRE, "agent");
            xb_add(&bar[XB_XGEN(b.x)], 1u);
            asm volatile("s_waitcnt vmcnt(0)" ::: "memory");
        } else {
            XB_SPIN(xb_ld(&bar[XB_XGEN(b.x)]) == gen, bar);
            __builtin_amdgcn_fence(__ATOMIC_ACQUIRE, "agent");
            asm volatile("s_waitcnt vmcnt(0)" ::: "memory");
        }
    }
    __syncthreads();
}

DEV void glds16(const void* gptr, unsigned lds_addr_lane) {
    const unsigned m = __builtin_amdgcn_readfirstlane(lds_addr_lane);
    unsigned keep;
    asm volatile("s_mov_b32 %0, m0\n\ts_mov_b32 m0, %2\n\ts_nop 0\n\tglobal_load_lds_dwordx4 %1, off\n\ts_mov_b32 m0, %0" : "=&s"(keep) : "v"(gptr), "s"(m) : "memory");
}

template <int WT, class Epi>
DEV void gemm_tile(const bf16_t* __restrict__ A, int lda, const bf16_t* __restrict__ Bt, int ldb, int K, unsigned char* lds, const Epi& epi) {
    constexpr int FI = WT / 16;
    constexpr int OPB = 2 * WT * 128;
    constexpr int STB = 2 * OPB;
    int tid = threadIdx.x & 255; asm volatile("" : "+v"(tid)); const int lane = tid & 63, wid = tid >> 6;
    const int wr = wid >> 1, wc = wid & 1, fr = lane & 15, fq = lane >> 4;
    f32x4 acc[FI][FI];
#pragma unroll
    for (int i = 0; i < FI; ++i)
#pragma unroll
        for (int j = 0; j < FI; ++j) acc[i][j] = (f32x4){0.f, 0.f, 0.f, 0.f};
    const int lrow = tid >> 3, lcs = (tid & 7) ^ (lrow & 7);
    const bf16_t* ap = A + (size_t)lrow * lda + lcs * 8;
    const bf16_t* bp = Bt + (size_t)lrow * ldb + lcs * 8;
    const unsigned l3a = (unsigned)(size_t)(LAS unsigned char*)lds;
    const int nk = K >> 6;
#define GLDS_STAGE(st, kt_) do { \
        _Pragma("unroll") for (int i_ = 0; i_ < FI; ++i_) { \
            glds16(ap + (size_t)(32 * i_) * lda + (kt_) * 64, l3a + (st) + tid * 16 + i_ * 4096); \
            glds16(bp + (size_t)(32 * i_) * ldb + (kt_) * 64, l3a + (st) + OPB + tid * 16 + i_ * 4096); } } while (0)
    constexpr int NSTG = 65536 / STB;
#pragma unroll
    for (int s_ = 0; s_ < NSTG - 1; ++s_) if (s_ < nk) GLDS_STAGE(s_ * STB, s_);
    const int aoff = (wr * WT + fr) * 128, boff = OPB + (wc * WT + fr) * 128, sw = fr & 7;
    int cur = 0, nxt = (NSTG - 1) * STB;
    for (int kt = 0; kt < nk; ++kt) {
        if (NSTG == 4 && kt + 2 < nk) { if (FI == 2) asm volatile("s_waitcnt vmcnt(8)" ::: "memory"); else asm volatile("s_waitcnt vmcnt(0)" ::: "memory"); }
        else asm volatile("s_waitcnt vmcnt(0)" ::: "memory");
        __syncthreads();
        if (kt + NSTG - 1 < nk) GLDS_STAGE(nxt, kt + NSTG - 1);
#pragma unroll
        for (int kh = 0; kh < 2; ++kh) {
            bf16x8 af[FI], bfr[FI];
            const int ch = ((kh * 4 + fq) ^ sw) << 4;
#pragma unroll
            for (int i = 0; i < FI; ++i) { af[i] = *(const bf16x8*)(lds + cur + aoff + i * 2048 + ch); bfr[i] = *(const bf16x8*)(lds + cur + boff + i * 2048 + ch); }
#pragma unroll
            for (int mi = 0; mi < FI; ++mi)
#pragma unroll
                for (int ni = 0; ni < FI; ++ni) acc[mi][ni] = __builtin_amdgcn_mfma_f32_16x16x32_bf16(bfr[ni], af[mi], acc[mi][ni], 0, 0, 0);
        }
        nxt = cur; cur += STB; if (cur == NSTG * STB) cur = 0;
    }
#undef GLDS_STAGE
    __syncthreads();
#pragma unroll
    for (int mi = 0; mi < FI; ++mi)
#pragma unroll
        for (int ni = 0; ni < FI; ++ni) epi(wr * WT + mi * 16 + fr, wc * WT + ni * 16 + fq * 4, acc[mi][ni]);
}

template <class Epi>
DEV void gemm256_tile(const bf16_t* __restrict__ A, int lda, const bf16_t* __restrict__ Bt, int ldb, int K, unsigned char* lds, const Epi& epi) {
    int tid = threadIdx.x; asm volatile("" : "+v"(tid)); const int lane = tid & 63, wid = tid >> 6;
    const int wr = wid >> 2, wc = wid & 3, fr = lane & 15, fq = lane >> 4;
    f32x4 acc[8][4];
#pragma unroll
    for (int i = 0; i < 8; ++i)
#pragma unroll
        for (int j = 0; j < 4; ++j) acc[i][j] = (f32x4){0.f, 0.f, 0.f, 0.f};
    const int lrow = tid >> 3, lcs = (tid & 7) ^ (lrow & 7);
    const bf16_t* ap = A + (size_t)lrow * lda + lcs * 8;
    const bf16_t* bp = Bt + (size_t)lrow * ldb + lcs * 8;
    const unsigned l3a = (unsigned)(size_t)(LAS unsigned char*)lds;
    const int nk = K >> 6;
#define GLDS_STAGE(st, kt_) do { \
        _Pragma("unroll") for (int i_ = 0; i_ < 4; ++i_) { \
            glds16(ap + (size_t)(64 * i_) * lda + (kt_) * 64, l3a + (st) + tid * 16 + i_ * 8192); \
            glds16(bp + (size_t)(64 * i_) * ldb + (kt_) * 64, l3a + (st) + 32768 + tid * 16 + i_ * 8192); } } while (0)
    GLDS_STAGE(0, 0);
    const int aoff = (wr * 128 + fr) * 128, boff = 32768 + (wc * 64 + fr) * 128, sw = fr & 7;
    for (int kt = 0; kt < nk; ++kt) {
        const int cur = (kt & 1) * 65536;
        asm volatile("s_waitcnt vmcnt(0)" ::: "memory");
        __syncthreads();
        if (kt + 1 < nk) GLDS_STAGE(cur ^ 65536, kt + 1);
#pragma unroll
        for (int kh = 0; kh < 2; ++kh) {
            bf16x8 bfr[4];
            const int ch = ((kh * 4 + fq) ^ sw) << 4;
#pragma unroll
            for (int i = 0; i < 4; ++i) bfr[i] = *(const bf16x8*)(lds + cur + boff + i * 2048 + ch);
#pragma unroll
            for (int mh = 0; mh < 2; ++mh) {
                bf16x8 af[4];
#pragma unroll
                for (int i = 0; i < 4; ++i) af[i] = *(const bf16x8*)(lds + cur + aoff + (mh * 4 + i) * 2048 + ch);
#pragma unroll
                for (int mi = 0; mi < 4; ++mi)
#pragma unroll
                    for (int ni = 0; ni < 4; ++ni) acc[mh * 4 + mi][ni] = __builtin_amdgcn_mfma_f32_16x16x32_bf16(bfr[ni], af[mi], acc[mh * 4 + mi][ni], 0, 0, 0);
            }
        }
    }
#undef GLDS_STAGE
    __syncthreads();
    if constexpr (Epi::STAGE) {
#pragma unroll
        for (int mi = 0; mi < 8; ++mi)
#pragma unroll
            for (int ni = 0; ni < 4; ++ni) {
                const int row = wr * 128 + mi * 16 + fr, col = wc * 64 + ni * 16 + fq * 4;
                const f32x4 v = epi.xform(row, col, acc[mi][ni]);
                uint2 w; w.x = cvt_pk_bf16(v[0], v[1]); w.y = cvt_pk_bf16(v[2], v[3]);
                *(uint2*)(lds + row * 512 + ((((col >> 3) ^ (row & 31)) << 4) | (((col >> 2) & 1) << 3))) = w;
            }
        __syncthreads();
#pragma unroll 4
        for (int i = 0; i < 16; ++i) {
            const int idx = tid + 512 * i, row = idx >> 5, cp = idx & 31, c = cp ^ (row & 31);
            const uint4 d = *(const uint4*)(lds + row * 512 + (cp << 4));
            *(uint4*)(epi.obase + (size_t)row * epi.old + c * 8) = epi.finish(row, c * 8, d);
        }
        __syncthreads();
    } else {
#pragma unroll
        for (int mi = 0; mi < 8; ++mi)
#pragma unroll
            for (int ni = 0; ni < 4; ++ni) epi(wr * 128 + mi * 16 + fr, wc * 64 + ni * 16 + fq * 4, acc[mi][ni]);
    }
}

DEV void ab_rows16(const bf16_t* __restrict__ h, const bf16_t* __restrict__ wab, float* __restrict__ ab4, int rt, int kq, int lane) {
    const int fr = lane & 15, fq = lane >> 4;
    const bf16_t* ap = h + (size_t)(rt * 16 + fr) * LDB + kq * 512 + fq * 8;
    const bf16_t* bp = wab + (size_t)fr * LDB + kq * 512 + fq * 8;
    bf16x8 a[16], b[16];
#pragma unroll
    for (int s = 0; s < 16; ++s) { a[s] = *(const bf16x8*)(ap + s * 32); b[s] = *(const bf16x8*)(bp + s * 32); }
    f32x4 acc = {0.f, 0.f, 0.f, 0.f};
#pragma unroll
    for (int s = 0; s < 16; ++s) acc = __builtin_amdgcn_mfma_f32_16x16x32_bf16(b[s], a[s], acc, 0, 0, 0);
    *(f32x4*)(ab4 + (size_t)kq * TT * 16 + (size_t)(rt * 16 + fr) * 16 + fq * 4) = acc;
}

DEV void tile_map(int L, int nM, int nN, int& pm, int& pn) {
    const int T = nM * nN, q = T >> 3, r = T & 7, xcd = L & 7, off = L >> 3;
    const int w = (xcd < r ? xcd * (q + 1) : r * (q + 1) + (xcd - r) * q) + off;
    const int nig = 8 * nN, gid = w / nig, fm = gid * 8, gsz = (nM - fm) < 8 ? (nM - fm) : 8;
    pm = fm + (w % nig) % gsz; pn = (w % nig) / gsz;
}

struct EpiProj {
    static constexpr bool STAGE = false;
    int m0, n0; bf16_t* proj; float* ab; float* out;
    DEV void operator()(int r, int c, f32x4 v) const {
        const int row = m0 + r, col = n0 + c;
        if (col < NPJ) {
            store_bf4(proj + (size_t)row * NPJ + col, v);
            const bool isconv = col < 3072, ispool = (col >= C_U && col < C_ZB);
            if (isconv || ispool) {
                if (row < TP) {
                    const int b = row >> 11, t = row & 2047;
                    if (isconv) { if (t >= 2045) *(f32x4*)(out + O_CP + ((size_t)(b * 3 + (t - 2045))) * 3072 + col) = v; }
                    else { if (t >= 2033) *(f32x4*)(out + O_PP + ((size_t)(b * 15 + (t - 2033))) * 1024 + (col - C_U)) = v; }
                } else {
                    const int sb = (row - TP) >> 2, t = (row - TP) & 3;
                    if (isconv) { if (t >= 1) *(f32x4*)(out + O_CS + ((size_t)(sb * 3 + (t - 1))) * 3072 + col) = v; }
                    else *(f32x4*)(out + O_PS + ((size_t)(sb * 15 + 11 + t)) * 1024 + (col - C_U)) = v;
                }
            }
        } else if (col < NPJ + 16) {
            *(f32x4*)(ab + (size_t)row * 16 + (col - NPJ)) = v;
        }
    }
};
struct EpiMKV {
    static constexpr bool STAGE = false;
    int m0, n0; bf16_t* mkb; bf16_t* mvt; float* out;
    DEV void operator()(int r, int c, f32x4 v) const {
        const int row = m0 + r, col = n0 + c;
        if (col < D) {
            __builtin_nontemporal_store(v, (f32x4*)(out + O_MK + (size_t)row * D + col));
            store_bf4(mkb + (size_t)row * LDB + col, v);
        } else {
            const int cc = col - D, b = row >> 8, m = row & 255;
            __builtin_nontemporal_store(v, (f32x4*)(out + O_MV + (size_t)row * D + cc));
            bf16_t* p = mvt + ((size_t)b * D + cc) * LDM + m;
            p[0] = f2bf(v[0]); p[LDM] = f2bf(v[1]); p[2 * LDM] = f2bf(v[2]); p[3 * LDM] = f2bf(v[3]);
        }
    }
};
struct EpiPool {
    static constexpr bool STAGE = false;
    int m0, n0; const bf16_t* proj; const float* scale; bf16_t* mix;
    DEV void operator()(int r, int c, f32x4 v) const {
        const int row = m0 + r, col = n0 + c;
        const uint2 z = *(const uint2*)(proj + (size_t)row * NPJ + C_ZB + col);
        const f32x4 s = *(const f32x4*)(scale + col);
        f32x4 o;
        o[0] = v[0] * s[0] * silu_f(bflo(z.x)); o[1] = v[1] * s[1] * silu_f(bfhi(z.x));
        o[2] = v[2] * s[2] * silu_f(bflo(z.y)); o[3] = v[3] * s[3] * silu_f(bfhi(z.y));
        store_bf4(mix + (size_t)row * LDB + 1024 + col, o);
    }
};
struct EpiResid {   static constexpr bool STAGE = false;
    const float* res; bf16_t* dst;
    DEV void operator()(int r, int c, f32x4 v) const {
        const f32x4 x = __builtin_nontemporal_load((const f32x4*)(res + (size_t)r * D + c));
        store_bf4(dst + (size_t)r * LDB + c, x + v);
    }
};
struct EpiResidB {  static constexpr bool STAGE = false;
    const bf16_t* res; bf16_t* dst;
    DEV void operator()(int r, int c, f32x4 v) const {
        const uint2 u = *(const uint2*)(res + (size_t)r * LDB + c);
        f32x4 x; x[0] = bflo(u.x); x[1] = bfhi(u.x); x[2] = bflo(u.y); x[3] = bfhi(u.y);
        store_bf4(dst + (size_t)r * LDB + c, x + v);
    }
};
struct EpiBf {
    static constexpr bool STAGE = false;
    bf16_t* dst; int ld;
    DEV void operator()(int r, int c, f32x4 v) const { store_bf4(dst + (size_t)r * ld + c, v); }
};
struct EpiF32s {
    static constexpr bool STAGE = false;
    float* dst; int ld; float s;
    DEV void operator()(int r, int c, f32x4 v) const { *(f32x4*)(dst + (size_t)r * ld + c) = v * s; }
};

struct EpiProjS {
    static constexpr bool STAGE = true;
    int m0, n0; bf16_t* obase; int old; float* out;
    DEV f32x4 xform(int r, int c, f32x4 v) const {
        const int row = m0 + r, col = n0 + c;
        const bool isconv = col < 3072, ispool = (col >= C_U && col < C_ZB);
        if (isconv || ispool) {
            const int b = row >> 11, t = row & 2047;
            if (isconv) { if (t >= 2045) *(f32x4*)(out + O_CP + ((size_t)(b * 3 + (t - 2045))) * 3072 + col) = v; }
            else { if (t >= 2033) *(f32x4*)(out + O_PP + ((size_t)(b * 15 + (t - 2033))) * 1024 + (col - C_U)) = v; }
        }
        return v;
    }
};
struct EpiBfS {
    static constexpr bool STAGE = true;
    bf16_t* obase; int old;
    DEV f32x4 xform(int, int, f32x4 v) const { return v; }
    DEV uint4 finish(int, int, uint4 d) const { return d; }
};
DEV uint4 add8_bf16(uint4 d, const float* r8) {
    uint4 o; o.x = cvt_pk_bf16(bflo(d.x) + r8[0], bfhi(d.x) + r8[1]); o.y = cvt_pk_bf16(bflo(d.y) + r8[2], bfhi(d.y) + r8[3]);
    o.z = cvt_pk_bf16(bflo(d.z) + r8[4], bfhi(d.z) + r8[5]); o.w = cvt_pk_bf16(bflo(d.w) + r8[6], bfhi(d.w) + r8[7]); return o;
}
struct EpiResidS {
    static constexpr bool STAGE = true;
    const float* res; bf16_t* obase; int old;
    DEV f32x4 xform(int, int, f32x4 v) const { return v; }
    DEV uint4 finish(int r, int c, uint4 d) const {
        const f32x4 a = __builtin_nontemporal_load((const f32x4*)(res + (size_t)r * D + c)), b = __builtin_nontemporal_load((const f32x4*)(res + (size_t)r * D + c + 4));
        const float r8[8] = {a[0], a[1], a[2], a[3], b[0], b[1], b[2], b[3]};
        return add8_bf16(d, r8);
    }
};
struct EpiResidBS {
    static constexpr bool STAGE = true;
    const bf16_t* res; bf16_t* obase; int old;
    DEV f32x4 xform(int, int, f32x4 v) const { return v; }
    DEV uint4 finish(int r, int c, uint4 d) const {
        const uint4 u = *(const uint4*)(res + (size_t)r * LDB + c);
        const float r8[8] = {bflo(u.x), bfhi(u.x), bflo(u.y), bfhi(u.y), bflo(u.z), bfhi(u.z), bflo(u.w), bfhi(u.w)};
        return add8_bf16(d, r8);
    }
};
DEV int win_srccol(int n) { return n < 4096 ? n : (n < 6144 ? n + 16 : (n < 6160 ? 4096 + (n - 6144) : -1)); }
DEV void transpose_tile(const float* __restrict__ src, int ld, int srccol0, bool remap, int k0, bf16_t* __restrict__ dstrow0, int ldd, float* tile) {
    int tid = threadIdx.x & 255; asm volatile("" : "+v"(tid));
    const int tx = tid & 63, ty = tid >> 6;
    const int sc = remap ? win_srccol(srccol0 + tx) : (srccol0 + tx);
    float tv[32];
#pragma unroll
    for (int i = 0; i < 32; ++i) tv[i] = sc >= 0 ? __builtin_nontemporal_load(src + (size_t)(k0 + ty + 4 * i) * ld + sc) : 0.f;
#pragma unroll
    for (int i = 0; i < 32; ++i) tile[(ty + 4 * i) * 65 + tx] = tv[i];
    __syncthreads();
#pragma unroll
    for (int i = 0; i < 16; ++i) { const int r = ty + 4 * i; *(unsigned*)(dstrow0 + (size_t)r * ldd + k0 + 2 * tx) = cvt_pk_bf16(tile[(2 * tx) * 65 + r], tile[(2 * tx + 1) * 65 + r]); }
    __syncthreads();
}
DEV void rmsnorm_row_bf16(const float* __restrict__ x, const float* __restrict__ g, bf16_t* __restrict__ y, int lane) {
    f32x4 v[8]; float ss = 0.f;
#pragma unroll
    for (int i = 0; i < 8; ++i) { v[i] = __builtin_nontemporal_load((const f32x4*)x + i * 64 + lane); ss += v[i][0] * v[i][0] + v[i][1] * v[i][1] + v[i][2] * v[i][2] + v[i][3] * v[i][3]; }
    ss = wave_sum(ss);
    const float rs = rsqrtf(ss * (1.f / 2048.f) + EPS);
#pragma unroll
    for (int i = 0; i < 8; ++i) { const f32x4 gg = ((const f32x4*)g)[i * 64 + lane]; store_bf4(y + (size_t)(i * 64 + lane) * 4, v[i] * rs * gg); }
}
template <bool OUT_F32>
DEV void rmsnorm_row_from_bf16(const bf16_t* __restrict__ x, const float* __restrict__ g, void* __restrict__ y, int lane) {
    float v[4][8]; float ss = 0.f;
#pragma unroll
    for (int i = 0; i < 4; ++i) { uint4 u; if (OUT_F32) { const u32x4 t_ = __builtin_nontemporal_load((const u32x4*)x + i * 64 + lane); u = make_uint4(t_[0], t_[1], t_[2], t_[3]); } else u = ((const uint4*)x)[i * 64 + lane];
        v[i][0] = bflo(u.x); v[i][1] = bfhi(u.x); v[i][2] = bflo(u.y); v[i][3] = bfhi(u.y); v[i][4] = bflo(u.z); v[i][5] = bfhi(u.z); v[i][6] = bflo(u.w); v[i][7] = bfhi(u.w);
#pragma unroll
        for (int e = 0; e < 8; ++e) ss += v[i][e] * v[i][e]; }
    ss = wave_sum(ss);
    const float rs = rsqrtf(ss * (1.f / 2048.f) + EPS);
#pragma unroll
    for (int i = 0; i < 4; ++i) {
        const f32x4 g0 = ((const f32x4*)g)[(i * 64 + lane) * 2], g1 = ((const f32x4*)g)[(i * 64 + lane) * 2 + 1];
        const f32x4 o0 = (f32x4){v[i][0], v[i][1], v[i][2], v[i][3]} * rs * g0, o1 = (f32x4){v[i][4], v[i][5], v[i][6], v[i][7]} * rs * g1;
        if (OUT_F32) { __builtin_nontemporal_store(o0, (f32x4*)y + (i * 64 + lane) * 2); __builtin_nontemporal_store(o1, (f32x4*)y + (i * 64 + lane) * 2 + 1); }
        else { uint4 w; w.x = cvt_pk_bf16(o0[0], o0[1]); w.y = cvt_pk_bf16(o0[2], o0[3]); w.z = cvt_pk_bf16(o1[0], o1[1]); w.w = cvt_pk_bf16(o1[2], o1[3]); ((uint4*)y)[i * 64 + lane] = w; }
    }
}
DEV void rmsnorm_row_f32(const float* __restrict__ x, const float* __restrict__ g, float* __restrict__ y, int lane) {
    f32x4 v[8]; float ss = 0.f;
#pragma unroll
    for (int i = 0; i < 8; ++i) { v[i] = ((const f32x4*)x)[i * 64 + lane]; ss += v[i][0] * v[i][0] + v[i][1] * v[i][1] + v[i][2] * v[i][2] + v[i][3] * v[i][3]; }
    ss = wave_sum(ss);
    const float rs = rsqrtf(ss * (1.f / 2048.f) + EPS);
#pragma unroll
    for (int i = 0; i < 8; ++i) { const f32x4 gg = ((const f32x4*)g)[i * 64 + lane]; __builtin_nontemporal_store(v[i] * rs * gg, (f32x4*)y + i * 64 + lane); }
}

constexpr int QS = 136;
DEV void gdn_prep_chunk(const Params& p, int item, unsigned char* lds) {
    int tid = threadIdx.x & 255; asm volatile("" : "+v"(tid)); const int lane = tid & 63, wid = tid >> 6;
    const int c = item & 31, h = (item >> 5) & 7, b = item >> 8;
    const int row0 = b * SEQ + c * 64;
    const bf16_t* proj = (const bf16_t*)(p.ws + WS_PROJ);
    const float* ab = (const float*)(p.ws + WS_AB);
    bf16_t* qs = (bf16_t*)lds; bf16_t* ks = qs + 64 * QS; bf16_t* vs = ks + 64 * QS;
    float* lowT = (float*)lds;
    float* gcs = (float*)(lds + 3 * 64 * QS * 2);
    float* bts = gcs + 64;
    bf16_t* gW = (bf16_t*)(p.ws + WS_GW) + (size_t)item * 8192;
    bf16_t* gQ = (bf16_t*)(p.ws + WS_GQ) + (size_t)item * 8192;
    bf16_t* gKT = (bf16_t*)(p.ws + WS_GKT) + (size_t)item * 8192;
    bf16_t* gA = (bf16_t*)(p.ws + WS_GA) + (size_t)item * 4096;
    float* gU = (float*)(p.ws + WS_GU) + (size_t)item * 8192;
    float* gE = (float*)(p.ws + WS_GE) + item;

    if (wid == 3) {
        float a = 0.f, bb = 0.f;
#pragma unroll
        for (int kq = 0; kq < 4; ++kq) { a += ab[(size_t)kq * TT * 16 + (size_t)(row0 + lane) * 16 + h]; bb += ab[(size_t)kq * TT * 16 + (size_t)(row0 + lane) * 16 + 8 + h]; }
        const float xx = a + p.in[12][h];
        const float sp = xx > 20.f ? xx : log1pf(__expf(xx));
        float s = -__expf(p.in[11][h]) * sp;
#pragma unroll
        for (int d = 1; d < 64; d <<= 1) { const float t = __shfl_up(s, d); if (lane >= d) s += t; }
        gcs[lane] = s; bts[lane] = 1.f / (1.f + __expf(-bb));
    } else {
        const int mat = wid, rg = lane >> 4, cv = lane & 15;
        const int colg = mat * 1024 + h * 128 + cv * 8;
        const float* cw = p.in[10];
        float w[4][8];
#pragma unroll
        for (int j = 0; j < 4; ++j) { const f32x4 w0 = *(const f32x4*)(cw + j * 3072 + colg), w1 = *(const f32x4*)(cw + j * 3072 + colg + 4);
            w[j][0] = w0[0]; w[j][1] = w0[1]; w[j][2] = w0[2]; w[j][3] = w0[3]; w[j][4] = w1[0]; w[j][5] = w1[1]; w[j][6] = w1[2]; w[j][7] = w1[3]; }
        const int tl0 = rg * 16;
        uint4 raw[19];
#pragma unroll
        for (int i = 0; i < 19; ++i) {
            const int tl = tl0 - 3 + i;
            if (c * 64 + tl >= 0) raw[i] = *(const uint4*)(proj + (size_t)(row0 + tl) * NPJ + colg);
            else raw[i] = make_uint4(0u, 0u, 0u, 0u);
        }
        bf16_t* dst = (mat == 0 ? qs : (mat == 1 ? ks : vs));
#pragma unroll
        for (int r = 0; r < 16; ++r) {
            float y[8]; float ss = 0.f;
#pragma unroll
            for (int e = 0; e < 8; ++e) {
                float a = 0.f;
#pragma unroll
                for (int j = 0; j < 4; ++j) {
                    const uint4 u = raw[r + j];
                    const unsigned wd = (e < 2 ? u.x : (e < 4 ? u.y : (e < 6 ? u.z : u.w)));
                    const float xv = (e & 1) ? bfhi(wd) : bflo(wd);
                    a += w[j][e] * xv;
                }
                y[e] = silu_f(a); ss += y[e] * y[e];
            }
            if (mat < 2) {
                ss += __shfl_xor(ss, 1); ss += __shfl_xor(ss, 2); ss += __shfl_xor(ss, 4); ss += __shfl_xor(ss, 8);
                float inv = rsqrtf(ss + EPS); if (mat == 0) inv *= 0.08838834764831845f;
#pragma unroll
                for (int e = 0; e < 8; ++e) y[e] *= inv;
            }
            uint4 o; o.x = cvt_pk_bf16(y[0], y[1]); o.y = cvt_pk_bf16(y[2], y[3]); o.z = cvt_pk_bf16(y[4], y[5]); o.w = cvt_pk_bf16(y[6], y[7]);
            *(uint4*)(dst + (tl0 + r) * QS + cv * 8) = o;
        }
    }
    __syncthreads();
    {
        const float glast = gcs[63];
        if (tid == 0) *gE = __expf(glast);
#pragma unroll
        for (int i = 0; i < 4; ++i) {
            const int ci = tid + 256 * i, t = ci >> 4, cc = (ci & 15) * 8;
            const uint4 u = *(const uint4*)(qs + t * QS + cc);
            const float e = __expf(gcs[t]);
            uint4 o; o.x = cvt_pk_bf16(bflo(u.x) * e, bfhi(u.x) * e); o.y = cvt_pk_bf16(bflo(u.y) * e, bfhi(u.y) * e);
            o.z = cvt_pk_bf16(bflo(u.z) * e, bfhi(u.z) * e); o.w = cvt_pk_bf16(bflo(u.w) * e, bfhi(u.w) * e);
            *(uint4*)(gQ + (cc >> 5) * 2048 + t * 32 + (cc & 31)) = o;
        }
        const float dk = __expf(glast - gcs[lane]);
#pragma unroll 8
        for (int i = 0; i < 32; ++i) { const int d = wid * 32 + i; gKT[(lane >> 5) * 4096 + d * 32 + (lane & 31)] = f2bf(bf2f(ks[lane * QS + d]) * dk);     }
    }
    f32x4 kk[4], qk[4];
    {
        const int fr = lane & 15, fq = lane >> 4, it = wid;
        bf16x8 kfi[4], qfi[4];
#pragma unroll
        for (int s = 0; s < 4; ++s) { kfi[s] = *(const bf16x8*)(ks + (it * 16 + fr) * QS + s * 32 + fq * 8); qfi[s] = *(const bf16x8*)(qs + (it * 16 + fr) * QS + s * 32 + fq * 8); }
#pragma unroll
        for (int jt = 0; jt < 4; ++jt) {
            kk[jt] = (f32x4){0.f, 0.f, 0.f, 0.f}; qk[jt] = (f32x4){0.f, 0.f, 0.f, 0.f};
#pragma unroll
            for (int s = 0; s < 4; ++s) {
                const bf16x8 kfj = *(const bf16x8*)(ks + (jt * 16 + fr) * QS + s * 32 + fq * 8);
                kk[jt] = __builtin_amdgcn_mfma_f32_16x16x32_bf16(kfi[s], kfj, kk[jt], 0, 0, 0);
                qk[jt] = __builtin_amdgcn_mfma_f32_16x16x32_bf16(kfj, qfi[s], qk[jt], 0, 0, 0);
            }
        }
    }
    __syncthreads();
    {
        const int fr = lane & 15, fq = lane >> 4, it = wid;
#pragma unroll
        for (int jt = 0; jt < 4; ++jt) {
            const int j = jt * 16 + fr; const float gj = gcs[j];
            f32x4 lv;
#pragma unroll
            for (int e = 0; e < 4; ++e) { const int i = it * 16 + fq * 4 + e; lv[e] = (i > j) ? bts[i] * kk[jt][e] * __expf(gcs[i] - gj) : 0.f; }
            *(f32x4*)(lowT + j * 68 + it * 16 + fq * 4) = lv;
            const int i2 = it * 16 + fr; const float gi = gcs[i2];
            f32x4 av;
#pragma unroll
            for (int e = 0; e < 4; ++e) { const int j2 = jt * 16 + fq * 4 + e; av[e] = (i2 >= j2) ? qk[jt][e] * __expf(gi - gcs[j2]) : 0.f; }
            store_bf4(gA + (jt >> 1) * 2048 + i2 * 32 + (jt & 1) * 16 + fq * 4, av);
        }
    }
    __syncthreads();
    {
        const int cc = tid & 127; const bool isw = tid >= 128;
        bf16_t* src = isw ? ks : vs;
#pragma unroll 1
        for (int ib = 0; ib < 4; ++ib) {
            f32x2_t acc[8];
#pragma unroll
            for (int r = 0; r < 16; ++r) { const int j = ib * 16 + r; float f = bts[j]; if (isw) f *= __expf(gcs[j]); acc[r >> 1][r & 1] = f * bf2f(src[j * QS + cc]); }
            const float* lrow = lowT + ib * 16;
#pragma unroll 4
            for (int j = 0; j < ib * 16; ++j) {
                const float xj = -bf2f(src[j * QS + cc]); const f32x2_t nx = {xj, xj};
                const f32x4 l0 = *(const f32x4*)(lrow + j * 68), l1 = *(const f32x4*)(lrow + j * 68 + 4), l2 = *(const f32x4*)(lrow + j * 68 + 8), l3 = *(const f32x4*)(lrow + j * 68 + 12);
                acc[0] += (f32x2_t){l0[0], l0[1]} * nx; acc[1] += (f32x2_t){l0[2], l0[3]} * nx; acc[2] += (f32x2_t){l1[0], l1[1]} * nx; acc[3] += (f32x2_t){l1[2], l1[3]} * nx;
                acc[4] += (f32x2_t){l2[0], l2[1]} * nx; acc[5] += (f32x2_t){l2[2], l2[3]} * nx; acc[6] += (f32x2_t){l3[0], l3[1]} * nx; acc[7] += (f32x2_t){l3[2], l3[3]} * nx;
            }
#pragma unroll
            for (int r2 = 0; r2 < 15; ++r2) {
                asm volatile("" ::: "memory");
                const float xj = -acc[r2 >> 1][r2 & 1]; const f32x2_t nx = {xj, xj};
                const float* lp = lrow + (ib * 16 + r2) * 68;
#pragma unroll
                for (int q = (r2 + 1) >> 2; q < 4; ++q) {
                    const f32x4 l = *(const f32x4*)(lp + q * 4);
                    acc[2 * q] += (f32x2_t){l[0], l[1]} * nx; acc[2 * q + 1] += (f32x2_t){l[2], l[3]} * nx;
                }
            }
#pragma unroll
            for (int r = 0; r < 16; ++r) {
                const int j = ib * 16 + r; const float xv = acc[r >> 1][r & 1]; const bf16_t xb = f2bf(xv);
                src[j * QS + cc] = xb;
                if (isw) gW[(cc >> 5) * 2048 + j * 32 + (cc & 31)] = xb;
                else gU[(((((cc >> 4) * 4 + (j >> 4)) * 4 + (j & 3)) * 4 + ((j >> 2) & 3)) << 4) + (cc & 15)] = xv;
            }
        }
    }
    __syncthreads();
}

#define LDS_BARRIER() do { asm volatile("s_waitcnt lgkmcnt(0)" ::: "memory"); __builtin_amdgcn_s_barrier(); asm volatile("" ::: "memory"); } while (0)
struct ScanEarly { bf16x8 w[4], q[4]; f32x4 u; };
struct ScanLate { bf16x8 a[2], k0[2], k1[2]; };
DEV void gdn_scan_item(const Params& p, int item, unsigned char* lds) {
    int tid = threadIdx.x & 255; asm volatile("" : "+v"(tid)); const int lane = tid & 63, w = tid >> 6, fr = lane & 15, fq = lane >> 4;
    const int s = item & 7, bh = item >> 3;
    const int b = bh >> 3, h = bh & 7;
    bf16_t* ST = (bf16_t*)lds;
    bf16_t* VT = ST + 16 * QS;
    const char* bW = (const char*)((const bf16_t*)(p.ws + WS_GW) + (size_t)bh * 32 * 8192);
    const char* bQ = (const char*)((const bf16_t*)(p.ws + WS_GQ) + (size_t)bh * 32 * 8192);
    const char* bK = (const char*)((const bf16_t*)(p.ws + WS_GKT) + (size_t)bh * 32 * 8192);
    const char* bA = (const char*)((const bf16_t*)(p.ws + WS_GA) + (size_t)bh * 32 * 4096);
    const char* bU = (const char*)((const float*)(p.ws + WS_GU) + (size_t)bh * 32 * 8192);
    const float* gE = (const float*)(p.ws + WS_GE) + bh * 32;
    float* obuf = (float*)(p.ws + WS_O);
    f32x4 S0 = {0.f, 0.f, 0.f, 0.f}, S1 = {0.f, 0.f, 0.f, 0.f};
    for (int i = tid; i < 16 * QS / 2; i += 256) ((unsigned*)ST)[i] = 0u;
    const float egv = gE[lane & 31];
    const unsigned offWQ = (unsigned)(((w * 16 + fr) * 32 + fq * 8) * 2), offA = offWQ;
    const unsigned offK = (unsigned)(((w * 32 + fr) * 32 + fq * 8) * 2), offU = (unsigned)((((s * 4 + w) * 16 + fq) * 16 + fr) * 4);
    ScanEarly E0, E1, E2; ScanLate L0, L1;
#define LOAD_E(F, ch) do { \
        const char* W_ = bW + (size_t)(ch) * 16384; const char* Q_ = bQ + (size_t)(ch) * 16384; \
        _Pragma("unroll") for (int k_ = 0; k_ < 4; ++k_) { F.w[k_] = *(const bf16x8*)(W_ + (offWQ + k_ * 4096)); F.q[k_] = *(const bf16x8*)(Q_ + (offWQ + k_ * 4096)); } \
        const char* U_ = bU + (size_t)(ch) * 32768; F.u[0] = *(const float*)(U_ + offU); F.u[1] = *(const float*)(U_ + (offU + 256)); F.u[2] = *(const float*)(U_ + (offU + 512)); F.u[3] = *(const float*)(U_ + (offU + 768)); \
        } while (0)
#define LOAD_L(F, ch) do { \
        const char* A_ = bA + (size_t)(ch) * 8192; F.a[0] = *(const bf16x8*)(A_ + offA); F.a[1] = *(const bf16x8*)(A_ + (offA + 4096)); \
        const char* K_ = bK + (size_t)(ch) * 16384; F.k0[0] = *(const bf16x8*)(K_ + offK); F.k0[1] = *(const bf16x8*)(K_ + (offK + 8192)); \
        F.k1[0] = *(const bf16x8*)(K_ + (offK + 1024)); F.k1[1] = *(const bf16x8*)(K_ + (offK + 1024 + 8192)); \
        } while (0)
#define SCAN_STEP(X, XL, Y, YL, ch) do { \
        if ((ch) + 2 < 32) LOAD_E(XL, (ch) + 2); \
        if ((ch) + 1 < 32) LOAD_L(YL, (ch) + 1); \
        const float ceg = __builtin_bit_cast(float, __builtin_amdgcn_readlane(__builtin_bit_cast(int, egv), (ch))); \
        f32x4 ws_ = {0.f, 0.f, 0.f, 0.f}, oo = {0.f, 0.f, 0.f, 0.f}; \
        _Pragma("unroll") for (int k = 0; k < 4; ++k) { \
            const bf16x8 sf = *(const bf16x8*)(ST + fr * QS + k * 32 + fq * 8); \
            ws_ = __builtin_amdgcn_mfma_f32_16x16x32_bf16(X.w[k], sf, ws_, 0, 0, 0); \
            oo = __builtin_amdgcn_mfma_f32_16x16x32_bf16(X.q[k], sf, oo, 0, 0, 0); } \
        store_bf4(VT + fr * 72 + w * 16 + fq * 4, X.u - ws_); \
        LDS_BARRIER(); \
        const bf16x8 v0 = *(const bf16x8*)(VT + fr * 72 + fq * 8), v1 = *(const bf16x8*)(VT + fr * 72 + 32 + fq * 8); \
        oo = __builtin_amdgcn_mfma_f32_16x16x32_bf16(Y.a[0], v0, oo, 0, 0, 0); \
        oo = __builtin_amdgcn_mfma_f32_16x16x32_bf16(Y.a[1], v1, oo, 0, 0, 0); \
        S0 = S0 * ceg; S1 = S1 * ceg; \
        S0 = __builtin_amdgcn_mfma_f32_16x16x32_bf16(Y.k0[0], v0, S0, 0, 0, 0); \
        S0 = __builtin_amdgcn_mfma_f32_16x16x32_bf16(Y.k0[1], v1, S0, 0, 0, 0); \
        S1 = __builtin_amdgcn_mfma_f32_16x16x32_bf16(Y.k1[0], v0, S1, 0, 0, 0); \
        S1 = __builtin_amdgcn_mfma_f32_16x16x32_bf16(Y.k1[1], v1, S1, 0, 0, 0); \
        store_bf4(ST + fr * QS + w * 32 + fq * 4, S0); \
        store_bf4(ST + fr * QS + w * 32 + 16 + fq * 4, S1); \
        { float* op = obuf + (size_t)(b * SEQ + (ch) * 64 + w * 16 + fq * 4) * 1024 + h * 128 + s * 16 + fr; \
          op[0] = oo[0]; op[1024] = oo[1]; op[2048] = oo[2]; op[3072] = oo[3]; } \
        LDS_BARRIER(); } while (0)
    LOAD_E(E0, 0); LOAD_L(L0, 0); LOAD_E(E1, 1);
    __syncthreads();
    for (int ch = 0; ch < 30; ch += 6) {
        SCAN_STEP(E0, E2, L0, L1, ch);     SCAN_STEP(E1, E0, L1, L0, ch + 1); SCAN_STEP(E2, E1, L0, L1, ch + 2);
        SCAN_STEP(E0, E2, L1, L0, ch + 3); SCAN_STEP(E1, E0, L0, L1, ch + 4); SCAN_STEP(E2, E1, L1, L0, ch + 5);
    }
    SCAN_STEP(E0, E2, L0, L1, 30); SCAN_STEP(E1, E0, L1, L0, 31);
#undef SCAN_STEP
#undef LOAD_E
#undef LOAD_L
    {
        float* dp = p.out + O_DP + ((size_t)bh * 128 + w * 32 + fq * 4) * 128 + s * 16 + fr;
#pragma unroll
        for (int e = 0; e < 4; ++e) { dp[e * 128] = S0[e]; dp[(16 + e) * 128] = S1[e]; }
    }
    __syncthreads();
}

DEV void gdn_sample_item(const Params& p, int item, unsigned char* lds) {
    int tid = threadIdx.x & 255; asm volatile("" : "+v"(tid)); const int lane = tid & 63, wid = tid >> 6;
    const int sb = item >> 3, h = item & 7, half = tid >> 7, c = tid & 127;
    const int r0 = TP + sb * 4;
    const bf16_t* proj = (const bf16_t*)(p.ws + WS_PROJ);
    const float* ab = (const float*)(p.ws + WS_AB);
    float* ksh = (float*)lds;
    float* qsh = ksh + 512;
    float* red = qsh + 512;
    float* red2 = red + 32;
    float* part = red2 + 32;
    float* opart = part + 1024;
    float qv[4], kv[4], vv[4];
#pragma unroll
    for (int m = 0; m < 3; ++m) {
        const int col = m * 1024 + h * 128 + c;
        float x[7], wj[4];
#pragma unroll
        for (int j = 0; j < 3; ++j) x[j] = p.in[6][((size_t)sb * 3 + j) * 3072 + col];
#pragma unroll
        for (int t = 0; t < 4; ++t) x[3 + t] = bf2f(proj[(size_t)(r0 + t) * NPJ + col]);
#pragma unroll
        for (int j = 0; j < 4; ++j) wj[j] = p.in[10][j * 3072 + col];
#pragma unroll
        for (int t = 0; t < 4; ++t) {
            const float y = silu_f(wj[0] * x[t] + wj[1] * x[t + 1] + wj[2] * x[t + 2] + wj[3] * x[t + 3]);
            if (m == 0) qv[t] = y; else if (m == 1) kv[t] = y; else vv[t] = y;
        }
    }
#pragma unroll
    for (int t = 0; t < 4; ++t) {
        const float a = wave_sum(qv[t] * qv[t]), bq = wave_sum(kv[t] * kv[t]);
        if (lane == 0) { red[wid * 8 + t] = a; red[wid * 8 + 4 + t] = bq; }
    }
    __syncthreads();
    float gt[4], bt[4];
#pragma unroll
    for (int t = 0; t < 4; ++t) {
        const float sq = red[(2 * half) * 8 + t] + red[(2 * half + 1) * 8 + t], sk = red[(2 * half) * 8 + 4 + t] + red[(2 * half + 1) * 8 + 4 + t];
        if (half == 0) {
            qsh[t * 128 + c] = qv[t] * rsqrtf(sq + EPS) * 0.08838834764831845f;
            ksh[t * 128 + c] = kv[t] * rsqrtf(sk + EPS);
        }
        float a = 0.f, bb = 0.f;
#pragma unroll
        for (int kq = 0; kq < 4; ++kq) { a += ab[(size_t)kq * TT * 16 + (size_t)(r0 + t) * 16 + h]; bb += ab[(size_t)kq * TT * 16 + (size_t)(r0 + t) * 16 + 8 + h]; }
        const float xx = a + p.in[12][h];
        const float sp = xx > 20.f ? xx : log1pf(__expf(xx));
        gt[t] = __expf(-__expf(p.in[11][h]) * sp);
        bt[t] = 1.f / (1.f + __expf(-bb));
    }
    f32x2_t S[32];
    const float* sp0 = p.in[5] + ((size_t)(sb * 8 + h) * 128 + half * 64) * 128 + c;
#pragma unroll
    for (int d = 0; d < 64; ++d) S[d >> 1][d & 1] = __builtin_nontemporal_load(sp0 + (size_t)d * 128);
    __syncthreads();
    float ot[4];
#pragma unroll
    for (int t = 0; t < 4; ++t) {
        const float* kk = ksh + t * 128 + half * 64; const float* qq = qsh + t * 128 + half * 64;
        f32x2_t ks2 = {0.f, 0.f};
#pragma unroll
        for (int d4 = 0; d4 < 16; ++d4) { const f32x4 k4 = *(const f32x4*)(kk + d4 * 4); ks2 += (f32x2_t){k4[0], k4[1]} * S[d4 * 2]; ks2 += (f32x2_t){k4[2], k4[3]} * S[d4 * 2 + 1]; }
        part[(t * 2 + half) * 128 + c] = ks2[0] + ks2[1];
        __syncthreads();
        const float kS = part[(t * 2) * 128 + c] + part[(t * 2 + 1) * 128 + c];
        const float eg = gt[t], dl = bt[t] * (vv[t] - eg * kS);
        const f32x2_t eg2 = {eg, eg}, dl2 = {dl, dl};
        f32x2_t o2 = {0.f, 0.f};
#pragma unroll
        for (int d4 = 0; d4 < 16; ++d4) {
            const f32x4 k4 = *(const f32x4*)(kk + d4 * 4), q4 = *(const f32x4*)(qq + d4 * 4);
            const f32x2_t s0 = S[d4 * 2] * eg2 + (f32x2_t){k4[0], k4[1]} * dl2, s1 = S[d4 * 2 + 1] * eg2 + (f32x2_t){k4[2], k4[3]} * dl2;
            S[d4 * 2] = s0; S[d4 * 2 + 1] = s1;
            o2 += (f32x2_t){q4[0], q4[1]} * s0; o2 += (f32x2_t){q4[2], q4[3]} * s1;
        }
        const float o = o2[0] + o2[1];
        ot[t] = o;
        if (half == 1) opart[t * 128 + c] = o;
    }
    float* dso = p.out + O_DS + ((size_t)(sb * 8 + h) * 128 + half * 64) * 128 + c;
#pragma unroll
    for (int d = 0; d < 64; ++d) __builtin_nontemporal_store(S[d >> 1][d & 1], dso + (size_t)d * 128);
    __syncthreads();
    if (half == 0) {
#pragma unroll
        for (int t = 0; t < 4; ++t) { ot[t] += opart[t * 128 + c]; const float a = wave_sum(ot[t] * ot[t]); if (lane == 0) red2[wid * 4 + t] = a; }
    }
    __syncthreads();
    if (half == 0) {
        bf16_t* mix = (bf16_t*)(p.ws + WS_MIX);
        const float gn = p.in[13][c];
#pragma unroll
        for (int t = 0; t < 4; ++t) {
            const float ms = (red2[t] + red2[4 + t]) * (1.f / 128.f);
            const float z = bf2f(proj[(size_t)(r0 + t) * NPJ + C_ZA + h * 128 + c]);
            mix[(size_t)(r0 + t) * LDB + h * 128 + c] = f2bf(ot[t] * rsqrtf(ms + EPS) * gn * silu_f(z));
        }
    }
    __syncthreads();
}

DEV void attn_sample_item(const Params& p, int item, unsigned char* lds) {
    int tid = threadIdx.x & 255; asm volatile("" : "+v"(tid)); const int lane = tid & 63, wid = tid >> 6;
    const int sb = item >> 2, hd = item & 3;
    float* qs = (float*)lds;
    float* pm = qs + 2048;
    float* red = pm + 1024;
    const bf16_t* qx = (const bf16_t*)(p.ws + WS_QX);
    for (int i = tid; i < 2048; i += 256) { const int t = i >> 9, d = i & 511; qs[i] = bf2f(qx[(size_t)(TP + sb * 4 + t) * LDB + hd * 512 + d]) * 0.04419417382415922f; }
    __syncthreads();
    const float* Kc = p.in[3] + ((size_t)sb * 256) * D + hd * 512;
    const float* Vc = p.in[4] + ((size_t)sb * 256) * D + hd * 512;
    {
        const int sub = lane >> 4, l16 = lane & 15;
        f32x4 kv[8];
        {
            const float* kr = Kc + (size_t)(wid * 64 + sub) * D;
#pragma unroll
            for (int i = 0; i < 8; ++i) kv[i] = __builtin_nontemporal_load((const f32x4*)(kr + (i * 16 + l16) * 4));
        }
        for (int it = 0; it < 16; ++it) {
            const int m = wid * 64 + it * 4 + sub;
            f32x4 cv[8];
#pragma unroll
            for (int i = 0; i < 8; ++i) cv[i] = kv[i];
            if (it + 1 < 16) {
                const float* kr = Kc + (size_t)(m + 4) * D;
#pragma unroll
                for (int i = 0; i < 8; ++i) kv[i] = __builtin_nontemporal_load((const f32x4*)(kr + (i * 16 + l16) * 4));
            }
            float a0 = 0.f, a1 = 0.f, a2 = 0.f, a3 = 0.f;
#pragma unroll
            for (int i = 0; i < 8; ++i) {
                const int d = (i * 16 + l16) * 4;
                const f32x4 q0 = *(const f32x4*)(qs + d), q1 = *(const f32x4*)(qs + 512 + d), q2 = *(const f32x4*)(qs + 1024 + d), q3 = *(const f32x4*)(qs + 1536 + d);
                a0 += cv[i][0] * q0[0] + cv[i][1] * q0[1] + cv[i][2] * q0[2] + cv[i][3] * q0[3];
                a1 += cv[i][0] * q1[0] + cv[i][1] * q1[1] + cv[i][2] * q1[2] + cv[i][3] * q1[3];
                a2 += cv[i][0] * q2[0] + cv[i][1] * q2[1] + cv[i][2] * q2[2] + cv[i][3] * q2[3];
                a3 += cv[i][0] * q3[0] + cv[i][1] * q3[1] + cv[i][2] * q3[2] + cv[i][3] * q3[3];
            }
#pragma unroll
            for (int o = 1; o < 16; o <<= 1) { a0 += __shfl_xor(a0, o); a1 += __shfl_xor(a1, o); a2 += __shfl_xor(a2, o); a3 += __shfl_xor(a3, o); }
            if (l16 == 0) *(f32x4*)(pm + m * 4) = (f32x4){a0, a1, a2, a3};
        }
    }
    __syncthreads();
    {
        const int t = wid;
        float v[4]; float mx = -3.0e38f;
#pragma unroll
        for (int i = 0; i < 4; ++i) { v[i] = pm[(i * 64 + lane) * 4 + t]; mx = fmaxf(mx, v[i]); }
        mx = wave_max(mx);
        float sm = 0.f;
#pragma unroll
        for (int i = 0; i < 4; ++i) { v[i] = __expf(v[i] - mx); sm += v[i]; }
        sm = wave_sum(sm);
        const float inv = 1.f / sm;
#pragma unroll
        for (int i = 0; i < 4; ++i) pm[(i * 64 + lane) * 4 + t] = v[i] * inv;
    }
    __syncthreads();
    {
        f32x4 acc[4][2];
#pragma unroll
        for (int t = 0; t < 4; ++t) { acc[t][0] = (f32x4){0.f, 0.f, 0.f, 0.f}; acc[t][1] = (f32x4){0.f, 0.f, 0.f, 0.f}; }
        f32x4 va[4], vb[4];
#pragma unroll
        for (int i = 0; i < 4; ++i) { const float* vr = Vc + (size_t)(wid * 64 + i) * D; va[i] = __builtin_nontemporal_load((const f32x4*)(vr + lane * 4)); vb[i] = __builtin_nontemporal_load((const f32x4*)(vr + 256 + lane * 4)); }
        for (int m4 = 0; m4 < 16; ++m4) {
            f32x4 ca[4], cb[4];
#pragma unroll
            for (int i = 0; i < 4; ++i) { ca[i] = va[i]; cb[i] = vb[i]; }
            if (m4 + 1 < 16) {
#pragma unroll
                for (int i = 0; i < 4; ++i) { const float* vr = Vc + (size_t)(wid * 64 + (m4 + 1) * 4 + i) * D; va[i] = __builtin_nontemporal_load((const f32x4*)(vr + lane * 4)); vb[i] = __builtin_nontemporal_load((const f32x4*)(vr + 256 + lane * 4)); }
            }
#pragma unroll
            for (int i = 0; i < 4; ++i) {
                const f32x4 pr = *(const f32x4*)(pm + (wid * 64 + m4 * 4 + i) * 4);
#pragma unroll
                for (int t = 0; t < 4; ++t) { acc[t][0] += ca[i] * pr[t]; acc[t][1] += cb[i] * pr[t]; }
            }
        }
#pragma unroll
        for (int t = 0; t < 4; ++t) { *(f32x4*)(red + (wid * 4 + t) * 512 + lane * 4) = acc[t][0]; *(f32x4*)(red + (wid * 4 + t) * 512 + 256 + lane * 4) = acc[t][1]; }
    }
    __syncthreads();
    {
        bf16_t* ctx = (bf16_t*)(p.ws + WS_CTX);
#pragma unroll
        for (int i = 0; i < 2; ++i) {
            const int e = (tid + 256 * i) * 4, t = e >> 9, d = e & 511;
            const f32x4 s = *(const f32x4*)(red + (0 * 4 + t) * 512 + d) + *(const f32x4*)(red + (1 * 4 + t) * 512 + d) + *(const f32x4*)(red + (2 * 4 + t) * 512 + d) + *(const f32x4*)(red + (3 * 4 + t) * 512 + d);
            store_bf4(ctx + (size_t)(TP + sb * 4 + t) * LDB + hd * 512 + d, s);
        }
    }
    __syncthreads();
}

template <int WIN>
DEV void pool_d_prompt8(const bf16_t* __restrict__ proj, bf16_t* __restrict__ dpl, int row0, int c8) {
    const int t0 = row0 & 2047;
    uint4 u[WIN + 7];
#pragma unroll
    for (int i = 0; i < WIN + 7; ++i) { const int tt = t0 - (WIN - 1) + i; u[i] = (tt >= 0) ? *(const uint4*)(proj + (size_t)(row0 - (WIN - 1) + i) * NPJ + C_U + c8) : make_uint4(0u, 0u, 0u, 0u); }
    float acc[8] = {0.f, 0.f, 0.f, 0.f, 0.f, 0.f, 0.f, 0.f};
#pragma unroll
    for (int i = 0; i < WIN - 1; ++i) { acc[0] += bflo(u[i].x); acc[1] += bfhi(u[i].x); acc[2] += bflo(u[i].y); acc[3] += bfhi(u[i].y); acc[4] += bflo(u[i].z); acc[5] += bfhi(u[i].z); acc[6] += bflo(u[i].w); acc[7] += bfhi(u[i].w); }
#pragma unroll
    for (int j = 0; j < 8; ++j) {
        const uint4 x = u[j + WIN - 1];
        const float xs[8] = {bflo(x.x), bfhi(x.x), bflo(x.y), bfhi(x.y), bflo(x.z), bfhi(x.z), bflo(x.w), bfhi(x.w)};
#pragma unroll
        for (int e_ = 0; e_ < 8; ++e_) acc[e_] += xs[e_];
        const float ic = 1.f / (float)min(WIN, t0 + j + 1);
        uint4 o;
        o.x = cvt_pk_bf16(acc[0] * ic - xs[0], acc[1] * ic - xs[1]); o.y = cvt_pk_bf16(acc[2] * ic - xs[2], acc[3] * ic - xs[3]);
        o.z = cvt_pk_bf16(acc[4] * ic - xs[4], acc[5] * ic - xs[5]); o.w = cvt_pk_bf16(acc[6] * ic - xs[6], acc[7] * ic - xs[7]);
        *(uint4*)(dpl + (size_t)(row0 + j) * LDP + c8) = o;
        const uint4 y = u[j];
        acc[0] -= bflo(y.x); acc[1] -= bfhi(y.x); acc[2] -= bflo(y.y); acc[3] -= bfhi(y.y); acc[4] -= bflo(y.z); acc[5] -= bfhi(y.z); acc[6] -= bflo(y.w); acc[7] -= bfhi(y.w);
    }
}

#ifndef REP0
#define REP0 1
#endif
#ifndef REP1
#define REP1 1
#endif
#ifndef REP2
#define REP2 1
#endif
#ifndef REP3
#define REP3 1
#endif
#ifndef REP4
#define REP4 1
#endif
#ifndef REP5
#define REP5 1
#endif
#ifndef REP6
#define REP6 1
#endif
#ifndef REP7
#define REP7 1
#endif
#ifndef REP8
#define REP8 1
#endif
#ifndef REP9
#define REP9 1
#endif
#ifndef REP10
#define REP10 1
#endif
#ifndef REP11
#define REP11 1
#endif
#ifndef REP12
#define REP12 1
#endif
#ifndef NLAUNCH
#define NLAUNCH 1
#endif
#define GRID_BAR() do { if (NLAUNCH == 1) xcd_barrier(bar); } while (0)
#define IN_PH(k) (p.ph_lo <= (k) && (k) < p.ph_hi)
__global__ void __launch_bounds__(512) hymba_fwd(Params p) {
    __shared__ __attribute__((aligned(16))) unsigned char lds[131072];
    __shared__ uint4 xb_words;
    const int G = gridDim.x, bid = blockIdx.x, VG = 2 * G;
    if (threadIdx.x == 0) xb_words = make_uint4(0u, 0u, 0u, 0u);
#define PH_LOCALS int tid = threadIdx.x; asm volatile("" : "+v"(tid)); const int lane = tid & 63, wid = tid >> 6; const int vb = __builtin_amdgcn_readfirstlane(tid >> 8); \
    unsigned char* vlds = lds + vb * 65536; (void)lane; (void)wid; (void)vlds;
    __syncthreads();
    XcdBarrier bar; bar.bar = (unsigned*)(p.ws + WS_BAR); bar.x = 0; bar.st = (volatile LAS unsigned*)&xb_words;
    if (NLAUNCH == 1) bar = xcd_barrier_post((unsigned*)(p.ws + WS_BAR), (volatile LAS unsigned*)&xb_words);
    unsigned char* ws = p.ws;
    bf16_t* Wt_in = (bf16_t*)(ws + WS_WIN); bf16_t* Wt_out = (bf16_t*)(ws + WS_WOUT); bf16_t* Wt_cq = (bf16_t*)(ws + WS_WCQ); bf16_t* Wt_co = (bf16_t*)(ws + WS_WCO);
    bf16_t* Wt_ckv = (bf16_t*)(ws + WS_WCKV); bf16_t* Wt_pool = (bf16_t*)(ws + WS_WPOOL);
    bf16_t* hbuf = (bf16_t*)(ws + WS_H); bf16_t* hm = (bf16_t*)(ws + WS_HM); bf16_t* proj = (bf16_t*)(ws + WS_PROJ); float* ab = (float*)(ws + WS_AB);
    bf16_t* mkb = (bf16_t*)(ws + WS_MKB); bf16_t* mvt = (bf16_t*)(ws + WS_MVT); bf16_t* dpl = (bf16_t*)(ws + WS_DPL); bf16_t* mix = (bf16_t*)(ws + WS_MIX);
    bf16_t* x1 = (bf16_t*)(ws + WS_X1); bf16_t* qx = (bf16_t*)(ws + WS_QX); float* sc = (float*)(ws + WS_SC); bf16_t* pb = (bf16_t*)(ws + WS_PB);
    bf16_t* ctx = (bf16_t*)(ws + WS_CTX); bf16_t* x2 = (bf16_t*)(ws + WS_X2); float* obuf = (float*)(ws + WS_O);
#define VLOOP(t, N) for (int t##0_ = 2 * bid, t = min(t##0_ + vb, (N) - 1); t##0_ < (N); t##0_ += VG, t = min(t##0_ + vb, (N) - 1))

    if (IN_PH(0)) { PH_LOCALS
        const int NT_IN = 98 * 16, NT_SQ = 32 * 16;
        const int total = NT_IN + 5 * NT_SQ + 32;
        VLOOP(t, total) {
            if (t < NT_IN) { const int nt = t >> 4, kt = t & 15; transpose_tile(p.in[9], 6160, nt * 64, true, kt * 128, Wt_in + (size_t)nt * 64 * LDB, LDB, (float*)vlds); }
            else if (t < NT_IN + 5 * NT_SQ) {
                const int u = t - NT_IN, j = u >> 9, v = u & 511, nt = v >> 4, kt = v & 15;
                const float* src = p.in[j == 0 ? 16 : (j == 1 ? 19 : (j == 2 ? 22 : (j == 3 ? 20 : 21)))];
                bf16_t* dst = j == 0 ? Wt_out : (j == 1 ? Wt_cq : (j == 2 ? Wt_co : (j == 3 ? Wt_ckv : Wt_ckv + (size_t)D * LDB)));
                transpose_tile(src, D, nt * 64, false, kt * 128, dst + (size_t)nt * 64 * LDB, LDB, (float*)vlds);
            } else {
                const int u = t - NT_IN - 5 * NT_SQ, g = u >> 3, v = u & 7, nt = v >> 1, kt = v & 1;
                transpose_tile(p.in[14] + (size_t)g * 65536, 256, nt * 64, false, kt * 128, Wt_pool + ((size_t)g * 256 + nt * 64) * LDM, LDM, (float*)vlds);
            }
        }
        for (int r = bid * 8 + wid; r < TT + 1024; r += G * 8) {
            if (r < TP) rmsnorm_row_bf16(p.in[0] + (size_t)r * D, p.in[8], hbuf + (size_t)r * LDB, lane);
            else if (r < TT) rmsnorm_row_bf16(p.in[1] + (size_t)(r - TP) * D, p.in[8], hbuf + (size_t)r * LDB, lane);
            else rmsnorm_row_bf16(p.in[2] + (size_t)(r - TT) * D, p.in[17], hm + (size_t)(r - TT) * LDB, lane);
        }
    }
    GRID_BAR();
    if (IN_PH(1)) { PH_LOCALS
        for (int t = bid; t < 32 * 24; t += G) { int nt, mt; tile_map(t, 32, 24, mt, nt);
            EpiBfS e{proj + (size_t)mt * 256 * NPJ + nt * 256, NPJ};
            gemm256_tile(hbuf + (size_t)mt * 256 * LDB, LDB, Wt_in + (size_t)nt * 256 * LDB, LDB, D, lds, e);
        }
        VLOOP(t, 4 * 48 + 256) {
            if (t < 192) { const int mt = t & 3, nt = t >> 2;
                EpiProj e{TP + mt * 128, nt * 128, proj, ab, p.out};
                gemm_tile<64>(hbuf + (size_t)(TP + mt * 128) * LDB, LDB, Wt_in + (size_t)nt * 128 * LDB, LDB, D, vlds, e);
            } else { const int u = t - 192, mt = u & 7, nt = u >> 3;
                EpiMKV e{mt * 128, nt * 128, mkb, mvt, p.out};
                gemm_tile<64>(hm + (size_t)mt * 128 * LDB, LDB, Wt_ckv + (size_t)nt * 128 * LDB, LDB, D, vlds, e);
            }
        }
        for (int tk = bid * 8 + wid; tk < (TT / 16) * 4; tk += G * 8) ab_rows16(hbuf, Wt_in + (size_t)NPJ * LDB, ab, tk >> 2, tk & 3, lane);
    }
    GRID_BAR();
    if (IN_PH(2)) { PH_LOCALS
        VLOOP(t, 1024) gdn_prep_chunk(p, t, vlds);
        for (int i = bid * 512 + tid; i < (TP / 8) * 128; i += G * 512) {
            const int row0 = (i >> 7) * 8, c8 = (i & 127) * 8, g = c8 >> 8;
            if (g == 0) pool_d_prompt8<2>(proj, dpl, row0, c8); else if (g == 1) pool_d_prompt8<4>(proj, dpl, row0, c8);
            else if (g == 2) pool_d_prompt8<8>(proj, dpl, row0, c8); else pool_d_prompt8<16>(proj, dpl, row0, c8);
        }
        for (int i = TP * 128 + bid * 512 + tid; i < TT * 128; i += G * 512) {
            const int row = i >> 7, c8 = (i & 127) * 8, g = c8 >> 8, win = 2 << g;
            float acc[8] = {0.f, 0.f, 0.f, 0.f, 0.f, 0.f, 0.f, 0.f}, self[8];
            const int tloc = (row - TP) & 3;
            for (int k = 0; k < win; ++k) {
                const int tt = tloc - k;
                if (tt >= 0) {
                    const uint4 u = *(const uint4*)(proj + (size_t)(row - k) * NPJ + C_U + c8);
                    const float f[8] = {bflo(u.x), bfhi(u.x), bflo(u.y), bfhi(u.y), bflo(u.z), bfhi(u.z), bflo(u.w), bfhi(u.w)};
#pragma unroll
                    for (int e = 0; e < 8; ++e) { acc[e] += f[e]; if (k == 0) self[e] = f[e]; }
                } else {
                    const float* sp = p.in[7] + ((size_t)((row - TP) >> 2) * 15 + (15 + tt)) * 1024 + c8;
                    const f32x4 s0 = *(const f32x4*)sp, s1 = *(const f32x4*)(sp + 4);
                    acc[0] += s0[0]; acc[1] += s0[1]; acc[2] += s0[2]; acc[3] += s0[3]; acc[4] += s1[0]; acc[5] += s1[1]; acc[6] += s1[2]; acc[7] += s1[3];
                }
            }
            const float ic = 1.f / (float)win;
            uint4 o; o.x = cvt_pk_bf16(acc[0] * ic - self[0], acc[1] * ic - self[1]); o.y = cvt_pk_bf16(acc[2] * ic - self[2], acc[3] * ic - self[3]);
            o.z = cvt_pk_bf16(acc[4] * ic - self[4], acc[5] * ic - self[5]); o.w = cvt_pk_bf16(acc[6] * ic - self[6], acc[7] * ic - self[7]);
            *(uint4*)(dpl + (size_t)row * LDP + c8) = o;
        }
        for (int i = bid * 512 + tid; i < NB * (3 * 3072 + 15 * 1024); i += G * 512) {
            const int b = i / (3 * 3072 + 15 * 1024), u = i - b * (3 * 3072 + 15 * 1024);
            if (u < 3 * 3072) { const int rr = u / 3072, col = u - rr * 3072; p.out[O_CP + ((size_t)(b * 3 + rr)) * 3072 + col] = bf2f(proj[(size_t)(b * SEQ + 2045 + rr) * NPJ + col]); }
            else { const int v = u - 3 * 3072, rr = v >> 10, col = v & 1023; p.out[O_PP + ((size_t)(b * 15 + rr)) * 1024 + col] = bf2f(proj[(size_t)(b * SEQ + 2033 + rr) * NPJ + C_U + col]); }
        }
        for (int i = bid * 512 + tid; i < SB * 11 * 256; i += G * 512) {
            const int c4 = (i & 255) * 4, rr = (i >> 8) % 11, sb = (i >> 8) / 11;
            *(f32x4*)(p.out + O_PS + ((size_t)sb * 15 + rr) * 1024 + c4) = *(const f32x4*)(p.in[7] + ((size_t)sb * 15 + rr + 4) * 1024 + c4);
        }
    }
    GRID_BAR();
    if (IN_PH(3)) { PH_LOCALS
        const int NSC = 256, NSM = 1024, NPL = 68 * 8;
        const int nsb = G >> 1;
        if (bid < nsb) {
            if (G == 256) {
                const int x = bid & 7, j = bid >> 3;
                gdn_scan_item(p, ((x * 4 + (j >> 2)) << 3) | ((j & 3) << 1) | vb, vlds);
            } else
            for (int t0 = 2 * bid; t0 < NSC; t0 += 2 * nsb) gdn_scan_item(p, min(t0 + vb, NSC - 1), vlds);
        } else {
            const int ob = bid - nsb, no = G - nsb;
            for (int t0 = 2 * ob; t0 < NSM; t0 += 2 * no) gdn_sample_item(p, min(t0 + vb, NSM - 1), vlds);
            for (int t0 = 2 * ob; t0 < NPL; t0 += 2 * no) { const int t = min(t0 + vb, NPL - 1); int nt, mt; tile_map(t, 68, 8, mt, nt); const int g = nt >> 1;
                EpiPool e{mt * 128, nt * 128, proj, p.in[15], mix};
                gemm_tile<64>(dpl + (size_t)mt * 128 * LDP + g * 256, LDP, Wt_pool + (size_t)nt * 128 * LDM, LDM, 256, vlds, e);
            }
        }
    }
    GRID_BAR();
    if (IN_PH(4)) { PH_LOCALS
        for (int i = bid * 512 + tid; i < TP * 8 * 16; i += G * 512) {
            const int l16 = i & 15, rh = i >> 4, h = rh & 7, row = rh >> 3;
            const float* op = obuf + (size_t)row * 1024 + h * 128 + l16 * 8;
            const f32x4 a = __builtin_nontemporal_load((const f32x4*)op), b4 = __builtin_nontemporal_load((const f32x4*)(op + 4));
            float ss = a[0] * a[0] + a[1] * a[1] + a[2] * a[2] + a[3] * a[3] + b4[0] * b4[0] + b4[1] * b4[1] + b4[2] * b4[2] + b4[3] * b4[3];
            ss += __shfl_xor(ss, 1); ss += __shfl_xor(ss, 2); ss += __shfl_xor(ss, 4); ss += __shfl_xor(ss, 8);
            const float rs = rsqrtf(ss * (1.f / 128.f) + EPS);
            const f32x4 g0 = *(const f32x4*)(p.in[13] + l16 * 8), g1 = *(const f32x4*)(p.in[13] + l16 * 8 + 4);
            const uint4 z = *(const uint4*)(proj + (size_t)row * NPJ + C_ZA + h * 128 + l16 * 8);
            uint4 o;
            o.x = cvt_pk_bf16(a[0] * rs * g0[0] * silu_f(bflo(z.x)), a[1] * rs * g0[1] * silu_f(bfhi(z.x)));
            o.y = cvt_pk_bf16(a[2] * rs * g0[2] * silu_f(bflo(z.y)), a[3] * rs * g0[3] * silu_f(bfhi(z.y)));
            o.z = cvt_pk_bf16(b4[0] * rs * g1[0] * silu_f(bflo(z.z)), b4[1] * rs * g1[1] * silu_f(bfhi(z.z)));
            o.w = cvt_pk_bf16(b4[2] * rs * g1[2] * silu_f(bflo(z.w)), b4[3] * rs * g1[3] * silu_f(bfhi(z.w)));
            *(uint4*)(mix + (size_t)row * LDB + h * 128 + l16 * 8) = o;
        }
    }
    GRID_BAR();
    if (IN_PH(5)) { PH_LOCALS
        for (int t = bid; t < 32 * 8; t += G) { int nt, mt; tile_map(t, 32, 8, mt, nt);
            EpiResidS e{p.in[0] + (size_t)mt * 256 * D + nt * 256, x1 + (size_t)mt * 256 * LDB + nt * 256, LDB};
            gemm256_tile(mix + (size_t)mt * 256 * LDB, LDB, Wt_out + (size_t)nt * 256 * LDB, LDB, D, lds, e);
        }
        VLOOP(t, 8 * 32) { const int mt = t & 7, nt = t >> 3;
            EpiResid e{p.in[1] + (size_t)mt * 64 * D + nt * 64, x1 + (size_t)(TP + mt * 64) * LDB + nt * 64};
            gemm_tile<32>(mix + (size_t)(TP + mt * 64) * LDB, LDB, Wt_out + (size_t)nt * 64 * LDB, LDB, D, vlds, e);
        }
    }
    GRID_BAR();
    if (IN_PH(6)) { PH_LOCALS
    for (int r = bid * 8 + wid; r < TT; r += G * 8) rmsnorm_row_from_bf16<false>(x1 + (size_t)r * LDB, p.in[18], hbuf + (size_t)r * LDB, lane);
    }
    GRID_BAR();
    if (IN_PH(7)) { PH_LOCALS
        VLOOP(t, 8 * 32) { const int mt = t & 7, nt = t >> 3;
            EpiBf e{qx + (size_t)(TP + mt * 64) * LDB + nt * 64, LDB};
            gemm_tile<32>(hbuf + (size_t)(TP + mt * 64) * LDB, LDB, Wt_cq + (size_t)nt * 64 * LDB, LDB, D, vlds, e);
        }
    }
    GRID_BAR();
    if (IN_PH(7)) { PH_LOCALS
        const int ng = G >> 1;
        if (bid < ng) {
            for (int t = bid; t < 32 * 8; t += ng) { int nt, mt; tile_map(t, 32, 8, mt, nt);
                EpiBfS e{qx + (size_t)mt * 256 * LDB + nt * 256, LDB};
                gemm256_tile(hbuf + (size_t)mt * 256 * LDB, LDB, Wt_cq + (size_t)nt * 256 * LDB, LDB, D, lds, e);
            }
        } else {
            const int ob = bid - ng, no = G - ng;
            for (int t0 = 2 * ob; t0 < 512; t0 += 2 * no) attn_sample_item(p, min(t0 + vb, 511), vlds);
        }
    }
    GRID_BAR();
    if (IN_PH(8)) { PH_LOCALS
        const int NS1 = 16 * 16 * 2;
        VLOOP(t, NS1) { const int bhd = t >> 5, v = t & 31, mt = v >> 1, nt = v & 1, b = bhd >> 2, hd = bhd & 3;
            EpiF32s e{sc + (size_t)(b * SEQ + mt * 128) * 1024 + hd * 256 + nt * 128, 1024, 0.04419417382415922f};
            gemm_tile<64>(qx + (size_t)(b * SEQ + mt * 128) * LDB + hd * 512, LDB, mkb + (size_t)(b * 256 + nt * 128) * LDB + hd * 512, LDB, 512, vlds, e);
        }
    }
    GRID_BAR();
    if (IN_PH(9)) { PH_LOCALS
    for (int r = bid * 8 + wid; r < TP * 4; r += G * 8) {
        const f32x4 v = __builtin_nontemporal_load((const f32x4*)(sc + (size_t)r * 256 + lane * 4));
        const float mx = wave_max(fmaxf(fmaxf(v[0], v[1]), fmaxf(v[2], v[3])));
        f32x4 e; e[0] = __expf(v[0] - mx); e[1] = __expf(v[1] - mx); e[2] = __expf(v[2] - mx); e[3] = __expf(v[3] - mx);
        const float inv = 1.f / wave_sum(e[0] + e[1] + e[2] + e[3]);
        store_bf4(pb + (size_t)(r >> 2) * LDP + (r & 3) * 256 + lane * 4, e * inv);
    }
    }
    GRID_BAR();
    if (IN_PH(10)) { PH_LOCALS
        VLOOP(t, 16 * 16 * 4) { const int bhd = t >> 6, v = t & 63, mt = v >> 2, nt = v & 3, b = bhd >> 2, hd = bhd & 3;
            EpiBf e{ctx + (size_t)(b * SEQ + mt * 128) * LDB + hd * 512 + nt * 128, LDB};
            gemm_tile<64>(pb + (size_t)(b * SEQ + mt * 128) * LDP + hd * 256, LDP, mvt + ((size_t)b * D + hd * 512 + nt * 128) * LDM, LDM, 256, vlds, e);
        }
    }
    GRID_BAR();
    if (IN_PH(11)) { PH_LOCALS
        for (int t = bid; t < 32 * 8; t += G) { int nt, mt; tile_map(t, 32, 8, mt, nt);
            EpiResidBS e{x1 + (size_t)mt * 256 * LDB + nt * 256, x2 + (size_t)mt * 256 * LDB + nt * 256, LDB};
            gemm256_tile(ctx + (size_t)mt * 256 * LDB, LDB, Wt_co + (size_t)nt * 256 * LDB, LDB, D, lds, e);
        }
        VLOOP(t, 8 * 32) { const int mt = t & 7, nt = t >> 3;
            EpiResidB e{x1 + (size_t)(TP + mt * 64) * LDB + nt * 64, x2 + (size_t)(TP + mt * 64) * LDB + nt * 64};
            gemm_tile<32>(ctx + (size_t)(TP + mt * 64) * LDB, LDB, Wt_co + (size_t)nt * 64 * LDB, LDB, D, vlds, e);
        }
    }
    GRID_BAR();
    if (IN_PH(12)) { PH_LOCALS
    for (int r = bid * 8 + wid; r < TT; r += G * 8) rmsnorm_row_from_bf16<true>(x2 + (size_t)r * LDB, p.in[23], p.out + (r < TP ? O_YP + (size_t)r * D : O_YS + (size_t)(r - TP) * D), lane);
    }
}

extern "C" void kernel_launch(void* const* d_in, const int* in_sizes, int n_in, void* d_out, int out_size, void* d_ws, size_t ws_size, hipStream_t stream) {
    static int grid = 0;
    if (grid == 0) {
        if (n_in != 24 || ws_size < WS_END) { fprintf(stderr, "kernel_launch: need 24 inputs and %zu bytes of workspace (got %d, %zu)\n", (size_t)WS_END, n_in, ws_size); grid = -1; return; }
        int dev = 0, cus = 0, per_cu = 0;
        hipGetDevice(&dev);
        hipDeviceGetAttribute(&cus, hipDeviceAttributeMultiprocessorCount, dev);
        if (hipOccupancyMaxActiveBlocksPerMultiprocessor(&per_cu, (const void*)hymba_fwd, 512, 0) != hipSuccess || per_cu < 1) { fprintf(stderr, "kernel_launch: occupancy query failed\n"); grid = -1; return; }
        if (per_cu > 1) per_cu = 1;
        grid = cus * per_cu;
        fprintf(stderr, "kernel_launch: grid %d (%d per CU)\n", grid, per_cu);
    }
    if (grid < 0) return;
    hipMemsetAsync((char*)d_ws + WS_BAR, 0, 16384, stream);
    Params p{};
    for (int i = 0; i < 24; ++i) p.in[i] = (const float*)d_in[i];
    p.out = (float*)d_out; p.ws = (unsigned char*)d_ws;
    if (NLAUNCH == 1) {
        p.ph_lo = 0; p.ph_hi = 13;
        void* args[] = {&p};
        hipError_t e = hipLaunchCooperativeKernel((const void*)hymba_fwd, dim3(grid), dim3(512), args, 0, stream);
        if (e != hipSuccess) fprintf(stderr, "kernel_launch: cooperative launch failed: %s (grid %d)\n", hipGetErrorString(e), grid);
    } else {
        for (int k = 0; k < 13; ++k) { p.ph_lo = k; p.ph_hi = k + 1; hipLaunchKernelGGL(hymba_fwd, dim3(grid), dim3(512), 0, stream, p); }
    }
}
```

```cpp
#include <hip/hip_runtime.h>
#include <hip/hip_cooperative_groups.h>
#include <cstdio>
#include <cstdint>

typedef unsigned short bf16_t;
typedef short bf16x8 __attribute__((ext_vector_type(8)));
typedef float f32x4 __attribute__((ext_vector_type(4)));
typedef unsigned u32x4 __attribute__((ext_vector_type(4)));
#define DEV __device__ __forceinline__
#define LAS __attribute__((address_space(3)))

constexpr int D = 2048, TP = 8192, TS = 512, TT = 8704, SEQ = 2048, NB = 4, SB = 128;
constexpr int NPJ = 6144;
constexpr int C_ZA = 3072, C_U = 4096, C_ZB = 5120;
constexpr int NWIN = 6272;
constexpr float EPS = 1e-6f;
constexpr int LDB = 2112, LDP = 1088, LDM = 288;

constexpr size_t O_YP = 0, O_YS = 16777216, O_MK = 17825792, O_MV = 19922944, O_DP = 22020096, O_CP = 22544384,
                 O_PP = 22581248, O_DS = 22642688, O_CS = 39419904, O_PS = 40599552;

constexpr size_t al256(size_t x) { return (x + 255) & ~(size_t)255; }
constexpr size_t WS_BAR = 0;
constexpr size_t WS_WIN = 16384;
constexpr size_t WS_WOUT = WS_WIN + (size_t)NWIN * LDB * 2;
constexpr size_t WS_WCQ = WS_WOUT + (size_t)D * LDB * 2;
constexpr size_t WS_WCO = WS_WCQ + (size_t)D * LDB * 2;
constexpr size_t WS_WCKV = WS_WCO + (size_t)D * LDB * 2;
constexpr size_t WS_WPOOL = WS_WCKV + (size_t)2 * D * LDB * 2;
constexpr size_t WS_H = WS_WPOOL + (size_t)1024 * LDM * 2;
constexpr size_t WS_HM = WS_H + (size_t)TT * LDB * 2;
constexpr size_t WS_PROJ = WS_HM + (size_t)1024 * LDB * 2;
constexpr size_t WS_AB = WS_PROJ + (size_t)TT * NPJ * 2;
constexpr size_t WS_MKB = WS_AB + (size_t)4 * TT * 16 * 4;
constexpr size_t WS_MVT = WS_MKB + (size_t)1024 * LDB * 2;
constexpr size_t WS_GW = WS_MVT + (size_t)4 * D * LDM * 2;
constexpr size_t WS_GQ = WS_GW + (size_t)1024 * 8192 * 2;
constexpr size_t WS_GKT = WS_GQ + (size_t)1024 * 8192 * 2;
constexpr size_t WS_GA = WS_GKT + (size_t)1024 * 8192 * 2;
constexpr size_t WS_GU = WS_GA + (size_t)1024 * 4096 * 2;
constexpr size_t WS_GE = WS_GU + (size_t)1024 * 8192 * 4;
constexpr size_t WS_O = WS_GE + 4096;
constexpr size_t WS_DPL = WS_O + (size_t)TP * 1024 * 4;
constexpr size_t WS_MIX = WS_DPL + (size_t)TT * LDP * 2;
constexpr size_t WS_X1 = WS_MIX + (size_t)TT * LDB * 2;
constexpr size_t WS_QX = WS_X1 + (size_t)TT * D * 4;
constexpr size_t WS_SC = WS_QX + (size_t)TT * LDB * 2;
constexpr size_t WS_PB = WS_SC + (size_t)TP * 1024 * 4;
constexpr size_t WS_CTX = WS_PB + (size_t)TP * LDP * 2;
constexpr size_t WS_X2 = WS_CTX + (size_t)TT * LDB * 2;
constexpr size_t WS_END = WS_X2 + (size_t)TT * D * 4;

#ifndef LASTP
#define LASTP 99
#endif
struct Params { const float* in[24]; float* out; unsigned char* ws; int ph_lo, ph_hi; };

typedef __bf16 bf16x2_t __attribute__((ext_vector_type(2)));
typedef float f32x2_t __attribute__((ext_vector_type(2)));
DEV unsigned cvt_pk_bf16(float lo, float hi) { const f32x2_t v = {lo, hi}; const bf16x2_t b = __builtin_convertvector(v, bf16x2_t); return __builtin_bit_cast(unsigned, b); }
DEV bf16_t f2bf(float f) { return (bf16_t)(cvt_pk_bf16(f, 0.f) & 0xffffu); }
DEV float bf2f(unsigned b) { return __uint_as_float(b << 16); }
DEV float bflo(unsigned u) { return __uint_as_float(u << 16); }
DEV float bfhi(unsigned u) { return __uint_as_float(u & 0xffff0000u); }
DEV float silu_f(float x) { return x / (1.f + __expf(-x)); }
DEV float wave_sum(float v) {
#pragma unroll
    for (int o = 32; o >= 1; o >>= 1) v += __shfl_xor(v, o);
    return v;
}
DEV float wave_max(float v) {
#pragma unroll
    for (int o = 32; o >= 1; o >>= 1) v = fmaxf(v, __shfl_xor(v, o));
    return v;
}
DEV void store_bf4(bf16_t* p, f32x4 v) { uint2 w; w.x = cvt_pk_bf16(v[0], v[1]); w.y = cvt_pk_bf16(v[2], v[3]); *(uint2*)p = w; }

#define XB_TMO      128
#define XB_XCNT(j)  (256  + 64 * (j))
#define XB_XSUB(j)  (1280 + 64 * (j))
#define XB_XGEN(j)  (2304 + 64 * (j))
#define XB_TOP      3328
#define XB_TOPGEN   3392
#define XCD_BAR_WORDS 3456
#define XB_SPIN_CAP (1u << 22)
DEV unsigned xb_ld(unsigned* p) { return __hip_atomic_load(p, __ATOMIC_RELAXED, __HIP_MEMORY_SCOPE_AGENT); }
DEV unsigned xb_add(unsigned* p, unsigned v) { return __hip_atomic_fetch_add(p, v, __ATOMIC_RELAXED, __HIP_MEMORY_SCOPE_AGENT); }
DEV unsigned xb_xcc_id() { return (unsigned)__builtin_amdgcn_s_getreg((3 << 11) | 20) & 0xFu; }
#define XB_SPIN(cond, bar) do { unsigned _sp = 0; while (cond) { __builtin_amdgcn_s_sleep(1); \
    if ((++_sp & 255u) == 0u) { if (xb_ld(&(bar)[XB_TMO])) break; if (_sp > XB_SPIN_CAP) { atomicAdd(&(bar)[XB_TMO], 1u); break; } } } } while (0)
struct XcdBarrier { unsigned* bar; unsigned x; volatile LAS unsigned* st; };
DEV XcdBarrier xcd_barrier_post(unsigned* bar, volatile LAS unsigned* st) {
    XcdBarrier b; b.bar = bar; b.x = xb_xcc_id(); b.st = st;
    if (threadIdx.x == 0) (void)xb_add(&bar[XB_XCNT(b.x)], 1u);
    return b;
}
DEV void xcd_barrier_complete(unsigned* bar, unsigned x, unsigned& nloc, unsigned& nx) {
    const unsigned G = gridDim.x;
    unsigned sum, cnt, mine, sp = 0u;
    for (;;) {
        sum = 0u; cnt = 0u; mine = 0u;
#pragma unroll
        for (unsigned j = 0; j < 16; ++j) { const unsigned c = xb_ld(&bar[XB_XCNT(j)]); sum += c; cnt += (c > 0u) ? 1u : 0u; mine = (j == x) ? c : mine; }
        if (sum == G) break;
        __builtin_amdgcn_s_sleep(1);
        if ((++sp & 255u) == 0u) { if (xb_ld(&bar[XB_TMO])) break; if (sp > XB_SPIN_CAP) { atomicAdd(&bar[XB_TMO], 1u); break; } }
    }
    nloc = mine > 0u ? mine : 1u; nx = cnt > 0u ? cnt : 1u;
}
DEV void xcd_barrier(const XcdBarrier& b) {
    asm volatile("s_waitcnt vmcnt(0)" ::: "memory");
    __syncthreads();
    if (threadIdx.x == 0) {
        unsigned* bar = b.bar;
        __builtin_amdgcn_s_waitcnt(0);
        unsigned nloc = b.st[0], nx = b.st[1];
        if (nloc == 0u) { xcd_barrier_complete(bar, b.x, nloc, nx); b.st[0] = nloc; b.st[1] = nx; }
        const unsigned old = xb_add(&bar[XB_XSUB(b.x)], 1u);
        const unsigned gen = old / nloc;
        if (old + 1u == (gen + 1u) * nloc) {
            __builtin_amdgcn_fence(__ATOMIC_RELEASE, "agent");
            asm volatile("s_waitcnt vmcnt(0)" ::: "memory");
            const unsigned og = xb_add(&bar[XB_TOP], 1u);
            const unsigned tg = og / nx;
            if (og + 1u == (tg + 1u) * nx) xb_add(&bar[XB_TOPGEN], 1u);
            else XB_SPIN(xb_ld(&bar[XB_TOPGEN]) == tg, bar);
            __builtin_amdgcn_fence(__ATOMIC_ACQUIRE, "agent");
            xb_add(&bar[XB_XGEN(b.x)], 1u);
            asm volatile("s_waitcnt vmcnt(0)" ::: "memory");
        } else {
            XB_SPIN(xb_ld(&bar[XB_XGEN(b.x)]) == gen, bar);
            __builtin_amdgcn_fence(__ATOMIC_ACQUIRE, "agent");
            asm volatile("s_waitcnt vmcnt(0)" ::: "memory");
        }
    }
    __syncthreads();
}

DEV void glds16(const void* gptr, unsigned lds_addr_lane) {
    const unsigned m = __builtin_amdgcn_readfirstlane(lds_addr_lane);
    unsigned keep;
    asm volatile("s_mov_b32 %0, m0\n\ts_mov_b32 m0, %2\n\ts_nop 0\n\tglobal_load_lds_dwordx4 %1, off\n\ts_mov_b32 m0, %0" : "=&s"(keep) : "v"(gptr), "s"(m) : "memory");
}

template <int WT, class Epi>
DEV void gemm_tile(const bf16_t* __restrict__ A, int lda, const bf16_t* __restrict__ Bt, int ldb, int K, unsigned char* lds, const Epi& epi) {
    constexpr int FI = WT / 16;
    constexpr int OPB = 2 * WT * 128;
    constexpr int STB = 2 * OPB;
    int tid = threadIdx.x & 255; asm volatile("" : "+v"(tid)); const int lane = tid & 63, wid = tid >> 6;
    const int wr = wid >> 1, wc = wid & 1, fr = lane & 15, fq = lane >> 4;
    f32x4 acc[FI][FI];
#pragma unroll
    for (int i = 0; i < FI; ++i)
#pragma unroll
        for (int j = 0; j < FI; ++j) acc[i][j] = (f32x4){0.f, 0.f, 0.f, 0.f};
    const int lrow = tid >> 3, lcs = (tid & 7) ^ (lrow & 7);
    const bf16_t* ap = A + (size_t)lrow * lda + lcs * 8;
    const bf16_t* bp = Bt + (size_t)lrow * ldb + lcs * 8;
    const unsigned l3a = (unsigned)(size_t)(LAS unsigned char*)lds;
    const int nk = K >> 6;
#define GLDS_STAGE(st, kt_) do { \
        _Pragma("unroll") for (int i_ = 0; i_ < FI; ++i_) { \
            glds16(ap + (size_t)(32 * i_) * lda + (kt_) * 64, l3a + (st) + tid * 16 + i_ * 4096); \
            glds16(bp + (size_t)(32 * i_) * ldb + (kt_) * 64, l3a + (st) + OPB + tid * 16 + i_ * 4096); } } while (0)
    constexpr int NSTG = 65536 / STB;
#pragma unroll
    for (int s_ = 0; s_ < NSTG - 1; ++s_) if (s_ < nk) GLDS_STAGE(s_ * STB, s_);
    const int aoff = (wr * WT + fr) * 128, boff = OPB + (wc * WT + fr) * 128, sw = fr & 7;
    int cur = 0, nxt = (NSTG - 1) * STB;
    for (int kt = 0; kt < nk; ++kt) {
        if (NSTG == 4 && kt + 2 < nk) { if (FI == 2) asm volatile("s_waitcnt vmcnt(8)" ::: "memory"); else asm volatile("s_waitcnt vmcnt(0)" ::: "memory"); }
        else asm volatile("s_waitcnt vmcnt(0)" ::: "memory");
        __syncthreads();
        if (kt + NSTG - 1 < nk) GLDS_STAGE(nxt, kt + NSTG - 1);
#pragma unroll
        for (int kh = 0; kh < 2; ++kh) {
            bf16x8 af[FI], bfr[FI];
            const int ch = ((kh * 4 + fq) ^ sw) << 4;
#pragma unroll
            for (int i = 0; i < FI; ++i) { af[i] = *(const bf16x8*)(lds + cur + aoff + i * 2048 + ch); bfr[i] = *(const bf16x8*)(lds + cur + boff + i * 2048 + ch); }
#pragma unroll
            for (int mi = 0; mi < FI; ++mi)
#pragma unroll
                for (int ni = 0; ni < FI; ++ni) acc[mi][ni] = __builtin_amdgcn_mfma_f32_16x16x32_bf16(bfr[ni], af[mi], acc[mi][ni], 0, 0, 0);
        }
        nxt = cur; cur += STB; if (cur == NSTG * STB) cur = 0;
    }
#undef GLDS_STAGE
    __syncthreads();
    if constexpr (Epi::STAGE) {
        constexpr int RB = 4 * WT, CPR = RB / 16;
#pragma unroll
        for (int mi = 0; mi < FI; ++mi)
#pragma unroll
            for (int ni = 0; ni < FI; ++ni) {
                const int row = wr * WT + mi * 16 + fr, col = wc * WT + ni * 16 + fq * 4;
                const f32x4 v = epi.xform(row, col, acc[mi][ni]);
                uint2 w; w.x = cvt_pk_bf16(v[0], v[1]); w.y = cvt_pk_bf16(v[2], v[3]);
                *(uint2*)(lds + row * RB + ((((col >> 3) ^ (row & (CPR - 1))) << 4) | (((col >> 2) & 1) << 3))) = w;
            }
        __syncthreads();
#pragma unroll
        for (int i = 0; i < (2 * WT * CPR) / 256; ++i) {
            const int idx = tid + 256 * i, row = idx / CPR, cp = idx % CPR, c = cp ^ (row & (CPR - 1));
            const uint4 d = *(const uint4*)(lds + row * RB + (cp << 4));
            *(uint4*)(epi.obase + (size_t)row * epi.old + c * 8) = epi.finish(row, c * 8, d);
        }
        __syncthreads();
    } else {
#pragma unroll
        for (int mi = 0; mi < FI; ++mi)
#pragma unroll
            for (int ni = 0; ni < FI; ++ni) epi(wr * WT + mi * 16 + fr, wc * WT + ni * 16 + fq * 4, acc[mi][ni]);
    }
}

template <class Epi>
DEV void gemm256_tile(const bf16_t* __restrict__ A, int lda, const bf16_t* __restrict__ Bt, int ldb, int K, unsigned char* lds, const Epi& epi) {
    int tid = threadIdx.x; asm volatile("" : "+v"(tid)); const int lane = tid & 63, wid = tid >> 6;
    const int wr = wid >> 2, wc = wid & 3, fr = lane & 15, fq = lane >> 4;
    f32x4 acc[8][4];
#pragma unroll
    for (int i = 0; i < 8; ++i)
#pragma unroll
        for (int j = 0; j < 4; ++j) acc[i][j] = (f32x4){0.f, 0.f, 0.f, 0.f};
    const int lrow = tid >> 3, lcs = (tid & 7) ^ (lrow & 7);
    const bf16_t* ap = A + (size_t)lrow * lda + lcs * 8;
    const bf16_t* bp = Bt + (size_t)lrow * ldb + lcs * 8;
    const unsigned l3a = (unsigned)(size_t)(LAS unsigned char*)lds;
    const int nk = K >> 6;
#define GLDS_STAGE(st, kt_) do { \
        _Pragma("unroll") for (int i_ = 0; i_ < 4; ++i_) { \
            glds16(ap + (size_t)(64 * i_) * lda + (kt_) * 64, l3a + (st) + tid * 16 + i_ * 8192); \
            glds16(bp + (size_t)(64 * i_) * ldb + (kt_) * 64, l3a + (st) + 32768 + tid * 16 + i_ * 8192); } } while (0)
    GLDS_STAGE(0, 0);
    const int aoff = (wr * 128 + fr) * 128, boff = 32768 + (wc * 64 + fr) * 128, sw = fr & 7;
    for (int kt = 0; kt < nk; ++kt) {
        const int cur = (kt & 1) * 65536;
        asm volatile("s_waitcnt vmcnt(0)" ::: "memory");
        __syncthreads();
        if (kt + 1 < nk) GLDS_STAGE(cur ^ 65536, kt + 1);
#pragma unroll
        for (int kh = 0; kh < 2; ++kh) {
            bf16x8 bfr[4];
            const int ch = ((kh * 4 + fq) ^ sw) << 4;
#pragma unroll
            for (int i = 0; i < 4; ++i) bfr[i] = *(const bf16x8*)(lds + cur + boff + i * 2048 + ch);
#pragma unroll
            for (int mh = 0; mh < 2; ++mh) {
                bf16x8 af[4];
#pragma unroll
                for (int i = 0; i < 4; ++i) af[i] = *(const bf16x8*)(lds + cur + aoff + (mh * 4 + i) * 2048 + ch);
#pragma unroll
                for (int mi = 0; mi < 4; ++mi)
#pragma unroll
                    for (int ni = 0; ni < 4; ++ni) acc[mh * 4 + mi][ni] = __builtin_amdgcn_mfma_f32_16x16x32_bf16(bfr[ni], af[mi], acc[mh * 4 + mi][ni], 0, 0, 0);
            }
        }
    }
#undef GLDS_STAGE
    __syncthreads();
    if constexpr (Epi::STAGE) {
#pragma unroll
        for (int mi = 0; mi < 8; ++mi)
#pragma unroll
            for (int ni = 0; ni < 4; ++ni) {
                const int row = wr * 128 + mi * 16 + fr, col = wc * 64 + ni * 16 + fq * 4;
                const f32x4 v = epi.xform(row, col, acc[mi][ni]);
                uint2 w; w.x = cvt_pk_bf16(v[0], v[1]); w.y = cvt_pk_bf16(v[2], v[3]);
                *(uint2*)(lds + row * 512 + ((((col >> 3) ^ (row & 31)) << 4) | (((col >> 2) & 1) << 3))) = w;
            }
        __syncthreads();
#pragma unroll 4
        for (int i = 0; i < 16; ++i) {
            const int idx = tid + 512 * i, row = idx >> 5, cp = idx & 31, c = cp ^ (row & 31);
            const uint4 d = *(const uint4*)(lds + row * 512 + (cp << 4));
            *(uint4*)(epi.obase + (size_t)row * epi.old + c * 8) = epi.finish(row, c * 8, d);
        }
        __syncthreads();
    } else {
#pragma unroll
        for (int mi = 0; mi < 8; ++mi)
#pragma unroll
            for (int ni = 0; ni < 4; ++ni) epi(wr * 128 + mi * 16 + fr, wc * 64 + ni * 16 + fq * 4, acc[mi][ni]);
    }
}

DEV void ab_rows16(const bf16_t* __restrict__ h, const bf16_t* __restrict__ wab, float* __restrict__ ab4, int rt, int kq, int lane) {
    const int fr = lane & 15, fq = lane >> 4;
    const bf16_t* ap = h + (size_t)(rt * 16 + fr) * LDB + kq * 512 + fq * 8;
    const bf16_t* bp = wab + (size_t)fr * LDB + kq * 512 + fq * 8;
    bf16x8 a[16], b[16];
#pragma unroll
    for (int s = 0; s < 16; ++s) { a[s] = *(const bf16x8*)(ap + s * 32); b[s] = *(const bf16x8*)(bp + s * 32); }
    f32x4 acc = {0.f, 0.f, 0.f, 0.f};
#pragma unroll
    for (int s = 0; s < 16; ++s) acc = __builtin_amdgcn_mfma_f32_16x16x32_bf16(b[s], a[s], acc, 0, 0, 0);
    *(f32x4*)(ab4 + (size_t)kq * TT * 16 + (size_t)(rt * 16 + fr) * 16 + fq * 4) = acc;
}

DEV void tile_map(int L, int nM, int nN, int& pm, int& pn) {
    const int T = nM * nN, q = T >> 3, r = T & 7, xcd = L & 7, off = L >> 3;
    const int w = (xcd < r ? xcd * (q + 1) : r * (q + 1) + (xcd - r) * q) + off;
    const int nig = 8 * nN, gid = w / nig, fm = gid * 8, gsz = (nM - fm) < 8 ? (nM - fm) : 8;
    pm = fm + (w % nig) % gsz; pn = (w % nig) / gsz;
}

struct EpiProj {
    static constexpr bool STAGE = false;
    int m0, n0; bf16_t* proj; float* ab; float* out;
    DEV void operator()(int r, int c, f32x4 v) const {
        const int row = m0 + r, col = n0 + c;
        if (col < NPJ) {
            store_bf4(proj + (size_t)row * NPJ + col, v);
            const bool isconv = col < 3072, ispool = (col >= C_U && col < C_ZB);
            if (isconv || ispool) {
                if (row < TP) {
                    const int b = row >> 11, t = row & 2047;
                    if (isconv) { if (t >= 2045) *(f32x4*)(out + O_CP + ((size_t)(b * 3 + (t - 2045))) * 3072 + col) = v; }
                    else { if (t >= 2033) *(f32x4*)(out + O_PP + ((size_t)(b * 15 + (t - 2033))) * 1024 + (col - C_U)) = v; }
                } else {
                    const int sb = (row - TP) >> 2, t = (row - TP) & 3;
                    if (isconv) { if (t >= 1) *(f32x4*)(out + O_CS + ((size_t)(sb * 3 + (t - 1))) * 3072 + col) = v; }
                    else *(f32x4*)(out + O_PS + ((size_t)(sb * 15 + 11 + t)) * 1024 + (col - C_U)) = v;
                }
            }
        } else if (col < NPJ + 16) {
            *(f32x4*)(ab + (size_t)row * 16 + (col - NPJ)) = v;
        }
    }
};
struct EpiMKV {
    static constexpr bool STAGE = false;
    int m0, n0; bf16_t* mkb; bf16_t* mvt; float* out;
    DEV void operator()(int r, int c, f32x4 v) const {
        const int row = m0 + r, col = n0 + c;
        if (col < D) {
            __builtin_nontemporal_store(v, (f32x4*)(out + O_MK + (size_t)row * D + col));
            store_bf4(mkb + (size_t)row * LDB + col, v);
        } else {
            const int cc = col - D, b = row >> 8, m = row & 255;
            __builtin_nontemporal_store(v, (f32x4*)(out + O_MV + (size_t)row * D + cc));
            bf16_t* p = mvt + ((size_t)b * D + cc) * LDM + m;
            p[0] = f2bf(v[0]); p[LDM] = f2bf(v[1]); p[2 * LDM] = f2bf(v[2]); p[3 * LDM] = f2bf(v[3]);
        }
    }
};
struct EpiPool {
    static constexpr bool STAGE = false;
    int m0, n0; const bf16_t* proj; const float* scale; bf16_t* mix;
    DEV void operator()(int r, int c, f32x4 v) const {
        const int row = m0 + r, col = n0 + c;
        const uint2 z = *(const uint2*)(proj + (size_t)row * NPJ + C_ZB + col);
        const f32x4 s = *(const f32x4*)(scale + col);
        f32x4 o;
        o[0] = v[0] * s[0] * silu_f(bflo(z.x)); o[1] = v[1] * s[1] * silu_f(bfhi(z.x));
        o[2] = v[2] * s[2] * silu_f(bflo(z.y)); o[3] = v[3] * s[3] * silu_f(bfhi(z.y));
        store_bf4(mix + (size_t)row * LDB + 1024 + col, o);
    }
};
struct EpiResid {   static constexpr bool STAGE = false;
    const float* res; bf16_t* dst;
    DEV void operator()(int r, int c, f32x4 v) const {
        const f32x4 x = __builtin_nontemporal_load((const f32x4*)(res + (size_t)r * D + c));
        store_bf4(dst + (size_t)r * LDB + c, x + v);
    }
};
struct EpiResidB {  static constexpr bool STAGE = false;
    const bf16_t* res; bf16_t* dst;
    DEV void operator()(int r, int c, f32x4 v) const {
        const uint2 u = *(const uint2*)(res + (size_t)r * LDB + c);
        f32x4 x; x[0] = bflo(u.x); x[1] = bfhi(u.x); x[2] = bflo(u.y); x[3] = bfhi(u.y);
        store_bf4(dst + (size_t)r * LDB + c, x + v);
    }
};
struct EpiBf {
    static constexpr bool STAGE = false;
    bf16_t* dst; int ld;
    DEV void operator()(int r, int c, f32x4 v) const { store_bf4(dst + (size_t)r * ld + c, v); }
};
struct EpiF32s {
    static constexpr bool STAGE = false;
    float* dst; int ld; float s;
    DEV void operator()(int r, int c, f32x4 v) const { *(f32x4*)(dst + (size_t)r * ld + c) = v * s; }
};

struct EpiProjS {
    static constexpr bool STAGE = true;
    int m0, n0; bf16_t* obase; int old; float* out;
    DEV f32x4 xform(int r, int c, f32x4 v) const {
        const int row = m0 + r, col = n0 + c;
        const bool isconv = col < 3072, ispool = (col >= C_U && col < C_ZB);
        if (isconv || ispool) {
            const int b = row >> 11, t = row & 2047;
            if (isconv) { if (t >= 2045) *(f32x4*)(out + O_CP + ((size_t)(b * 3 + (t - 2045))) * 3072 + col) = v; }
            else { if (t >= 2033) *(f32x4*)(out + O_PP + ((size_t)(b * 15 + (t - 2033))) * 1024 + (col - C_U)) = v; }
        }
        return v;
    }
};
struct EpiBfS {
    static constexpr bool STAGE = true;
    bf16_t* obase; int old;
    DEV f32x4 xform(int, int, f32x4 v) const { return v; }
    DEV uint4 finish(int, int, uint4 d) const { return d; }
};
DEV uint4 add8_bf16(uint4 d, const float* r8) {
    uint4 o; o.x = cvt_pk_bf16(bflo(d.x) + r8[0], bfhi(d.x) + r8[1]); o.y = cvt_pk_bf16(bflo(d.y) + r8[2], bfhi(d.y) + r8[3]);
    o.z = cvt_pk_bf16(bflo(d.z) + r8[4], bfhi(d.z) + r8[5]); o.w = cvt_pk_bf16(bflo(d.w) + r8[6], bfhi(d.w) + r8[7]); return o;
}
struct EpiResidS {
    static constexpr bool STAGE = true;
    const float* res; bf16_t* obase; int old;
    DEV f32x4 xform(int, int, f32x4 v) const { return v; }
    DEV uint4 finish(int r, int c, uint4 d) const {
        const f32x4 a = __builtin_nontemporal_load((const f32x4*)(res + (size_t)r * D + c)), b = __builtin_nontemporal_load((const f32x4*)(res + (size_t)r * D + c + 4));
        const float r8[8] = {a[0], a[1], a[2], a[3], b[0], b[1], b[2], b[3]};
        return add8_bf16(d, r8);
    }
};
struct EpiResidBS {
    static constexpr bool STAGE = true;
    const bf16_t* res; bf16_t* obase; int old;
    DEV f32x4 xform(int, int, f32x4 v) const { return v; }
    DEV uint4 finish(int r, int c, uint4 d) const {
        const uint4 u = *(const uint4*)(res + (size_t)r * LDB + c);
        const float r8[8] = {bflo(u.x), bfhi(u.x), bflo(u.y), bfhi(u.y), bflo(u.z), bfhi(u.z), bflo(u.w), bfhi(u.w)};
        return add8_bf16(d, r8);
    }
};
DEV int win_srccol(int n) { return n < 4096 ? n : (n < 6144 ? n + 16 : (n < 6160 ? 4096 + (n - 6144) : -1)); }
DEV void transpose_tile(const float* __restrict__ src, int ld, int srccol0, bool remap, int k0, bf16_t* __restrict__ dstrow0, int ldd, float* tile) {
    int tid = threadIdx.x & 255; asm volatile("" : "+v"(tid));
    const int tx = tid & 63, ty = tid >> 6;
    const int sc = remap ? win_srccol(srccol0 + tx) : (srccol0 + tx);
    float tv[32];
#pragma unroll
    for (int i = 0; i < 32; ++i) tv[i] = sc >= 0 ? __builtin_nontemporal_load(src + (size_t)(k0 + ty + 4 * i) * ld + sc) : 0.f;
#pragma unroll
    for (int i = 0; i < 32; ++i) tile[(ty + 4 * i) * 65 + tx] = tv[i];
    __syncthreads();
#pragma unroll
    for (int i = 0; i < 16; ++i) { const int r = ty + 4 * i; *(unsigned*)(dstrow0 + (size_t)r * ldd + k0 + 2 * tx) = cvt_pk_bf16(tile[(2 * tx) * 65 + r], tile[(2 * tx + 1) * 65 + r]); }
    __syncthreads();
}
DEV void rmsnorm_row_bf16(const float* __restrict__ x, const float* __restrict__ g, bf16_t* __restrict__ y, int lane) {
    f32x4 v[8]; float ss = 0.f;
#pragma unroll
    for (int i = 0; i < 8; ++i) { v[i] = __builtin_nontemporal_load((const f32x4*)x + i * 64 + lane); ss += v[i][0] * v[i][0] + v[i][1] * v[i][1] + v[i][2] * v[i][2] + v[i][3] * v[i][3]; }
    ss = wave_sum(ss);
    const float rs = rsqrtf(ss * (1.f / 2048.f) + EPS);
#pragma unroll
    for (int i = 0; i < 8; ++i) { const f32x4 gg = ((const f32x4*)g)[i * 64 + lane]; store_bf4(y + (size_t)(i * 64 + lane) * 4, v[i] * rs * gg); }
}
template <bool OUT_F32>
DEV void rmsnorm_row_from_bf16(const bf16_t* __restrict__ x, const float* __restrict__ g, void* __restrict__ y, int lane) {
    float v[4][8]; float ss = 0.f;
#pragma unroll
    for (int i = 0; i < 4; ++i) { uint4 u; if (OUT_F32) { const u32x4 t_ = __builtin_nontemporal_load((const u32x4*)x + i * 64 + lane); u = make_uint4(t_[0], t_[1], t_[2], t_[3]); } else u = ((const uint4*)x)[i * 64 + lane];
        v[i][0] = bflo(u.x); v[i][1] = bfhi(u.x); v[i][2] = bflo(u.y); v[i][3] = bfhi(u.y); v[i][4] = bflo(u.z); v[i][5] = bfhi(u.z); v[i][6] = bflo(u.w); v[i][7] = bfhi(u.w);
#pragma unroll
        for (int e = 0; e < 8; ++e) ss += v[i][e] * v[i][e]; }
    ss = wave_sum(ss);
    const float rs = rsqrtf(ss * (1.f / 2048.f) + EPS);
#pragma unroll
    for (int i = 0; i < 4; ++i) {
        const f32x4 g0 = ((const f32x4*)g)[(i * 64 + lane) * 2], g1 = ((const f32x4*)g)[(i * 64 + lane) * 2 + 1];
        const f32x4 o0 = (f32x4){v[i][0], v[i][1], v[i][2], v[i][3]} * rs * g0, o1 = (f32x4){v[i][4], v[i][5], v[i][6], v[i][7]} * rs * g1;
        if (OUT_F32) { __builtin_nontemporal_store(o0, (f32x4*)y + (i * 64 + lane) * 2); __builtin_nontemporal_store(o1, (f32x4*)y + (i * 64 + lane) * 2 + 1); }
        else { uint4 w; w.x = cvt_pk_bf16(o0[0], o0[1]); w.y = cvt_pk_bf16(o0[2], o0[3]); w.z = cvt_pk_bf16(o1[0], o1[1]); w.w = cvt_pk_bf16(o1[2], o1[3]); ((uint4*)y)[i * 64 + lane] = w; }
    }
}
DEV void rmsnorm_row_f32(const float* __restrict__ x, const float* __restrict__ g, float* __restrict__ y, int lane) {
    f32x4 v[8]; float ss = 0.f;
#pragma unroll
    for (int i = 0; i < 8; ++i) { v[i] = ((const f32x4*)x)[i * 64 + lane]; ss += v[i][0] * v[i][0] + v[i][1] * v[i][1] + v[i][2] * v[i][2] + v[i][3] * v[i][3]; }
    ss = wave_sum(ss);
    const float rs = rsqrtf(ss * (1.f / 2048.f) + EPS);
#pragma unroll
    for (int i = 0; i < 8; ++i) { const f32x4 gg = ((const f32x4*)g)[i * 64 + lane]; __builtin_nontemporal_store(v[i] * rs * gg, (f32x4*)y + i * 64 + lane); }
}

constexpr int QS = 136;
DEV void gdn_prep_chunk(const Params& p, int item, unsigned char* lds) {
    int tid = threadIdx.x & 255; asm volatile("" : "+v"(tid)); const int lane = tid & 63, wid = tid >> 6;
    const int c = item & 31, h = (item >> 5) & 7, b = item >> 8;
    const int row0 = b * SEQ + c * 64;
    const bf16_t* proj = (const bf16_t*)(p.ws + WS_PROJ);
    const float* ab = (const float*)(p.ws + WS_AB);
    bf16_t* qs = (bf16_t*)lds; bf16_t* ks = qs + 64 * QS; bf16_t* vs = ks + 64 * QS;
    float* lowT = (float*)lds;
    float* gcs = (float*)(lds + 3 * 64 * QS * 2);
    float* bts = gcs + 64;
    bf16_t* gW = (bf16_t*)(p.ws + WS_GW) + (size_t)item * 8192;
    bf16_t* gQ = (bf16_t*)(p.ws + WS_GQ) + (size_t)item * 8192;
    bf16_t* gKT = (bf16_t*)(p.ws + WS_GKT) + (size_t)item * 8192;
    bf16_t* gA = (bf16_t*)(p.ws + WS_GA) + (size_t)item * 4096;
    float* gU = (float*)(p.ws + WS_GU) + (size_t)item * 8192;
    float* gE = (float*)(p.ws + WS_GE) + item;

    if (wid == 3) {
        float a = 0.f, bb = 0.f;
#pragma unroll
        for (int kq = 0; kq < 4; ++kq) { a += ab[(size_t)kq * TT * 16 + (size_t)(row0 + lane) * 16 + h]; bb += ab[(size_t)kq * TT * 16 + (size_t)(row0 + lane) * 16 + 8 + h]; }
        const float xx = a + p.in[12][h];
        const float sp = xx > 20.f ? xx : log1pf(__expf(xx));
        float s = -__expf(p.in[11][h]) * sp;
#pragma unroll
        for (int d = 1; d < 64; d <<= 1) { const float t = __shfl_up(s, d); if (lane >= d) s += t; }
        gcs[lane] = s; bts[lane] = 1.f / (1.f + __expf(-bb));
    } else {
        const int mat = wid, rg = lane >> 4, cv = lane & 15;
        const int colg = mat * 1024 + h * 128 + cv * 8;
        const float* cw = p.in[10];
        float w[4][8];
#pragma unroll
        for (int j = 0; j < 4; ++j) { const f32x4 w0 = *(const f32x4*)(cw + j * 3072 + colg), w1 = *(const f32x4*)(cw + j * 3072 + colg + 4);
            w[j][0] = w0[0]; w[j][1] = w0[1]; w[j][2] = w0[2]; w[j][3] = w0[3]; w[j][4] = w1[0]; w[j][5] = w1[1]; w[j][6] = w1[2]; w[j][7] = w1[3]; }
        const int tl0 = rg * 16;
        uint4 raw[19];
#pragma unroll
        for (int i = 0; i < 19; ++i) {
            const int tl = tl0 - 3 + i;
            if (c * 64 + tl >= 0) raw[i] = *(const uint4*)(proj + (size_t)(row0 + tl) * NPJ + colg);
            else raw[i] = make_uint4(0u, 0u, 0u, 0u);
        }
        bf16_t* dst = (mat == 0 ? qs : (mat == 1 ? ks : vs));
#pragma unroll
        for (int r = 0; r < 16; ++r) {
            float y[8]; float ss = 0.f;
#pragma unroll
            for (int e = 0; e < 8; ++e) {
                float a = 0.f;
#pragma unroll
                for (int j = 0; j < 4; ++j) {
                    const uint4 u = raw[r + j];
                    const unsigned wd = (e < 2 ? u.x : (e < 4 ? u.y : (e < 6 ? u.z : u.w)));
                    const float xv = (e & 1) ? bfhi(wd) : bflo(wd);
                    a += w[j][e] * xv;
                }
                y[e] = silu_f(a); ss += y[e] * y[e];
            }
            if (mat < 2) {
                ss += __shfl_xor(ss, 1); ss += __shfl_xor(ss, 2); ss += __shfl_xor(ss, 4); ss += __shfl_xor(ss, 8);
                float inv = rsqrtf(ss + EPS); if (mat == 0) inv *= 0.08838834764831845f;
#pragma unroll
                for (int e = 0; e < 8; ++e) y[e] *= inv;
            }
            uint4 o; o.x = cvt_pk_bf16(y[0], y[1]); o.y = cvt_pk_bf16(y[2], y[3]); o.z = cvt_pk_bf16(y[4], y[5]); o.w = cvt_pk_bf16(y[6], y[7]);
            *(uint4*)(dst + (tl0 + r) * QS + cv * 8) = o;
        }
    }
    __syncthreads();
    {
        const float glast = gcs[63];
        if (tid == 0) *gE = __expf(glast);
#pragma unroll
        for (int i = 0; i < 4; ++i) {
            const int ci = tid + 256 * i, t = ci >> 4, cc = (ci & 15) * 8;
            const uint4 u = *(const uint4*)(qs + t * QS + cc);
            const float e = __expf(gcs[t]);
            uint4 o; o.x = cvt_pk_bf16(bflo(u.x) * e, bfhi(u.x) * e); o.y = cvt_pk_bf16(bflo(u.y) * e, bfhi(u.y) * e);
            o.z = cvt_pk_bf16(bflo(u.z) * e, bfhi(u.z) * e); o.w = cvt_pk_bf16(bflo(u.w) * e, bfhi(u.w) * e);
            *(uint4*)(gQ + (cc >> 5) * 2048 + t * 32 + (cc & 31)) = o;
        }
        const float dk = __expf(glast - gcs[lane]);
#pragma unroll 8
        for (int i = 0; i < 32; ++i) { const int d = wid * 32 + i; gKT[(lane >> 5) * 4096 + d * 32 + (lane & 31)] = f2bf(bf2f(ks[lane * QS + d]) * dk);     }
    }
    f32x4 kk[4], qk[4];
    {
        const int fr = lane & 15, fq = lane >> 4, it = wid;
        bf16x8 kfi[4], qfi[4];
#pragma unroll
        for (int s = 0; s < 4; ++s) { kfi[s] = *(const bf16x8*)(ks + (it * 16 + fr) * QS + s * 32 + fq * 8); qfi[s] = *(const bf16x8*)(qs + (it * 16 + fr) * QS + s * 32 + fq * 8); }
#pragma unroll
        for (int jt = 0; jt < 4; ++jt) {
            kk[jt] = (f32x4){0.f, 0.f, 0.f, 0.f}; qk[jt] = (f32x4){0.f, 0.f, 0.f, 0.f};
#pragma unroll
            for (int s = 0; s < 4; ++s) {
                const bf16x8 kfj = *(const bf16x8*)(ks + (jt * 16 + fr) * QS + s * 32 + fq * 8);
                kk[jt] = __builtin_amdgcn_mfma_f32_16x16x32_bf16(kfi[s], kfj, kk[jt], 0, 0, 0);
                qk[jt] = __builtin_amdgcn_mfma_f32_16x16x32_bf16(kfj, qfi[s], qk[jt], 0, 0, 0);
            }
        }
    }
    __syncthreads();
    {
        const int fr = lane & 15, fq = lane >> 4, it = wid;
#pragma unroll
        for (int jt = 0; jt < 4; ++jt) {
            const int j = jt * 16 + fr; const float gj = gcs[j];
            f32x4 lv;
#pragma unroll
            for (int e = 0; e < 4; ++e) { const int i = it * 16 + fq * 4 + e; lv[e] = (i > j) ? bts[i] * kk[jt][e] * __expf(gcs[i] - gj) : 0.f; }
            *(f32x4*)(lowT + j * 68 + it * 16 + fq * 4) = lv;
            const int i2 = it * 16 + fr; const float gi = gcs[i2];
            f32x4 av;
#pragma unroll
            for (int e = 0; e < 4; ++e) { const int j2 = jt * 16 + fq * 4 + e; av[e] = (i2 >= j2) ? qk[jt][e] * __expf(gi - gcs[j2]) : 0.f; }
            store_bf4(gA + (jt >> 1) * 2048 + i2 * 32 + (jt & 1) * 16 + fq * 4, av);
        }
    }
    __syncthreads();
    {
        const int cc = tid & 127; const bool isw = tid >= 128;
        bf16_t* src = isw ? ks : vs;
#pragma unroll 1
        for (int ib = 0; ib < 4; ++ib) {
            f32x2_t acc[8];
#pragma unroll
            for (int r = 0; r < 16; ++r) { const int j = ib * 16 + r; float f = bts[j]; if (isw) f *= __expf(gcs[j]); acc[r >> 1][r & 1] = f * bf2f(src[j * QS + cc]); }
            const float* lrow = lowT + ib * 16;
#pragma unroll 4
            for (int j = 0; j < ib * 16; ++j) {
                const float xj = -bf2f(src[j * QS + cc]); const f32x2_t nx = {xj, xj};
                const f32x4 l0 = *(const f32x4*)(lrow + j * 68), l1 = *(const f32x4*)(lrow + j * 68 + 4), l2 = *(const f32x4*)(lrow + j * 68 + 8), l3 = *(const f32x4*)(lrow + j * 68 + 12);
                acc[0] += (f32x2_t){l0[0], l0[1]} * nx; acc[1] += (f32x2_t){l0[2], l0[3]} * nx; acc[2] += (f32x2_t){l1[0], l1[1]} * nx; acc[3] += (f32x2_t){l1[2], l1[3]} * nx;
                acc[4] += (f32x2_t){l2[0], l2[1]} * nx; acc[5] += (f32x2_t){l2[2], l2[3]} * nx; acc[6] += (f32x2_t){l3[0], l3[1]} * nx; acc[7] += (f32x2_t){l3[2], l3[3]} * nx;
            }
#pragma unroll
            for (int r2 = 0; r2 < 15; ++r2) {
                asm volatile("" ::: "memory");
                const float xj = -acc[r2 >> 1][r2 & 1]; const f32x2_t nx = {xj, xj};
                const float* lp = lrow + (ib * 16 + r2) * 68;
#pragma unroll
                for (int q = (r2 + 1) >> 2; q < 4; ++q) {
                    const f32x4 l = *(const f32x4*)(lp + q * 4);
                    acc[2 * q] += (f32x2_t){l[0], l[1]} * nx; acc[2 * q + 1] += (f32x2_t){l[2], l[3]} * nx;
                }
            }
#pragma unroll
            for (int r = 0; r < 16; ++r) {
                const int j = ib * 16 + r; const float xv = acc[r >> 1][r & 1]; const bf16_t xb = f2bf(xv);
                src[j * QS + cc] = xb;
                if (isw) gW[(cc >> 5) * 2048 + j * 32 + (cc & 31)] = xb;
                else gU[(((((cc >> 4) * 4 + (j >> 4)) * 4 + (j & 3)) * 4 + ((j >> 2) & 3)) << 4) + (cc & 15)] = xv;
            }
        }
    }
    __syncthreads();
}

#define LDS_BARRIER() do { asm volatile("s_waitcnt lgkmcnt(0)" ::: "memory"); __builtin_amdgcn_s_barrier(); asm volatile("" ::: "memory"); } while (0)
struct ScanEarly { bf16x8 w[4], q[4]; f32x4 u; };
struct ScanLate { bf16x8 a[2], k0[2], k1[2]; };
DEV void gdn_scan_item(const Params& p, int item, unsigned char* lds) {
    int tid = threadIdx.x & 255; asm volatile("" : "+v"(tid)); const int lane = tid & 63, w = tid >> 6, fr = lane & 15, fq = lane >> 4;
    const int s = item & 7, bh = item >> 3;
    const int b = bh >> 3, h = bh & 7;
    bf16_t* ST = (bf16_t*)lds;
    bf16_t* VT = ST + 16 * QS;
    const char* bW = (const char*)((const bf16_t*)(p.ws + WS_GW) + (size_t)bh * 32 * 8192);
    const char* bQ = (const char*)((const bf16_t*)(p.ws + WS_GQ) + (size_t)bh * 32 * 8192);
    const char* bK = (const char*)((const bf16_t*)(p.ws + WS_GKT) + (size_t)bh * 32 * 8192);
    const char* bA = (const char*)((const bf16_t*)(p.ws + WS_GA) + (size_t)bh * 32 * 4096);
    const char* bU = (const char*)((const float*)(p.ws + WS_GU) + (size_t)bh * 32 * 8192);
    const float* gE = (const float*)(p.ws + WS_GE) + bh * 32;
    float* obuf = (float*)(p.ws + WS_O);
    f32x4 S0 = {0.f, 0.f, 0.f, 0.f}, S1 = {0.f, 0.f, 0.f, 0.f};
    for (int i = tid; i < 16 * QS / 2; i += 256) ((unsigned*)ST)[i] = 0u;
    const float egv = gE[lane & 31];
    const unsigned offWQ = (unsigned)(((w * 16 + fr) * 32 + fq * 8) * 2), offA = offWQ;
    const unsigned offK = (unsigned)(((w * 32 + fr) * 32 + fq * 8) * 2), offU = (unsigned)((((s * 4 + w) * 16 + fq) * 16 + fr) * 4);
    ScanEarly E0, E1, E2; ScanLate L0, L1;
#define LOAD_E(F, ch) do { \
        const char* W_ = bW + (size_t)(ch) * 16384; const char* Q_ = bQ + (size_t)(ch) * 16384; \
        _Pragma("unroll") for (int k_ = 0; k_ < 4; ++k_) { F.w[k_] = *(const bf16x8*)(W_ + (offWQ + k_ * 4096)); F.q[k_] = *(const bf16x8*)(Q_ + (offWQ + k_ * 4096)); } \
        const char* U_ = bU + (size_t)(ch) * 32768; F.u[0] = *(const float*)(U_ + offU); F.u[1] = *(const float*)(U_ + (offU + 256)); F.u[2] = *(const float*)(U_ + (offU + 512)); F.u[3] = *(const float*)(U_ + (offU + 768)); \
        } while (0)
#define LOAD_L(F, ch) do { \
        const char* A_ = bA + (size_t)(ch) * 8192; F.a[0] = *(const bf16x8*)(A_ + offA); F.a[1] = *(const bf16x8*)(A_ + (offA + 4096)); \
        const char* K_ = bK + (size_t)(ch) * 16384; F.k0[0] = *(const bf16x8*)(K_ + offK); F.k0[1] = *(const bf16x8*)(K_ + (offK + 8192)); \
        F.k1[0] = *(const bf16x8*)(K_ + (offK + 1024)); F.k1[1] = *(const bf16x8*)(K_ + (offK + 1024 + 8192)); \
        } while (0)
#define SCAN_STEP(X, XL, Y, YL, ch) do { \
        if ((ch) + 2 < 32) LOAD_E(XL, (ch) + 2); \
        if ((ch) + 1 < 32) LOAD_L(YL, (ch) + 1); \
        const float ceg = __builtin_bit_cast(float, __builtin_amdgcn_readlane(__builtin_bit_cast(int, egv), (ch))); \
        f32x4 ws_ = {0.f, 0.f, 0.f, 0.f}, oo = {0.f, 0.f, 0.f, 0.f}; \
        _Pragma("unroll") for (int k = 0; k < 4; ++k) { \
            const bf16x8 sf = *(const bf16x8*)(ST + fr * QS + k * 32 + fq * 8); \
            ws_ = __builtin_amdgcn_mfma_f32_16x16x32_bf16(X.w[k], sf, ws_, 0, 0, 0); \
            oo = __builtin_amdgcn_mfma_f32_16x16x32_bf16(X.q[k], sf, oo, 0, 0, 0); } \
        store_bf4(VT + fr * 72 + w * 16 + fq * 4, X.u - ws_); \
        LDS_BARRIER(); \
        const bf16x8 v0 = *(const bf16x8*)(VT + fr * 72 + fq * 8), v1 = *(const bf16x8*)(VT + fr * 72 + 32 + fq * 8); \
        oo = __builtin_amdgcn_mfma_f32_16x16x32_bf16(Y.a[0], v0, oo, 0, 0, 0); \
        oo = __builtin_amdgcn_mfma_f32_16x16x32_bf16(Y.a[1], v1, oo, 0, 0, 0); \
        S0 = S0 * ceg; S1 = S1 * ceg; \
        S0 = __builtin_amdgcn_mfma_f32_16x16x32_bf16(Y.k0[0], v0, S0, 0, 0, 0); \
        S0 = __builtin_amdgcn_mfma_f32_16x16x32_bf16(Y.k0[1], v1, S0, 0, 0, 0); \
        S1 = __builtin_amdgcn_mfma_f32_16x16x32_bf16(Y.k1[0], v0, S1, 0, 0, 0); \
        S1 = __builtin_amdgcn_mfma_f32_16x16x32_bf16(Y.k1[1], v1, S1, 0, 0, 0); \
        store_bf4(ST + fr * QS + w * 32 + fq * 4, S0); \
        store_bf4(ST + fr * QS + w * 32 + 16 + fq * 4, S1); \
        { float* op = obuf + (size_t)(b * SEQ + (ch) * 64 + w * 16 + fq * 4) * 1024 + h * 128 + s * 16 + fr; \
          op[0] = oo[0]; op[1024] = oo[1]; op[2048] = oo[2]; op[3072] = oo[3]; } \
        LDS_BARRIER(); } while (0)
    LOAD_E(E0, 0); LOAD_L(L0, 0); LOAD_E(E1, 1);
    __syncthreads();
    for (int ch = 0; ch < 30; ch += 6) {
        SCAN_STEP(E0, E2, L0, L1, ch);     SCAN_STEP(E1, E0, L1, L0, ch + 1); SCAN_STEP(E2, E1, L0, L1, ch + 2);
        SCAN_STEP(E0, E2, L1, L0, ch + 3); SCAN_STEP(E1, E0, L0, L1, ch + 4); SCAN_STEP(E2, E1, L1, L0, ch + 5);
    }
    SCAN_STEP(E0, E2, L0, L1, 30); SCAN_STEP(E1, E0, L1, L0, 31);
#undef SCAN_STEP
#undef LOAD_E
#undef LOAD_L
    {
        float* dp = p.out + O_DP + ((size_t)bh * 128 + w * 32 + fq * 4) * 128 + s * 16 + fr;
#pragma unroll
        for (int e = 0; e < 4; ++e) { dp[e * 128] = S0[e]; dp[(16 + e) * 128] = S1[e]; }
    }
    __syncthreads();
}

DEV void gdn_sample_item(const Params& p, int item, unsigned char* lds) {
    int tid = threadIdx.x & 255; asm volatile("" : "+v"(tid)); const int lane = tid & 63, wid = tid >> 6;
    const int sb = item >> 3, h = item & 7, half = tid >> 7, c = tid & 127;
    const int r0 = TP + sb * 4;
    const bf16_t* proj = (const bf16_t*)(p.ws + WS_PROJ);
    const float* ab = (const float*)(p.ws + WS_AB);
    float* ksh = (float*)lds;
    float* qsh = ksh + 512;
    float* red = qsh + 512;
    float* red2 = red + 32;
    float* part = red2 + 32;
    float* opart = part + 1024;
    float qv[4], kv[4], vv[4];
#pragma unroll
    for (int m = 0; m < 3; ++m) {
        const int col = m * 1024 + h * 128 + c;
        float x[7], wj[4];
#pragma unroll
        for (int j = 0; j < 3; ++j) x[j] = p.in[6][((size_t)sb * 3 + j) * 3072 + col];
#pragma unroll
        for (int t = 0; t < 4; ++t) x[3 + t] = bf2f(proj[(size_t)(r0 + t) * NPJ + col]);
#pragma unroll
        for (int j = 0; j < 4; ++j) wj[j] = p.in[10][j * 3072 + col];
#pragma unroll
        for (int t = 0; t < 4; ++t) {
            const float y = silu_f(wj[0] * x[t] + wj[1] * x[t + 1] + wj[2] * x[t + 2] + wj[3] * x[t + 3]);
            if (m == 0) qv[t] = y; else if (m == 1) kv[t] = y; else vv[t] = y;
        }
    }
#pragma unroll
    for (int t = 0; t < 4; ++t) {
        const float a = wave_sum(qv[t] * qv[t]), bq = wave_sum(kv[t] * kv[t]);
        if (lane == 0) { red[wid * 8 + t] = a; red[wid * 8 + 4 + t] = bq; }
    }
    __syncthreads();
    float gt[4], bt[4];
#pragma unroll
    for (int t = 0; t < 4; ++t) {
        const float sq = red[(2 * half) * 8 + t] + red[(2 * half + 1) * 8 + t], sk = red[(2 * half) * 8 + 4 + t] + red[(2 * half + 1) * 8 + 4 + t];
        if (half == 0) {
            qsh[t * 128 + c] = qv[t] * rsqrtf(sq + EPS) * 0.08838834764831845f;
            ksh[t * 128 + c] = kv[t] * rsqrtf(sk + EPS);
        }
        float a = 0.f, bb = 0.f;
#pragma unroll
        for (int kq = 0; kq < 4; ++kq) { a += ab[(size_t)kq * TT * 16 + (size_t)(r0 + t) * 16 + h]; bb += ab[(size_t)kq * TT * 16 + (size_t)(r0 + t) * 16 + 8 + h]; }
        const float xx = a + p.in[12][h];
        const float sp = xx > 20.f ? xx : log1pf(__expf(xx));
        gt[t] = __expf(-__expf(p.in[11][h]) * sp);
        bt[t] = 1.f / (1.f + __expf(-bb));
    }
    f32x2_t S[32];
    const float* sp0 = p.in[5] + ((size_t)(sb * 8 + h) * 128 + half * 64) * 128 + c;
#pragma unroll
    for (int d = 0; d < 64; ++d) S[d >> 1][d & 1] = __builtin_nontemporal_load(sp0 + (size_t)d * 128);
    __syncthreads();
    float ot[4];
#pragma unroll
    for (int t = 0; t < 4; ++t) {
        const float* kk = ksh + t * 128 + half * 64; const float* qq = qsh + t * 128 + half * 64;
        f32x2_t ks2 = {0.f, 0.f};
#pragma unroll
        for (int d4 = 0; d4 < 16; ++d4) { const f32x4 k4 = *(const f32x4*)(kk + d4 * 4); ks2 += (f32x2_t){k4[0], k4[1]} * S[d4 * 2]; ks2 += (f32x2_t){k4[2], k4[3]} * S[d4 * 2 + 1]; }
        part[(t * 2 + half) * 128 + c] = ks2[0] + ks2[1];
        __syncthreads();
        const float kS = part[(t * 2) * 128 + c] + part[(t * 2 + 1) * 128 + c];
        const float eg = gt[t], dl = bt[t] * (vv[t] - eg * kS);
        const f32x2_t eg2 = {eg, eg}, dl2 = {dl, dl};
        f32x2_t o2 = {0.f, 0.f};
#pragma unroll
        for (int d4 = 0; d4 < 16; ++d4) {
            const f32x4 k4 = *(const f32x4*)(kk + d4 * 4), q4 = *(const f32x4*)(qq + d4 * 4);
            const f32x2_t s0 = S[d4 * 2] * eg2 + (f32x2_t){k4[0], k4[1]} * dl2, s1 = S[d4 * 2 + 1] * eg2 + (f32x2_t){k4[2], k4[3]} * dl2;
            S[d4 * 2] = s0; S[d4 * 2 + 1] = s1;
            o2 += (f32x2_t){q4[0], q4[1]} * s0; o2 += (f32x2_t){q4[2], q4[3]} * s1;
        }
        const float o = o2[0] + o2[1];
        ot[t] = o;
        if (half == 1) opart[t * 128 + c] = o;
    }
    float* dso = p.out + O_DS + ((size_t)(sb * 8 + h) * 128 + half * 64) * 128 + c;
#pragma unroll
    for (int d = 0; d < 64; ++d) __builtin_nontemporal_store(S[d >> 1][d & 1], dso + (size_t)d * 128);
    __syncthreads();
    if (half == 0) {
#pragma unroll
        for (int t = 0; t < 4; ++t) { ot[t] += opart[t * 128 + c]; const float a = wave_sum(ot[t] * ot[t]); if (lane == 0) red2[wid * 4 + t] = a; }
    }
    __syncthreads();
    if (half == 0) {
        bf16_t* mix = (bf16_t*)(p.ws + WS_MIX);
        const float gn = p.in[13][c];
#pragma unroll
        for (int t = 0; t < 4; ++t) {
            const float ms = (red2[t] + red2[4 + t]) * (1.f / 128.f);
            const float z = bf2f(proj[(size_t)(r0 + t) * NPJ + C_ZA + h * 128 + c]);
            mix[(size_t)(r0 + t) * LDB + h * 128 + c] = f2bf(ot[t] * rsqrtf(ms + EPS) * gn * silu_f(z));
        }
    }
    __syncthreads();
}

DEV void attn_sample_item(const Params& p, int item, unsigned char* lds) {
    int tid = threadIdx.x & 255; asm volatile("" : "+v"(tid)); const int lane = tid & 63, wid = tid >> 6;
    const int sb = item >> 2, hd = item & 3;
    float* qs = (float*)lds;
    float* pm = qs + 2048;
    float* red = pm + 1024;
    const bf16_t* qx = (const bf16_t*)(p.ws + WS_QX);
    for (int i = tid; i < 2048; i += 256) { const int t = i >> 9, d = i & 511; qs[i] = bf2f(qx[(size_t)(TP + sb * 4 + t) * LDB + hd * 512 + d]) * 0.04419417382415922f; }
    __syncthreads();
    const float* Kc = p.in[3] + ((size_t)sb * 256) * D + hd * 512;
    const float* Vc = p.in[4] + ((size_t)sb * 256) * D + hd * 512;
    {
        const int sub = lane >> 4, l16 = lane & 15;
        f32x4 kv[8];
        {
            const float* kr = Kc + (size_t)(wid * 64 + sub) * D;
#pragma unroll
            for (int i = 0; i < 8; ++i) kv[i] = __builtin_nontemporal_load((const f32x4*)(kr + (i * 16 + l16) * 4));
        }
        for (int it = 0; it < 16; ++it) {
            const int m = wid * 64 + it * 4 + sub;
            f32x4 cv[8];
#pragma unroll
            for (int i = 0; i < 8; ++i) cv[i] = kv[i];
            if (it + 1 < 16) {
                const float* kr = Kc + (size_t)(m + 4) * D;
#pragma unroll
                for (int i = 0; i < 8; ++i) kv[i] = __builtin_nontemporal_load((const f32x4*)(kr + (i * 16 + l16) * 4));
            }
            float a0 = 0.f, a1 = 0.f, a2 = 0.f, a3 = 0.f;
#pragma unroll
            for (int i = 0; i < 8; ++i) {
                const int d = (i * 16 + l16) * 4;
                const f32x4 q0 = *(const f32x4*)(qs + d), q1 = *(const f32x4*)(qs + 512 + d), q2 = *(const f32x4*)(qs + 1024 + d), q3 = *(const f32x4*)(qs + 1536 + d);
                a0 += cv[i][0] * q0[0] + cv[i][1] * q0[1] + cv[i][2] * q0[2] + cv[i][3] * q0[3];
                a1 += cv[i][0] * q1[0] + cv[i][1] * q1[1] + cv[i][2] * q1[2] + cv[i][3] * q1[3];
                a2 += cv[i][0] * q2[0] + cv[i][1] * q2[1] + cv[i][2] * q2[2] + cv[i][3] * q2[3];
                a3 += cv[i][0] * q3[0] + cv[i][1] * q3[1] + cv[i][2] * q3[2] + cv[i][3] * q3[3];
            }
#pragma unroll
            for (int o = 1; o < 16; o <<= 1) { a0 += __shfl_xor(a0, o); a1 += __shfl_xor(a1, o); a2 += __shfl_xor(a2, o); a3 += __shfl_xor(a3, o); }
            if (l16 == 0) *(f32x4*)(pm + m * 4) = (f32x4){a0, a1, a2, a3};
        }
    }
    __syncthreads();
    {
        const int t = wid;
        float v[4]; float mx = -3.0e38f;
#pragma unroll
        for (int i = 0; i < 4; ++i) { v[i] = pm[(i * 64 + lane) * 4 + t]; mx = fmaxf(mx, v[i]); }
        mx = wave_max(mx);
        float sm = 0.f;
#pragma unroll
        for (int i = 0; i < 4; ++i) { v[i] = __expf(v[i] - mx); sm += v[i]; }
        sm = wave_sum(sm);
        const float inv = 1.f / sm;
#pragma unroll
        for (int i = 0; i < 4; ++i) pm[(i * 64 + lane) * 4 + t] = v[i] * inv;
    }
    __syncthreads();
    {
        f32x4 acc[4][2];
#pragma unroll
        for (int t = 0; t < 4; ++t) { acc[t][0] = (f32x4){0.f, 0.f, 0.f, 0.f}; acc[t][1] = (f32x4){0.f, 0.f, 0.f, 0.f}; }
        f32x4 va[4], vb[4];
#pragma unroll
        for (int i = 0; i < 4; ++i) { const float* vr = Vc + (size_t)(wid * 64 + i) * D; va[i] = __builtin_nontemporal_load((const f32x4*)(vr + lane * 4)); vb[i] = __builtin_nontemporal_load((const f32x4*)(vr + 256 + lane * 4)); }
        for (int m4 = 0; m4 < 16; ++m4) {
            f32x4 ca[4], cb[4];
#pragma unroll
            for (int i = 0; i < 4; ++i) { ca[i] = va[i]; cb[i] = vb[i]; }
            if (m4 + 1 < 16) {
#pragma unroll
                for (int i = 0; i < 4; ++i) { const float* vr = Vc + (size_t)(wid * 64 + (m4 + 1) * 4 + i) * D; va[i] = __builtin_nontemporal_load((const f32x4*)(vr + lane * 4)); vb[i] = __builtin_nontemporal_load((const f32x4*)(vr + 256 + lane * 4)); }
            }
#pragma unroll
            for (int i = 0; i < 4; ++i) {
                const f32x4 pr = *(const f32x4*)(pm + (wid * 64 + m4 * 4 + i) * 4);
#pragma unroll
                for (int t = 0; t < 4; ++t) { acc[t][0] += ca[i] * pr[t]; acc[t][1] += cb[i] * pr[t]; }
            }
        }
#pragma unroll
        for (int t = 0; t < 4; ++t) { *(f32x4*)(red + (wid * 4 + t) * 512 + lane * 4) = acc[t][0]; *(f32x4*)(red + (wid * 4 + t) * 512 + 256 + lane * 4) = acc[t][1]; }
    }
    __syncthreads();
    {
        bf16_t* ctx = (bf16_t*)(p.ws + WS_CTX);
#pragma unroll
        for (int i = 0; i < 2; ++i) {
            const int e = (tid + 256 * i) * 4, t = e >> 9, d = e & 511;
            const f32x4 s = *(const f32x4*)(red + (0 * 4 + t) * 512 + d) + *(const f32x4*)(red + (1 * 4 + t) * 512 + d) + *(const f32x4*)(red + (2 * 4 + t) * 512 + d) + *(const f32x4*)(red + (3 * 4 + t) * 512 + d);
            store_bf4(ctx + (size_t)(TP + sb * 4 + t) * LDB + hd * 512 + d, s);
        }
    }
    __syncthreads();
}

template <int WIN>
DEV void pool_d_prompt8(const bf16_t* __restrict__ proj, bf16_t* __restrict__ dpl, int row0, int c8) {
    const int t0 = row0 & 2047;
    uint4 u[WIN + 7];
#pragma unroll
    for (int i = 0; i < WIN + 7; ++i) { const int tt = t0 - (WIN - 1) + i; u[i] = (tt >= 0) ? *(const uint4*)(proj + (size_t)(row0 - (WIN - 1) + i) * NPJ + C_U + c8) : make_uint4(0u, 0u, 0u, 0u); }
    float acc[8] = {0.f, 0.f, 0.f, 0.f, 0.f, 0.f, 0.f, 0.f};
#pragma unroll
    for (int i = 0; i < WIN - 1; ++i) { acc[0] += bflo(u[i].x); acc[1] += bfhi(u[i].x); acc[2] += bflo(u[i].y); acc[3] += bfhi(u[i].y); acc[4] += bflo(u[i].z); acc[5] += bfhi(u[i].z); acc[6] += bflo(u[i].w); acc[7] += bfhi(u[i].w); }
#pragma unroll
    for (int j = 0; j < 8; ++j) {
        const uint4 x = u[j + WIN - 1];
        const float xs[8] = {bflo(x.x), bfhi(x.x), bflo(x.y), bfhi(x.y), bflo(x.z), bfhi(x.z), bflo(x.w), bfhi(x.w)};
#pragma unroll
        for (int e_ = 0; e_ < 8; ++e_) acc[e_] += xs[e_];
        const float ic = 1.f / (float)min(WIN, t0 + j + 1);
        uint4 o;
        o.x = cvt_pk_bf16(acc[0] * ic - xs[0], acc[1] * ic - xs[1]); o.y = cvt_pk_bf16(acc[2] * ic - xs[2], acc[3] * ic - xs[3]);
        o.z = cvt_pk_bf16(acc[4] * ic - xs[4], acc[5] * ic - xs[5]); o.w = cvt_pk_bf16(acc[6] * ic - xs[6], acc[7] * ic - xs[7]);
        *(uint4*)(dpl + (size_t)(row0 + j) * LDP + c8) = o;
        const uint4 y = u[j];
        acc[0] -= bflo(y.x); acc[1] -= bfhi(y.x); acc[2] -= bflo(y.y); acc[3] -= bfhi(y.y); acc[4] -= bflo(y.z); acc[5] -= bfhi(y.z); acc[6] -= bflo(y.w); acc[7] -= bfhi(y.w);
    }
}

#ifndef REP0
#define REP0 1
#endif
#ifndef REP1
#define REP1 1
#endif
#ifndef REP2
#define REP2 1
#endif
#ifndef REP3
#define REP3 1
#endif
#ifndef REP4
#define REP4 1
#endif
#ifndef REP5
#define REP5 1
#endif
#ifndef REP6
#define REP6 1
#endif
#ifndef REP7
#define REP7 1
#endif
#ifndef REP8
#define REP8 1
#endif
#ifndef REP9
#define REP9 1
#endif
#ifndef REP10
#define REP10 1
#endif
#ifndef REP11
#define REP11 1
#endif
#ifndef REP12
#define REP12 1
#endif
#ifndef NLAUNCH
#define NLAUNCH 1
#endif
#define GRID_BAR() do { if (NLAUNCH == 1) xcd_barrier(bar); } while (0)
#define IN_PH(k) (p.ph_lo <= (k) && (k) < p.ph_hi)
__global__ void __launch_bounds__(512) hymba_fwd(Params p) {
    __shared__ __attribute__((aligned(16))) unsigned char lds[131072];
    __shared__ uint4 xb_words;
    const int G = gridDim.x, bid = blockIdx.x, VG = 2 * G;
    if (threadIdx.x == 0) xb_words = make_uint4(0u, 0u, 0u, 0u);
#define PH_LOCALS int tid = threadIdx.x; asm volatile("" : "+v"(tid)); const int lane = tid & 63, wid = tid >> 6; const int vb = __builtin_amdgcn_readfirstlane(tid >> 8); \
    unsigned char* vlds = lds + vb * 65536; (void)lane; (void)wid; (void)vlds;
    __syncthreads();
    XcdBarrier bar; bar.bar = (unsigned*)(p.ws + WS_BAR); bar.x = 0; bar.st = (volatile LAS unsigned*)&xb_words;
    if (NLAUNCH == 1) bar = xcd_barrier_post((unsigned*)(p.ws + WS_BAR), (volatile LAS unsigned*)&xb_words);
    unsigned char* ws = p.ws;
    bf16_t* Wt_in = (bf16_t*)(ws + WS_WIN); bf16_t* Wt_out = (bf16_t*)(ws + WS_WOUT); bf16_t* Wt_cq = (bf16_t*)(ws + WS_WCQ); bf16_t* Wt_co = (bf16_t*)(ws + WS_WCO);
    bf16_t* Wt_ckv = (bf16_t*)(ws + WS_WCKV); bf16_t* Wt_pool = (bf16_t*)(ws + WS_WPOOL);
    bf16_t* hbuf = (bf16_t*)(ws + WS_H); bf16_t* hm = (bf16_t*)(ws + WS_HM); bf16_t* proj = (bf16_t*)(ws + WS_PROJ); float* ab = (float*)(ws + WS_AB);
    bf16_t* mkb = (bf16_t*)(ws + WS_MKB); bf16_t* mvt = (bf16_t*)(ws + WS_MVT); bf16_t* dpl = (bf16_t*)(ws + WS_DPL); bf16_t* mix = (bf16_t*)(ws + WS_MIX);
    bf16_t* x1 = (bf16_t*)(ws + WS_X1); bf16_t* qx = (bf16_t*)(ws + WS_QX); float* sc = (float*)(ws + WS_SC); bf16_t* pb = (bf16_t*)(ws + WS_PB);
    bf16_t* ctx = (bf16_t*)(ws + WS_CTX); bf16_t* x2 = (bf16_t*)(ws + WS_X2); float* obuf = (float*)(ws + WS_O);
#define VLOOP(t, N) for (int t##0_ = 2 * bid, t = min(t##0_ + vb, (N) - 1); t##0_ < (N); t##0_ += VG, t = min(t##0_ + vb, (N) - 1))

    if (IN_PH(0)) { PH_LOCALS
        const int NT_IN = 98 * 16, NT_SQ = 32 * 16;
        const int total = NT_IN + 5 * NT_SQ + 32;
        VLOOP(t, total) {
            if (t < NT_IN) { const int nt = t >> 4, kt = t & 15; transpose_tile(p.in[9], 6160, nt * 64, true, kt * 128, Wt_in + (size_t)nt * 64 * LDB, LDB, (float*)vlds); }
            else if (t < NT_IN + 5 * NT_SQ) {
                const int u = t - NT_IN, j = u >> 9, v = u & 511, nt = v >> 4, kt = v & 15;
                const float* src = p.in[j == 0 ? 16 : (j == 1 ? 19 : (j == 2 ? 22 : (j == 3 ? 20 : 21)))];
                bf16_t* dst = j == 0 ? Wt_out : (j == 1 ? Wt_cq : (j == 2 ? Wt_co : (j == 3 ? Wt_ckv : Wt_ckv + (size_t)D * LDB)));
                transpose_tile(src, D, nt * 64, false, kt * 128, dst + (size_t)nt * 64 * LDB, LDB, (float*)vlds);
            } else {
                const int u = t - NT_IN - 5 * NT_SQ, g = u >> 3, v = u & 7, nt = v >> 1, kt = v & 1;
                transpose_tile(p.in[14] + (size_t)g * 65536, 256, nt * 64, false, kt * 128, Wt_pool + ((size_t)g * 256 + nt * 64) * LDM, LDM, (float*)vlds);
            }
        }
        for (int r = bid * 8 + wid; r < TT + 1024; r += G * 8) {
            if (r < TP) rmsnorm_row_bf16(p.in[0] + (size_t)r * D, p.in[8], hbuf + (size_t)r * LDB, lane);
            else if (r < TT) rmsnorm_row_bf16(p.in[1] + (size_t)(r - TP) * D, p.in[8], hbuf + (size_t)r * LDB, lane);
            else rmsnorm_row_bf16(p.in[2] + (size_t)(r - TT) * D, p.in[17], hm + (size_t)(r - TT) * LDB, lane);
        }
    }
    GRID_BAR();
    if (IN_PH(1)) { PH_LOCALS
        for (int t = bid; t < 32 * 24; t += G) { int nt, mt; tile_map(t, 32, 24, mt, nt);
            EpiBfS e{proj + (size_t)mt * 256 * NPJ + nt * 256, NPJ};
            gemm256_tile(hbuf + (size_t)mt * 256 * LDB, LDB, Wt_in + (size_t)nt * 256 * LDB, LDB, D, lds, e);
        }
        VLOOP(t, 4 * 48 + 256) {
            if (t < 192) { const int mt = t & 3, nt = t >> 2;
                EpiProj e{TP + mt * 128, nt * 128, proj, ab, p.out};
                gemm_tile<64>(hbuf + (size_t)(TP + mt * 128) * LDB, LDB, Wt_in + (size_t)nt * 128 * LDB, LDB, D, vlds, e);
            } else { const int u = t - 192, mt = u & 7, nt = u >> 3;
                EpiMKV e{mt * 128, nt * 128, mkb, mvt, p.out};
                gemm_tile<64>(hm + (size_t)mt * 128 * LDB, LDB, Wt_ckv + (size_t)nt * 128 * LDB, LDB, D, vlds, e);
            }
        }
        for (int tk = bid * 8 + wid; tk < (TT / 16) * 4; tk += G * 8) ab_rows16(hbuf, Wt_in + (size_t)NPJ * LDB, ab, tk >> 2, tk & 3, lane);
    }
    GRID_BAR();
    if (IN_PH(2)) { PH_LOCALS
        VLOOP(t, 1024) gdn_prep_chunk(p, t, vlds);
        for (int i = bid * 512 + tid; i < (TP / 8) * 128; i += G * 512) {
            const int row0 = (i >> 7) * 8, c8 = (i & 127) * 8, g = c8 >> 8;
            if (g == 0) pool_d_prompt8<2>(proj, dpl, row0, c8); else if (g == 1) pool_d_prompt8<4>(proj, dpl, row0, c8);
            else if (g == 2) pool_d_prompt8<8>(proj, dpl, row0, c8); else pool_d_prompt8<16>(proj, dpl, row0, c8);
        }
        for (int i = TP * 128 + bid * 512 + tid; i < TT * 128; i += G * 512) {
            const int row = i >> 7, c8 = (i & 127) * 8, g = c8 >> 8, win = 2 << g;
            float acc[8] = {0.f, 0.f, 0.f, 0.f, 0.f, 0.f, 0.f, 0.f}, self[8];
            const int tloc = (row - TP) & 3;
            for (int k = 0; k < win; ++k) {
                const int tt = tloc - k;
                if (tt >= 0) {
                    const uint4 u = *(const uint4*)(proj + (size_t)(row - k) * NPJ + C_U + c8);
                    const float f[8] = {bflo(u.x), bfhi(u.x), bflo(u.y), bfhi(u.y), bflo(u.z), bfhi(u.z), bflo(u.w), bfhi(u.w)};
#pragma unroll
                    for (int e = 0; e < 8; ++e) { acc[e] += f[e]; if (k == 0) self[e] = f[e]; }
                } else {
                    const float* sp = p.in[7] + ((size_t)((row - TP) >> 2) * 15 + (15 + tt)) * 1024 + c8;
                    const f32x4 s0 = *(const f32x4*)sp, s1 = *(const f32x4*)(sp + 4);
                    acc[0] += s0[0]; acc[1] += s0[1]; acc[2] += s0[2]; acc[3] += s0[3]; acc[4] += s1[0]; acc[5] += s1[1]; acc[6] += s1[2]; acc[7] += s1[3];
                }
            }
            const float ic = 1.f / (float)win;
            uint4 o; o.x = cvt_pk_bf16(acc[0] * ic - self[0], acc[1] * ic - self[1]); o.y = cvt_pk_bf16(acc[2] * ic - self[2], acc[3] * ic - self[3]);
            o.z = cvt_pk_bf16(acc[4] * ic - self[4], acc[5] * ic - self[5]); o.w = cvt_pk_bf16(acc[6] * ic - self[6], acc[7] * ic - self[7]);
            *(uint4*)(dpl + (size_t)row * LDP + c8) = o;
        }
        for (int i = bid * 512 + tid; i < NB * (3 * 3072 + 15 * 1024); i += G * 512) {
            const int b = i / (3 * 3072 + 15 * 1024), u = i - b * (3 * 3072 + 15 * 1024);
            if (u < 3 * 3072) { const int rr = u / 3072, col = u - rr * 3072; p.out[O_CP + ((size_t)(b * 3 + rr)) * 3072 + col] = bf2f(proj[(size_t)(b * SEQ + 2045 + rr) * NPJ + col]); }
            else { const int v = u - 3 * 3072, rr = v >> 10, col = v & 1023; p.out[O_PP + ((size_t)(b * 15 + rr)) * 1024 + col] = bf2f(proj[(size_t)(b * SEQ + 2033 + rr) * NPJ + C_U + col]); }
        }
        for (int i = bid * 512 + tid; i < SB * 11 * 256; i += G * 512) {
            const int c4 = (i & 255) * 4, rr = (i >> 8) % 11, sb = (i >> 8) / 11;
            *(f32x4*)(p.out + O_PS + ((size_t)sb * 15 + rr) * 1024 + c4) = *(const f32x4*)(p.in[7] + ((size_t)sb * 15 + rr + 4) * 1024 + c4);
        }
    }
    GRID_BAR();
    if (IN_PH(3)) { PH_LOCALS
        const int NSC = 256, NSM = 1024, NPL = 68 * 8;
        const int nsb = G >> 1;
        if (bid < nsb) {
            if (G == 256) {
                const int x = bid & 7, j = bid >> 3;
                gdn_scan_item(p, ((x * 4 + (j >> 2)) << 3) | ((j & 3) << 1) | vb, vlds);
            } else
            for (int t0 = 2 * bid; t0 < NSC; t0 += 2 * nsb) gdn_scan_item(p, min(t0 + vb, NSC - 1), vlds);
        } else {
            const int ob = bid - nsb, no = G - nsb;
            for (int t0 = 2 * ob; t0 < NSM; t0 += 2 * no) gdn_sample_item(p, min(t0 + vb, NSM - 1), vlds);
            for (int t0 = 2 * ob; t0 < NPL; t0 += 2 * no) { const int t = min(t0 + vb, NPL - 1); int nt, mt; tile_map(t, 68, 8, mt, nt); const int g = nt >> 1;
                EpiPool e{mt * 128, nt * 128, proj, p.in[15], mix};
                gemm_tile<64>(dpl + (size_t)mt * 128 * LDP + g * 256, LDP, Wt_pool + (size_t)nt * 128 * LDM, LDM, 256, vlds, e);
            }
        }
    }
    GRID_BAR();
    if (IN_PH(4)) { PH_LOCALS
        for (int i = bid * 512 + tid; i < TP * 8 * 16; i += G * 512) {
            const int l16 = i & 15, rh = i >> 4, h = rh & 7, row = rh >> 3;
            const float* op = obuf + (size_t)row * 1024 + h * 128 + l16 * 8;
            const f32x4 a = __builtin_nontemporal_load((const f32x4*)op), b4 = __builtin_nontemporal_load((const f32x4*)(op + 4));
            float ss = a[0] * a[0] + a[1] * a[1] + a[2] * a[2] + a[3] * a[3] + b4[0] * b4[0] + b4[1] * b4[1] + b4[2] * b4[2] + b4[3] * b4[3];
            ss += __shfl_xor(ss, 1); ss += __shfl_xor(ss, 2); ss += __shfl_xor(ss, 4); ss += __shfl_xor(ss, 8);
            const float rs = rsqrtf(ss * (1.f / 128.f) + EPS);
            const f32x4 g0 = *(const f32x4*)(p.in[13] + l16 * 8), g1 = *(const f32x4*)(p.in[13] + l16 * 8 + 4);
            const uint4 z = *(const uint4*)(proj + (size_t)row * NPJ + C_ZA + h * 128 + l16 * 8);
            uint4 o;
            o.x = cvt_pk_bf16(a[0] * rs * g0[0] * silu_f(bflo(z.x)), a[1] * rs * g0[1] * silu_f(bfhi(z.x)));
            o.y = cvt_pk_bf16(a[2] * rs * g0[2] * silu_f(bflo(z.y)), a[3] * rs * g0[3] * silu_f(bfhi(z.y)));
            o.z = cvt_pk_bf16(b4[0] * rs * g1[0] * silu_f(bflo(z.z)), b4[1] * rs * g1[1] * silu_f(bfhi(z.z)));
            o.w = cvt_pk_bf16(b4[2] * rs * g1[2] * silu_f(bflo(z.w)), b4[3] * rs * g1[3] * silu_f(bfhi(z.w)));
            *(uint4*)(mix + (size_t)row * LDB + h * 128 + l16 * 8) = o;
        }
    }
    GRID_BAR();
    if (IN_PH(5)) { PH_LOCALS
        for (int t = bid; t < 32 * 8; t += G) { int nt, mt; tile_map(t, 32, 8, mt, nt);
            EpiResidS e{p.in[0] + (size_t)mt * 256 * D + nt * 256, x1 + (size_t)mt * 256 * LDB + nt * 256, LDB};
            gemm256_tile(mix + (size_t)mt * 256 * LDB, LDB, Wt_out + (size_t)nt * 256 * LDB, LDB, D, lds, e);
        }
        VLOOP(t, 8 * 32) { const int mt = t & 7, nt = t >> 3;
            EpiResidS e{p.in[1] + (size_t)mt * 64 * D + nt * 64, x1 + (size_t)(TP + mt * 64) * LDB + nt * 64, LDB};
            gemm_tile<32>(mix + (size_t)(TP + mt * 64) * LDB, LDB, Wt_out + (size_t)nt * 64 * LDB, LDB, D, vlds, e);
        }
    }
    GRID_BAR();
    if (IN_PH(6)) { PH_LOCALS
    for (int r = bid * 8 + wid; r < TT; r += G * 8) rmsnorm_row_from_bf16<false>(x1 + (size_t)r * LDB, p.in[18], hbuf + (size_t)r * LDB, lane);
    }
    GRID_BAR();
    if (IN_PH(7)) { PH_LOCALS
        VLOOP(t, 8 * 32) { const int mt = t & 7, nt = t >> 3;
            EpiBfS e{qx + (size_t)(TP + mt * 64) * LDB + nt * 64, LDB};
            gemm_tile<32>(hbuf + (size_t)(TP + mt * 64) * LDB, LDB, Wt_cq + (size_t)nt * 64 * LDB, LDB, D, vlds, e);
        }
    }
    GRID_BAR();
    if (IN_PH(7)) { PH_LOCALS
        const int ng = G >> 1;
        if (bid < ng) {
            for (int t = bid; t < 32 * 8; t += ng) { int nt, mt; tile_map(t, 32, 8, mt, nt);
                EpiBfS e{qx + (size_t)mt * 256 * LDB + nt * 256, LDB};
                gemm256_tile(hbuf + (size_t)mt * 256 * LDB, LDB, Wt_cq + (size_t)nt * 256 * LDB, LDB, D, lds, e);
            }
        } else {
            const int ob = bid - ng, no = G - ng;
            for (int t0 = 2 * ob; t0 < 512; t0 += 2 * no) attn_sample_item(p, min(t0 + vb, 511), vlds);
        }
    }
    GRID_BAR();
    if (IN_PH(8)) { PH_LOCALS
        const int NS1 = 16 * 16 * 2;
        VLOOP(t, NS1) { const int bhd = t >> 5, v = t & 31, mt = v >> 1, nt = v & 1, b = bhd >> 2, hd = bhd & 3;
            EpiF32s e{sc + (size_t)(b * SEQ + mt * 128) * 1024 + hd * 256 + nt * 128, 1024, 0.04419417382415922f};
            gemm_tile<64>(qx + (size_t)(b * SEQ + mt * 128) * LDB + hd * 512, LDB, mkb + (size_t)(b * 256 + nt * 128) * LDB + hd * 512, LDB, 512, vlds, e);
        }
    }
    GRID_BAR();
    if (IN_PH(9)) { PH_LOCALS
    for (int r = bid * 8 + wid; r < TP * 4; r += G * 8) {
        const f32x4 v = __builtin_nontemporal_load((const f32x4*)(sc + (size_t)r * 256 + lane * 4));
        const float mx = wave_max(fmaxf(fmaxf(v[0], v[1]), fmaxf(v[2], v[3])));
        f32x4 e; e[0] = __expf(v[0] - mx); e[1] = __expf(v[1] - mx); e[2] = __expf(v[2] - mx); e[3] = __expf(v[3] - mx);
        const float inv = 1.f / wave_sum(e[0] + e[1] + e[2] + e[3]);
        store_bf4(pb + (size_t)(r >> 2) * LDP + (r & 3) * 256 + lane * 4, e * inv);
    }
    }
    GRID_BAR();
    if (IN_PH(10)) { PH_LOCALS
        VLOOP(t, 16 * 16 * 4) { const int bhd = t >> 6, v = t & 63, mt = v >> 2, nt = v & 3, b = bhd >> 2, hd = bhd & 3;
            EpiBfS e{ctx + (size_t)(b * SEQ + mt * 128) * LDB + hd * 512 + nt * 128, LDB};
            gemm_tile<64>(pb + (size_t)(b * SEQ + mt * 128) * LDP + hd * 256, LDP, mvt + ((size_t)b * D + hd * 512 + nt * 128) * LDM, LDM, 256, vlds, e);
        }
    }
    GRID_BAR();
    if (IN_PH(11)) { PH_LOCALS
        for (int t = bid; t < 32 * 8; t += G) { int nt, mt; tile_map(t, 32, 8, mt, nt);
            EpiResidBS e{x1 + (size_t)mt * 256 * LDB + nt * 256, x2 + (size_t)mt * 256 * LDB + nt * 256, LDB};
            gemm256_tile(ctx + (size_t)mt * 256 * LDB, LDB, Wt_co + (size_t)nt * 256 * LDB, LDB, D, lds, e);
        }
        VLOOP(t, 8 * 32) { const int mt = t & 7, nt = t >> 3;
            EpiResidBS e{x1 + (size_t)(TP + mt * 64) * LDB + nt * 64, x2 + (size_t)(TP + mt * 64) * LDB + nt * 64, LDB};
            gemm_tile<32>(ctx + (size_t)(TP + mt * 64) * LDB, LDB, Wt_co + (size_t)nt * 64 * LDB, LDB, D, vlds, e);
        }
    }
    GRID_BAR();
    if (IN_PH(12)) { PH_LOCALS
    for (int r = bid * 8 + wid; r < TT; r += G * 8) rmsnorm_row_from_bf16<true>(x2 + (size_t)r * LDB, p.in[23], p.out + (r < TP ? O_YP + (size_t)r * D : O_YS + (size_t)(r - TP) * D), lane);
    }
}

extern "C" void kernel_launch(void* const* d_in, const int* in_sizes, int n_in, void* d_out, int out_size, void* d_ws, size_t ws_size, hipStream_t stream) {
    static int grid = 0;
    if (grid == 0) {
        if (n_in != 24 || ws_size < WS_END) { fprintf(stderr, "kernel_launch: need 24 inputs and %zu bytes of workspace (got %d, %zu)\n", (size_t)WS_END, n_in, ws_size); grid = -1; return; }
        int dev = 0, cus = 0, per_cu = 0;
        hipGetDevice(&dev);
        hipDeviceGetAttribute(&cus, hipDeviceAttributeMultiprocessorCount, dev);
        if (hipOccupancyMaxActiveBlocksPerMultiprocessor(&per_cu, (const void*)hymba_fwd, 512, 0) != hipSuccess || per_cu < 1) { fprintf(stderr, "kernel_launch: occupancy query failed\n"); grid = -1; return; }
        if (per_cu > 1) per_cu = 1;
        grid = cus * per_cu;
        fprintf(stderr, "kernel_launch: grid %d (%d per CU)\n", grid, per_cu);
    }
    if (grid < 0) return;
    hipMemsetAsync((char*)d_ws + WS_BAR, 0, 16384, stream);
    Params p{};
    for (int i = 0; i < 24; ++i) p.in[i] = (const float*)d_in[i];
    p.out = (float*)d_out; p.ws = (unsigned char*)d_ws;
    if (NLAUNCH == 1) {
        p.ph_lo = 0; p.ph_hi = 13;
        void* args[] = {&p};
        hipError_t e = hipLaunchCooperativeKernel((const void*)hymba_fwd, dim3(grid), dim3(512), args, 0, stream);
        if (e != hipSuccess) fprintf(stderr, "kernel_launch: cooperative launch failed: %s (grid %d)\n", hipGetErrorString(e), grid);
    } else {
        for (int k = 0; k < 13; ++k) { p.ph_lo = k; p.ph_hi = k + 1; hipLaunchKernelGGL(hymba_fwd, dim3(grid), dim3(512), 0, stream, p); }
    }
}
```

```cpp
#include <hip/hip_runtime.h>
#include <hip/hip_cooperative_groups.h>
#include <cstdio>
#include <cstdint>

typedef unsigned short bf16_t;
typedef short bf16x8 __attribute__((ext_vector_type(8)));
typedef float f32x4 __attribute__((ext_vector_type(4)));
typedef unsigned u32x4 __attribute__((ext_vector_type(4)));
#define DEV __device__ __forceinline__
#define LAS __attribute__((address_space(3)))

constexpr int D = 2048, TP = 8192, TS = 512, TT = 8704, SEQ = 2048, NB = 4, SB = 128;
constexpr int NPJ = 6144;
constexpr int C_ZA = 3072, C_U = 4096, C_ZB = 5120;
constexpr int NWIN = 6272;
constexpr float EPS = 1e-6f;
constexpr int LDB = 2112, LDP = 1088, LDM = 288;

constexpr size_t O_YP = 0, O_YS = 16777216, O_MK = 17825792, O_MV = 19922944, O_DP = 22020096, O_CP = 22544384,
                 O_PP = 22581248, O_DS = 22642688, O_CS = 39419904, O_PS = 40599552;

constexpr size_t al256(size_t x) { return (x + 255) & ~(size_t)255; }
constexpr size_t WS_BAR = 0;
constexpr size_t WS_WIN = 16384;
constexpr size_t WS_WOUT = WS_WIN + (size_t)NWIN * LDB * 2;
constexpr size_t WS_WCQ = WS_WOUT + (size_t)D * LDB * 2;
constexpr size_t WS_WCO = WS_WCQ + (size_t)D * LDB * 2;
constexpr size_t WS_WCKV = WS_WCO + (size_t)D * LDB * 2;
constexpr size_t WS_WPOOL = WS_WCKV + (size_t)2 * D * LDB * 2;
constexpr size_t WS_H = WS_WPOOL + (size_t)1024 * LDM * 2;
constexpr size_t WS_HM = WS_H + (size_t)TT * LDB * 2;
constexpr size_t WS_PROJ = WS_HM + (size_t)1024 * LDB * 2;
constexpr size_t WS_AB = WS_PROJ + (size_t)TT * NPJ * 2;
constexpr size_t WS_MKB = WS_AB + (size_t)4 * TT * 16 * 4;
constexpr size_t WS_MVT = WS_MKB + (size_t)1024 * LDB * 2;
constexpr size_t WS_GW = WS_MVT + (size_t)4 * D * LDM * 2;
constexpr size_t WS_GQ = WS_GW + (size_t)1024 * 8192 * 2;
constexpr size_t WS_GKT = WS_GQ + (size_t)1024 * 8192 * 2;
constexpr size_t WS_GA = WS_GKT + (size_t)1024 * 8192 * 2;
constexpr size_t WS_GU = WS_GA + (size_t)1024 * 4096 * 2;
constexpr size_t WS_GE = WS_GU + (size_t)1024 * 8192 * 4;
constexpr size_t WS_O = WS_GE + 4096;
constexpr size_t WS_DPL = WS_O + (size_t)TP * 1024 * 4;
constexpr size_t WS_MIX = WS_DPL + (size_t)TT * LDP * 2;
constexpr size_t WS_X1 = WS_MIX + (size_t)TT * LDB * 2;
constexpr size_t WS_QX = WS_X1 + (size_t)TT * D * 4;
constexpr size_t WS_SC = WS_QX + (size_t)TT * LDB * 2;
constexpr size_t WS_PB = WS_SC + (size_t)TP * 1024 * 4;
constexpr size_t WS_CTX = WS_PB + (size_t)TP * LDP * 2;
constexpr size_t WS_X2 = WS_CTX + (size_t)TT * LDB * 2;
constexpr size_t WS_END = WS_X2 + (size_t)TT * D * 4;

#ifndef LASTP
#define LASTP 99
#endif
struct Params { const float* in[24]; float* out; unsigned char* ws; int ph_lo, ph_hi; };

typedef __bf16 bf16x2_t __attribute__((ext_vector_type(2)));
typedef float f32x2_t __attribute__((ext_vector_type(2)));
DEV unsigned cvt_pk_bf16(float lo, float hi) { const f32x2_t v = {lo, hi}; const bf16x2_t b = __builtin_convertvector(v, bf16x2_t); return __builtin_bit_cast(unsigned, b); }
DEV bf16_t f2bf(float f) { return (bf16_t)(cvt_pk_bf16(f, 0.f) & 0xffffu); }
DEV float bf2f(unsigned b) { return __uint_as_float(b << 16); }
DEV float bflo(unsigned u) { return __uint_as_float(u << 16); }
DEV float bfhi(unsigned u) { return __uint_as_float(u & 0xffff0000u); }
DEV float silu_f(float x) { return x / (1.f + __expf(-x)); }
DEV float wave_sum(float v) {
#pragma unroll
    for (int o = 32; o >= 1; o >>= 1) v += __shfl_xor(v, o);
    return v;
}
DEV float wave_max(float v) {
#pragma unroll
    for (int o = 32; o >= 1; o >>= 1) v = fmaxf(v, __shfl_xor(v, o));
    return v;
}
DEV void store_bf4(bf16_t* p, f32x4 v) { uint2 w; w.x = cvt_pk_bf16(v[0], v[1]); w.y = cvt_pk_bf16(v[2], v[3]); *(uint2*)p = w; }

#define XB_TMO      128
#define XB_XCNT(j)  (256  + 64 * (j))
#define XB_XSUB(j)  (1280 + 64 * (j))
#define XB_XGEN(j)  (2304 + 64 * (j))
#define XB_TOP      3328
#define XB_TOPGEN   3392
#define XCD_BAR_WORDS 3456
#define XB_SPIN_CAP (1u << 22)
DEV unsigned xb_ld(unsigned* p) { return __hip_atomic_load(p, __ATOMIC_RELAXED, __HIP_MEMORY_SCOPE_AGENT); }
DEV unsigned xb_add(unsigned* p, unsigned v) { return __hip_atomic_fetch_add(p, v, __ATOMIC_RELAXED, __HIP_MEMORY_SCOPE_AGENT); }
DEV unsigned xb_xcc_id() { return (unsigned)__builtin_amdgcn_s_getreg((3 << 11) | 20) & 0xFu; }
#define XB_SPIN(cond, bar) do { unsigned _sp = 0; while (cond) { __builtin_amdgcn_s_sleep(1); \
    if ((++_sp & 255u) == 0u) { if (xb_ld(&(bar)[XB_TMO])) break; if (_sp > XB_SPIN_CAP) { atomicAdd(&(bar)[XB_TMO], 1u); break; } } } } while (0)
struct XcdBarrier { unsigned* bar; unsigned x; volatile LAS unsigned* st; };
DEV XcdBarrier xcd_barrier_post(unsigned* bar, volatile LAS unsigned* st) {
    XcdBarrier b; b.bar = bar; b.x = xb_xcc_id(); b.st = st;
    if (threadIdx.x == 0) (void)xb_add(&bar[XB_XCNT(b.x)], 1u);
    return b;
}
DEV void xcd_barrier_complete(unsigned* bar, unsigned x, unsigned& nloc, unsigned& nx) {
    const unsigned G = gridDim.x;
    unsigned sum, cnt, mine, sp = 0u;
    for (;;) {
        sum = 0u; cnt = 0u; mine = 0u;
#pragma unroll
        for (unsigned j = 0; j < 16; ++j) { const unsigned c = xb_ld(&bar[XB_XCNT(j)]); sum += c; cnt += (c > 0u) ? 1u : 0u; mine = (j == x) ? c : mine; }
        if (sum == G) break;
        __builtin_amdgcn_s_sleep(1);
        if ((++sp & 255u) == 0u) { if (xb_ld(&bar[XB_TMO])) break; if (sp > XB_SPIN_CAP) { atomicAdd(&bar[XB_TMO], 1u); break; } }
    }
    nloc = mine > 0u ? mine : 1u; nx = cnt > 0u ? cnt : 1u;
}
DEV void xcd_barrier(const XcdBarrier& b) {
    asm volatile("s_waitcnt vmcnt(0)" ::: "memory");
    __syncthreads();
    if (threadIdx.x == 0) {
        unsigned* bar = b.bar;
        __builtin_amdgcn_s_waitcnt(0);
        unsigned nloc = b.st[0], nx = b.st[1];
        if (nloc == 0u) { xcd_barrier_complete(bar, b.x, nloc, nx); b.st[0] = nloc; b.st[1] = nx; }
        const unsigned old = xb_add(&bar[XB_XSUB(b.x)], 1u);
        const unsigned gen = old / nloc;
        if (old + 1u == (gen + 1u) * nloc) {
            __builtin_amdgcn_fence(__ATOMIC_RELEASE, "agent");
            asm volatile("s_waitcnt vmcnt(0)" ::: "memory");
            const unsigned og = xb_add(&bar[XB_TOP], 1u);
            const unsigned tg = og / nx;
            if (og + 1u == (tg + 1u) * nx) xb_add(&bar[XB_TOPGEN], 1u);
            else XB_SPIN(xb_ld(&bar[XB_TOPGEN]) == tg, bar);
            __builtin_amdgcn_fence(__ATOMIC_ACQUIRE, "agent");
            xb_add(&bar[XB_XGEN(b.x)], 1u);
            asm volatile("s_waitcnt vmcnt(0)" ::: "memory");
        } else {
            XB_SPIN(xb_ld(&bar[XB_XGEN(b.x)]) == gen, bar);
            __builtin_amdgcn_fence(__ATOMIC_ACQUIRE, "agent");
            asm volatile("s_waitcnt vmcnt(0)" ::: "memory");
        }
    }
    __syncthreads();
}

DEV void glds16(const void* gptr, unsigned lds_addr_lane) {
    const unsigned m = __builtin_amdgcn_readfirstlane(lds_addr_lane);
    unsigned keep;
    asm volatile("s_mov_b32 %0, m0\n\ts_mov_b32 m0, %2\n\ts_nop 0\n\tglobal_load_lds_dwordx4 %1, off\n\ts_mov_b32 m0, %0" : "=&s"(keep) : "v"(gptr), "s"(m) : "memory");
}

template <int WT, class Epi>
DEV void gemm_tile(const bf16_t* __restrict__ A, int lda, const bf16_t* __restrict__ Bt, int ldb, int K, unsigned char* lds, const Epi& epi) {
    constexpr int FI = WT / 16;
    constexpr int OPB = 2 * WT * 128;
    constexpr int STB = 2 * OPB;
    int tid = threadIdx.x & 255; asm volatile("" : "+v"(tid)); const int lane = tid & 63, wid = tid >> 6;
    const int wr = wid >> 1, wc = wid & 1, fr = lane & 15, fq = lane >> 4;
    f32x4 acc[FI][FI];
#pragma unroll
    for (int i = 0; i < FI; ++i)
#pragma unroll
        for (int j = 0; j < FI; ++j) acc[i][j] = (f32x4){0.f, 0.f, 0.f, 0.f};
    const int lrow = tid >> 3, lcs = (tid & 7) ^ (lrow & 7);
    const bf16_t* ap = A + (size_t)lrow * lda + lcs * 8;
    const bf16_t* bp = Bt + (size_t)lrow * ldb + lcs * 8;
    const unsigned l3a = (unsigned)(size_t)(LAS unsigned char*)lds;
    const int nk = K >> 6;
#define GLDS_STAGE(st, kt_) do { \
        _Pragma("unroll") for (int i_ = 0; i_ < FI; ++i_) { \
            glds16(ap + (size_t)(32 * i_) * lda + (kt_) * 64, l3a + (st) + tid * 16 + i_ * 4096); \
            glds16(bp + (size_t)(32 * i_) * ldb + (kt_) * 64, l3a + (st) + OPB + tid * 16 + i_ * 4096); } } while (0)
    constexpr int NSTG = 65536 / STB;
#pragma unroll
    for (int s_ = 0; s_ < NSTG - 1; ++s_) if (s_ < nk) GLDS_STAGE(s_ * STB, s_);
    const int aoff = (wr * WT + fr) * 128, boff = OPB + (wc * WT + fr) * 128, sw = fr & 7;
    int cur = 0, nxt = (NSTG - 1) * STB;
    for (int kt = 0; kt < nk; ++kt) {
        if (NSTG == 4 && kt + 2 < nk) { if (FI == 2) asm volatile("s_waitcnt vmcnt(8)" ::: "memory"); else asm volatile("s_waitcnt vmcnt(0)" ::: "memory"); }
        else asm volatile("s_waitcnt vmcnt(0)" ::: "memory");
        __syncthreads();
        if (kt + NSTG - 1 < nk) GLDS_STAGE(nxt, kt + NSTG - 1);
#pragma unroll
        for (int kh = 0; kh < 2; ++kh) {
            bf16x8 af[FI], bfr[FI];
            const int ch = ((kh * 4 + fq) ^ sw) << 4;
#pragma unroll
            for (int i = 0; i < FI; ++i) { af[i] = *(const bf16x8*)(lds + cur + aoff + i * 2048 + ch); bfr[i] = *(const bf16x8*)(lds + cur + boff + i * 2048 + ch); }
#pragma unroll
            for (int mi = 0; mi < FI; ++mi)
#pragma unroll
                for (int ni = 0; ni < FI; ++ni) acc[mi][ni] = __builtin_amdgcn_mfma_f32_16x16x32_bf16(bfr[ni], af[mi], acc[mi][ni], 0, 0, 0);
        }
        nxt = cur; cur += STB; if (cur == NSTG * STB) cur = 0;
    }
#undef GLDS_STAGE
    __syncthreads();
    if constexpr (Epi::STAGE) {
        constexpr int RB = 4 * WT, CPR = RB / 16;
#pragma unroll
        for (int mi = 0; mi < FI; ++mi)
#pragma unroll
            for (int ni = 0; ni < FI; ++ni) {
                const int row = wr * WT + mi * 16 + fr, col = wc * WT + ni * 16 + fq * 4;
                const f32x4 v = epi.xform(row, col, acc[mi][ni]);
                uint2 w; w.x = cvt_pk_bf16(v[0], v[1]); w.y = cvt_pk_bf16(v[2], v[3]);
                *(uint2*)(lds + row * RB + ((((col >> 3) ^ (row & (CPR - 1))) << 4) | (((col >> 2) & 1) << 3))) = w;
            }
        __syncthreads();
#pragma unroll
        for (int i = 0; i < (2 * WT * CPR) / 256; ++i) {
            const int idx = tid + 256 * i, row = idx / CPR, cp = idx % CPR, c = cp ^ (row & (CPR - 1));
            const uint4 d = *(const uint4*)(lds + row * RB + (cp << 4));
            *(uint4*)(epi.obase + (size_t)row * epi.old + c * 8) = epi.finish(row, c * 8, d);
        }
        __syncthreads();
    } else {
#pragma unroll
        for (int mi = 0; mi < FI; ++mi)
#pragma unroll
            for (int ni = 0; ni < FI; ++ni) epi(wr * WT + mi * 16 + fr, wc * WT + ni * 16 + fq * 4, acc[mi][ni]);
    }
}

template <class Epi>
DEV void gemm256_tile(const bf16_t* __restrict__ A, int lda, const bf16_t* __restrict__ Bt, int ldb, int K, unsigned char* lds, const Epi& epi) {
    int tid = threadIdx.x; asm volatile("" : "+v"(tid)); const int lane = tid & 63, wid = tid >> 6;
    const int wr = wid >> 2, wc = wid & 3, fr = lane & 15, fq = lane >> 4;
    f32x4 acc[8][4];
#pragma unroll
    for (int i = 0; i < 8; ++i)
#pragma unroll
        for (int j = 0; j < 4; ++j) acc[i][j] = (f32x4){0.f, 0.f, 0.f, 0.f};
    const int lrow = tid >> 3, lcs = (tid & 7) ^ (lrow & 7);
    const bf16_t* ap = A + (size_t)lrow * lda + lcs * 8;
    const bf16_t* bp = Bt + (size_t)lrow * ldb + lcs * 8;
    const unsigned l3a = (unsigned)(size_t)(LAS unsigned char*)lds;
    const int nk = K >> 6;
#define GLDS_STAGE(st, kt_) do { \
        _Pragma("unroll") for (int i_ = 0; i_ < 4; ++i_) { \
            glds16(ap + (size_t)(64 * i_) * lda + (kt_) * 64, l3a + (st) + tid * 16 + i_ * 8192); \
            glds16(bp + (size_t)(64 * i_) * ldb + (kt_) * 64, l3a + (st) + 32768 + tid * 16 + i_ * 8192); } } while (0)
    GLDS_STAGE(0, 0);
    const int aoff = (wr * 128 + fr) * 128, boff = 32768 + (wc * 64 + fr) * 128, sw = fr & 7;
    for (int kt = 0; kt < nk; ++kt) {
        const int cur = (kt & 1) * 65536;
        asm volatile("s_waitcnt vmcnt(0)" ::: "memory");
        __syncthreads();
        if (kt + 1 < nk) GLDS_STAGE(cur ^ 65536, kt + 1);
#pragma unroll
        for (int kh = 0; kh < 2; ++kh) {
            bf16x8 bfr[4];
            const int ch = ((kh * 4 + fq) ^ sw) << 4;
#pragma unroll
            for (int i = 0; i < 4; ++i) bfr[i] = *(const bf16x8*)(lds + cur + boff + i * 2048 + ch);
#pragma unroll
            for (int mh = 0; mh < 2; ++mh) {
                bf16x8 af[4];
#pragma unroll
                for (int i = 0; i < 4; ++i) af[i] = *(const bf16x8*)(lds + cur + aoff + (mh * 4 + i) * 2048 + ch);
#pragma unroll
                for (int mi = 0; mi < 4; ++mi)
#pragma unroll
                    for (int ni = 0; ni < 4; ++ni) acc[mh * 4 + mi][ni] = __builtin_amdgcn_mfma_f32_16x16x32_bf16(bfr[ni], af[mi], acc[mh * 4 + mi][ni], 0, 0, 0);
            }
        }
    }
#undef GLDS_STAGE
    __syncthreads();
    if constexpr (Epi::STAGE) {
#pragma unroll
        for (int mi = 0; mi < 8; ++mi)
#pragma unroll
            for (int ni = 0; ni < 4; ++ni) {
                const int row = wr * 128 + mi * 16 + fr, col = wc * 64 + ni * 16 + fq * 4;
                const f32x4 v = epi.xform(row, col, acc[mi][ni]);
                uint2 w; w.x = cvt_pk_bf16(v[0], v[1]); w.y = cvt_pk_bf16(v[2], v[3]);
                *(uint2*)(lds + row * 512 + ((((col >> 3) ^ (row & 31)) << 4) | (((col >> 2) & 1) << 3))) = w;
            }
        __syncthreads();
#pragma unroll 4
        for (int i = 0; i < 16; ++i) {
            const int idx = tid + 512 * i, row = idx >> 5, cp = idx & 31, c = cp ^ (row & 31);
            const uint4 d = *(const uint4*)(lds + row * 512 + (cp << 4));
            *(uint4*)(epi.obase + (size_t)row * epi.old + c * 8) = epi.finish(row, c * 8, d);
        }
        __syncthreads();
    } else {
#pragma unroll
        for (int mi = 0; mi < 8; ++mi)
#pragma unroll
            for (int ni = 0; ni < 4; ++ni) epi(wr * 128 + mi * 16 + fr, wc * 64 + ni * 16 + fq * 4, acc[mi][ni]);
    }
}

DEV void ab_rows16(const bf16_t* __restrict__ h, const bf16_t* __restrict__ wab, float* __restrict__ ab4, int rt, int kq, int lane) {
    const int fr = lane & 15, fq = lane >> 4;
    const bf16_t* ap = h + (size_t)(rt * 16 + fr) * LDB + kq * 512 + fq * 8;
    const bf16_t* bp = wab + (size_t)fr * LDB + kq * 512 + fq * 8;
    bf16x8 a[16], b[16];
#pragma unroll
    for (int s = 0; s < 16; ++s) { a[s] = *(const bf16x8*)(ap + s * 32); b[s] = *(const bf16x8*)(bp + s * 32); }
    f32x4 acc = {0.f, 0.f, 0.f, 0.f};
#pragma unroll
    for (int s = 0; s < 16; ++s) acc = __builtin_amdgcn_mfma_f32_16x16x32_bf16(b[s], a[s], acc, 0, 0, 0);
    *(f32x4*)(ab4 + (size_t)kq * TT * 16 + (size_t)(rt * 16 + fr) * 16 + fq * 4) = acc;
}

DEV void tile_map(int L, int nM, int nN, int& pm, int& pn) {
    const int T = nM * nN, q = T >> 3, r = T & 7, xcd = L & 7, off = L >> 3;
    const int w = (xcd < r ? xcd * (q + 1) : r * (q + 1) + (xcd - r) * q) + off;
    const int nig = 8 * nN, gid = w / nig, fm = gid * 8, gsz = (nM - fm) < 8 ? (nM - fm) : 8;
    pm = fm + (w % nig) % gsz; pn = (w % nig) / gsz;
}

struct EpiProj {
    static constexpr bool STAGE = false;
    int m0, n0; bf16_t* proj; float* ab; float* out;
    DEV void operator()(int r, int c, f32x4 v) const {
        const int row = m0 + r, col = n0 + c;
        if (col < NPJ) {
            store_bf4(proj + (size_t)row * NPJ + col, v);
            const bool isconv = col < 3072, ispool = (col >= C_U && col < C_ZB);
            if (isconv || ispool) {
                if (row < TP) {
                    const int b = row >> 11, t = row & 2047;
                    if (isconv) { if (t >= 2045) *(f32x4*)(out + O_CP + ((size_t)(b * 3 + (t - 2045))) * 3072 + col) = v; }
                    else { if (t >= 2033) *(f32x4*)(out + O_PP + ((size_t)(b * 15 + (t - 2033))) * 1024 + (col - C_U)) = v; }
                } else {
                    const int sb = (row - TP) >> 2, t = (row - TP) & 3;
                    if (isconv) { if (t >= 1) *(f32x4*)(out + O_CS + ((size_t)(sb * 3 + (t - 1))) * 3072 + col) = v; }
                    else *(f32x4*)(out + O_PS + ((size_t)(sb * 15 + 11 + t)) * 1024 + (col - C_U)) = v;
                }
            }
        } else if (col < NPJ + 16) {
            *(f32x4*)(ab + (size_t)row * 16 + (col - NPJ)) = v;
        }
    }
};
struct EpiMKV {
    static constexpr bool STAGE = false;
    int m0, n0; bf16_t* mkb; bf16_t* mvt; float* out;
    DEV void operator()(int r, int c, f32x4 v) const {
        const int row = m0 + r, col = n0 + c;
        if (col < D) {
            __builtin_nontemporal_store(v, (f32x4*)(out + O_MK + (size_t)row * D + col));
            store_bf4(mkb + (size_t)row * LDB + col, v);
        } else {
            const int cc = col - D, b = row >> 8, m = row & 255;
            __builtin_nontemporal_store(v, (f32x4*)(out + O_MV + (size_t)row * D + cc));
            bf16_t* p = mvt + ((size_t)b * D + cc) * LDM + m;
            p[0] = f2bf(v[0]); p[LDM] = f2bf(v[1]); p[2 * LDM] = f2bf(v[2]); p[3 * LDM] = f2bf(v[3]);
        }
    }
};
struct EpiPool {
    static constexpr bool STAGE = false;
    int m0, n0; const bf16_t* proj; const float* scale; bf16_t* mix;
    DEV void operator()(int r, int c, f32x4 v) const {
        const int row = m0 + r, col = n0 + c;
        const uint2 z = *(const uint2*)(proj + (size_t)row * NPJ + C_ZB + col);
        const f32x4 s = *(const f32x4*)(scale + col);
        f32x4 o;
        o[0] = v[0] * s[0] * silu_f(bflo(z.x)); o[1] = v[1] * s[1] * silu_f(bfhi(z.x));
        o[2] = v[2] * s[2] * silu_f(bflo(z.y)); o[3] = v[3] * s[3] * silu_f(bfhi(z.y));
        store_bf4(mix + (size_t)row * LDB + 1024 + col, o);
    }
};
struct EpiResid {   static constexpr bool STAGE = false;
    const float* res; bf16_t* dst;
    DEV void operator()(int r, int c, f32x4 v) const {
        const f32x4 x = __builtin_nontemporal_load((const f32x4*)(res + (size_t)r * D + c));
        store_bf4(dst + (size_t)r * LDB + c, x + v);
    }
};
struct EpiResidB {  static constexpr bool STAGE = false;
    const bf16_t* res; bf16_t* dst;
    DEV void operator()(int r, int c, f32x4 v) const {
        const uint2 u = *(const uint2*)(res + (size_t)r * LDB + c);
        f32x4 x; x[0] = bflo(u.x); x[1] = bfhi(u.x); x[2] = bflo(u.y); x[3] = bfhi(u.y);
        store_bf4(dst + (size_t)r * LDB + c, x + v);
    }
};
struct EpiBf {
    static constexpr bool STAGE = false;
    bf16_t* dst; int ld;
    DEV void operator()(int r, int c, f32x4 v) const { store_bf4(dst + (size_t)r * ld + c, v); }
};
struct EpiF32s {
    static constexpr bool STAGE = false;
    float* dst; int ld; float s;
    DEV void operator()(int r, int c, f32x4 v) const { *(f32x4*)(dst + (size_t)r * ld + c) = v * s; }
};

struct EpiProjS {
    static constexpr bool STAGE = true;
    int m0, n0; bf16_t* obase; int old; float* out;
    DEV f32x4 xform(int r, int c, f32x4 v) const {
        const int row = m0 + r, col = n0 + c;
        const bool isconv = col < 3072, ispool = (col >= C_U && col < C_ZB);
        if (isconv || ispool) {
            const int b = row >> 11, t = row & 2047;
            if (isconv) { if (t >= 2045) *(f32x4*)(out + O_CP + ((size_t)(b * 3 + (t - 2045))) * 3072 + col) = v; }
            else { if (t >= 2033) *(f32x4*)(out + O_PP + ((size_t)(b * 15 + (t - 2033))) * 1024 + (col - C_U)) = v; }
        }
        return v;
    }
};
struct EpiBfS {
    static constexpr bool STAGE = true;
    bf16_t* obase; int old;
    DEV f32x4 xform(int, int, f32x4 v) const { return v; }
    DEV uint4 finish(int, int, uint4 d) const { return d; }
};
struct EpiPoolS {
    static constexpr bool STAGE = true;
    int m0, n0; const bf16_t* proj; const float* scale; bf16_t* obase; int old;
    DEV f32x4 xform(int r, int c, f32x4 v) const {
        const int row = m0 + r, col = n0 + c;
        const uint2 z = *(const uint2*)(proj + (size_t)row * NPJ + C_ZB + col);
        const f32x4 s = *(const f32x4*)(scale + col);
        f32x4 o;
        o[0] = v[0] * s[0] * silu_f(bflo(z.x)); o[1] = v[1] * s[1] * silu_f(bfhi(z.x));
        o[2] = v[2] * s[2] * silu_f(bflo(z.y)); o[3] = v[3] * s[3] * silu_f(bfhi(z.y));
        return o;
    }
    DEV uint4 finish(int, int, uint4 d) const { return d; }
};
DEV uint4 add8_bf16(uint4 d, const float* r8) {
    uint4 o; o.x = cvt_pk_bf16(bflo(d.x) + r8[0], bfhi(d.x) + r8[1]); o.y = cvt_pk_bf16(bflo(d.y) + r8[2], bfhi(d.y) + r8[3]);
    o.z = cvt_pk_bf16(bflo(d.z) + r8[4], bfhi(d.z) + r8[5]); o.w = cvt_pk_bf16(bflo(d.w) + r8[6], bfhi(d.w) + r8[7]); return o;
}
struct EpiResidS {
    static constexpr bool STAGE = true;
    const float* res; bf16_t* obase; int old;
    DEV f32x4 xform(int, int, f32x4 v) const { return v; }
    DEV uint4 finish(int r, int c, uint4 d) const {
        const f32x4 a = __builtin_nontemporal_load((const f32x4*)(res + (size_t)r * D + c)), b = __builtin_nontemporal_load((const f32x4*)(res + (size_t)r * D + c + 4));
        const float r8[8] = {a[0], a[1], a[2], a[3], b[0], b[1], b[2], b[3]};
        return add8_bf16(d, r8);
    }
};
struct EpiResidBS {
    static constexpr bool STAGE = true;
    const bf16_t* res; bf16_t* obase; int old;
    DEV f32x4 xform(int, int, f32x4 v) const { return v; }
    DEV uint4 finish(int r, int c, uint4 d) const {
        const uint4 u = *(const uint4*)(res + (size_t)r * LDB + c);
        const float r8[8] = {bflo(u.x), bfhi(u.x), bflo(u.y), bfhi(u.y), bflo(u.z), bfhi(u.z), bflo(u.w), bfhi(u.w)};
        return add8_bf16(d, r8);
    }
};
DEV int win_srccol(int n) { return n < 4096 ? n : (n < 6144 ? n + 16 : (n < 6160 ? 4096 + (n - 6144) : -1)); }
DEV void transpose_tile(const float* __restrict__ src, int ld, int srccol0, bool remap, int k0, bf16_t* __restrict__ dstrow0, int ldd, float* tile) {
    int tid = threadIdx.x & 255; asm volatile("" : "+v"(tid));
    const int tx = tid & 63, ty = tid >> 6;
    const int sc = remap ? win_srccol(srccol0 + tx) : (srccol0 + tx);
    float tv[32];
#pragma unroll
    for (int i = 0; i < 32; ++i) tv[i] = sc >= 0 ? __builtin_nontemporal_load(src + (size_t)(k0 + ty + 4 * i) * ld + sc) : 0.f;
#pragma unroll
    for (int i = 0; i < 32; ++i) tile[(ty + 4 * i) * 65 + tx] = tv[i];
    __syncthreads();
#pragma unroll
    for (int i = 0; i < 16; ++i) { const int r = ty + 4 * i; *(unsigned*)(dstrow0 + (size_t)r * ldd + k0 + 2 * tx) = cvt_pk_bf16(tile[(2 * tx) * 65 + r], tile[(2 * tx + 1) * 65 + r]); }
    __syncthreads();
}
DEV void rmsnorm_row_bf16(const float* __restrict__ x, const float* __restrict__ g, bf16_t* __restrict__ y, int lane) {
    f32x4 v[8]; float ss = 0.f;
#pragma unroll
    for (int i = 0; i < 8; ++i) { v[i] = __builtin_nontemporal_load((const f32x4*)x + i * 64 + lane); ss += v[i][0] * v[i][0] + v[i][1] * v[i][1] + v[i][2] * v[i][2] + v[i][3] * v[i][3]; }
    ss = wave_sum(ss);
    const float rs = rsqrtf(ss * (1.f / 2048.f) + EPS);
#pragma unroll
    for (int i = 0; i < 8; ++i) { const f32x4 gg = ((const f32x4*)g)[i * 64 + lane]; store_bf4(y + (size_t)(i * 64 + lane) * 4, v[i] * rs * gg); }
}
template <bool OUT_F32>
DEV void rmsnorm_row_from_bf16(const bf16_t* __restrict__ x, const float* __restrict__ g, void* __restrict__ y, int lane) {
    float v[4][8]; float ss = 0.f;
#pragma unroll
    for (int i = 0; i < 4; ++i) { uint4 u; if (OUT_F32) { const u32x4 t_ = __builtin_nontemporal_load((const u32x4*)x + i * 64 + lane); u = make_uint4(t_[0], t_[1], t_[2], t_[3]); } else u = ((const uint4*)x)[i * 64 + lane];
        v[i][0] = bflo(u.x); v[i][1] = bfhi(u.x); v[i][2] = bflo(u.y); v[i][3] = bfhi(u.y); v[i][4] = bflo(u.z); v[i][5] = bfhi(u.z); v[i][6] = bflo(u.w); v[i][7] = bfhi(u.w);
#pragma unroll
        for (int e = 0; e < 8; ++e) ss += v[i][e] * v[i][e]; }
    ss = wave_sum(ss);
    const float rs = rsqrtf(ss * (1.f / 2048.f) + EPS);
#pragma unroll
    for (int i = 0; i < 4; ++i) {
        const f32x4 g0 = ((const f32x4*)g)[(i * 64 + lane) * 2], g1 = ((const f32x4*)g)[(i * 64 + lane) * 2 + 1];
        const f32x4 o0 = (f32x4){v[i][0], v[i][1], v[i][2], v[i][3]} * rs * g0, o1 = (f32x4){v[i][4], v[i][5], v[i][6], v[i][7]} * rs * g1;
        if (OUT_F32) { __builtin_nontemporal_store(o0, (f32x4*)y + (i * 64 + lane) * 2); __builtin_nontemporal_store(o1, (f32x4*)y + (i * 64 + lane) * 2 + 1); }
        else { uint4 w; w.x = cvt_pk_bf16(o0[0], o0[1]); w.y = cvt_pk_bf16(o0[2], o0[3]); w.z = cvt_pk_bf16(o1[0], o1[1]); w.w = cvt_pk_bf16(o1[2], o1[3]); ((uint4*)y)[i * 64 + lane] = w; }
    }
}
DEV void rmsnorm_row_f32(const float* __restrict__ x, const float* __restrict__ g, float* __restrict__ y, int lane) {
    f32x4 v[8]; float ss = 0.f;
#pragma unroll
    for (int i = 0; i < 8; ++i) { v[i] = ((const f32x4*)x)[i * 64 + lane]; ss += v[i][0] * v[i][0] + v[i][1] * v[i][1] + v[i][2] * v[i][2] + v[i][3] * v[i][3]; }
    ss = wave_sum(ss);
    const float rs = rsqrtf(ss * (1.f / 2048.f) + EPS);
#pragma unroll
    for (int i = 0; i < 8; ++i) { const f32x4 gg = ((const f32x4*)g)[i * 64 + lane]; __builtin_nontemporal_store(v[i] * rs * gg, (f32x4*)y + i * 64 + lane); }
}

constexpr int QS = 136;
DEV void gdn_prep_chunk(const Params& p, int item, unsigned char* lds) {
    int tid = threadIdx.x & 255; asm volatile("" : "+v"(tid)); const int lane = tid & 63, wid = tid >> 6;
    const int c = item & 31, h = (item >> 5) & 7, b = item >> 8;
    const int row0 = b * SEQ + c * 64;
    const bf16_t* proj = (const bf16_t*)(p.ws + WS_PROJ);
    const float* ab = (const float*)(p.ws + WS_AB);
    bf16_t* qs = (bf16_t*)lds; bf16_t* ks = qs + 64 * QS; bf16_t* vs = ks + 64 * QS;
    float* lowT = (float*)lds;
    float* gcs = (float*)(lds + 3 * 64 * QS * 2);
    float* bts = gcs + 64;
    bf16_t* gW = (bf16_t*)(p.ws + WS_GW) + (size_t)item * 8192;
    bf16_t* gQ = (bf16_t*)(p.ws + WS_GQ) + (size_t)item * 8192;
    bf16_t* gKT = (bf16_t*)(p.ws + WS_GKT) + (size_t)item * 8192;
    bf16_t* gA = (bf16_t*)(p.ws + WS_GA) + (size_t)item * 4096;
    float* gU = (float*)(p.ws + WS_GU) + (size_t)item * 8192;
    float* gE = (float*)(p.ws + WS_GE) + item;

    if (wid == 3) {
        float a = 0.f, bb = 0.f;
#pragma unroll
        for (int kq = 0; kq < 4; ++kq) { a += ab[(size_t)kq * TT * 16 + (size_t)(row0 + lane) * 16 + h]; bb += ab[(size_t)kq * TT * 16 + (size_t)(row0 + lane) * 16 + 8 + h]; }
        const float xx = a + p.in[12][h];
        const float sp = xx > 20.f ? xx : log1pf(__expf(xx));
        float s = -__expf(p.in[11][h]) * sp;
#pragma unroll
        for (int d = 1; d < 64; d <<= 1) { const float t = __shfl_up(s, d); if (lane >= d) s += t; }
        gcs[lane] = s; bts[lane] = 1.f / (1.f + __expf(-bb));
    } else {
        const int mat = wid, rg = lane >> 4, cv = lane & 15;
        const int colg = mat * 1024 + h * 128 + cv * 8;
        const float* cw = p.in[10];
        float w[4][8];
#pragma unroll
        for (int j = 0; j < 4; ++j) { const f32x4 w0 = *(const f32x4*)(cw + j * 3072 + colg), w1 = *(const f32x4*)(cw + j * 3072 + colg + 4);
            w[j][0] = w0[0]; w[j][1] = w0[1]; w[j][2] = w0[2]; w[j][3] = w0[3]; w[j][4] = w1[0]; w[j][5] = w1[1]; w[j][6] = w1[2]; w[j][7] = w1[3]; }
        const int tl0 = rg * 16;
        uint4 raw[19];
#pragma unroll
        for (int i = 0; i < 19; ++i) {
            const int tl = tl0 - 3 + i;
            if (c * 64 + tl >= 0) raw[i] = *(const uint4*)(proj + (size_t)(row0 + tl) * NPJ + colg);
            else raw[i] = make_uint4(0u, 0u, 0u, 0u);
        }
        bf16_t* dst = (mat == 0 ? qs : (mat == 1 ? ks : vs));
#pragma unroll
        for (int r = 0; r < 16; ++r) {
            float y[8]; float ss = 0.f;
#pragma unroll
            for (int e = 0; e < 8; ++e) {
                float a = 0.f;
#pragma unroll
                for (int j = 0; j < 4; ++j) {
                    const uint4 u = raw[r + j];
                    const unsigned wd = (e < 2 ? u.x : (e < 4 ? u.y : (e < 6 ? u.z : u.w)));
                    const float xv = (e & 1) ? bfhi(wd) : bflo(wd);
                    a += w[j][e] * xv;
                }
                y[e] = silu_f(a); ss += y[e] * y[e];
            }
            if (mat < 2) {
                ss += __shfl_xor(ss, 1); ss += __shfl_xor(ss, 2); ss += __shfl_xor(ss, 4); ss += __shfl_xor(ss, 8);
                float inv = rsqrtf(ss + EPS); if (mat == 0) inv *= 0.08838834764831845f;
#pragma unroll
                for (int e = 0; e < 8; ++e) y[e] *= inv;
            }
            uint4 o; o.x = cvt_pk_bf16(y[0], y[1]); o.y = cvt_pk_bf16(y[2], y[3]); o.z = cvt_pk_bf16(y[4], y[5]); o.w = cvt_pk_bf16(y[6], y[7]);
            *(uint4*)(dst + (tl0 + r) * QS + cv * 8) = o;
        }
    }
    __syncthreads();
    {
        const float glast = gcs[63];
        if (tid == 0) *gE = __expf(glast);
#pragma unroll
        for (int i = 0; i < 4; ++i) {
            const int ci = tid + 256 * i, t = ci >> 4, cc = (ci & 15) * 8;
            const uint4 u = *(const uint4*)(qs + t * QS + cc);
            const float e = __expf(gcs[t]);
            uint4 o; o.x = cvt_pk_bf16(bflo(u.x) * e, bfhi(u.x) * e); o.y = cvt_pk_bf16(bflo(u.y) * e, bfhi(u.y) * e);
            o.z = cvt_pk_bf16(bflo(u.z) * e, bfhi(u.z) * e); o.w = cvt_pk_bf16(bflo(u.w) * e, bfhi(u.w) * e);
            *(uint4*)(gQ + (cc >> 5) * 2048 + t * 32 + (cc & 31)) = o;
        }
        const float dk = __expf(glast - gcs[lane]);
#pragma unroll 8
        for (int i = 0; i < 32; ++i) { const int d = wid * 32 + i; gKT[(lane >> 5) * 4096 + d * 32 + (lane & 31)] = f2bf(bf2f(ks[lane * QS + d]) * dk);     }
    }
    f32x4 kk[4], qk[4];
    {
        const int fr = lane & 15, fq = lane >> 4, it = wid;
        bf16x8 kfi[4], qfi[4];
#pragma unroll
        for (int s = 0; s < 4; ++s) { kfi[s] = *(const bf16x8*)(ks + (it * 16 + fr) * QS + s * 32 + fq * 8); qfi[s] = *(const bf16x8*)(qs + (it * 16 + fr) * QS + s * 32 + fq * 8); }
#pragma unroll
        for (int jt = 0; jt < 4; ++jt) {
            kk[jt] = (f32x4){0.f, 0.f, 0.f, 0.f}; qk[jt] = (f32x4){0.f, 0.f, 0.f, 0.f};
#pragma unroll
            for (int s = 0; s < 4; ++s) {
                const bf16x8 kfj = *(const bf16x8*)(ks + (jt * 16 + fr) * QS + s * 32 + fq * 8);
                kk[jt] = __builtin_amdgcn_mfma_f32_16x16x32_bf16(kfi[s], kfj, kk[jt], 0, 0, 0);
                qk[jt] = __builtin_amdgcn_mfma_f32_16x16x32_bf16(kfj, qfi[s], qk[jt], 0, 0, 0);
            }
        }
    }
    __syncthreads();
    {
        const int fr = lane & 15, fq = lane >> 4, it = wid;
#pragma unroll
        for (int jt = 0; jt < 4; ++jt) {
            const int j = jt * 16 + fr; const float gj = gcs[j];
            f32x4 lv;
#pragma unroll
            for (int e = 0; e < 4; ++e) { const int i = it * 16 + fq * 4 + e; lv[e] = (i > j) ? bts[i] * kk[jt][e] * __expf(gcs[i] - gj) : 0.f; }
            *(f32x4*)(lowT + j * 68 + it * 16 + fq * 4) = lv;
            const int i2 = it * 16 + fr; const float gi = gcs[i2];
            f32x4 av;
#pragma unroll
            for (int e = 0; e < 4; ++e) { const int j2 = jt * 16 + fq * 4 + e; av[e] = (i2 >= j2) ? qk[jt][e] * __expf(gi - gcs[j2]) : 0.f; }
            store_bf4(gA + (jt >> 1) * 2048 + i2 * 32 + (jt & 1) * 16 + fq * 4, av);
        }
    }
    __syncthreads();
    {
        const int cc = tid & 127; const bool isw = tid >= 128;
        bf16_t* src = isw ? ks : vs;
#pragma unroll 1
        for (int ib = 0; ib < 4; ++ib) {
            f32x2_t acc[8];
#pragma unroll
            for (int r = 0; r < 16; ++r) { const int j = ib * 16 + r; float f = bts[j]; if (isw) f *= __expf(gcs[j]); acc[r >> 1][r & 1] = f * bf2f(src[j * QS + cc]); }
            const float* lrow = lowT + ib * 16;
#pragma unroll 4
            for (int j = 0; j < ib * 16; ++j) {
                const float xj = -bf2f(src[j * QS + cc]); const f32x2_t nx = {xj, xj};
                const f32x4 l0 = *(const f32x4*)(lrow + j * 68), l1 = *(const f32x4*)(lrow + j * 68 + 4), l2 = *(const f32x4*)(lrow + j * 68 + 8), l3 = *(const f32x4*)(lrow + j * 68 + 12);
                acc[0] += (f32x2_t){l0[0], l0[1]} * nx; acc[1] += (f32x2_t){l0[2], l0[3]} * nx; acc[2] += (f32x2_t){l1[0], l1[1]} * nx; acc[3] += (f32x2_t){l1[2], l1[3]} * nx;
                acc[4] += (f32x2_t){l2[0], l2[1]} * nx; acc[5] += (f32x2_t){l2[2], l2[3]} * nx; acc[6] += (f32x2_t){l3[0], l3[1]} * nx; acc[7] += (f32x2_t){l3[2], l3[3]} * nx;
            }
#pragma unroll
            for (int r2 = 0; r2 < 15; ++r2) {
                asm volatile("" ::: "memory");
                const float xj = -acc[r2 >> 1][r2 & 1]; const f32x2_t nx = {xj, xj};
                const float* lp = lrow + (ib * 16 + r2) * 68;
#pragma unroll
                for (int q = (r2 + 1) >> 2; q < 4; ++q) {
                    const f32x4 l = *(const f32x4*)(lp + q * 4);
                    acc[2 * q] += (f32x2_t){l[0], l[1]} * nx; acc[2 * q + 1] += (f32x2_t){l[2], l[3]} * nx;
                }
            }
#pragma unroll
            for (int r = 0; r < 16; ++r) {
                const int j = ib * 16 + r; const float xv = acc[r >> 1][r & 1]; const bf16_t xb = f2bf(xv);
                src[j * QS + cc] = xb;
                if (isw) gW[(cc >> 5) * 2048 + j * 32 + (cc & 31)] = xb;
                else gU[(((((cc >> 4) * 4 + (j >> 4)) * 4 + (j & 3)) * 4 + ((j >> 2) & 3)) << 4) + (cc & 15)] = xv;
            }
        }
    }
    __syncthreads();
}

#define LDS_BARRIER() do { asm volatile("s_waitcnt lgkmcnt(0)" ::: "memory"); __builtin_amdgcn_s_barrier(); asm volatile("" ::: "memory"); } while (0)
struct ScanEarly { bf16x8 w[4], q[4]; f32x4 u; };
struct ScanLate { bf16x8 a[2], k0[2], k1[2]; };
DEV void gdn_scan_item(const Params& p, int item, unsigned char* lds) {
    int tid = threadIdx.x & 255; asm volatile("" : "+v"(tid)); const int lane = tid & 63, w = tid >> 6, fr = lane & 15, fq = lane >> 4;
    const int s = item & 7, bh = item >> 3;
    const int b = bh >> 3, h = bh & 7;
    bf16_t* ST = (bf16_t*)lds;
    bf16_t* VT = ST + 16 * QS;
    const char* bW = (const char*)((const bf16_t*)(p.ws + WS_GW) + (size_t)bh * 32 * 8192);
    const char* bQ = (const char*)((const bf16_t*)(p.ws + WS_GQ) + (size_t)bh * 32 * 8192);
    const char* bK = (const char*)((const bf16_t*)(p.ws + WS_GKT) + (size_t)bh * 32 * 8192);
    const char* bA = (const char*)((const bf16_t*)(p.ws + WS_GA) + (size_t)bh * 32 * 4096);
    const char* bU = (const char*)((const float*)(p.ws + WS_GU) + (size_t)bh * 32 * 8192);
    const float* gE = (const float*)(p.ws + WS_GE) + bh * 32;
    float* obuf = (float*)(p.ws + WS_O);
    f32x4 S0 = {0.f, 0.f, 0.f, 0.f}, S1 = {0.f, 0.f, 0.f, 0.f};
    for (int i = tid; i < 16 * QS / 2; i += 256) ((unsigned*)ST)[i] = 0u;
    const float egv = gE[lane & 31];
    const unsigned offWQ = (unsigned)(((w * 16 + fr) * 32 + fq * 8) * 2), offA = offWQ;
    const unsigned offK = (unsigned)(((w * 32 + fr) * 32 + fq * 8) * 2), offU = (unsigned)((((s * 4 + w) * 16 + fq) * 16 + fr) * 4);
    ScanEarly E0, E1, E2; ScanLate L0, L1;
#define LOAD_E(F, ch) do { \
        const char* W_ = bW + (size_t)(ch) * 16384; const char* Q_ = bQ + (size_t)(ch) * 16384; \
        _Pragma("unroll") for (int k_ = 0; k_ < 4; ++k_) { F.w[k_] = *(const bf16x8*)(W_ + (offWQ + k_ * 4096)); F.q[k_] = *(const bf16x8*)(Q_ + (offWQ + k_ * 4096)); } \
        const char* U_ = bU + (size_t)(ch) * 32768; F.u[0] = *(const float*)(U_ + offU); F.u[1] = *(const float*)(U_ + (offU + 256)); F.u[2] = *(const float*)(U_ + (offU + 512)); F.u[3] = *(const float*)(U_ + (offU + 768)); \
        } while (0)
#define LOAD_L(F, ch) do { \
        const char* A_ = bA + (size_t)(ch) * 8192; F.a[0] = *(const bf16x8*)(A_ + offA); F.a[1] = *(const bf16x8*)(A_ + (offA + 4096)); \
        const char* K_ = bK + (size_t)(ch) * 16384; F.k0[0] = *(const bf16x8*)(K_ + offK); F.k0[1] = *(const bf16x8*)(K_ + (offK + 8192)); \
        F.k1[0] = *(const bf16x8*)(K_ + (offK + 1024)); F.k1[1] = *(const bf16x8*)(K_ + (offK + 1024 + 8192)); \
        } while (0)
#define SCAN_STEP(X, XL, Y, YL, ch) do { \
        if ((ch) + 2 < 32) LOAD_E(XL, (ch) + 2); \
        if ((ch) + 1 < 32) LOAD_L(YL, (ch) + 1); \
        const float ceg = __builtin_bit_cast(float, __builtin_amdgcn_readlane(__builtin_bit_cast(int, egv), (ch))); \
        f32x4 ws_ = {0.f, 0.f, 0.f, 0.f}, oo = {0.f, 0.f, 0.f, 0.f}; \
        _Pragma("unroll") for (int k = 0; k < 4; ++k) { \
            const bf16x8 sf = *(const bf16x8*)(ST + fr * QS + k * 32 + fq * 8); \
            ws_ = __builtin_amdgcn_mfma_f32_16x16x32_bf16(X.w[k], sf, ws_, 0, 0, 0); \
            oo = __builtin_amdgcn_mfma_f32_16x16x32_bf16(X.q[k], sf, oo, 0, 0, 0); } \
        store_bf4(VT + fr * 72 + w * 16 + fq * 4, X.u - ws_); \
        LDS_BARRIER(); \
        const bf16x8 v0 = *(const bf16x8*)(VT + fr * 72 + fq * 8), v1 = *(const bf16x8*)(VT + fr * 72 + 32 + fq * 8); \
        oo = __builtin_amdgcn_mfma_f32_16x16x32_bf16(Y.a[0], v0, oo, 0, 0, 0); \
        oo = __builtin_amdgcn_mfma_f32_16x16x32_bf16(Y.a[1], v1, oo, 0, 0, 0); \
        S0 = S0 * ceg; S1 = S1 * ceg; \
        S0 = __builtin_amdgcn_mfma_f32_16x16x32_bf16(Y.k0[0], v0, S0, 0, 0, 0); \
        S0 = __builtin_amdgcn_mfma_f32_16x16x32_bf16(Y.k0[1], v1, S0, 0, 0, 0); \
        S1 = __builtin_amdgcn_mfma_f32_16x16x32_bf16(Y.k1[0], v0, S1, 0, 0, 0); \
        S1 = __builtin_amdgcn_mfma_f32_16x16x32_bf16(Y.k1[1], v1, S1, 0, 0, 0); \
        store_bf4(ST + fr * QS + w * 32 + fq * 4, S0); \
        store_bf4(ST + fr * QS + w * 32 + 16 + fq * 4, S1); \
        { float* op = obuf + (size_t)(b * SEQ + (ch) * 64 + w * 16 + fq * 4) * 1024 + h * 128 + s * 16 + fr; \
          op[0] = oo[0]; op[1024] = oo[1]; op[2048] = oo[2]; op[3072] = oo[3]; } \
        LDS_BARRIER(); } while (0)
    LOAD_E(E0, 0); LOAD_L(L0, 0); LOAD_E(E1, 1);
    __syncthreads();
    for (int ch = 0; ch < 30; ch += 6) {
        SCAN_STEP(E0, E2, L0, L1, ch);     SCAN_STEP(E1, E0, L1, L0, ch + 1); SCAN_STEP(E2, E1, L0, L1, ch + 2);
        SCAN_STEP(E0, E2, L1, L0, ch + 3); SCAN_STEP(E1, E0, L0, L1, ch + 4); SCAN_STEP(E2, E1, L1, L0, ch + 5);
    }
    SCAN_STEP(E0, E2, L0, L1, 30); SCAN_STEP(E1, E0, L1, L0, 31);
#undef SCAN_STEP
#undef LOAD_E
#undef LOAD_L
    {
        float* dp = p.out + O_DP + ((size_t)bh * 128 + w * 32 + fq * 4) * 128 + s * 16 + fr;
#pragma unroll
        for (int e = 0; e < 4; ++e) { dp[e * 128] = S0[e]; dp[(16 + e) * 128] = S1[e]; }
    }
    __syncthreads();
}

DEV void gdn_sample_item(const Params& p, int item, unsigned char* lds) {
    int tid = threadIdx.x & 255; asm volatile("" : "+v"(tid)); const int lane = tid & 63, wid = tid >> 6;
    const int sb = item >> 3, h = item & 7, half = tid >> 7, c = tid & 127;
    const int r0 = TP + sb * 4;
    const bf16_t* proj = (const bf16_t*)(p.ws + WS_PROJ);
    const float* ab = (const float*)(p.ws + WS_AB);
    float* ksh = (float*)lds;
    float* qsh = ksh + 512;
    float* red = qsh + 512;
    float* red2 = red + 32;
    float* part = red2 + 32;
    float* opart = part + 1024;
    float qv[4], kv[4], vv[4];
#pragma unroll
    for (int m = 0; m < 3; ++m) {
        const int col = m * 1024 + h * 128 + c;
        float x[7], wj[4];
#pragma unroll
        for (int j = 0; j < 3; ++j) x[j] = p.in[6][((size_t)sb * 3 + j) * 3072 + col];
#pragma unroll
        for (int t = 0; t < 4; ++t) x[3 + t] = bf2f(proj[(size_t)(r0 + t) * NPJ + col]);
#pragma unroll
        for (int j = 0; j < 4; ++j) wj[j] = p.in[10][j * 3072 + col];
#pragma unroll
        for (int t = 0; t < 4; ++t) {
            const float y = silu_f(wj[0] * x[t] + wj[1] * x[t + 1] + wj[2] * x[t + 2] + wj[3] * x[t + 3]);
            if (m == 0) qv[t] = y; else if (m == 1) kv[t] = y; else vv[t] = y;
        }
    }
#pragma unroll
    for (int t = 0; t < 4; ++t) {
        const float a = wave_sum(qv[t] * qv[t]), bq = wave_sum(kv[t] * kv[t]);
        if (lane == 0) { red[wid * 8 + t] = a; red[wid * 8 + 4 + t] = bq; }
    }
    __syncthreads();
    float gt[4], bt[4];
#pragma unroll
    for (int t = 0; t < 4; ++t) {
        const float sq = red[(2 * half) * 8 + t] + red[(2 * half + 1) * 8 + t], sk = red[(2 * half) * 8 + 4 + t] + red[(2 * half + 1) * 8 + 4 + t];
        if (half == 0) {
            qsh[t * 128 + c] = qv[t] * rsqrtf(sq + EPS) * 0.08838834764831845f;
            ksh[t * 128 + c] = kv[t] * rsqrtf(sk + EPS);
        }
        float a = 0.f, bb = 0.f;
#pragma unroll
        for (int kq = 0; kq < 4; ++kq) { a += ab[(size_t)kq * TT * 16 + (size_t)(r0 + t) * 16 + h]; bb += ab[(size_t)kq * TT * 16 + (size_t)(r0 + t) * 16 + 8 + h]; }
        const float xx = a + p.in[12][h];
        const float sp = xx > 20.f ? xx : log1pf(__expf(xx));
        gt[t] = __expf(-__expf(p.in[11][h]) * sp);
        bt[t] = 1.f / (1.f + __expf(-bb));
    }
    f32x2_t S[32];
    const float* sp0 = p.in[5] + ((size_t)(sb * 8 + h) * 128 + half * 64) * 128 + c;
#pragma unroll
    for (int d = 0; d < 64; ++d) S[d >> 1][d & 1] = __builtin_nontemporal_load(sp0 + (size_t)d * 128);
    __syncthreads();
    float ot[4];
#pragma unroll
    for (int t = 0; t < 4; ++t) {
        const float* kk = ksh + t * 128 + half * 64; const float* qq = qsh + t * 128 + half * 64;
        f32x2_t ks2 = {0.f, 0.f};
#pragma unroll
        for (int d4 = 0; d4 < 16; ++d4) { const f32x4 k4 = *(const f32x4*)(kk + d4 * 4); ks2 += (f32x2_t){k4[0], k4[1]} * S[d4 * 2]; ks2 += (f32x2_t){k4[2], k4[3]} * S[d4 * 2 + 1]; }
        part[(t * 2 + half) * 128 + c] = ks2[0] + ks2[1];
        __syncthreads();
        const float kS = part[(t * 2) * 128 + c] + part[(t * 2 + 1) * 128 + c];
        const float eg = gt[t], dl = bt[t] * (vv[t] - eg * kS);
        const f32x2_t eg2 = {eg, eg}, dl2 = {dl, dl};
        f32x2_t o2 = {0.f, 0.f};
#pragma unroll
        for (int d4 = 0; d4 < 16; ++d4) {
            const f32x4 k4 = *(const f32x4*)(kk + d4 * 4), q4 = *(const f32x4*)(qq + d4 * 4);
            const f32x2_t s0 = S[d4 * 2] * eg2 + (f32x2_t){k4[0], k4[1]} * dl2, s1 = S[d4 * 2 + 1] * eg2 + (f32x2_t){k4[2], k4[3]} * dl2;
            S[d4 * 2] = s0; S[d4 * 2 + 1] = s1;
            o2 += (f32x2_t){q4[0], q4[1]} * s0; o2 += (f32x2_t){q4[2], q4[3]} * s1;
        }
        const float o = o2[0] + o2[1];
        ot[t] = o;
        if (half == 1) opart[t * 128 + c] = o;
    }
    float* dso = p.out + O_DS + ((size_t)(sb * 8 + h) * 128 + half * 64) * 128 + c;
#pragma unroll
    for (int d = 0; d < 64; ++d) __builtin_nontemporal_store(S[d >> 1][d & 1], dso + (size_t)d * 128);
    __syncthreads();
    if (half == 0) {
#pragma unroll
        for (int t = 0; t < 4; ++t) { ot[t] += opart[t * 128 + c]; const float a = wave_sum(ot[t] * ot[t]); if (lane == 0) red2[wid * 4 + t] = a; }
    }
    __syncthreads();
    if (half == 0) {
        bf16_t* mix = (bf16_t*)(p.ws + WS_MIX);
        const float gn = p.in[13][c];
#pragma unroll
        for (int t = 0; t < 4; ++t) {
            const float ms = (red2[t] + red2[4 + t]) * (1.f / 128.f);
            const float z = bf2f(proj[(size_t)(r0 + t) * NPJ + C_ZA + h * 128 + c]);
            mix[(size_t)(r0 + t) * LDB + h * 128 + c] = f2bf(ot[t] * rsqrtf(ms + EPS) * gn * silu_f(z));
        }
    }
    __syncthreads();
}

DEV void attn_sample_item(const Params& p, int item, unsigned char* lds) {
    int tid = threadIdx.x & 255; asm volatile("" : "+v"(tid)); const int lane = tid & 63, wid = tid >> 6;
    const int sb = item >> 2, hd = item & 3;
    float* qs = (float*)lds;
    float* pm = qs + 2048;
    float* red = pm + 1024;
    const bf16_t* qx = (const bf16_t*)(p.ws + WS_QX);
    for (int i = tid; i < 2048; i += 256) { const int t = i >> 9, d = i & 511; qs[i] = bf2f(qx[(size_t)(TP + sb * 4 + t) * LDB + hd * 512 + d]) * 0.04419417382415922f; }
    __syncthreads();
    const float* Kc = p.in[3] + ((size_t)sb * 256) * D + hd * 512;
    const float* Vc = p.in[4] + ((size_t)sb * 256) * D + hd * 512;
    {
        const int sub = lane >> 4, l16 = lane & 15;
        f32x4 kv[8];
        {
            const float* kr = Kc + (size_t)(wid * 64 + sub) * D;
#pragma unroll
            for (int i = 0; i < 8; ++i) kv[i] = __builtin_nontemporal_load((const f32x4*)(kr + (i * 16 + l16) * 4));
        }
        for (int it = 0; it < 16; ++it) {
            const int m = wid * 64 + it * 4 + sub;
            f32x4 cv[8];
#pragma unroll
            for (int i = 0; i < 8; ++i) cv[i] = kv[i];
            if (it + 1 < 16) {
                const float* kr = Kc + (size_t)(m + 4) * D;
#pragma unroll
                for (int i = 0; i < 8; ++i) kv[i] = __builtin_nontemporal_load((const f32x4*)(kr + (i * 16 + l16) * 4));
            }
            float a0 = 0.f, a1 = 0.f, a2 = 0.f, a3 = 0.f;
#pragma unroll
            for (int i = 0; i < 8; ++i) {
                const int d = (i * 16 + l16) * 4;
                const f32x4 q0 = *(const f32x4*)(qs + d), q1 = *(const f32x4*)(qs + 512 + d), q2 = *(const f32x4*)(qs + 1024 + d), q3 = *(const f32x4*)(qs + 1536 + d);
                a0 += cv[i][0] * q0[0] + cv[i][1] * q0[1] + cv[i][2] * q0[2] + cv[i][3] * q0[3];
                a1 += cv[i][0] * q1[0] + cv[i][1] * q1[1] + cv[i][2] * q1[2] + cv[i][3] * q1[3];
                a2 += cv[i][0] * q2[0] + cv[i][1] * q2[1] + cv[i][2] * q2[2] + cv[i][3] * q2[3];
                a3 += cv[i][0] * q3[0] + cv[i][1] * q3[1] + cv[i][2] * q3[2] + cv[i][3] * q3[3];
            }
#pragma unroll
            for (int o = 1; o < 16; o <<= 1) { a0 += __shfl_xor(a0, o); a1 += __shfl_xor(a1, o); a2 += __shfl_xor(a2, o); a3 += __shfl_xor(a3, o); }
            if (l16 == 0) *(f32x4*)(pm + m * 4) = (f32x4){a0, a1, a2, a3};
        }
    }
    __syncthreads();
    {
        const int t = wid;
        float v[4]; float mx = -3.0e38f;
#pragma unroll
        for (int i = 0; i < 4; ++i) { v[i] = pm[(i * 64 + lane) * 4 + t]; mx = fmaxf(mx, v[i]); }
        mx = wave_max(mx);
        float sm = 0.f;
#pragma unroll
        for (int i = 0; i < 4; ++i) { v[i] = __expf(v[i] - mx); sm += v[i]; }
        sm = wave_sum(sm);
        const float inv = 1.f / sm;
#pragma unroll
        for (int i = 0; i < 4; ++i) pm[(i * 64 + lane) * 4 + t] = v[i] * inv;
    }
    __syncthreads();
    {
        f32x4 acc[4][2];
#pragma unroll
        for (int t = 0; t < 4; ++t) { acc[t][0] = (f32x4){0.f, 0.f, 0.f, 0.f}; acc[t][1] = (f32x4){0.f, 0.f, 0.f, 0.f}; }
        f32x4 va[4], vb[4];
#pragma unroll
        for (int i = 0; i < 4; ++i) { const float* vr = Vc + (size_t)(wid * 64 + i) * D; va[i] = __builtin_nontemporal_load((const f32x4*)(vr + lane * 4)); vb[i] = __builtin_nontemporal_load((const f32x4*)(vr + 256 + lane * 4)); }
        for (int m4 = 0; m4 < 16; ++m4) {
            f32x4 ca[4], cb[4];
#pragma unroll
            for (int i = 0; i < 4; ++i) { ca[i] = va[i]; cb[i] = vb[i]; }
            if (m4 + 1 < 16) {
#pragma unroll
                for (int i = 0; i < 4; ++i) { const float* vr = Vc + (size_t)(wid * 64 + (m4 + 1) * 4 + i) * D; va[i] = __builtin_nontemporal_load((const f32x4*)(vr + lane * 4)); vb[i] = __builtin_nontemporal_load((const f32x4*)(vr + 256 + lane * 4)); }
            }
#pragma unroll
            for (int i = 0; i < 4; ++i) {
                const f32x4 pr = *(const f32x4*)(pm + (wid * 64 + m4 * 4 + i) * 4);
#pragma unroll
                for (int t = 0; t < 4; ++t) { acc[t][0] += ca[i] * pr[t]; acc[t][1] += cb[i] * pr[t]; }
            }
        }
#pragma unroll
        for (int t = 0; t < 4; ++t) { *(f32x4*)(red + (wid * 4 + t) * 512 + lane * 4) = acc[t][0]; *(f32x4*)(red + (wid * 4 + t) * 512 + 256 + lane * 4) = acc[t][1]; }
    }
    __syncthreads();
    {
        bf16_t* ctx = (bf16_t*)(p.ws + WS_CTX);
#pragma unroll
        for (int i = 0; i < 2; ++i) {
            const int e = (tid + 256 * i) * 4, t = e >> 9, d = e & 511;
            const f32x4 s = *(const f32x4*)(red + (0 * 4 + t) * 512 + d) + *(const f32x4*)(red + (1 * 4 + t) * 512 + d) + *(const f32x4*)(red + (2 * 4 + t) * 512 + d) + *(const f32x4*)(red + (3 * 4 + t) * 512 + d);
            store_bf4(ctx + (size_t)(TP + sb * 4 + t) * LDB + hd * 512 + d, s);
        }
    }
    __syncthreads();
}

template <int WIN>
DEV void pool_d_prompt8(const bf16_t* __restrict__ proj, bf16_t* __restrict__ dpl, int row0, int c8) {
    const int t0 = row0 & 2047;
    uint4 u[WIN + 7];
#pragma unroll
    for (int i = 0; i < WIN + 7; ++i) { const int tt = t0 - (WIN - 1) + i; u[i] = (tt >= 0) ? *(const uint4*)(proj + (size_t)(row0 - (WIN - 1) + i) * NPJ + C_U + c8) : make_uint4(0u, 0u, 0u, 0u); }
    float acc[8] = {0.f, 0.f, 0.f, 0.f, 0.f, 0.f, 0.f, 0.f};
#pragma unroll
    for (int i = 0; i < WIN - 1; ++i) { acc[0] += bflo(u[i].x); acc[1] += bfhi(u[i].x); acc[2] += bflo(u[i].y); acc[3] += bfhi(u[i].y); acc[4] += bflo(u[i].z); acc[5] += bfhi(u[i].z); acc[6] += bflo(u[i].w); acc[7] += bfhi(u[i].w); }
#pragma unroll
    for (int j = 0; j < 8; ++j) {
        const uint4 x = u[j + WIN - 1];
        const float xs[8] = {bflo(x.x), bfhi(x.x), bflo(x.y), bfhi(x.y), bflo(x.z), bfhi(x.z), bflo(x.w), bfhi(x.w)};
#pragma unroll
        for (int e_ = 0; e_ < 8; ++e_) acc[e_] += xs[e_];
        const float ic = 1.f / (float)min(WIN, t0 + j + 1);
        uint4 o;
        o.x = cvt_pk_bf16(acc[0] * ic - xs[0], acc[1] * ic - xs[1]); o.y = cvt_pk_bf16(acc[2] * ic - xs[2], acc[3] * ic - xs[3]);
        o.z = cvt_pk_bf16(acc[4] * ic - xs[4], acc[5] * ic - xs[5]); o.w = cvt_pk_bf16(acc[6] * ic - xs[6], acc[7] * ic - xs[7]);
        *(uint4*)(dpl + (size_t)(row0 + j) * LDP + c8) = o;
        const uint4 y = u[j];
        acc[0] -= bflo(y.x); acc[1] -= bfhi(y.x); acc[2] -= bflo(y.y); acc[3] -= bfhi(y.y); acc[4] -= bflo(y.z); acc[5] -= bfhi(y.z); acc[6] -= bflo(y.w); acc[7] -= bfhi(y.w);
    }
}

#ifndef REP0
#define REP0 1
#endif
#ifndef REP1
#define REP1 1
#endif
#ifndef REP2
#define REP2 1
#endif
#ifndef REP3
#define REP3 1
#endif
#ifndef REP4
#define REP4 1
#endif
#ifndef REP5
#define REP5 1
#endif
#ifndef REP6
#define REP6 1
#endif
#ifndef REP7
#define REP7 1
#endif
#ifndef REP8
#define REP8 1
#endif
#ifndef REP9
#define REP9 1
#endif
#ifndef REP10
#define REP10 1
#endif
#ifndef REP11
#define REP11 1
#endif
#ifndef REP12
#define REP12 1
#endif
#ifndef NLAUNCH
#define NLAUNCH 1
#endif
#define GRID_BAR() do { if (NLAUNCH == 1) xcd_barrier(bar); } while (0)
#define IN_PH(k) (p.ph_lo <= (k) && (k) < p.ph_hi)
__global__ void __launch_bounds__(512) hymba_fwd(Params p) {
    __shared__ __attribute__((aligned(16))) unsigned char lds[131072];
    __shared__ uint4 xb_words;
    const int G = gridDim.x, bid = blockIdx.x, VG = 2 * G;
    if (threadIdx.x == 0) xb_words = make_uint4(0u, 0u, 0u, 0u);
#define PH_LOCALS int tid = threadIdx.x; asm volatile("" : "+v"(tid)); const int lane = tid & 63, wid = tid >> 6; const int vb = __builtin_amdgcn_readfirstlane(tid >> 8); \
    unsigned char* vlds = lds + vb * 65536; (void)lane; (void)wid; (void)vlds;
    __syncthreads();
    XcdBarrier bar; bar.bar = (unsigned*)(p.ws + WS_BAR); bar.x = 0; bar.st = (volatile LAS unsigned*)&xb_words;
    if (NLAUNCH == 1) bar = xcd_barrier_post((unsigned*)(p.ws + WS_BAR), (volatile LAS unsigned*)&xb_words);
    unsigned char* ws = p.ws;
    bf16_t* Wt_in = (bf16_t*)(ws + WS_WIN); bf16_t* Wt_out = (bf16_t*)(ws + WS_WOUT); bf16_t* Wt_cq = (bf16_t*)(ws + WS_WCQ); bf16_t* Wt_co = (bf16_t*)(ws + WS_WCO);
    bf16_t* Wt_ckv = (bf16_t*)(ws + WS_WCKV); bf16_t* Wt_pool = (bf16_t*)(ws + WS_WPOOL);
    bf16_t* hbuf = (bf16_t*)(ws + WS_H); bf16_t* hm = (bf16_t*)(ws + WS_HM); bf16_t* proj = (bf16_t*)(ws + WS_PROJ); float* ab = (float*)(ws + WS_AB);
    bf16_t* mkb = (bf16_t*)(ws + WS_MKB); bf16_t* mvt = (bf16_t*)(ws + WS_MVT); bf16_t* dpl = (bf16_t*)(ws + WS_DPL); bf16_t* mix = (bf16_t*)(ws + WS_MIX);
    bf16_t* x1 = (bf16_t*)(ws + WS_X1); bf16_t* qx = (bf16_t*)(ws + WS_QX); float* sc = (float*)(ws + WS_SC); bf16_t* pb = (bf16_t*)(ws + WS_PB);
    bf16_t* ctx = (bf16_t*)(ws + WS_CTX); bf16_t* x2 = (bf16_t*)(ws + WS_X2); float* obuf = (float*)(ws + WS_O);
#define VLOOP(t, N) for (int t##0_ = 2 * bid, t = min(t##0_ + vb, (N) - 1); t##0_ < (N); t##0_ += VG, t = min(t##0_ + vb, (N) - 1))

    if (IN_PH(0)) { PH_LOCALS
        const int NT_IN = 98 * 16, NT_SQ = 32 * 16;
        const int total = NT_IN + 5 * NT_SQ + 32;
        VLOOP(t, total) {
            if (t < NT_IN) { const int nt = t >> 4, kt = t & 15; transpose_tile(p.in[9], 6160, nt * 64, true, kt * 128, Wt_in + (size_t)nt * 64 * LDB, LDB, (float*)vlds); }
            else if (t < NT_IN + 5 * NT_SQ) {
                const int u = t - NT_IN, j = u >> 9, v = u & 511, nt = v >> 4, kt = v & 15;
                const float* src = p.in[j == 0 ? 16 : (j == 1 ? 19 : (j == 2 ? 22 : (j == 3 ? 20 : 21)))];
                bf16_t* dst = j == 0 ? Wt_out : (j == 1 ? Wt_cq : (j == 2 ? Wt_co : (j == 3 ? Wt_ckv : Wt_ckv + (size_t)D * LDB)));
                transpose_tile(src, D, nt * 64, false, kt * 128, dst + (size_t)nt * 64 * LDB, LDB, (float*)vlds);
            } else {
                const int u = t - NT_IN - 5 * NT_SQ, g = u >> 3, v = u & 7, nt = v >> 1, kt = v & 1;
                transpose_tile(p.in[14] + (size_t)g * 65536, 256, nt * 64, false, kt * 128, Wt_pool + ((size_t)g * 256 + nt * 64) * LDM, LDM, (float*)vlds);
            }
        }
        for (int r = bid * 8 + wid; r < TT + 1024; r += G * 8) {
            if (r < TP) rmsnorm_row_bf16(p.in[0] + (size_t)r * D, p.in[8], hbuf + (size_t)r * LDB, lane);
            else if (r < TT) rmsnorm_row_bf16(p.in[1] + (size_t)(r - TP) * D, p.in[8], hbuf + (size_t)r * LDB, lane);
            else rmsnorm_row_bf16(p.in[2] + (size_t)(r - TT) * D, p.in[17], hm + (size_t)(r - TT) * LDB, lane);
        }
    }
    GRID_BAR();
    if (IN_PH(1)) { PH_LOCALS
        for (int t = bid; t < 32 * 24; t += G) { int nt, mt; tile_map(t, 32, 24, mt, nt);
            EpiBfS e{proj + (size_t)mt * 256 * NPJ + nt * 256, NPJ};
            gemm256_tile(hbuf + (size_t)mt * 256 * LDB, LDB, Wt_in + (size_t)nt * 256 * LDB, LDB, D, lds, e);
        }
        VLOOP(t, 4 * 48 + 256) {
            if (t < 192) { const int mt = t & 3, nt = t >> 2;
                EpiProj e{TP + mt * 128, nt * 128, proj, ab, p.out};
                gemm_tile<64>(hbuf + (size_t)(TP + mt * 128) * LDB, LDB, Wt_in + (size_t)nt * 128 * LDB, LDB, D, vlds, e);
            } else { const int u = t - 192, mt = u & 7, nt = u >> 3;
                EpiMKV e{mt * 128, nt * 128, mkb, mvt, p.out};
                gemm_tile<64>(hm + (size_t)mt * 128 * LDB, LDB, Wt_ckv + (size_t)nt * 128 * LDB, LDB, D, vlds, e);
            }
        }
        for (int tk = bid * 8 + wid; tk < (TT / 16) * 4; tk += G * 8) ab_rows16(hbuf, Wt_in + (size_t)NPJ * LDB, ab, tk >> 2, tk & 3, lane);
    }
    GRID_BAR();
    if (IN_PH(2)) { PH_LOCALS
        VLOOP(t, 1024) gdn_prep_chunk(p, t, vlds);
        for (int i = bid * 512 + tid; i < (TP / 8) * 128; i += G * 512) {
            const int row0 = (i >> 7) * 8, c8 = (i & 127) * 8, g = c8 >> 8;
            if (g == 0) pool_d_prompt8<2>(proj, dpl, row0, c8); else if (g == 1) pool_d_prompt8<4>(proj, dpl, row0, c8);
            else if (g == 2) pool_d_prompt8<8>(proj, dpl, row0, c8); else pool_d_prompt8<16>(proj, dpl, row0, c8);
        }
        for (int i = TP * 128 + bid * 512 + tid; i < TT * 128; i += G * 512) {
            const int row = i >> 7, c8 = (i & 127) * 8, g = c8 >> 8, win = 2 << g;
            float acc[8] = {0.f, 0.f, 0.f, 0.f, 0.f, 0.f, 0.f, 0.f}, self[8];
            const int tloc = (row - TP) & 3;
            for (int k = 0; k < win; ++k) {
                const int tt = tloc - k;
                if (tt >= 0) {
                    const uint4 u = *(const uint4*)(proj + (size_t)(row - k) * NPJ + C_U + c8);
                    const float f[8] = {bflo(u.x), bfhi(u.x), bflo(u.y), bfhi(u.y), bflo(u.z), bfhi(u.z), bflo(u.w), bfhi(u.w)};
#pragma unroll
                    for (int e = 0; e < 8; ++e) { acc[e] += f[e]; if (k == 0) self[e] = f[e]; }
                } else {
                    const float* sp = p.in[7] + ((size_t)((row - TP) >> 2) * 15 + (15 + tt)) * 1024 + c8;
                    const f32x4 s0 = *(const f32x4*)sp, s1 = *(const f32x4*)(sp + 4);
                    acc[0] += s0[0]; acc[1] += s0[1]; acc[2] += s0[2]; acc[3] += s0[3]; acc[4] += s1[0]; acc[5] += s1[1]; acc[6] += s1[2]; acc[7] += s1[3];
                }
            }
            const float ic = 1.f / (float)win;
            uint4 o; o.x = cvt_pk_bf16(acc[0] * ic - self[0], acc[1] * ic - self[1]); o.y = cvt_pk_bf16(acc[2] * ic - self[2], acc[3] * ic - self[3]);
            o.z = cvt_pk_bf16(acc[4] * ic - self[4], acc[5] * ic - self[5]); o.w = cvt_pk_bf16(acc[6] * ic - self[6], acc[7] * ic - self[7]);
            *(uint4*)(dpl + (size_t)row * LDP + c8) = o;
        }
        for (int i = bid * 512 + tid; i < NB * (3 * 3072 + 15 * 1024); i += G * 512) {
            const int b = i / (3 * 3072 + 15 * 1024), u = i - b * (3 * 3072 + 15 * 1024);
            if (u < 3 * 3072) { const int rr = u / 3072, col = u - rr * 3072; p.out[O_CP + ((size_t)(b * 3 + rr)) * 3072 + col] = bf2f(proj[(size_t)(b * SEQ + 2045 + rr) * NPJ + col]); }
            else { const int v = u - 3 * 3072, rr = v >> 10, col = v & 1023; p.out[O_PP + ((size_t)(b * 15 + rr)) * 1024 + col] = bf2f(proj[(size_t)(b * SEQ + 2033 + rr) * NPJ + C_U + col]); }
        }
        for (int i = bid * 512 + tid; i < SB * 11 * 256; i += G * 512) {
            const int c4 = (i & 255) * 4, rr = (i >> 8) % 11, sb = (i >> 8) / 11;
            *(f32x4*)(p.out + O_PS + ((size_t)sb * 15 + rr) * 1024 + c4) = *(const f32x4*)(p.in[7] + ((size_t)sb * 15 + rr + 4) * 1024 + c4);
        }
    }
    GRID_BAR();
    if (IN_PH(3)) { PH_LOCALS
        const int NSC = 256, NSM = 1024, NPL = 68 * 8;
        const int nsb = G >> 1;
        if (bid < nsb) {
            if (G == 256) {
                const int x = bid & 7, j = bid >> 3;
                gdn_scan_item(p, ((x * 4 + (j >> 2)) << 3) | ((j & 3) << 1) | vb, vlds);
            } else
            for (int t0 = 2 * bid; t0 < NSC; t0 += 2 * nsb) gdn_scan_item(p, min(t0 + vb, NSC - 1), vlds);
        } else {
            const int ob = bid - nsb, no = G - nsb;
            for (int t0 = 2 * ob; t0 < NSM; t0 += 2 * no) gdn_sample_item(p, min(t0 + vb, NSM - 1), vlds);
            for (int t0 = 2 * ob; t0 < NPL; t0 += 2 * no) { const int t = min(t0 + vb, NPL - 1); int nt, mt; tile_map(t, 68, 8, mt, nt); const int g = nt >> 1;
                EpiPoolS e{mt * 128, nt * 128, proj, p.in[15], mix + (size_t)mt * 128 * LDB + 1024 + nt * 128, LDB};
                gemm_tile<64>(dpl + (size_t)mt * 128 * LDP + g * 256, LDP, Wt_pool + (size_t)nt * 128 * LDM, LDM, 256, vlds, e);
            }
        }
    }
    GRID_BAR();
    if (IN_PH(4)) { PH_LOCALS
        for (int i = bid * 512 + tid; i < TP * 8 * 16; i += G * 512) {
            const int l16 = i & 15, rh = i >> 4, h = rh & 7, row = rh >> 3;
            const float* op = obuf + (size_t)row * 1024 + h * 128 + l16 * 8;
            const f32x4 a = __builtin_nontemporal_load((const f32x4*)op), b4 = __builtin_nontemporal_load((const f32x4*)(op + 4));
            float ss = a[0] * a[0] + a[1] * a[1] + a[2] * a[2] + a[3] * a[3] + b4[0] * b4[0] + b4[1] * b4[1] + b4[2] * b4[2] + b4[3] * b4[3];
            ss += __shfl_xor(ss, 1); ss += __shfl_xor(ss, 2); ss += __shfl_xor(ss, 4); ss += __shfl_xor(ss, 8);
            const float rs = rsqrtf(ss * (1.f / 128.f) + EPS);
            const f32x4 g0 = *(const f32x4*)(p.in[13] + l16 * 8), g1 = *(const f32x4*)(p.in[13] + l16 * 8 + 4);
            const uint4 z = *(const uint4*)(proj + (size_t)row * NPJ + C_ZA + h * 128 + l16 * 8);
            uint4 o;
            o.x = cvt_pk_bf16(a[0] * rs * g0[0] * silu_f(bflo(z.x)), a[1] * rs * g0[1] * silu_f(bfhi(z.x)));
            o.y = cvt_pk_bf16(a[2] * rs * g0[2] * silu_f(bflo(z.y)), a[3] * rs * g0[3] * silu_f(bfhi(z.y)));
            o.z = cvt_pk_bf16(b4[0] * rs * g1[0] * silu_f(bflo(z.z)), b4[1] * rs * g1[1] * silu_f(bfhi(z.z)));
            o.w = cvt_pk_bf16(b4[2] * rs * g1[2] * silu_f(bflo(z.w)), b4[3] * rs * g1[3] * silu_f(bfhi(z.w)));
            *(uint4*)(mix + (size_t)row * LDB + h * 128 + l16 * 8) = o;
        }
    }
    GRID_BAR();
    if (IN_PH(5)) { PH_LOCALS
        for (int t = bid; t < 32 * 8; t += G) { int nt, mt; tile_map(t, 32, 8, mt, nt);
            EpiResidS e{p.in[0] + (size_t)mt * 256 * D + nt * 256, x1 + (size_t)mt * 256 * LDB + nt * 256, LDB};
            gemm256_tile(mix + (size_t)mt * 256 * LDB, LDB, Wt_out + (size_t)nt * 256 * LDB, LDB, D, lds, e);
        }
        VLOOP(t, 8 * 32) { const int mt = t & 7, nt = t >> 3;
            EpiResidS e{p.in[1] + (size_t)mt * 64 * D + nt * 64, x1 + (size_t)(TP + mt * 64) * LDB + nt * 64, LDB};
            gemm_tile<32>(mix + (size_t)(TP + mt * 64) * LDB, LDB, Wt_out + (size_t)nt * 64 * LDB, LDB, D, vlds, e);
        }
    }
    GRID_BAR();
    if (IN_PH(6)) { PH_LOCALS
    for (int r = bid * 8 + wid; r < TT; r += G * 8) rmsnorm_row_from_bf16<false>(x1 + (size_t)r * LDB, p.in[18], hbuf + (size_t)r * LDB, lane);
    }
    GRID_BAR();
    if (IN_PH(7)) { PH_LOCALS
        VLOOP(t, 8 * 32) { const int mt = t & 7, nt = t >> 3;
            EpiBfS e{qx + (size_t)(TP + mt * 64) * LDB + nt * 64, LDB};
            gemm_tile<32>(hbuf + (size_t)(TP + mt * 64) * LDB, LDB, Wt_cq + (size_t)nt * 64 * LDB, LDB, D, vlds, e);
        }
    }
    GRID_BAR();
    if (IN_PH(7)) { PH_LOCALS
        const int ng = G >> 1;
        if (bid < ng) {
            for (int t = bid; t < 32 * 8; t += ng) { int nt, mt; tile_map(t, 32, 8, mt, nt);
                EpiBfS e{qx + (size_t)mt * 256 * LDB + nt * 256, LDB};
                gemm256_tile(hbuf + (size_t)mt * 256 * LDB, LDB, Wt_cq + (size_t)nt * 256 * LDB, LDB, D, lds, e);
            }
        } else {
            const int ob = bid - ng, no = G - ng;
            for (int t0 = 2 * ob; t0 < 512; t0 += 2 * no) attn_sample_item(p, min(t0 + vb, 511), vlds);
        }
    }
    GRID_BAR();
    if (IN_PH(8)) { PH_LOCALS
        const int NS1 = 16 * 16 * 2;
        VLOOP(t, NS1) { const int bhd = t >> 5, v = t & 31, mt = v >> 1, nt = v & 1, b = bhd >> 2, hd = bhd & 3;
            EpiF32s e{sc + (size_t)(b * SEQ + mt * 128) * 1024 + hd * 256 + nt * 128, 1024, 0.04419417382415922f};
            gemm_tile<64>(qx + (size_t)(b * SEQ + mt * 128) * LDB + hd * 512, LDB, mkb + (size_t)(b * 256 + nt * 128) * LDB + hd * 512, LDB, 512, vlds, e);
        }
    }
    GRID_BAR();
    if (IN_PH(9)) { PH_LOCALS
    for (int r = bid * 8 + wid; r < TP * 4; r += G * 8) {
        const f32x4 v = __builtin_nontemporal_load((const f32x4*)(sc + (size_t)r * 256 + lane * 4));
        const float mx = wave_max(fmaxf(fmaxf(v[0], v[1]), fmaxf(v[2], v[3])));
        f32x4 e; e[0] = __expf(v[0] - mx); e[1] = __expf(v[1] - mx); e[2] = __expf(v[2] - mx); e[3] = __expf(v[3] - mx);
        const float inv = 1.f / wave_sum(e[0] + e[1] + e[2] + e[3]);
        store_bf4(pb + (size_t)(r >> 2) * LDP + (r & 3) * 256 + lane * 4, e * inv);
    }
    }
    GRID_BAR();
    if (IN_PH(10)) { PH_LOCALS
        VLOOP(t, 16 * 16 * 4) { const int bhd = t >> 6, v = t & 63, mt = v >> 2, nt = v & 3, b = bhd >> 2, hd = bhd & 3;
            EpiBfS e{ctx + (size_t)(b * SEQ + mt * 128) * LDB + hd * 512 + nt * 128, LDB};
            gemm_tile<64>(pb + (size_t)(b * SEQ + mt * 128) * LDP + hd * 256, LDP, mvt + ((size_t)b * D + hd * 512 + nt * 128) * LDM, LDM, 256, vlds, e);
        }
    }
    GRID_BAR();
    if (IN_PH(11)) { PH_LOCALS
        for (int t = bid; t < 32 * 8; t += G) { int nt, mt; tile_map(t, 32, 8, mt, nt);
            EpiResidBS e{x1 + (size_t)mt * 256 * LDB + nt * 256, x2 + (size_t)mt * 256 * LDB + nt * 256, LDB};
            gemm256_tile(ctx + (size_t)mt * 256 * LDB, LDB, Wt_co + (size_t)nt * 256 * LDB, LDB, D, lds, e);
        }
        VLOOP(t, 8 * 32) { const int mt = t & 7, nt = t >> 3;
            EpiResidBS e{x1 + (size_t)(TP + mt * 64) * LDB + nt * 64, x2 + (size_t)(TP + mt * 64) * LDB + nt * 64, LDB};
            gemm_tile<32>(ctx + (size_t)(TP + mt * 64) * LDB, LDB, Wt_co + (size_t)nt * 64 * LDB, LDB, D, vlds, e);
        }
    }
    GRID_BAR();
    if (IN_PH(12)) { PH_LOCALS
    for (int r = bid * 8 + wid; r < TT; r += G * 8) rmsnorm_row_from_bf16<true>(x2 + (size_t)r * LDB, p.in[23], p.out + (r < TP ? O_YP + (size_t)r * D : O_YS + (size_t)(r - TP) * D), lane);
    }
}

extern "C" void kernel_launch(void* const* d_in, const int* in_sizes, int n_in, void* d_out, int out_size, void* d_ws, size_t ws_size, hipStream_t stream) {
    static int grid = 0;
    if (grid == 0) {
        if (n_in != 24 || ws_size < WS_END) { fprintf(stderr, "kernel_launch: need 24 inputs and %zu bytes of workspace (got %d, %zu)\n", (size_t)WS_END, n_in, ws_size); grid = -1; return; }
        int dev = 0, cus = 0, per_cu = 0;
        hipGetDevice(&dev);
        hipDeviceGetAttribute(&cus, hipDeviceAttributeMultiprocessorCount, dev);
        if (hipOccupancyMaxActiveBlocksPerMultiprocessor(&per_cu, (const void*)hymba_fwd, 512, 0) != hipSuccess || per_cu < 1) { fprintf(stderr, "kernel_launch: occupancy query failed\n"); grid = -1; return; }
        if (per_cu > 1) per_cu = 1;
        grid = cus * per_cu;
        fprintf(stderr, "kernel_launch: grid %d (%d per CU)\n", grid, per_cu);
    }
    if (grid < 0) return;
    hipMemsetAsync((char*)d_ws + WS_BAR, 0, 16384, stream);
    Params p{};
    for (int i = 0; i < 24; ++i) p.in[i] = (const float*)d_in[i];
    p.out = (float*)d_out; p.ws = (unsigned char*)d_ws;
    if (NLAUNCH == 1) {
        p.ph_lo = 0; p.ph_hi = 13;
        void* args[] = {&p};
        hipError_t e = hipLaunchCooperativeKernel((const void*)hymba_fwd, dim3(grid), dim3(512), args, 0, stream);
        if (e != hipSuccess) fprintf(stderr, "kernel_launch: cooperative launch failed: %s (grid %d)\n", hipGetErrorString(e), grid);
    } else {
        for (int k = 0; k < 13; ++k) { p.ph_lo = k; p.ph_hi = k + 1; hipLaunchKernelGGL(hymba_fwd, dim3(grid), dim3(512), 0, stream, p); }
    }
}
```
